# Optimizing an MI355X kernel written in HIP

```python
import math
import jax, jax.numpy as jnp
from jax import lax
import numpy as np

D_MODEL = 1024
BATCH = 8
SEQ = 4096
DEPTH = 4

CHUNK = 64
HEAD_DIM = 64
EPS = 1e-6
ROPE_THETA = 10000.0
A_HEADS = 4
A_LEFT_CHUNKS = 8
A_BAND = (A_LEFT_CHUNKS + 1) * CHUNK
REL_CLIP = 128
B_HEADS = 4
IDX_HEADS = 4
IDX_DIM = 64
TOPK_MAX = 256
Q_BLOCK = 128
C_WIDTH = 512
C_BLOCKS = 8
C_BLOCK_DIM = C_WIDTH // C_BLOCKS
C_CONV = 4
LRU_C = 8.0
N_BRANCH = 3
A_WIDTH = A_HEADS * HEAD_DIM
B_WIDTH = B_HEADS * HEAD_DIM
MIX_WIDTH = A_WIDTH + B_WIDTH + C_WIDTH
D_FF = -(-8 * D_MODEL // (3 * 256)) * 256
IN_SPLITS = (A_WIDTH, A_WIDTH, A_WIDTH,
             B_WIDTH, B_WIDTH, B_WIDTH,
             IDX_HEADS * IDX_DIM, IDX_DIM, IDX_HEADS,
             C_WIDTH, C_WIDTH,
             N_BRANCH * D_MODEL)
D_IN = sum(IN_SPLITS)

kernel_name = "hybrid_chunk_attn_dsa_rglru_gated"


def rms_norm(x, g):
    x32 = x.astype(jnp.float32)
    y = x32 * lax.rsqrt(jnp.mean(x32 * x32, axis=-1, keepdims=True) + EPS)
    return (y * g.astype(jnp.float32)).astype(x.dtype)


def rope_tables(seq):
    pos = jnp.arange(seq, dtype=jnp.float32)
    inv = 1.0 / (ROPE_THETA ** (jnp.arange(0, HEAD_DIM, 2, dtype=jnp.float32) / HEAD_DIM))
    ang = pos[:, None] * inv[None, :]
    ang = jnp.concatenate([ang, ang], axis=-1)
    return jnp.cos(ang), jnp.sin(ang)


def apply_rope(x, cos, sin):
    shape = (cos.shape[0],) + (1,) * (x.ndim - 3) + (cos.shape[1],)
    c, s = cos.reshape(shape), sin.reshape(shape)
    x32 = x.astype(jnp.float32)
    x1, x2 = jnp.split(x32, 2, axis=-1)
    rot = jnp.concatenate([-x2, x1], axis=-1)
    return (x32 * c + rot * s).astype(x.dtype)


def split_cols(z):
    offs, acc = [], 0
    for w in IN_SPLITS[:-1]:
        acc += w
        offs.append(acc)
    return jnp.split(z, offs, axis=-1)


def chunk_relpos_attention(q, k, v, rel_bias, rel_idx):
    b, s, h, d = q.shape
    n_c = s // CHUNK
    qc = q.reshape(b, n_c, CHUNK, h, d)
    pad = ((0, 0), (A_LEFT_CHUNKS, 0), (0, 0), (0, 0), (0, 0))
    kp = jnp.pad(k.reshape(b, n_c, CHUNK, h, d), pad)
    vp = jnp.pad(v.reshape(b, n_c, CHUNK, h, d), pad)
    kb = jnp.concatenate([kp[:, j:j + n_c] for j in range(A_LEFT_CHUNKS + 1)], axis=2)
    vb = jnp.concatenate([vp[:, j:j + n_c] for j in range(A_LEFT_CHUNKS + 1)], axis=2)
    sc = jnp.einsum('bcqhd,bckhd->bhcqk', qc, kb).astype(jnp.float32) * (d ** -0.5)
    bias = rel_bias.astype(jnp.float32)[:, rel_idx]
    sc = sc + bias[:, None]
    key_chunk = jnp.arange(n_c)[:, None] - A_LEFT_CHUNKS + jnp.arange(A_BAND)[None, :] // CHUNK
    valid = key_chunk >= 0
    sc = jnp.where(valid[None, None, :, None, :], sc, -jnp.inf)
    p = jax.nn.softmax(sc, axis=-1).astype(v.dtype)
    o = jnp.einsum('bhcqk,bckhd->bcqhd', p, vb)
    return o.reshape(b, s, h * d)


def indexer_sparse_attention(q, k, v, qi, ki, wi):
    b, s, h, d = q.shape
    topk = min(TOPK_MAX, s // 4)
    n_blk = s // Q_BLOCK
    key_chunk = jnp.arange(s) // CHUNK
    bidx = jnp.arange(b)[:, None, None]
    scale = d ** -0.5

    def to_blocks(t):
        return jnp.moveaxis(t.reshape((b, n_blk, Q_BLOCK) + t.shape[2:]), 1, 0)

    def block(args):
        blk, qb, qib, wib = args
        q_chunk = (blk * Q_BLOCK + jnp.arange(Q_BLOCK)) // CHUNK
        admissible = key_chunk[None, :] <= q_chunk[:, None]
        dots = jnp.einsum('bqhe,bse->bqhs', qib, ki).astype(jnp.float32)
        score = jnp.einsum('bqhs,bqh->bqs', jax.nn.relu(dots), wib.astype(jnp.float32))
        score = jnp.where(admissible[None], score, -jnp.inf)
        _, idx = lax.top_k(score, topk)
        sel_valid = (idx // CHUNK) <= q_chunk[None, :, None]
        ks = k[bidx, idx]
        vs = v[bidx, idx]
        att = jnp.einsum('bqhd,bqkhd->bhqk', qb, ks).astype(jnp.float32) * scale
        att = jnp.where(sel_valid[:, None], att, -jnp.inf)
        p = jax.nn.softmax(att, axis=-1).astype(v.dtype)
        return jnp.einsum('bhqk,bqkhd->bqhd', p, vs)

    out = lax.map(block, (jnp.arange(n_blk), to_blocks(q), to_blocks(qi), to_blocks(wi)))
    return jnp.moveaxis(out, 0, 1).reshape(b, s, h * d)


def rglru_branch(xc, yc, conv_w, conv_b, wa, ba, wx, bx, lam):
    b, s, c = xc.shape
    xp = jnp.pad(xc, ((0, 0), (C_CONV - 1, 0), (0, 0)))
    u = conv_b + sum(xp[:, j:j + s] * conv_w[j] for j in range(C_CONV))
    ub = u.reshape(b, s, C_BLOCKS, C_BLOCK_DIM)
    r = jax.nn.sigmoid(jnp.einsum('bsgi,gij->bsgj', ub, wa).reshape(b, s, c) + ba)
    i = jax.nn.sigmoid(jnp.einsum('bsgi,gij->bsgj', ub, wx).reshape(b, s, c) + bx)
    log_a = -LRU_C * r.astype(jnp.float32) * jax.nn.softplus(-lam.astype(jnp.float32))
    a = jnp.exp(log_a)
    gated_in = jnp.sqrt(-jnp.expm1(2.0 * log_a)) * (i * u).astype(jnp.float32)

    def combine(left, right):
        a1, b1 = left
        a2, b2 = right
        return a1 * a2, a2 * b1 + b2

    _, hs = lax.associative_scan(combine, (a, gated_in), axis=1)
    return hs.astype(xc.dtype) * jax.nn.gelu(yc)


def setup_inputs(seed: int = 0) -> dict:
    key = jax.random.key(seed)
    ks = jax.random.split(key, 20)
    f32 = jnp.float32
    nrm = lambda k, shp: jax.random.normal(k, shp, f32)
    x = nrm(ks[0], (BATCH, SEQ, D_MODEL))
    g_mix = 1.0 + 0.02 * nrm(ks[1], (DEPTH, D_MODEL))
    w_in = nrm(ks[2], (DEPTH, D_MODEL, D_IN)) * D_MODEL ** -0.5
    qk_gain_a = 1.0 + 0.02 * nrm(ks[3], (DEPTH, 2, HEAD_DIM))
    rel_bias = 0.1 * nrm(ks[4], (DEPTH, A_HEADS, 2 * REL_CLIP + 1))
    qk_gain_b = 1.0 + 0.02 * nrm(ks[5], (DEPTH, 2, HEAD_DIM))
    g_idx_k = 1.0 + 0.02 * nrm(ks[6], (DEPTH, IDX_DIM))
    conv_w = nrm(ks[7], (DEPTH, C_CONV, C_WIDTH)) * C_CONV ** -0.5
    conv_b = 0.01 * nrm(ks[8], (DEPTH, C_WIDTH))
    lru_wa = nrm(ks[9], (DEPTH, C_BLOCKS, C_BLOCK_DIM, C_BLOCK_DIM)) * C_BLOCK_DIM ** -0.5
    lru_ba = 0.01 * nrm(ks[10], (DEPTH, C_WIDTH))
    lru_wx = nrm(ks[11], (DEPTH, C_BLOCKS, C_BLOCK_DIM, C_BLOCK_DIM)) * C_BLOCK_DIM ** -0.5
    lru_bx = 0.01 * nrm(ks[12], (DEPTH, C_WIDTH))
    a_c = jax.random.uniform(ks[13], (DEPTH, C_WIDTH), f32, 0.9, 0.999)
    a0 = a_c ** (1.0 / LRU_C)
    lru_lambda = jnp.log(a0) - jnp.log1p(-a0)
    b_gate = 0.01 * nrm(ks[14], (DEPTH, N_BRANCH * D_MODEL))
    row_scale = jnp.concatenate([jnp.full((A_WIDTH,), A_WIDTH ** -0.5, f32),
                                 jnp.full((B_WIDTH,), B_WIDTH ** -0.5, f32),
                                 jnp.full((C_WIDTH,), C_WIDTH ** -0.5, f32)])
    w_branch = nrm(ks[15], (DEPTH, MIX_WIDTH, D_MODEL)) * row_scale[None, :, None]
    w_out = nrm(ks[16], (DEPTH, D_MODEL, D_MODEL)) * D_MODEL ** -0.5
    g_ffn = 1.0 + 0.02 * nrm(ks[17], (DEPTH, D_MODEL))
    w_ffn_in = nrm(ks[18], (DEPTH, D_MODEL, 2 * D_FF)) * D_MODEL ** -0.5
    w_ffn_out = nrm(ks[19], (DEPTH, D_FF, D_MODEL)) * D_FF ** -0.5
    return {"x": x, "g_mix": g_mix, "w_in": w_in, "qk_gain_a": qk_gain_a, "rel_bias": rel_bias,
            "qk_gain_b": qk_gain_b, "g_idx_k": g_idx_k, "conv_w": conv_w, "conv_b": conv_b,
            "lru_wa": lru_wa, "lru_ba": lru_ba, "lru_wx": lru_wx, "lru_bx": lru_bx,
            "lru_lambda": lru_lambda, "b_gate": b_gate, "w_branch": w_branch, "w_out": w_out,
            "g_ffn": g_ffn, "w_ffn_in": w_ffn_in, "w_ffn_out": w_ffn_out}


def reference(x, g_mix, w_in, qk_gain_a, rel_bias, qk_gain_b, g_idx_k, conv_w, conv_b,
              lru_wa, lru_ba, lru_wx, lru_bx, lru_lambda, b_gate, w_branch, w_out,
              g_ffn, w_ffn_in, w_ffn_out):
    b, s, _ = x.shape
    cos, sin = rope_tables(s)
    q_in_band = A_LEFT_CHUNKS * CHUNK + jnp.arange(CHUNK)
    rel_idx = jnp.clip(q_in_band[:, None] - jnp.arange(A_BAND)[None, :], -REL_CLIP, REL_CLIP) + REL_CLIP
    for l in range(DEPTH):
        h = rms_norm(x, g_mix[l])
        z = h @ w_in[l]
        aq, ak, av, bq, bk, bv, iq, ik, iw, cx, cy, gt = split_cols(z)
        hd = lambda t, n: t.reshape(b, s, n, HEAD_DIM)
        y_a = chunk_relpos_attention(rms_norm(hd(aq, A_HEADS), qk_gain_a[l, 0]),
                                     rms_norm(hd(ak, A_HEADS), qk_gain_a[l, 1]),
                                     hd(av, A_HEADS), rel_bias[l], rel_idx)
        q_b = apply_rope(rms_norm(hd(bq, B_HEADS), qk_gain_b[l, 0]), cos, sin)
        k_b = apply_rope(rms_norm(hd(bk, B_HEADS), qk_gain_b[l, 1]), cos, sin)
        q_i = apply_rope(iq.reshape(b, s, IDX_HEADS, IDX_DIM), cos, sin)
        k_i = apply_rope(rms_norm(ik, g_idx_k[l]), cos, sin)
        w_i = iw * (IDX_HEADS ** -0.5 * IDX_DIM ** -0.5)
        y_b = indexer_sparse_attention(q_b, k_b, hd(bv, B_HEADS), q_i, k_i, w_i)
        y_c = rglru_branch(cx, cy, conv_w[l], conv_b[l], lru_wa[l], lru_ba[l],
                           lru_wx[l], lru_bx[l], lru_lambda[l])
        gates = jax.nn.sigmoid(gt + b_gate[l]).reshape(b, s, N_BRANCH, D_MODEL)
        wb = w_branch[l]
        merged = (gates[:, :, 0] * (y_a @ wb[:A_WIDTH])
                  + gates[:, :, 1] * (y_b @ wb[A_WIDTH:A_WIDTH + B_WIDTH])
                  + gates[:, :, 2] * (y_c @ wb[A_WIDTH + B_WIDTH:]))
        x = x + merged @ w_out[l]
        gu = rms_norm(x, g_ffn[l]) @ w_ffn_in[l]
        g_, u_ = jnp.split(gu, 2, axis=-1)
        x = x + (jax.nn.silu(g_) * u_) @ w_ffn_out[l]
    return x
```

```cpp
#include <hip/hip_runtime.h>
#include <cstdio>
#include <cstdint>

#define WGT_LDS_OFF 139840
extern __shared__ __attribute__((aligned(16))) unsigned char lds[];
__device__ __forceinline__ unsigned wgt_slot() { return (unsigned)__builtin_amdgcn_s_getreg((5 << 11) | 4) & 63u; }
__device__ __forceinline__ int wg_lane() { int l; asm volatile("v_mbcnt_lo_u32_b32 %0, -1, 0\n\tv_mbcnt_hi_u32_b32 %0, -1, %0" : "=v"(l)); return l; }
__device__ __forceinline__ int wg_wave() { const volatile __attribute__((address_space(3))) unsigned* tab = (const volatile __attribute__((address_space(3))) unsigned*)((__attribute__((address_space(3))) unsigned char*)lds + WGT_LDS_OFF);
    return __builtin_amdgcn_readfirstlane((int)tab[wgt_slot()]); }
__device__ __forceinline__ int wg_tid() { return wg_wave() * 64 + wg_lane(); }
__device__ __forceinline__ float shflx(float v, int m) { return __builtin_bit_cast(float, __builtin_amdgcn_ds_bpermute((wg_lane() ^ m) << 2, __builtin_bit_cast(int, v))); }
__device__ __forceinline__ float shfl_from(float v, int src) { return __builtin_bit_cast(float, __builtin_amdgcn_ds_bpermute(src << 2, __builtin_bit_cast(int, v))); }
namespace pg8 {
#define PG8_LAS __attribute__((address_space(3)))
typedef unsigned short bf16_t;
typedef short bf16x8 __attribute__((ext_vector_type(8)));
typedef float f32x4 __attribute__((ext_vector_type(4)));
typedef unsigned u32x4 __attribute__((ext_vector_type(4)));
constexpr int BM = 256, BK = 64, HALF = 128, HTB = HALF * BK * 2  , STAGE_BYTES = 8 * HTB, NXCD = 8, WGM = 8;

__host__ __device__ __forceinline__ int lds_byte(int r, int c) { const int st = (r >> 4) * 2 + (c >> 5), rr = r & 15, cc = c & 31, ob = rr * 64 + cc * 2; return st * 1024 + (ob ^ (((ob >> 9) & 1) << 5)); }
__host__ __device__ __forceinline__ void stage_rc(int b, int& R, int& C) { const int st = b / 1024, sb = b % 1024, swz = sb ^ (((sb >> 9) & 1) << 5); R = (st >> 1) * 16 + swz / 64; C = (st & 1) * 32 + (swz % 64) / 2; }
__host__ __device__ __forceinline__ int perm32(int rho) { const int n = rho >> 4, i = rho & 15; return 8 * (i >> 2) + 4 * n + (i & 3); }

struct Unit { int pm, pn; };
struct Gemm { const bf16_t* A; const bf16_t* Bt; int M, N, K; };

struct StaticOrder {
    int nM, nN, nwg, G, c;
    __host__ __device__ void init(int M, int N, int G_, int c_) { nM = M / BM; nN = N / BM; nwg = nM * nN; G = G_; c = c_; }
    __host__ __device__ bool next(int i, Unit& u) const {
        const long L = (long)i * G + c; if (L >= nwg) return false;
        int wgid = (int)L; { const int q = nwg / NXCD, r = nwg % NXCD, xcd = wgid % NXCD, off = wgid / NXCD; wgid = (xcd < r ? xcd * (q + 1) : r * (q + 1) + (xcd - r) * q) + off; }
        const int nig = WGM * nN, gid = wgid / nig, fm = gid * WGM, gsz = (nM - fm) < WGM ? (nM - fm) : WGM;
        u.pm = fm + ((wgid % nig) % gsz); u.pn = (wgid % nig) / gsz; return true;
    }
    __device__ __forceinline__ void a_ready(const Unit&) const {}
    __device__ __forceinline__ void done(const Unit&) const {}
};


typedef float f32x2_t __attribute__((ext_vector_type(2))); typedef __bf16 bf16x2_t __attribute__((ext_vector_type(2)));
__device__ __forceinline__ unsigned cvt_pk_bf16(float lo, float hi) { const f32x2_t v = {lo, hi}; const bf16x2_t b = __builtin_convertvector(v, bf16x2_t); return __builtin_bit_cast(unsigned, b); }
__device__ __forceinline__ u32x4 pack8(const f32x4 a, const f32x4 b) { u32x4 w; w.x = cvt_pk_bf16(a[0], a[1]); w.y = cvt_pk_bf16(a[2], a[3]); w.z = cvt_pk_bf16(b[0], b[1]); w.w = cvt_pk_bf16(b[2], b[3]); return w; }
__device__ __forceinline__ float bflo(unsigned w) { return __builtin_bit_cast(float, w << 16); }
__device__ __forceinline__ float bfhi(unsigned w) { return __builtin_bit_cast(float, w & 0xffff0000u); }
__device__ __forceinline__ float fast_sigmoid(float x) { return __builtin_amdgcn_rcpf(1.f + __expf(-x)); }

__device__ __forceinline__ float row_rs(const float* ssp, int row) { const f32x4* q = (const f32x4*)(ssp + (size_t)row * 16); const f32x4 a = q[0], b = q[1], c = q[2], d = q[3];
    const f32x4 s = (a + b) + (c + d); return __builtin_amdgcn_rsqf(((s[0] + s[1]) + (s[2] + s[3])) * (1.f / 1024.f) + 1e-6f); }
__device__ __forceinline__ const PG8_LAS float* unit_row_scales(const float* ssp, PG8_LAS float* rsl, const Unit& u, int wr, int wc, int fr, int fq) {
    const int lane = fr + 16 * fq;
    PG8_LAS float* mine = rsl + (wr * 4 + wc) * 128;
    mine[lane] = row_rs(ssp, u.pm * BM + wr * 64 + lane); mine[64 + lane] = row_rs(ssp, u.pm * BM + HALF + wr * 64 + lane);
    asm volatile("s_waitcnt lgkmcnt(0)" ::: "memory");
    return mine;
}
constexpr float QSCALE = 0.125f * 1.4426950408889634f;

struct EpiIn {
    static constexpr bool PERM = true, AFTER_DRAIN = false;
    bf16_t *QA, *KA, *VA, *QB, *KB, *VB, *IQ, *IK; float* IW; bf16_t *CX, *CY, *GT;
    const float *gain_a, *gain_b, *gain_ik, *bgate, *rcos, *rsin;
    const float* ss;
    PG8_LAS float* rsl;
    __device__ __forceinline__ void operator()(const f32x4 (&acc)[2][2][4][2], const Unit& u, int wr, int wc, int fr, int fq) const {
        const int pn = u.pn; int row0 = u.pm * BM + wr * 64 + fr; asm volatile("" : "+v"(row0));
        const PG8_LAS float* rsw = unit_row_scales(ss, rsl, u, wr, wc, fr, fq) + fr;
        if (pn >= 12) {
            const int gi = (pn - 12) >> 2, ct = ((pn - 12) & 3) * BM; unsigned char* base = (unsigned char*)GT + (size_t)gi * 32768 * 1024;
            const int col0 = ct + wc * 32 + 8 * fq; const float* bp = bgate + gi * 1024 + col0;
            f32x4 bv[2][2];
#pragma unroll
            for (int bj = 0; bj < 2; ++bj)
#pragma unroll
                for (int n = 0; n < 2; ++n) bv[bj][n] = *(const f32x4*)(bp + bj * HALF + 4 * n);
#pragma unroll
            for (int ai = 0; ai < 2; ++ai)
#pragma unroll
                for (int m = 0; m < 4; ++m) { unsigned char* rowp = base + (size_t)(row0 + ai * HALF + m * 16) * 1024 + col0; const float rs = rsw[ai * 64 + m * 16];
#pragma unroll
                    for (int bj = 0; bj < 2; ++bj) { f32x4 v0 = acc[ai][bj][m][0] * rs + bv[bj][0], v1 = acc[ai][bj][m][1] * rs + bv[bj][1];
                        unsigned w0 = 0u, w1 = 0u;
#pragma unroll
                        for (int e = 0; e < 4; ++e) { w0 = __builtin_amdgcn_cvt_pk_u8_f32(fmaxf(__builtin_rintf(fast_sigmoid(v0[e]) * 255.f), 1.f), e, w0); w1 = __builtin_amdgcn_cvt_pk_u8_f32(fmaxf(__builtin_rintf(fast_sigmoid(v1[e]) * 255.f), 1.f), e, w1); }
                        uint2 wv; wv.x = w0; wv.y = w1; *(uint2*)(rowp + bj * HALF) = wv; }
                    asm volatile("" ::: "memory"); }
            return;
        }
        if (pn >= 8) {
            bf16_t* base = (pn < 10) ? CX : CY; const int col0 = ((pn - 8) & 1) * BM + wc * 32 + 8 * fq;
#pragma unroll
            for (int ai = 0; ai < 2; ++ai)
#pragma unroll
                for (int m = 0; m < 4; ++m) { bf16_t* rowp = base + (size_t)(row0 + ai * HALF + m * 16) * 512 + col0; const float rs = rsw[ai * 64 + m * 16];
#pragma unroll
                    for (int bj = 0; bj < 2; ++bj) *(u32x4*)(rowp + bj * HALF) = pack8(acc[ai][bj][m][0] * rs, acc[ai][bj][m][1] * rs);
                    asm volatile("" ::: "memory"); }
            return;
        }
        bf16_t* dst; const float* gain = nullptr; bool do_norm = false, do_rope = false; float scale = 1.f; int pitch = 256;
        switch (pn) {
            case 0: dst = QA; gain = gain_a; do_norm = true; scale = QSCALE; break;
            case 1: dst = KA; gain = gain_a + 64; do_norm = true; break;
            case 2: dst = VA; break;
            case 3: dst = QB; gain = gain_b; do_norm = true; do_rope = true; scale = QSCALE; break;
            case 4: dst = KB; gain = gain_b + 64; do_norm = true; do_rope = true; break;
            case 5: dst = VB; break;
            case 6: dst = IQ; do_rope = true; break;
            default: dst = IK; gain = gain_ik; do_norm = true; do_rope = true; pitch = 64; break;
        }
        if (pn == 7) {
            if (wc == 1) {
                if (fq == 0) {
#pragma unroll
                    for (int ai = 0; ai < 2; ++ai)
#pragma unroll
                        for (int m = 0; m < 4; ++m) { const int row = row0 + ai * HALF + m * 16; *(f32x4*)(IW + (size_t)row * 4) = acc[ai][0][m][0] * (0.0625f * rsw[ai * 64 + m * 16]); }
                }
                return;
            }
            if (wc != 0) return;
        }
        f32x4 g[2][2];
#pragma unroll
        for (int bj = 0; bj < 2; ++bj)
#pragma unroll
            for (int n = 0; n < 2; ++n) g[bj][n] = do_norm ? *(const f32x4*)(gain + bj * 32 + 8 * fq + 4 * n) * scale : (f32x4){scale, scale, scale, scale};
        const int colb = (pn == 7 ? 0 : wc * 64) + 8 * fq;
#pragma unroll
        for (int ai = 0; ai < 2; ++ai)
#pragma unroll
            for (int m = 0; m < 4; ++m) {
                const int row = row0 + ai * HALF + m * 16;
                const float rsx = rsw[ai * 64 + m * 16];
                f32x4 lo0 = acc[ai][0][m][0] * rsx, lo1 = acc[ai][0][m][1] * rsx, hi0 = acc[ai][1][m][0] * rsx, hi1 = acc[ai][1][m][1] * rsx;
                if (do_norm) {
                    f32x4 s4 = lo0 * lo0 + lo1 * lo1 + hi0 * hi0 + hi1 * hi1; float ss = (s4[0] + s4[1]) + (s4[2] + s4[3]);
                    ss += shflx(ss, 16); ss += shflx(ss, 32);
                    const float rs = __builtin_amdgcn_rsqf(ss * (1.f / 64.f) + 1e-6f);
                    lo0 = lo0 * rs; lo1 = lo1 * rs; hi0 = hi0 * rs; hi1 = hi1 * rs;
                }
                lo0 = lo0 * g[0][0]; lo1 = lo1 * g[0][1]; hi0 = hi0 * g[1][0]; hi1 = hi1 * g[1][1];
                if (do_rope) {
                    const int t = row & 4095; const float* cp = rcos + t * 32 + 8 * fq; const float* sp = rsin + t * 32 + 8 * fq;
                    const f32x4 c0 = *(const f32x4*)cp, c1 = *(const f32x4*)(cp + 4), s0 = *(const f32x4*)sp, s1 = *(const f32x4*)(sp + 4);
                    const f32x4 a0 = lo0 * c0 - hi0 * s0, a1 = lo1 * c1 - hi1 * s1, b0 = hi0 * c0 + lo0 * s0, b1 = hi1 * c1 + lo1 * s1;
                    lo0 = a0; lo1 = a1; hi0 = b0; hi1 = b1;
                }
                if (pn == 7) {
                    bf16_t* tp = dst + (size_t)(row >> 5) * 2048 + (fq >> 1) * 512 + ((fq & 1) * 32 + (row & 31)) * 8;
                    *(u32x4*)(tp) = pack8(lo0, lo1); *(u32x4*)(tp + 1024) = pack8(hi0, hi1);
                } else if (pn == 1 || pn == 4) {
                    bf16_t* tp = dst + ((size_t)(row >> 5) * 4 + wc) * 2048 + (fq >> 1) * 512 + ((fq & 1) * 32 + (row & 31)) * 8;
                    *(u32x4*)(tp) = pack8(lo0, lo1); *(u32x4*)(tp + 1024) = pack8(hi0, hi1);
                } else {
                    bf16_t* rowp = dst + (size_t)row * pitch + colb;
                    *(u32x4*)(rowp) = pack8(lo0, lo1); *(u32x4*)(rowp + 32) = pack8(hi0, hi1); }
                asm volatile("" ::: "memory");
            }
    }
};

struct EpiGate {
    static constexpr bool PERM = true, AFTER_DRAIN = false;
    bf16_t* MG; const bf16_t* G; bool first;
    __device__ __forceinline__ void operator()(const f32x4 (&acc)[2][2][4][2], const Unit& u, int wr, int wc, int fr, int fq) const {
        int row0 = u.pm * BM + wr * 64 + fr; const int col0 = u.pn * BM + wc * 32 + 8 * fq; asm volatile("" : "+v"(row0));
#pragma unroll
        for (int ai = 0; ai < 2; ++ai)
#pragma unroll
            for (int m = 0; m < 4; ++m) { const size_t off = (size_t)(row0 + ai * HALF + m * 16) * 1024 + col0;
#pragma unroll
                for (int bj = 0; bj < 2; ++bj) { const u32x4 gw = *(const u32x4*)(G + off + bj * HALF);
                    f32x4 v0 = acc[ai][bj][m][0], v1 = acc[ai][bj][m][1];
                    v0[0] *= bflo(gw.x); v0[1] *= bfhi(gw.x); v0[2] *= bflo(gw.y); v0[3] *= bfhi(gw.y); v1[0] *= bflo(gw.z); v1[1] *= bfhi(gw.z); v1[2] *= bflo(gw.w); v1[3] *= bfhi(gw.w);
                    if (!first) { const u32x4 ow = *(const u32x4*)(MG + off + bj * HALF);
                        v0[0] += bflo(ow.x); v0[1] += bfhi(ow.x); v0[2] += bflo(ow.y); v0[3] += bfhi(ow.y); v1[0] += bflo(ow.z); v1[1] += bfhi(ow.z); v1[2] += bflo(ow.w); v1[3] += bfhi(ow.w); }
                    *(u32x4*)(MG + off + bj * HALF) = pack8(v0, v1); asm volatile("" ::: "memory"); } }
    }
};

struct EpiResid {
    static constexpr bool PERM = true, AFTER_DRAIN = false;
    const float* xin; float* out; bf16_t* XB; float* ss;
    __device__ __forceinline__ void operator()(const f32x4 (&acc)[2][2][4][2], const Unit& u, int wr, int wc, int fr, int fq) const {
        int row0 = u.pm * BM + wr * 64 + fr; const int col0 = u.pn * BM + wc * 32 + 8 * fq; asm volatile("" : "+v"(row0));
#pragma unroll
        for (int ai = 0; ai < 2; ++ai)
#pragma unroll
            for (int m = 0; m < 4; ++m) { const int row = row0 + ai * HALF + m * 16; const size_t off = (size_t)row * 1024 + col0; float sq = 0.f;
#pragma unroll
                for (int bj = 0; bj < 2; ++bj) { const f32x4 r0 = *(const f32x4*)(xin + off + bj * HALF) + acc[ai][bj][m][0], r1 = *(const f32x4*)(xin + off + bj * HALF + 4) + acc[ai][bj][m][1];
                    *(f32x4*)(out + off + bj * HALF) = r0; *(f32x4*)(out + off + bj * HALF + 4) = r1;
                    if (XB) { *(u32x4*)(XB + off + bj * HALF) = pack8(r0, r1); const f32x4 q = r0 * r0 + r1 * r1; sq += (q[0] + q[1]) + (q[2] + q[3]); } }
                if (XB) { sq += shflx(sq, 16); sq += shflx(sq, 32); if (fq == 0) ss[(size_t)row * 16 + u.pn * 4 + wc] = sq; }
                asm volatile("" ::: "memory"); }
    }
};

struct EpiGateCat {
    static constexpr bool PERM = true, AFTER_DRAIN = false;
    bf16_t* MG; const bf16_t* G;
    __device__ __forceinline__ void mid(f32x4 (&acc)[2][2][4][2], const Unit& u, int kdone, int wr, int wc, int fr, int fq) const {
        if (kdone != 4 && kdone != 8) return;
        const unsigned char* Gp = (const unsigned char*)G + (size_t)(kdone == 4 ? 0 : 1) * 32768 * 1024; const unsigned char* Gn = Gp + (size_t)32768 * 1024;
        int row0 = u.pm * BM + wr * 64 + fr; const int col0 = u.pn * BM + wc * 32 + 8 * fq; asm volatile("" : "+v"(row0));
        {
            uint2 ga[2][4][2], gb[2][4][2];
#pragma unroll
            for (int ai = 0; ai < 2; ++ai)
#pragma unroll
                for (int mm = 0; mm < 4; ++mm)
#pragma unroll
                    for (int bj = 0; bj < 2; ++bj) { const size_t off = (size_t)(row0 + ai * HALF + mm * 16) * 1024 + col0 + bj * HALF; ga[ai][mm][bj] = *(const uint2*)(Gp + off); gb[ai][mm][bj] = *(const uint2*)(Gn + off); }
            asm volatile("" ::: "memory");
#pragma unroll
            for (int ai = 0; ai < 2; ++ai)
#pragma unroll
                for (int mm = 0; mm < 4; ++mm)
#pragma unroll
                    for (int bj = 0; bj < 2; ++bj) { const int m = mm; const uint2 a = ga[ai][mm][bj], b = gb[ai][mm][bj]; f32x4 r0, r1;
#pragma unroll
                        for (int e = 0; e < 4; ++e) { r0[e] = (float)((a.x >> (8 * e)) & 255u) * __builtin_amdgcn_rcpf((float)((b.x >> (8 * e)) & 255u)); r1[e] = (float)((a.y >> (8 * e)) & 255u) * __builtin_amdgcn_rcpf((float)((b.y >> (8 * e)) & 255u)); }
                        acc[ai][bj][m][0] = acc[ai][bj][m][0] * r0; acc[ai][bj][m][1] = acc[ai][bj][m][1] * r1; }
            asm volatile("" ::: "memory");
        }
    }
    __device__ __forceinline__ void operator()(const f32x4 (&acc)[2][2][4][2], const Unit& u, int wr, int wc, int fr, int fq) const {
        const unsigned char* G2 = (const unsigned char*)G + (size_t)2 * 32768 * 1024;
        int row0 = u.pm * BM + wr * 64 + fr; const int col0 = u.pn * BM + wc * 32 + 8 * fq; asm volatile("" : "+v"(row0));
#pragma unroll
        for (int ai = 0; ai < 2; ++ai) {
            uint2 gw[4][2];
#pragma unroll
            for (int m = 0; m < 4; ++m)
#pragma unroll
                for (int bj = 0; bj < 2; ++bj) gw[m][bj] = *(const uint2*)(G2 + (size_t)(row0 + ai * HALF + m * 16) * 1024 + col0 + bj * HALF);
            asm volatile("" ::: "memory");
#pragma unroll
            for (int m = 0; m < 4; ++m) { const size_t off = (size_t)(row0 + ai * HALF + m * 16) * 1024 + col0;
#pragma unroll
                for (int bj = 0; bj < 2; ++bj) { const uint2 g = gw[m][bj];
                    f32x4 v0 = acc[ai][bj][m][0], v1 = acc[ai][bj][m][1];
#pragma unroll
                    for (int e = 0; e < 4; ++e) { v0[e] *= (float)((g.x >> (8 * e)) & 255u) * (1.f / 255.f); v1[e] *= (float)((g.y >> (8 * e)) & 255u) * (1.f / 255.f); }
                    *(u32x4*)(MG + off + bj * HALF) = pack8(v0, v1); } }
            asm volatile("" ::: "memory"); }
    }
};

struct EpiResidB {
    static constexpr bool PERM = true, AFTER_DRAIN = false;
    bf16_t* XB; float* ss; float* out32;
    __device__ __forceinline__ void operator()(const f32x4 (&acc)[2][2][4][2], const Unit& u, int wr, int wc, int fr, int fq) const {
        int row0 = u.pm * BM + wr * 64 + fr; const int col0 = u.pn * BM + wc * 32 + 8 * fq; asm volatile("" : "+v"(row0));
#pragma unroll
        for (int ai = 0; ai < 2; ++ai) {
            u32x4 xw[4][2];
#pragma unroll
            for (int m = 0; m < 4; ++m)
#pragma unroll
                for (int bj = 0; bj < 2; ++bj) xw[m][bj] = *(const u32x4*)(XB + (size_t)(row0 + ai * HALF + m * 16) * 1024 + col0 + bj * HALF);
            asm volatile("" ::: "memory");
#pragma unroll
            for (int m = 0; m < 4; ++m) { const int row = row0 + ai * HALF + m * 16; const size_t off = (size_t)row * 1024 + col0; float sq = 0.f;
#pragma unroll
                for (int bj = 0; bj < 2; ++bj) { const u32x4 w = xw[m][bj];
                    f32x4 r0 = acc[ai][bj][m][0], r1 = acc[ai][bj][m][1];
                    r0[0] += bflo(w.x); r0[1] += bfhi(w.x); r0[2] += bflo(w.y); r0[3] += bfhi(w.y); r1[0] += bflo(w.z); r1[1] += bfhi(w.z); r1[2] += bflo(w.w); r1[3] += bfhi(w.w);
                    if (out32) { *(f32x4*)(out32 + off + bj * HALF) = r0; *(f32x4*)(out32 + off + bj * HALF + 4) = r1; }
                    else { *(u32x4*)(XB + off + bj * HALF) = pack8(r0, r1); const f32x4 q = r0 * r0 + r1 * r1; sq += (q[0] + q[1]) + (q[2] + q[3]); } }
                if (!out32) { sq += shflx(sq, 16); sq += shflx(sq, 32); if (fq == 0) ss[(size_t)row * 16 + u.pn * 4 + wc] = sq; } }
            asm volatile("" ::: "memory"); }
    }
};

struct EpiSwiGLU {
    static constexpr bool PERM = true, AFTER_DRAIN = false;
    bf16_t* ACT; const float* ss; PG8_LAS float* rsl;
    __device__ __forceinline__ void operator()(const f32x4 (&acc)[2][2][4][2], const Unit& u, int wr, int wc, int fr, int fq) const {
        int row0 = u.pm * BM + wr * 64 + fr; const int col0 = u.pn * HALF + wc * 32 + 8 * fq; asm volatile("" : "+v"(row0));
        const PG8_LAS float* rsw = unit_row_scales(ss, rsl, u, wr, wc, fr, fq) + fr;
#pragma unroll
        for (int ai = 0; ai < 2; ++ai)
#pragma unroll
            for (int m = 0; m < 4; ++m) { f32x4 o[2]; const float rs = rsw[ai * 64 + m * 16];
#pragma unroll
                for (int n = 0; n < 2; ++n) { const f32x4 gv = acc[ai][0][m][n] * rs, uv = acc[ai][1][m][n] * rs;
#pragma unroll
                    for (int e = 0; e < 4; ++e) o[n][e] = gv[e] * fast_sigmoid(gv[e]) * uv[e]; }
                *(u32x4*)(ACT + (size_t)(row0 + ai * HALF + m * 16) * 2816 + col0) = pack8(o[0], o[1]); asm volatile("" ::: "memory"); }
    }
};

template <class Epi, class Sched, bool ALIGN_EPI = false, bool SP2 = false, bool MIDHOOK = false>
__device__ __forceinline__ void gemm_phase(PG8_LAS unsigned char* lds, const Gemm g, const Sched& S, const Epi& E) {
    int tid_ = wg_tid(); asm volatile("" : "+v"(tid_));
    const int tid = tid_, wid = __builtin_amdgcn_readfirstlane(tid >> 6), lane = tid & 63, wr = wid >> 2, wc = wid & 3, fr = lane & 15, fq = lane >> 4;
    const int K = g.K, nt = K / BK;
    unsigned voffA[2], voffB[2];
#pragma unroll
    for (int i = 0; i < 2; ++i) { int R, C; stage_rc(tid * 16 + i * 8192, R, C); const int Rb = Epi::PERM ? ((R & ~31) + perm32(R & 31)) : R;
        voffA[i] = (unsigned)(R * K + C) * 2u; voffB[i] = (unsigned)(Rb * K + C) * 2u; }
    const size_t kstep = (size_t)(BK * 2);
    const size_t hstep = (size_t)HALF * K * 2;
    const size_t tstep = 2 * hstep;
    const unsigned ldsw = (unsigned)wid * 1024u;
    const int aoff = lds_byte(wr * 64 + fr, fq * 8), boff = lds_byte(wc * 32 + fr, fq * 8);
#define PG8_SA(b, h) (((b) * 2 + (h)) * HTB)
#define PG8_SB(b, h) ((4 + (b) * 2 + (h)) * HTB)
#define PG8_STAGE(bufoff, gbase, voff) do { _Pragma("unroll") for (int _i = 0; _i < 2; ++_i) \
        __builtin_amdgcn_global_load_lds((const unsigned*)((const char*)(gbase) + (voff)[_i]), (PG8_LAS unsigned*)(lds + (bufoff) + ldsw + _i * 8192), 16, 0, 0); } while (0)
#define PG8_LDA(dst, b, h) do { _Pragma("unroll") for (int m = 0; m < 4; ++m) _Pragma("unroll") for (int k = 0; k < 2; ++k) dst[m][k] = *(const PG8_LAS bf16x8*)(lds + PG8_SA(b, h) + aoff + m * 2048 + k * 1024); } while (0)
#define PG8_LDB(dst, b, h) do { _Pragma("unroll") for (int n = 0; n < 2; ++n) _Pragma("unroll") for (int k = 0; k < 2; ++k) dst[n][k] = *(const PG8_LAS bf16x8*)(lds + PG8_SB(b, h) + boff + n * 2048 + k * 1024); } while (0)
#define PG8_MMA(ai, bj, At, Bt) do { __builtin_amdgcn_s_setprio(1); _Pragma("unroll") for (int m = 0; m < 4; ++m) _Pragma("unroll") for (int n = 0; n < 2; ++n) _Pragma("unroll") for (int k = 0; k < 2; ++k) \
        acc[ai][bj][m][n] = __builtin_amdgcn_mfma_f32_16x16x32_bf16(Bt[n][k], At[m][k], acc[ai][bj][m][n], 0, 0, 0); __builtin_amdgcn_s_setprio(0); } while (0)
#define PG8_WAIT_V(n) asm volatile("s_waitcnt vmcnt(" #n ")" ::: "memory")
#define PG8_WAIT_L(n) asm volatile("s_waitcnt lgkmcnt(" #n ")" ::: "memory")
#define PG8_BAR __builtin_amdgcn_s_barrier()
#define PG8_SCHED __builtin_amdgcn_sched_barrier(0)
    Unit cur, nxt; int ui = 0;
    if (!S.next(0, cur)) return;
    f32x4 acc[2][2][4][2];
#pragma unroll
    for (int a = 0; a < 2; ++a)
#pragma unroll
        for (int b = 0; b < 2; ++b)
#pragma unroll
            for (int m = 0; m < 4; ++m)
#pragma unroll
                for (int n = 0; n < 2; ++n) acc[a][b][m][n] = (f32x4){0.f, 0.f, 0.f, 0.f};
    bf16x8 At[4][2], B0[2][2], B1[2][2];
    const char* cA = (const char*)g.A + (size_t)cur.pm * tstep; const char* cB = (const char*)g.Bt + (size_t)cur.pn * tstep;
    S.a_ready(cur);
    if constexpr (SP2) {
        PG8_STAGE(PG8_SB(0, 0), cB, voffB); PG8_STAGE(PG8_SB(0, 1), cB + hstep, voffB); PG8_STAGE(PG8_SA(0, 0), cA, voffA); PG8_STAGE(PG8_SA(0, 1), cA + hstep, voffA);
        if (wr == 1) PG8_BAR;
        PG8_WAIT_V(2); PG8_BAR;
        PG8_STAGE(PG8_SB(1, 0), cB + kstep, voffB); PG8_STAGE(PG8_SA(1, 0), cA + kstep, voffA); PG8_STAGE(PG8_SB(1, 1), cB + hstep + kstep, voffB);
        PG8_WAIT_V(6); PG8_BAR;
    } else {
        PG8_STAGE(PG8_SB(0, 0), cB, voffB); PG8_STAGE(PG8_SA(0, 0), cA, voffA); PG8_STAGE(PG8_SB(0, 1), cB + hstep, voffB); PG8_STAGE(PG8_SA(0, 1), cA + hstep, voffA);
        if (wr == 1) PG8_BAR;
        PG8_WAIT_V(4); PG8_BAR;
        PG8_STAGE(PG8_SB(1, 0), cB + kstep, voffB); PG8_STAGE(PG8_SA(1, 0), cA + kstep, voffA); PG8_STAGE(PG8_SB(1, 1), cB + hstep + kstep, voffB);
        PG8_WAIT_V(6); PG8_BAR;
    }
    for (;;) {
        const bool has_next = S.next(ui + 1, nxt);
        const char* nA = has_next ? (const char*)g.A + (size_t)nxt.pm * tstep : cA; const char* nB = has_next ? (const char*)g.Bt + (size_t)nxt.pn * tstep : cB;
        for (int t = 0; t < nt; t += 2) {
            const bool last = (t == nt - 2);
            const char* a1 = cA + (size_t)(t + 1) * kstep;
            const char* a2 = last ? nA : cA + (size_t)(t + 2) * kstep; const char* b2 = last ? nB : cB + (size_t)(t + 2) * kstep;
            const char* a3 = a2 + kstep; const char* b3 = b2 + kstep;
            if (last && has_next) S.a_ready(nxt);
            if constexpr (SP2) {
            PG8_LDB(B0, 0, 0); PG8_LDB(B1, 0, 1); PG8_SCHED; PG8_LDA(At, 0, 0); PG8_STAGE(PG8_SA(1, 1), a1 + hstep, voffA);
            PG8_WAIT_V(8); PG8_WAIT_L(0); PG8_BAR; PG8_MMA(0, 0, At, B0); PG8_MMA(0, 1, At, B1); PG8_BAR; PG8_SCHED;
            PG8_LDA(At, 0, 1); PG8_STAGE(PG8_SB(0, 0), b2, voffB); PG8_STAGE(PG8_SB(0, 1), b2 + hstep, voffB); PG8_STAGE(PG8_SA(0, 0), a2, voffA);
            PG8_WAIT_V(8); PG8_WAIT_L(0); PG8_BAR; PG8_MMA(1, 0, At, B0); PG8_MMA(1, 1, At, B1); PG8_BAR; PG8_SCHED;
            PG8_LDB(B0, 1, 0); PG8_LDB(B1, 1, 1); PG8_SCHED; PG8_LDA(At, 1, 0); PG8_STAGE(PG8_SA(0, 1), a2 + hstep, voffA);
            PG8_WAIT_V(8); PG8_WAIT_L(0); PG8_BAR; PG8_MMA(0, 0, At, B0); PG8_MMA(0, 1, At, B1); PG8_BAR; PG8_SCHED;
            PG8_LDA(At, 1, 1); PG8_STAGE(PG8_SB(1, 0), b3, voffB); PG8_STAGE(PG8_SB(1, 1), b3 + hstep, voffB); PG8_STAGE(PG8_SA(1, 0), a3, voffA);
            PG8_WAIT_V(8); PG8_WAIT_L(0); PG8_BAR; PG8_MMA(1, 0, At, B0); PG8_MMA(1, 1, At, B1); PG8_BAR; PG8_SCHED;
            } else {
            PG8_LDB(B0, 0, 0); PG8_SCHED; PG8_LDA(At, 0, 0); PG8_STAGE(PG8_SA(1, 1), a1 + hstep, voffA);
            PG8_WAIT_L(8); PG8_BAR; PG8_WAIT_L(0); PG8_MMA(0, 0, At, B0); PG8_BAR; PG8_SCHED;
            PG8_LDB(B1, 0, 1); PG8_STAGE(PG8_SB(0, 0), b2, voffB);
            PG8_BAR; PG8_WAIT_L(0); PG8_MMA(0, 1, At, B1); PG8_BAR;
            PG8_LDA(At, 0, 1); PG8_STAGE(PG8_SA(0, 0), a2, voffA);
            PG8_BAR; PG8_WAIT_L(0); PG8_MMA(1, 0, At, B0); PG8_BAR; PG8_SCHED;
            PG8_STAGE(PG8_SB(0, 1), b2 + hstep, voffB);
            PG8_WAIT_V(6); PG8_BAR; PG8_MMA(1, 1, At, B1); PG8_BAR;
            PG8_LDB(B0, 1, 0); PG8_SCHED; PG8_LDA(At, 1, 0); PG8_STAGE(PG8_SA(0, 1), a2 + hstep, voffA);
            PG8_WAIT_L(8); PG8_BAR; PG8_WAIT_L(0); PG8_MMA(0, 0, At, B0); PG8_BAR; PG8_SCHED;
            PG8_LDB(B1, 1, 1); PG8_STAGE(PG8_SB(1, 0), b3, voffB);
            PG8_BAR; PG8_WAIT_L(0); PG8_MMA(0, 1, At, B1); PG8_BAR;
            PG8_LDA(At, 1, 1); PG8_STAGE(PG8_SA(1, 0), a3, voffA);
            PG8_BAR; PG8_WAIT_L(0); PG8_MMA(1, 0, At, B0); PG8_BAR; PG8_SCHED;
            PG8_STAGE(PG8_SB(1, 1), b3 + hstep, voffB);
            PG8_WAIT_V(6); PG8_BAR; PG8_MMA(1, 1, At, B1); PG8_BAR;
            }
            if constexpr (MIDHOOK) E.mid(acc, cur, t + 2, wr, wc, fr, fq);
        }
        if constexpr (ALIGN_EPI) { if (wr == 0) PG8_BAR; }
        if constexpr (!Epi::AFTER_DRAIN) { E(acc, cur, wr, wc, fr, fq); S.done(cur); }
        if (!has_next) break;
#pragma unroll
        for (int a = 0; a < 2; ++a)
#pragma unroll
            for (int b = 0; b < 2; ++b)
#pragma unroll
                for (int m = 0; m < 4; ++m)
#pragma unroll
                    for (int n = 0; n < 2; ++n) acc[a][b][m][n] = (f32x4){0.f, 0.f, 0.f, 0.f};
        cur = nxt; cA = nA; cB = nB; ++ui;
        if constexpr (ALIGN_EPI) { if (wr == 1) PG8_BAR; }
    }
    PG8_WAIT_V(0);
    if constexpr (!ALIGN_EPI) { if (wr == 0) PG8_BAR; }
    PG8_BAR;
    if constexpr (Epi::AFTER_DRAIN) { E.fused(acc, cur, wr, wc, fr, fq, lds, wid, lane); S.done(cur); }
#undef PG8_SA
#undef PG8_SB
#undef PG8_STAGE
#undef PG8_LDA
#undef PG8_LDB
#undef PG8_MMA
#undef PG8_WAIT_V
#undef PG8_WAIT_L
#undef PG8_BAR
#undef PG8_SCHED
}
}

constexpr int NWAVES = 8;
#ifndef MK_PER_PHASE
#define MK_PER_PHASE 0
#endif
#ifndef PG8_SP2
#define PG8_SP2 true
#endif
#ifndef PG8_ALIGN
#define PG8_ALIGN true
#endif

constexpr int BATCH = 8, SEQ = 4096, D = 1024, DEPTH = 4, M = BATCH * SEQ;
constexpr int NIN = 6144, DIN = 5956, FF = 2816, NF1 = 2 * FF;
constexpr int NPH = 9;
constexpr float EPS = 1e-6f, LOG2E = 1.4426950408889634f;

constexpr size_t MiB = 1u << 20;
constexpr size_t WS_CTL = 0, CTL_ZERO_BYTES = 1 * MiB;
constexpr size_t WS_ROPE = 1 * MiB;
constexpr size_t WS_SS = 494 * MiB;
constexpr size_t WS_W = 4 * MiB;
constexpr size_t WO_IN = 0, WO_BA = 12 * MiB, WO_BB = WO_BA + MiB / 2, WO_BC = WO_BB + MiB / 2, WO_OUT = WO_BC + MiB, WO_F1 = WO_OUT + 2 * MiB, WO_F2 = WO_F1 + 11 * MiB;
constexpr size_t WS_H = 40 * MiB;
constexpr size_t WS_YC = WS_H;
constexpr size_t WS_QA = 104 * MiB, WS_QB = 120 * MiB, WS_KA = 136 * MiB, WS_VA = 152 * MiB, WS_KB = 168 * MiB, WS_VB = 184 * MiB, WS_IQ = 200 * MiB;
constexpr size_t WS_MG = WS_KA;
constexpr size_t WS_IK = 216 * MiB, WS_IW = 220 * MiB;
constexpr size_t WS_CX = 222 * MiB, WS_CY = 254 * MiB;
constexpr size_t WS_GT = 286 * MiB;
constexpr size_t WS_ACT = WS_GT;
constexpr size_t WS_MASK = 478 * MiB;
constexpr size_t WS_END = 510 * MiB;
constexpr int CW_TMO = 0, CW_CODE = 1, CW_BAR = 4096;

constexpr int RING_OFF = 0, RING_BYTES = 131072;
constexpr int XTRA_OFF = RING_BYTES, XTRA_BYTES = 8192;
constexpr int LDSCTL_OFF = XTRA_OFF + XTRA_BYTES, MISC_OFF = LDSCTL_OFF + 320;
constexpr int LDS_BYTES = 147456;
static_assert(MISC_OFF + 128 <= LDS_BYTES, "LDS map");

#define GAS __attribute__((address_space(1)))
#define LAS __attribute__((address_space(3)))
typedef unsigned short bf16;
typedef unsigned v4u __attribute__((ext_vector_type(4)));
typedef float f32x4 __attribute__((ext_vector_type(4)));
typedef short bf16x8 __attribute__((ext_vector_type(8)));
typedef GAS unsigned gu32;
typedef unsigned long long u64;
#define RLX_AGENT __ATOMIC_RELAXED, __HIP_MEMORY_SCOPE_AGENT
#define LDS_WAIT() asm volatile("s_waitcnt lgkmcnt(0)" ::: "memory")
#define VM_WAIT() asm volatile("s_waitcnt vmcnt(0)" ::: "memory")
__device__ __forceinline__ unsigned f2bf(float f) { unsigned u = __builtin_bit_cast(unsigned, f); return (u + 0x7fffu + ((u >> 16) & 1u)) >> 16; }
__device__ __forceinline__ unsigned pk2(float lo, float hi) { return f2bf(lo) | (f2bf(hi) << 16); }
__device__ __forceinline__ float bf2f(bf16 v) { return __builtin_bit_cast(float, (unsigned)v << 16); }
__device__ __forceinline__ float bflo(unsigned w) { return __builtin_bit_cast(float, w << 16); }
__device__ __forceinline__ float bfhi(unsigned w) { return __builtin_bit_cast(float, w & 0xffff0000u); }
__device__ __forceinline__ float wave_sum(float v) {
#pragma unroll
    for (int o = 1; o < 64; o <<= 1) v += shflx(v, o);
    return v;
}
__device__ __forceinline__ float wave_max(float v) {
#pragma unroll
    for (int o = 1; o < 64; o <<= 1) v = fmaxf(v, shflx(v, o));
    return v;
}
#define XB_TMO      128
#define XB_XCNT(j)  (256  + 64 * (j))
#define XB_XSUB(j)  (1280 + 64 * (j))
#define XB_XGEN(j)  (2304 + 64 * (j))
#define XB_TOP      3328
#define XB_TOPGEN   3392
#define XCD_BAR_WORDS 3456
#define XB_SPIN_CAP (1u << 27)

__device__ __forceinline__ unsigned xb_ld(unsigned* p)              { return __hip_atomic_load(p, __ATOMIC_RELAXED, __HIP_MEMORY_SCOPE_AGENT); }
__device__ __forceinline__ unsigned xb_add(unsigned* p, unsigned v) { return __hip_atomic_fetch_add(p, v, __ATOMIC_RELAXED, __HIP_MEMORY_SCOPE_AGENT); }
__device__ __forceinline__ unsigned xb_xcc_id() { return (unsigned)__builtin_amdgcn_s_getreg((3 << 11) | 20) & 0xFu; }
#define XB_SPIN(cond, bar) do { unsigned _sp = 0; while (cond) { __builtin_amdgcn_s_sleep(1); \
    if ((++_sp & 255u) == 0u) { if (xb_ld(&(bar)[XB_TMO])) break; if (_sp > XB_SPIN_CAP) { atomicAdd(&(bar)[XB_TMO], 1u); break; } } } } while (0)

struct XcdBarrier {
    unsigned* bar; unsigned x;
    volatile LAS unsigned* st;
};

__device__ __forceinline__ XcdBarrier xcd_barrier_post(unsigned* bar, volatile LAS unsigned* st) {
    XcdBarrier b; b.bar = bar; b.x = xb_xcc_id(); b.st = st;
    if (wg_tid() == 0) (void)xb_add(&bar[XB_XCNT(b.x)], 1u);
    return b;
}
__device__ __forceinline__ void xcd_barrier_complete(unsigned* bar, unsigned x, unsigned& nloc, unsigned& nx) {
    const unsigned G = gridDim.x * gridDim.y * gridDim.z;
    unsigned sum, cnt, mine, sp = 0u;
    for (;;) {
        sum = 0u; cnt = 0u; mine = 0u;
#pragma unroll
        for (unsigned j = 0; j < 16; ++j) { const unsigned c = xb_ld(&bar[XB_XCNT(j)]); sum += c; cnt += (c > 0u) ? 1u : 0u; mine = (j == x) ? c : mine; }
        if (sum == G) break;
        __builtin_amdgcn_s_sleep(1);
        if ((++sp & 255u) == 0u) { if (xb_ld(&bar[XB_TMO])) break; if (sp > XB_SPIN_CAP) { atomicAdd(&bar[XB_TMO], 1u); break; } }
    }
    nloc = mine > 0u ? mine : 1u; nx = cnt > 0u ? cnt : 1u;
}

__device__ __forceinline__ void xcd_barrier(const XcdBarrier& b) {
    asm volatile("s_waitcnt vmcnt(0)" ::: "memory");
    __syncthreads();
    if (wg_tid() == 0) {
        unsigned* bar = b.bar;
        __builtin_amdgcn_s_waitcnt(0);
        unsigned nloc = b.st[0], nx = b.st[1];
        if (nloc == 0u) { xcd_barrier_complete(bar, b.x, nloc, nx); b.st[0] = nloc; b.st[1] = nx; }
        const unsigned old = xb_add(&bar[XB_XSUB(b.x)], 1u);
        const unsigned gen = old / nloc;
        if (old + 1u == (gen + 1u) * nloc) {
            __builtin_amdgcn_fence(__ATOMIC_RELEASE, "agent");
            asm volatile("s_waitcnt vmcnt(0)" ::: "memory");
            const unsigned og = xb_add(&bar[XB_TOP], 1u);
            const unsigned tg = og / nx;
            if (og + 1u == (tg + 1u) * nx) xb_add(&bar[XB_TOPGEN], 1u);
            else XB_SPIN(xb_ld(&bar[XB_TOPGEN]) == tg, bar);
            __builtin_amdgcn_fence(__ATOMIC_ACQUIRE, "agent");
            xb_add(&bar[XB_XGEN(b.x)], 1u);
            asm volatile("s_waitcnt vmcnt(0)" ::: "memory");
        } else {
            XB_SPIN(xb_ld(&bar[XB_XGEN(b.x)]) == gen, bar);
            __builtin_amdgcn_fence(__ATOMIC_ACQUIRE, "agent");
            asm volatile("s_waitcnt vmcnt(0)" ::: "memory");
        }
    }
    __syncthreads();
}

struct Frame {
    LAS unsigned char* lds;
    volatile LAS unsigned* MISC;
    gu32* ctl;
    int tid, lane, wave, G;
    const float* x; float* out;
    const float *g_mix, *w_in, *qk_gain_a, *rel_bias, *qk_gain_b, *g_idx_k, *conv_w, *conv_b, *lru_wa, *lru_ba, *lru_wx, *lru_bx, *lru_lambda, *b_gate, *w_branch, *w_out, *g_ffn, *w_ffn_in, *w_ffn_out;
    float *rcos, *rsin, *SS;
    bf16 *W, *H, *YC, *YCAT, *QA, *QB, *KA, *VA, *KB, *VB, *IQ, *IK, *CX, *CY, *GT, *ACT, *MG; float* IW; u64* MASK;
    bf16 *W2a, *W2b;
};
struct WSet { bf16 *in, *ba, *out, *f1, *f2; };
__device__ __forceinline__ WSet wset(const Frame& F, int l) {
    WSet w;
    if (l & 1) { w.in = F.W + WO_IN / 2; w.ba = F.W + WO_BA / 2; w.out = F.W + WO_OUT / 2; w.f1 = F.W + WO_F1 / 2; w.f2 = F.W + WO_F2 / 2; }
    else { w.in = F.W2a; w.ba = F.W2a + (12 * MiB) / 2; w.out = F.W2a + (14 * MiB) / 2; w.f1 = F.W2b; w.f2 = F.W2b + (11 * MiB) / 2; }
    return w;
}

__device__ __forceinline__ void cvt_item(const float* W, int ldw, int k0, int n_src0, int nvalid, bf16* WT, int dpitch, int drow0, LAS float* scr, int lane, const float* gk = nullptr) {
    { const int col4 = (lane & 7) * 4; f32x4 v[8];
#pragma unroll
      for (int i = 0; i < 8; ++i) { const int kk = 8 * i + (lane >> 3); v[i] = (col4 < nvalid) ? *(const GAS f32x4*)(W + (size_t)(k0 + kk) * ldw + n_src0 + col4) : (f32x4){0.f, 0.f, 0.f, 0.f}; }
#pragma unroll
      for (int i = 0; i < 8; ++i) { const int kk = 8 * i + (lane >> 3); LAS float* d = scr + kk * 33 + col4; const float gg = gk ? gk[k0 + kk] : 1.f; d[0] = v[i].x * gg; d[1] = v[i].y * gg; d[2] = v[i].z * gg; d[3] = v[i].w * gg; } }
    LDS_WAIT(); asm volatile("" ::: "memory");
    const int c = lane & 7;
#pragma unroll
    for (int j = 0; j < 4; ++j) { const int n = (lane >> 3) + 8 * j; const LAS float* s = scr + (8 * c) * 33 + n;
        v4u o; o.x = pk2(s[0 * 33], s[1 * 33]); o.y = pk2(s[2 * 33], s[3 * 33]); o.z = pk2(s[4 * 33], s[5 * 33]); o.w = pk2(s[6 * 33], s[7 * 33]);
        *(GAS v4u*)(WT + (size_t)(drow0 + n) * dpitch + k0 + 8 * c) = o; }
    LDS_WAIT(); asm volatile("" ::: "memory");
}
__device__ __forceinline__ void phase_xb0(Frame& F, const float* xin, float* ss) {
    const int gw = blockIdx.x * NWAVES + F.wave, NGW = F.G * NWAVES;
    for (int m = gw; m < M; m += NGW) { const GAS f32x4* xr = (const GAS f32x4*)(xin + (size_t)m * D) + F.lane; f32x4 v[4]; float s = 0.f;
#pragma unroll
        for (int j = 0; j < 4; ++j) { v[j] = xr[64 * j]; s += (v[j].x * v[j].x + v[j].y * v[j].y) + (v[j].z * v[j].z + v[j].w * v[j].w); }
        s = wave_sum(s); if (F.lane < 16) ss[(size_t)m * 16 + F.lane] = (F.lane == 0) ? s : 0.f;
        GAS u64* o8 = (GAS u64*)(F.H + (size_t)m * D) + F.lane;
#pragma unroll
        for (int j = 0; j < 4; ++j) o8[64 * j] = (u64)pk2(v[j].x, v[j].y) | ((u64)pk2(v[j].z, v[j].w) << 32); }
}
__device__ __forceinline__ void phase_weights(Frame& F, int l, unsigned* queue = nullptr) {
    LAS float* scr = (LAS float*)(F.lds + RING_OFF + F.wave * 16384);
    const int gw = blockIdx.x * NWAVES + F.wave, NGW = F.G * NWAVES;
    const float* w_in = F.w_in + (size_t)l * D * DIN; const float* w_br = F.w_branch + (size_t)l * D * D; const float* w_out = F.w_out + (size_t)l * D * D;
    const float* w_f1 = F.w_ffn_in + (size_t)l * D * NF1; const float* w_f2 = F.w_ffn_out + (size_t)l * FF * D;
    const WSet WS = wset(F, l);
    constexpr int I_IN = 16 * 192, I_BA = 4 * 32, I_BB = 4 * 32, I_BC = 8 * 32, I_OUT = 16 * 32, I_F1 = 16 * 176, I_F2 = 44 * 32;
    constexpr int NITEMS = I_IN + I_BA + I_BB + I_BC + I_OUT + I_F1 + I_F2;
    for (int it0 = gw;; it0 += NGW) {
        int it = it0;
        if (queue) { unsigned v = 0u; if (F.lane == 0) v = __hip_atomic_fetch_add(queue, 1u, __ATOMIC_RELAXED, __HIP_MEMORY_SCOPE_AGENT); it = __builtin_amdgcn_readfirstlane((int)v); }
        if (it >= NITEMS) break;
        int r = it;
        if (r < I_IN) { const int kb = r / 192, ng = r % 192, pn = ng >> 3, grp = ng & 7, bj = grp >> 2, hh = grp & 3; int src = 0, nv = 32;
            if (pn < 7) src = pn * 256 + 64 * hh + 32 * bj;
            else if (pn == 7) { if (hh == 0) src = 1792 + 32 * bj; else if (grp == 1) { src = 1856; nv = 4; } else nv = 0; }
            else if (pn < 12) src = 1860 + (pn - 8) * 256 + grp * 32;
            else src = 2884 + (pn - 12) * 256 + grp * 32;
            cvt_item(w_in, DIN, kb * 64, src, nv, WS.in, D, ng * 32, scr, F.lane, F.g_mix + l * D); continue; } r -= I_IN;
        if (r < I_BA + I_BB + I_BC) { const int kb = r / 32, ng = r % 32; cvt_item(w_br, D, kb * 64, ng * 32, 32, WS.ba, D, ng * 32, scr, F.lane); continue; } r -= I_BA + I_BB + I_BC;
        if (r < I_OUT) { const int kb = r / 32, ng = r % 32; cvt_item(w_out, D, kb * 64, ng * 32, 32, WS.out, D, ng * 32, scr, F.lane); continue; } r -= I_OUT;
        if (r < I_F1) { const int kb = r / 176, ng = r % 176, pn = ng >> 3, grp = ng & 7, bj = grp >> 2; const int src = FF * bj + 128 * pn + (grp & 3) * 32;
            cvt_item(w_f1, NF1, kb * 64, src, 32, WS.f1, D, ng * 32, scr, F.lane, F.g_ffn + l * D); continue; } r -= I_F1;
        { const int kb = r / 32, ng = r % 32; cvt_item(w_f2, D, kb * 64, ng * 32, 32, WS.f2, FF, ng * 32, scr, F.lane); }
    }
    if (l == 0) {
        for (int i = blockIdx.x * 512 + F.tid; i < SEQ * 32; i += F.G * 512) { const int pos = i >> 5, k = i & 31;
            const float inv = exp2f(-(float)k * 0.41524101186092029f); const float ang = (float)pos * inv;
            F.rcos[i] = cosf(ang); F.rsin[i] = sinf(ang); }
    }
}

__device__ __forceinline__ void naive_attn_a(Frame& F, int l) {
    LAS float* bias_s = (LAS float*)F.lds;
    LAS float* qs = (LAS float*)F.lds + 320 + F.wave * 640;
    LAS float* ps = qs + 64;
    const int lane = F.lane;
    for (int u = blockIdx.x; u < BATCH * 4 * 64; u += F.G) {
        const int c = u & 63, h = (u >> 6) & 3, b = u >> 8;
        __syncthreads();
        for (int i = F.tid; i < 257; i += 512) bias_s[i] = F.rel_bias[(l * 4 + h) * 257 + i] * LOG2E;
        __syncthreads();
        const int kc0 = (c - 8 > 0) ? c - 8 : 0; const int nk = (c - kc0 + 1) * 64;
        for (int qi = 0; qi < 8; ++qi) {
            const int t = c * 64 + F.wave * 8 + qi; const size_t row = (size_t)b * SEQ + t;
            qs[lane] = bf2f(F.QA[row * 256 + h * 64 + lane]);
            LDS_WAIT();
            float s[9]; float mx = -INFINITY;
#pragma unroll
            for (int jj = 0; jj < 9; ++jj) { const int j = jj * 64 + lane; s[jj] = -INFINITY;
                if (j < nk) { const size_t krow = (size_t)b * SEQ + kc0 * 64 + j; const v4u* kp = (const v4u*)(F.KA + krow * 256 + h * 64); float dot = 0.f;
#pragma unroll
                    for (int i8 = 0; i8 < 8; ++i8) { const v4u kw = kp[i8]; const LAS float* q = qs + i8 * 8;
                        dot += q[0] * bflo(kw.x) + q[1] * bfhi(kw.x) + q[2] * bflo(kw.y) + q[3] * bfhi(kw.y) + q[4] * bflo(kw.z) + q[5] * bfhi(kw.z) + q[6] * bflo(kw.w) + q[7] * bfhi(kw.w); }
                    int rel = t - (kc0 * 64 + j); rel = rel < -128 ? -128 : (rel > 128 ? 128 : rel);
                    s[jj] = dot + bias_s[rel + 128]; }
                mx = fmaxf(mx, s[jj]); }
            mx = wave_max(mx); float sum = 0.f;
#pragma unroll
            for (int jj = 0; jj < 9; ++jj) { const int j = jj * 64 + lane; if (j < nk) { const float p = exp2f(s[jj] - mx); sum += p; ps[j] = p; } }
            sum = wave_sum(sum);
            LDS_WAIT();
            float o = 0.f; const bf16* vp = F.VA + ((size_t)b * SEQ + kc0 * 64) * 256 + h * 64 + lane;
            for (int j = 0; j < nk; ++j) o += ps[j] * bf2f(vp[(size_t)j * 256]);
            F.QA[row * 256 + h * 64 + lane] = (bf16)f2bf(o / sum);
            LDS_WAIT();
        }
    }
}
__device__ __forceinline__ unsigned fkey(float f) { const unsigned u = __builtin_bit_cast(unsigned, f); return (u & 0x80000000u) ? ~u : (u | 0x80000000u); }
__device__ __forceinline__ void naive_idx(Frame& F) {
    LAS float* sc = (LAS float*)F.lds + F.wave * 4096;
    LAS float* qs = (LAS float*)(F.lds + XTRA_OFF) + F.wave * 256;
    const int lane = F.lane;
    for (int u = blockIdx.x; u < BATCH * 512; u += F.G) {
        const int b = u >> 9, t = (u & 511) * 8 + F.wave; const size_t row = (size_t)b * SEQ + t; const int nw = (t >> 6) + 1;
        { const unsigned* qp = (const unsigned*)(F.IQ + row * 256) + lane * 2; const unsigned w0 = qp[0], w1 = qp[1];
          qs[4 * lane] = bflo(w0); qs[4 * lane + 1] = bfhi(w0); qs[4 * lane + 2] = bflo(w1); qs[4 * lane + 3] = bfhi(w1); }
        const f32x4 wv = *(const f32x4*)(F.IW + row * 4);
        LDS_WAIT();
        for (int jj = 0; jj < nw; ++jj) { const int j = jj * 64 + lane; const v4u* kp = (const v4u*)(F.IK + ((size_t)b * SEQ + j) * 64);
            float d0 = 0.f, d1 = 0.f, d2 = 0.f, d3 = 0.f;
#pragma unroll
            for (int i8 = 0; i8 < 8; ++i8) { const v4u kw = kp[i8]; float kf[8] = {bflo(kw.x), bfhi(kw.x), bflo(kw.y), bfhi(kw.y), bflo(kw.z), bfhi(kw.z), bflo(kw.w), bfhi(kw.w)};
#pragma unroll
                for (int e = 0; e < 8; ++e) { const int d = i8 * 8 + e; d0 += qs[d] * kf[e]; d1 += qs[64 + d] * kf[e]; d2 += qs[128 + d] * kf[e]; d3 += qs[192 + d] * kf[e]; } }
            float s = 0.f; s += wv[0] * fmaxf(d0, 0.f); s += wv[1] * fmaxf(d1, 0.f); s += wv[2] * fmaxf(d2, 0.f); s += wv[3] * fmaxf(d3, 0.f); s += 0.0f;
            sc[j] = s; }
        LDS_WAIT();
        u64* mrow = F.MASK + row * 64;
        if (nw <= 4) { if (lane < nw) { unsigned o1 = ~0u, o2 = ~0u; asm volatile("" : "+v"(o1), "+v"(o2)); ((unsigned*)mrow)[2 * lane] = o1; ((unsigned*)mrow)[2 * lane + 1] = o2; } }
        else {
            unsigned prefix = 0u;
            for (int bit = 31; bit >= 0; --bit) { const unsigned cand = prefix | (1u << bit); int cnt = 0;
                for (int jj = 0; jj < nw; ++jj) cnt += __popcll(__ballot(fkey(sc[jj * 64 + lane]) >= cand));
                if (cnt >= 256) prefix = cand; }
            int n_gt = 0;
            for (int jj = 0; jj < nw; ++jj) n_gt += __popcll(__ballot(fkey(sc[jj * 64 + lane]) > prefix));
            const int allowed = 256 - n_gt; int running = 0; const u64 lt = (1ull << lane) - 1ull;
            for (int jj = 0; jj < nw; ++jj) { const unsigned key = fkey(sc[jj * 64 + lane]); const bool gt = key > prefix, eq = key == prefix; const u64 eqb = __ballot(eq);
                const int rank = running + __popcll(eqb & lt); const bool sel = gt || (eq && rank < allowed); running += __popcll(eqb);
                const u64 w = __ballot(sel); if (lane == 0) mrow[jj] = w; }
        }
        LDS_WAIT();
    }
}
__device__ __forceinline__ void naive_sparse(Frame& F) {
    LAS int* list = (LAS int*)F.lds + F.wave * 256;
    LAS float* ps = (LAS float*)F.lds + 2048 + F.wave * 256;
    LAS float* qs = (LAS float*)F.lds + 4096 + F.wave * 64;
    const int lane = F.lane; const u64 lt = (1ull << lane) - 1ull;
    for (int u = blockIdx.x; u < BATCH * 512; u += F.G) {
        const int b = u >> 9, t = (u & 511) * 8 + F.wave; const size_t row = (size_t)b * SEQ + t; const int nw = (t >> 6) + 1;
        int running = 0;
        for (int jj = 0; jj < nw; ++jj) { const u64 w = F.MASK[row * 64 + jj]; if ((w >> lane) & 1ull) list[running + __popcll(w & lt)] = jj * 64 + lane; running += __popcll(w); }
        const int nsel = running < 256 ? running : 256;
        LDS_WAIT();
        for (int h = 0; h < 4; ++h) {
            qs[lane] = bf2f(F.QB[row * 256 + h * 64 + lane]);
            LDS_WAIT();
            float s[4]; float mx = -INFINITY;
#pragma unroll
            for (int e = 0; e < 4; ++e) { const int idx = e * 64 + lane; s[e] = -INFINITY;
                if (idx < nsel) { const int j = list[idx]; const v4u* kp = (const v4u*)(F.KB + ((size_t)b * SEQ + j) * 256 + h * 64); float dot = 0.f;
#pragma unroll
                    for (int i8 = 0; i8 < 8; ++i8) { const v4u kw = kp[i8]; const LAS float* q = qs + i8 * 8;
                        dot += q[0] * bflo(kw.x) + q[1] * bfhi(kw.x) + q[2] * bflo(kw.y) + q[3] * bfhi(kw.y) + q[4] * bflo(kw.z) + q[5] * bfhi(kw.z) + q[6] * bflo(kw.w) + q[7] * bfhi(kw.w); }
                    s[e] = dot; }
                mx = fmaxf(mx, s[e]); }
            mx = wave_max(mx); float sum = 0.f;
#pragma unroll
            for (int e = 0; e < 4; ++e) { const int idx = e * 64 + lane; if (idx < nsel) { const float p = exp2f(s[e] - mx); sum += p; ps[idx] = p; } }
            sum = wave_sum(sum);
            LDS_WAIT();
            float o = 0.f;
            for (int i = 0; i < nsel; ++i) o += ps[i] * bf2f(F.VB[((size_t)b * SEQ + list[i]) * 256 + h * 64 + lane]);
            F.QB[row * 256 + h * 64 + lane] = (bf16)f2bf(o / sum);
            LDS_WAIT();
        }
    }
}
__device__ __forceinline__ float gelu_tanh(float x) { return 0.5f * x * (1.f + tanhf(0.7978845608028654f * (x + 0.044715f * x * x * x))); }
__device__ __forceinline__ void naive_lru(Frame& F, int l) {
    LAS float* wa_s = (LAS float*)F.lds; LAS float* wx_s = wa_s + 4096; LAS float* us = wx_s + 4096; LAS float* as = us + 64 * 65; LAS float* gs = as + 4096;
    const int tid = F.tid, lane = F.lane;
    for (int u = blockIdx.x; u < 64; u += F.G) {
        const int b = u >> 3, g = u & 7;
        __syncthreads();
        for (int i = tid; i < 4096; i += 512) { wa_s[i] = F.lru_wa[(size_t)(l * 8 + g) * 4096 + i]; wx_s[i] = F.lru_wx[(size_t)(l * 8 + g) * 4096 + i]; }
        float h = 0.f;
        for (int tile = 0; tile < 64; ++tile) {
            __syncthreads();
            { const int tok = tid >> 3, t = tile * 64 + tok;
#pragma unroll
              for (int e = 0; e < 8; ++e) { const int ch = (tid & 7) * 8 + e, cg = g * 64 + ch; float acc = F.conv_b[l * 512 + cg];
#pragma unroll
                  for (int j = 0; j < 4; ++j) { const int tt = t - 3 + j; if (tt >= 0) acc += F.conv_w[(l * 4 + j) * 512 + cg] * bf2f(F.CX[((size_t)b * SEQ + tt) * 512 + cg]); }
                  us[tok * 65 + ch] = acc; } }
            __syncthreads();
            { const int tok = tid & 63, og = tid >> 6;
              for (int o = 0; o < 8; ++o) { const int cc = 8 * og + o, cg = g * 64 + cc; float ra = 0.f, rx = 0.f;
                  for (int k = 0; k < 64; ++k) { const float uv = us[tok * 65 + k]; ra += uv * wa_s[k * 64 + cc]; rx += uv * wx_s[k * 64 + cc]; }
                  const float r = 1.f / (1.f + expf(-(ra + F.lru_ba[l * 512 + cg]))), ig = 1.f / (1.f + expf(-(rx + F.lru_bx[l * 512 + cg])));
                  const float sp = log1pf(expf(-F.lru_lambda[l * 512 + cg])); const float log_a = -8.0f * r * sp;
                  as[tok * 64 + cc] = expf(log_a); gs[tok * 64 + cc] = sqrtf(-expm1f(2.f * log_a)) * (ig * us[tok * 65 + cc]); } }
            __syncthreads();
            if (F.wave == 0) {
                for (int tok = 0; tok < 64; ++tok) { h = as[tok * 64 + lane] * h + gs[tok * 64 + lane]; const size_t row = (size_t)b * SEQ + tile * 64 + tok;
                    const float cy = bf2f(F.CY[row * 512 + g * 64 + lane]); F.YC[row * 512 + g * 64 + lane] = (bf16)f2bf(h * gelu_tanh(cy)); }
            }
        }
    }
}


typedef float f32x16 __attribute__((ext_vector_type(16)));
typedef short s16x4 __attribute__((ext_vector_type(4)));
typedef float f32x2v __attribute__((ext_vector_type(2)));
typedef __bf16 bf16x2v __attribute__((ext_vector_type(2)));
__device__ __forceinline__ unsigned cvtpk(float lo, float hi) { const f32x2v v = {lo, hi}; const bf16x2v b = __builtin_convertvector(v, bf16x2v); return __builtin_bit_cast(unsigned, b); }
__device__ __forceinline__ int crow(int r, int hi) { return (r & 3) + 8 * (r >> 2) + 4 * hi; }
__device__ __forceinline__ s16x4 vtr(const LAS unsigned char* p) { return __builtin_bit_cast(s16x4, __builtin_amdgcn_ds_read_tr16_b64_v4i16((LAS s16x4*)p)); }

template <int MODE> __device__ __forceinline__ void flash_wave(int b, int h, int qblk, const bf16* Q, const bf16* K, const bf16* V, bf16* Y, LAS unsigned char* vl, const LAS float* bias_s, const u64* MASK, int lane) {
    asm volatile("" : "+v"(lane));
    const int r32 = lane & 31, hi = lane >> 5; const size_t row0 = (size_t)b * SEQ + (size_t)qblk * 32; const int c = qblk >> 1;
    bf16x8 qr[4];
#pragma unroll
    for (int d0 = 0; d0 < 4; ++d0) qr[d0] = *(const bf16x8*)(Q + (row0 + r32) * 256 + h * 64 + d0 * 16 + hi * 8);
    const int kb_lo = (MODE == 0) ? ((c > 8 ? c - 8 : 0) * 2) : 0, kb_hi = (c + 1) * 2;
    f32x16 o0, o1;
#pragma unroll
    for (int r = 0; r < 16; ++r) { o0[r] = 0.f; o1[r] = 0.f; }
    float m = -1e30f, lsum = 0.f; const int tq = qblk * 32 + r32;
    const LAS unsigned char* vrd = vl + ((lane >> 4) & 1) * 32 + (lane & 3) * 8 + (4 * hi + ((lane & 15) >> 2)) * 64;
    unsigned mword = 0, mnext = 0;
    const unsigned* M32 = (const unsigned*)MASK + (size_t)(b * 64 + c) * (128 * 64) + (qblk & 1) * 32 + r32;
    const bf16* Kt = K + ((size_t)b * 128 * 4 + h) * 2048 + lane * 8;
    bf16x8 kfn[4]; v4u vvn[4];
    { const size_t krow0 = (size_t)b * SEQ + (size_t)kb_lo * 32;
#pragma unroll
      for (int d0 = 0; d0 < 4; ++d0) kfn[d0] = *(const bf16x8*)(Kt + (size_t)kb_lo * 8192 + d0 * 512);
#pragma unroll
      for (int i = 0; i < 4; ++i) { const int c16 = i * 64 + lane, key = c16 >> 3, dch = c16 & 7; vvn[i] = *(const v4u*)(V + (krow0 + key) * 256 + h * 64 + dch * 8); }
      if (MODE == 1) mnext = M32[kb_lo * 64]; }
    for (int kb = kb_lo; kb < kb_hi; ++kb) {
        bf16x8 kf[4]; v4u vv[4];
#pragma unroll
        for (int d0 = 0; d0 < 4; ++d0) kf[d0] = kfn[d0];
#pragma unroll
        for (int i = 0; i < 4; ++i) vv[i] = vvn[i];
        if (MODE == 1) mword = mnext;
        if (kb + 1 < kb_hi) { const size_t krow1 = (size_t)b * SEQ + (size_t)(kb + 1) * 32;
#pragma unroll
            for (int d0 = 0; d0 < 4; ++d0) kfn[d0] = *(const bf16x8*)(Kt + (size_t)(kb + 1) * 8192 + d0 * 512);
#pragma unroll
            for (int i = 0; i < 4; ++i) { const int c16 = i * 64 + lane, key = c16 >> 3, dch = c16 & 7; vvn[i] = *(const v4u*)(V + (krow1 + key) * 256 + h * 64 + dch * 8); }
            if (MODE == 1) mnext = M32[(kb + 1) * 64]; }
#pragma unroll
        for (int i = 0; i < 4; ++i) { const int c16 = i * 64 + lane, key = c16 >> 3, dch = c16 & 7; *(LAS v4u*)(vl + (dch >> 2) * 2048 + (key >> 4) * 1024 + (key & 15) * 64 + (dch & 3) * 16) = vv[i]; }
        f32x16 p;
#pragma unroll
        for (int r = 0; r < 16; ++r) p[r] = 0.f;
#pragma unroll
        for (int d0 = 0; d0 < 4; ++d0) p = __builtin_amdgcn_mfma_f32_32x32x16_bf16(kf[d0], qr[d0], p, 0, 0, 0);
        if (MODE == 0) {
#pragma unroll
            for (int r = 0; r < 16; ++r) { int rel = tq - (kb * 32 + crow(r, hi)); rel = rel < -128 ? -128 : (rel > 128 ? 128 : rel); p[r] += bias_s[rel + 128]; }
        } else {
            const unsigned bits = mword >> (4 * hi);
#pragma unroll
            for (int r = 0; r < 16; ++r) p[r] = ((bits >> ((r & 3) + 8 * (r >> 2))) & 1u) ? p[r] : -INFINITY;
        }
        float bm = p[0];
#pragma unroll
        for (int r = 1; r < 16; ++r) bm = fmaxf(bm, p[r]);
        bm = fmaxf(bm, shflx(bm, 32));
        const float mn = fmaxf(m, bm), alpha = exp2f(m - mn); m = mn;
        float rs = 0.f;
#pragma unroll
        for (int r = 0; r < 16; ++r) { p[r] = exp2f(p[r] - mn); rs += p[r]; }
        lsum = lsum * alpha + rs;
#pragma unroll
        for (int r = 0; r < 16; ++r) { o0[r] *= alpha; o1[r] *= alpha; }
        bf16x8 pa[2];
#pragma unroll
        for (int s = 0; s < 2; ++s) { v4u w; w.x = cvtpk(p[8 * s], p[8 * s + 1]); w.y = cvtpk(p[8 * s + 2], p[8 * s + 3]); w.z = cvtpk(p[8 * s + 4], p[8 * s + 5]); w.w = cvtpk(p[8 * s + 6], p[8 * s + 7]); pa[s] = __builtin_bit_cast(bf16x8, w); }
#pragma unroll
        for (int s = 0; s < 2; ++s) {
            const s16x4 a_lo = vtr(vrd + s * 1024), a_hi = vtr(vrd + s * 1024 + 512), b_lo = vtr(vrd + 2048 + s * 1024), b_hi = vtr(vrd + 2048 + s * 1024 + 512);
            const bf16x8 va = {a_lo[0], a_lo[1], a_lo[2], a_lo[3], a_hi[0], a_hi[1], a_hi[2], a_hi[3]}, vb = {b_lo[0], b_lo[1], b_lo[2], b_lo[3], b_hi[0], b_hi[1], b_hi[2], b_hi[3]};
            o0 = __builtin_amdgcn_mfma_f32_32x32x16_bf16(va, pa[s], o0, 0, 0, 0); o1 = __builtin_amdgcn_mfma_f32_32x32x16_bf16(vb, pa[s], o1, 0, 0, 0);
        }
    }
    lsum += shflx(lsum, 32); const float inv = 1.f / lsum;
    bf16* yrow = Y + (row0 + r32) * 1024 + h * 64 + 4 * hi;
#pragma unroll
    for (int g4 = 0; g4 < 4; ++g4) {
        uint2 w0, w1; w0.x = cvtpk(o0[4 * g4] * inv, o0[4 * g4 + 1] * inv); w0.y = cvtpk(o0[4 * g4 + 2] * inv, o0[4 * g4 + 3] * inv); w1.x = cvtpk(o1[4 * g4] * inv, o1[4 * g4 + 1] * inv); w1.y = cvtpk(o1[4 * g4 + 2] * inv, o1[4 * g4 + 3] * inv);
        *(uint2*)(yrow + 8 * g4) = w0; *(uint2*)(yrow + 32 + 8 * g4) = w1; }
}

template <int MODE, bool FIXM, bool SPLIT = false> __device__ __forceinline__ void flash_wave2(int b, int h, int c, const bf16* Q, const bf16* K, const bf16* V, bf16* Y, LAS unsigned char* vl, const LAS float* bias_s, const u64* MASK, int lane, float mfix,
        int kb0 = -1, int kb1 = -1, int part = 0, LAS float* cmb = nullptr) {
    asm volatile("" : "+v"(lane));
    const int r32 = lane & 31, hi = lane >> 5; const size_t row0 = (size_t)b * SEQ + (size_t)c * 64;
    bf16x8 qr[2][4];
#pragma unroll
    for (int z = 0; z < 2; ++z)
#pragma unroll
        for (int d0 = 0; d0 < 4; ++d0) qr[z][d0] = *(const bf16x8*)(Q + (row0 + 32 * z + r32) * 256 + h * 64 + d0 * 16 + hi * 8);
    const int kb_lo = SPLIT ? kb0 : ((MODE == 0) ? ((c > 8 ? c - 8 : 0) * 2) : 0), kb_hi = SPLIT ? kb1 : (c + 1) * 2;
    f32x16 o[2][2];
#pragma unroll
    for (int z = 0; z < 2; ++z)
#pragma unroll
        for (int r = 0; r < 16; ++r) { o[z][0][r] = 0.f; o[z][1][r] = 0.f; }
    float m[2] = {-1e30f, -1e30f}, lsum[2] = {0.f, 0.f};
    const LAS unsigned char* vrd = vl + ((lane >> 4) & 1) * 32 + (lane & 3) * 8 + (4 * hi + ((lane & 15) >> 2)) * 64;
    unsigned mword[2] = {0, 0}, mnext[2] = {0, 0};
    constexpr int KSTEP = SPLIT ? 2 : 1;
    const unsigned* M32 = (const unsigned*)MASK + (size_t)(b * 64 + c) * (128 * 64) + r32;
    const bf16* Kt = K + ((size_t)b * 128 * 4 + h) * 2048 + lane * 8;
    if (MODE == 1) { mword[0] = M32[kb_lo * 64]; mword[1] = M32[kb_lo * 64 + 32]; }
    const int kb_last = kb_lo + ((kb_hi - 1 - kb_lo) / KSTEP) * KSTEP;
    bf16x8 kfn[4];
#pragma unroll
    for (int d0 = 0; d0 < 4; ++d0) kfn[d0] = *(const bf16x8*)(Kt + (size_t)kb_lo * 8192 + d0 * 512);
    for (int kb = kb_lo; kb < kb_hi; kb += KSTEP) {
        bf16x8 kf[4]; v4u vv[4];
#pragma unroll
        for (int d0 = 0; d0 < 4; ++d0) kf[d0] = kfn[d0];
        const bool mfetch = (MODE == 1) && kb + KSTEP < kb_hi;
        if (mfetch) { mnext[0] = M32[(kb + KSTEP) * 64]; mnext[1] = M32[(kb + KSTEP) * 64 + 32]; }
        { const int k1 = kb + KSTEP <= kb_last ? kb + KSTEP : kb_last;
          const size_t krowc = (size_t)b * SEQ + (size_t)kb * 32;
#pragma unroll
          for (int i = 0; i < 4; ++i) { const int c16 = i * 64 + lane, key = c16 >> 3, dch = c16 & 7; vv[i] = *(const v4u*)(V + (krowc + key) * 256 + h * 64 + dch * 8); }
#pragma unroll
          for (int d0 = 0; d0 < 4; ++d0) kfn[d0] = *(const bf16x8*)(Kt + (size_t)k1 * 8192 + d0 * 512); }
        bf16x8 pa[2][2];
        f32x16 pz[2];
#pragma unroll
        for (int z = 0; z < 2; ++z) {
#pragma unroll
            for (int r = 0; r < 16; ++r) pz[z][r] = FIXM ? -mfix : 0.f;
#pragma unroll
            for (int d0 = 0; d0 < 4; ++d0) pz[z] = __builtin_amdgcn_mfma_f32_32x32x16_bf16(kf[d0], qr[z][d0], pz[z], 0, 0, 0); }
        __builtin_amdgcn_sched_barrier(0);
#pragma unroll
        for (int z = 0; z < 2; ++z) {
            f32x16 p = pz[z];
            if (MODE == 0) { const int tq = c * 64 + 32 * z + r32;
#pragma unroll
                for (int r = 0; r < 16; ++r) { int rel = tq - (kb * 32 + crow(r, hi)); rel = rel < -128 ? -128 : (rel > 128 ? 128 : rel); p[r] += bias_s[rel + 128]; }
            }
            const unsigned bits = (MODE == 1) ? (mword[z] >> (4 * hi)) : 0u;
            float rs = 0.f;
            if (FIXM) {
#pragma unroll
                for (int r = 0; r < 16; ++r) { const float e = __builtin_amdgcn_exp2f(p[r]); p[r] = (MODE == 1) ? (((bits >> ((r & 3) + 8 * (r >> 2))) & 1u) ? e : 0.f) : e; rs += p[r]; }
            } else {
                if (MODE == 1) {
#pragma unroll
                    for (int r = 0; r < 16; ++r) p[r] = ((bits >> ((r & 3) + 8 * (r >> 2))) & 1u) ? p[r] : -INFINITY;
                }
                float bm = p[0];
#pragma unroll
                for (int r = 1; r < 16; ++r) bm = fmaxf(bm, p[r]);
                bm = fmaxf(bm, shflx(bm, 32));
                const float mn = fmaxf(m[z], bm);
                if (__any(mn != m[z])) {
                    const float alpha = __builtin_amdgcn_exp2f(m[z] - mn); lsum[z] *= alpha;
#pragma unroll
                    for (int r = 0; r < 16; ++r) { o[z][0][r] *= alpha; o[z][1][r] *= alpha; }
                    m[z] = mn; }
#pragma unroll
                for (int r = 0; r < 16; ++r) { p[r] = __builtin_amdgcn_exp2f(p[r] - mn); rs += p[r]; }
            }
            lsum[z] += rs;
#pragma unroll
            for (int s = 0; s < 2; ++s) { v4u w; w.x = cvtpk(p[8 * s], p[8 * s + 1]); w.y = cvtpk(p[8 * s + 2], p[8 * s + 3]); w.z = cvtpk(p[8 * s + 4], p[8 * s + 5]); w.w = cvtpk(p[8 * s + 6], p[8 * s + 7]); pa[z][s] = __builtin_bit_cast(bf16x8, w); }
        }
        asm volatile("" : "+v"(pa[0][0]), "+v"(pa[0][1]), "+v"(pa[1][0]), "+v"(pa[1][1]) :: "memory");
#pragma unroll
        for (int i = 0; i < 4; ++i) { const int c16 = i * 64 + lane, key = c16 >> 3, dch = c16 & 7; *(LAS v4u*)(vl + (dch >> 2) * 2048 + (key >> 4) * 1024 + (key & 15) * 64 + (dch & 3) * 16) = vv[i]; }
#pragma unroll
        for (int s = 0; s < 2; ++s) {
            const s16x4 a_lo = vtr(vrd + s * 1024), a_hi = vtr(vrd + s * 1024 + 512), b_lo = vtr(vrd + 2048 + s * 1024), b_hi = vtr(vrd + 2048 + s * 1024 + 512);
            const bf16x8 va = {a_lo[0], a_lo[1], a_lo[2], a_lo[3], a_hi[0], a_hi[1], a_hi[2], a_hi[3]}, vb = {b_lo[0], b_lo[1], b_lo[2], b_lo[3], b_hi[0], b_hi[1], b_hi[2], b_hi[3]};
#pragma unroll
            for (int z = 0; z < 2; ++z) { o[z][0] = __builtin_amdgcn_mfma_f32_32x32x16_bf16(va, pa[z][s], o[z][0], 0, 0, 0); o[z][1] = __builtin_amdgcn_mfma_f32_32x32x16_bf16(vb, pa[z][s], o[z][1], 0, 0, 0); }
        }
        if (mfetch) { mword[0] = mnext[0]; mword[1] = mnext[1]; }
    }
    if constexpr (SPLIT) {
        if (part == 1) {
#pragma unroll
            for (int z = 0; z < 2; ++z) {
#pragma unroll
                for (int r = 0; r < 16; ++r) { cmb[((z * 2 + 0) * 16 + r) * 64 + lane] = o[z][0][r]; cmb[((z * 2 + 1) * 16 + r) * 64 + lane] = o[z][1][r]; }
                cmb[4096 + z * 64 + lane] = lsum[z]; } }
        __syncthreads();
        if (part == 2) {
#pragma unroll
            for (int z = 0; z < 2; ++z) {
#pragma unroll
                for (int r = 0; r < 16; ++r) { o[z][0][r] += cmb[((z * 2 + 0) * 16 + r) * 64 + lane]; o[z][1][r] += cmb[((z * 2 + 1) * 16 + r) * 64 + lane]; }
                lsum[z] += cmb[4096 + z * 64 + lane]; } }
        __syncthreads();
        if (part == 1) return;
    }
#pragma unroll
    for (int z = 0; z < 2; ++z) {
        const float lt = lsum[z] + shflx(lsum[z], 32); const float inv = 1.f / lt;
        bf16* yrow = Y + (row0 + 32 * z + r32) * 1024 + h * 64 + 4 * hi;
#pragma unroll
        for (int g4 = 0; g4 < 4; ++g4) {
            uint2 w0, w1; w0.x = cvtpk(o[z][0][4 * g4] * inv, o[z][0][4 * g4 + 1] * inv); w0.y = cvtpk(o[z][0][4 * g4 + 2] * inv, o[z][0][4 * g4 + 3] * inv); w1.x = cvtpk(o[z][1][4 * g4] * inv, o[z][1][4 * g4 + 1] * inv); w1.y = cvtpk(o[z][1][4 * g4 + 2] * inv, o[z][1][4 * g4 + 3] * inv);
            *(uint2*)(yrow + 8 * g4) = w0; *(uint2*)(yrow + 32 + 8 * g4) = w1; }
    }
}
__device__ __forceinline__ void phase_attn_a(Frame& F, int l) {
    LAS float* bias_s = (LAS float*)(F.lds + 32768);
    LAS unsigned char* vl = F.lds + F.wave * 4096;
    __syncthreads();
    for (int i = F.tid; i < 4 * 257; i += 512) bias_s[(i / 257) * 260 + (i % 257)] = F.rel_bias[(size_t)l * 4 * 257 + i] * LOG2E;
    __syncthreads();
    for (int u = blockIdx.x * 8 + F.wave; u < BATCH * 4 * 64; u += F.G * 8) { const int wgi = u >> 3; const int b = wgi & 7, h = (wgi >> 3) & 3, c = (wgi >> 5) * 8 + (u & 7);
        flash_wave2<0, false>(b, h, c, F.QA, F.KA, F.VA, F.YCAT, vl, bias_s + h * 260, nullptr, F.lane, 0.f); }
}
__device__ __forceinline__ void phase_attn_b(Frame& F, int l) {
    LAS unsigned char* vl = F.lds + F.wave * 4096;
    __syncthreads();
    float gq = fabsf(F.qk_gain_b[l * 128 + F.lane]), gk = fabsf(F.qk_gain_b[l * 128 + 64 + F.lane]); gq = wave_max(gq); gk = wave_max(gk);
    const float mfix = 64.f * gq * gk * pg8::QSCALE; const bool fixm = mfix < 40.f;
    for (int wg = blockIdx.x; wg < 256; wg += F.G) { const int b = wg & 7, jc = wg >> 3, w = F.wave; const int h = w & 3;
        if (fixm) {
            LAS float* cmb = (LAS float*)(F.lds + 32768) + h * 4224;
#pragma unroll 1
            for (int ci = 0; ci < 2; ++ci) { const int c = ci ? jc : 63 - jc, half = w >> 2;
                flash_wave2<1, true, true>(b, h, c, F.QB, F.KB, F.VB, F.YCAT + 256, vl, nullptr, F.MASK, F.lane, mfix, half, 2 * (c + 1), half ? 1 : 2, cmb); }
        } else { const int c = (w & 4) ? 63 - jc : jc;
#pragma unroll 1
            for (int z = 0; z < 2; ++z) flash_wave<1>(b, h, 2 * c + z, F.QB, F.KB, F.VB, F.YCAT + 256, vl, nullptr, F.MASK, F.lane); } }
}

__device__ __forceinline__ float dpp_quad_sum(float v) {
    int x = __builtin_bit_cast(int, v); float a = v + __builtin_bit_cast(float, __builtin_amdgcn_update_dpp(0, x, 0xB1, 0xF, 0xF, false));
    x = __builtin_bit_cast(int, a); return a + __builtin_bit_cast(float, __builtin_amdgcn_update_dpp(0, x, 0x4E, 0xF, 0xF, false));
}
__device__ __forceinline__ int wave_sum_dpp(int x) {
    x += __builtin_amdgcn_update_dpp(0, x, 0x111, 0xF, 0xF, true); x += __builtin_amdgcn_update_dpp(0, x, 0x112, 0xF, 0xF, true);
    x += __builtin_amdgcn_update_dpp(0, x, 0x114, 0xF, 0xF, true); x += __builtin_amdgcn_update_dpp(0, x, 0x118, 0xF, 0xF, true);
    x += __builtin_amdgcn_update_dpp(0, x, 0x142, 0xA, 0xF, false); x += __builtin_amdgcn_update_dpp(0, x, 0x143, 0xC, 0xF, false);
    return __builtin_amdgcn_readlane(x, 63);
}
__device__ __forceinline__ int wave_scan_dpp(int x) {
    x += __builtin_amdgcn_update_dpp(0, x, 0x111, 0xF, 0xF, true); x += __builtin_amdgcn_update_dpp(0, x, 0x112, 0xF, 0xF, true);
    x += __builtin_amdgcn_update_dpp(0, x, 0x114, 0xF, 0xF, true); x += __builtin_amdgcn_update_dpp(0, x, 0x118, 0xF, 0xF, true);
    x += __builtin_amdgcn_update_dpp(0, x, 0x142, 0xA, 0xF, false); x += __builtin_amdgcn_update_dpp(0, x, 0x143, 0xC, 0xF, false);
    return x;
}
#define TK_CNT1(acc, key, cand) asm("v_cmp_ge_u32 vcc, %1, %2\n\tv_addc_co_u32 %0, vcc, 0, %0, vcc" : "+v"(acc) : "v"(key), "v"(cand) : "vcc")
template <int N> __device__ __forceinline__ int lane_count_ge(const unsigned (&k)[N], unsigned cand) {
    int c0 = 0, c1 = 0, c2 = 0, c3 = 0;
#pragma unroll
    for (int i = 0; i < N; ++i) { if ((i & 3) == 0) TK_CNT1(c0, k[i], cand); else if ((i & 3) == 1) TK_CNT1(c1, k[i], cand); else if ((i & 3) == 2) TK_CNT1(c2, k[i], cand); else TK_CNT1(c3, k[i], cand); }
    return (c0 + c1) + (c2 + c3);
}
__device__ __forceinline__ unsigned wave_max_dpp(unsigned x) {
    x = max(x, (unsigned)__builtin_amdgcn_update_dpp(0, (int)x, 0x111, 0xF, 0xF, true)); x = max(x, (unsigned)__builtin_amdgcn_update_dpp(0, (int)x, 0x112, 0xF, 0xF, true));
    x = max(x, (unsigned)__builtin_amdgcn_update_dpp(0, (int)x, 0x114, 0xF, 0xF, true)); x = max(x, (unsigned)__builtin_amdgcn_update_dpp(0, (int)x, 0x118, 0xF, 0xF, true));
    x = max(x, (unsigned)__builtin_amdgcn_update_dpp((int)x, (int)x, 0x142, 0xA, 0xF, false)); x = max(x, (unsigned)__builtin_amdgcn_update_dpp((int)x, (int)x, 0x143, 0xC, 0xF, false));
    return (unsigned)__builtin_amdgcn_readlane((int)x, 63);
}
template <int N> __device__ __forceinline__ void bisect_keys(const unsigned (&k)[N], int target, unsigned& prefix, bool& exact, unsigned prefix0 = 0u, int bit0 = 31) {
    prefix = prefix0; exact = false;
    for (int bit = bit0; bit >= 0; --bit) { const unsigned cand = prefix | (1u << bit);
        const int cnt = wave_sum_dpp(lane_count_ge<N>(k, cand));
        if (cnt >= target) { prefix = cand; if (cnt == target) { exact = true; break; } } }
}
template <int NR> __device__ __forceinline__ void topk_core(const unsigned (&k)[NR], int nw, LAS unsigned* mrow, int lane, LAS unsigned* cbuf) {
    unsigned prefix = 0u; bool exact = false, have = false;
    if constexpr (NR >= 32) {
        constexpr int NS = NR / 8; unsigned ks[NS];
#pragma unroll
        for (int j = 0; j < NS; ++j) ks[j] = k[4 + 8 * j];
        const int ns = (nw + 3) >> 3, rs = (352 * ns + nw - 1) / nw;
        unsigned L; bool exs; bisect_keys<NS>(ks, rs, L, exs);
        const int cl = lane_count_ge<NR>(k, L), incl = wave_scan_dpp(cl), C = __builtin_amdgcn_readlane(incl, 63);
        if (C >= 256 && C <= 512) {
            int off = incl - cl;
#pragma unroll
            for (int i = 0; i < NR; ++i) { const bool in = k[i] >= L; cbuf[in ? off : 512 + lane] = k[i]; off += in ? 1 : 0; }
            unsigned kc[8];
#pragma unroll
            for (int j = 0; j < 8; ++j) kc[j] = cbuf[j * 64 + lane];
            asm volatile("" ::: "memory");
#pragma unroll
            for (int j = 0; j < 8; ++j) kc[j] = (j * 64 + lane < C) ? kc[j] : 0u;
            unsigned kmx = kc[0];
#pragma unroll
            for (int j = 1; j < 8; ++j) kmx = max(kmx, kc[j]);
            kmx = wave_max_dpp(kmx);
            const unsigned dx = L ^ kmx; const int hb = dx ? 31 - __builtin_clz(dx) : -1;
            bisect_keys<8>(kc, 256, prefix, exact, hb >= 31 ? 0u : ((L >> (hb + 1)) << (hb + 1)), hb);
            if (exact && prefix < L) prefix = L;
            have = true;
        }
    }
    if (!have) bisect_keys<NR>(k, 256, prefix, exact);
    if (exact) {
#pragma unroll
        for (int i = 0; i < NR; ++i) { const u64 w = __ballot(k[i] >= prefix); if (i < nw && lane == 0) { mrow[2 * i] = (unsigned)w; mrow[2 * i + 1] = (unsigned)(w >> 32); } }
    } else {
        int n_gt = 0;
#pragma unroll
        for (int i = 0; i < NR; ++i) n_gt += __popcll(__ballot(k[i] > prefix));
        const int allowed = 256 - n_gt; int running = 0; const u64 lt = (1ull << lane) - 1ull;
#pragma unroll
        for (int i = 0; i < NR; ++i) { const bool gt = k[i] > prefix, eq = k[i] == prefix; const u64 eqb = __ballot(eq); const int rank = running + __popcll(eqb & lt); running += __popcll(eqb);
            const u64 w = __ballot(gt || (eq && rank < allowed)); if (i < nw && lane == 0) { mrow[2 * i] = (unsigned)w; mrow[2 * i + 1] = (unsigned)(w >> 32); } }
    }
}
constexpr int SCP = 2052;
__device__ __forceinline__ void idx_scores16(const bf16* IK, LAS unsigned* sc, int b, int t_lo, int t_hi, int wave, int lane, const bf16x8 (&qf)[2][4], const f32x4 (&wq)[2][4]) {
    asm volatile("" : "+v"(lane));
    const int r32 = lane & 31, hi = lane >> 5;
    const bf16* kbase = IK + (size_t)b * (SEQ * 64) + lane * 8;
    bf16x8 kn[2][4];
#pragma unroll
    for (int g = 0; g < 2; ++g) { const int tt = t_lo + wave + 8 * g, tc = tt < t_hi ? tt : t_hi - 1;
#pragma unroll
        for (int d0 = 0; d0 < 4; ++d0) kn[g][d0] = *(const bf16x8*)(kbase + tc * 2048 + d0 * 512); }
    for (int t = t_lo + wave; t < t_hi; t += 16) {
        bf16x8 kf[2][4];
#pragma unroll
        for (int g = 0; g < 2; ++g)
#pragma unroll
            for (int d0 = 0; d0 < 4; ++d0) kf[g][d0] = kn[g][d0];
        if (t + 16 < t_hi) {
#pragma unroll
            for (int g = 0; g < 2; ++g) { const int tt = t + 16 + 8 * g, tc = tt < t_hi ? tt : t_hi - 1;
#pragma unroll
                for (int d0 = 0; d0 < 4; ++d0) kn[g][d0] = *(const bf16x8*)(kbase + tc * 2048 + d0 * 512); } }
#pragma unroll
        for (int g = 0; g < 2; ++g) { const int tt = t + 8 * g;
            if (tt < t_hi) {
#pragma unroll
                for (int qg = 0; qg < 2; ++qg) {
                    f32x16 d;
#pragma unroll
                    for (int r = 0; r < 16; ++r) d[r] = 0.f;
#pragma unroll
                    for (int d0 = 0; d0 < 4; ++d0) d = __builtin_amdgcn_mfma_f32_32x32x16_bf16(qf[qg][d0], kf[g][d0], d, 0, 0, 0);
#pragma unroll
                    for (int k4 = 0; k4 < 4; ++k4) { float sv = 0.f;
#pragma unroll
                        for (int e = 0; e < 4; ++e) sv += wq[qg][k4][e] * __builtin_amdgcn_fmed3f(d[4 * k4 + e], 0.f, INFINITY);
                        sc[(8 * qg + 2 * k4 + hi) * SCP + (tt - t_lo) * 32 + r32] = fkey(sv + 0.0f); }
                }
            }
        }
    }
}
template <int NR> __device__ __forceinline__ void idx_select_row(const unsigned (&k)[NR], int nw, LAS unsigned* mrow, LAS unsigned* cbuf, unsigned* mg_row, int lane) {
    topk_core<NR>(k, nw, mrow, lane, cbuf);
    const int nt = 2 * nw;
    for (int kb = lane; kb < nt; kb += 64) mg_row[kb * 64] = mrow[kb];
}
__device__ __forceinline__ void phase_idx(Frame& F) {
    LAS unsigned* sc = (LAS unsigned*)F.lds;
    constexpr int MST = 136; LAS unsigned* mst = (LAS unsigned*)(F.lds + 16 * SCP * 4) + F.wave * MST;
    const int lane = F.lane, r32 = lane & 31, hi = lane >> 5, qq = r32 >> 2, hd = r32 & 3;
    __syncthreads();
    for (int u = blockIdx.x; u < BATCH * 256; u += F.G) {
        const int wgv = u & 255, i8 = u >> 8; const int b = wgv & 7, jc = wgv >> 3; const int chunk = (i8 & 4) ? 63 - jc : jc; const int q0 = chunk * 64 + (i8 & 3) * 16;
        const size_t row0 = (size_t)b * SEQ + q0; const int c = q0 >> 6, nw = c + 1, nt = 2 * nw;
        unsigned* mg = (unsigned*)F.MASK + (size_t)(b * 64 + c) * (128 * 64) + (q0 & 63);
        if (nw <= 4) { int tidl = F.tid; asm volatile("" : "+v"(tidl)); const int kbq = tidl >> 4, r16 = tidl & 15; if (kbq < nt) mg[kbq * 64 + r16] = ~0u; continue; }
        bf16x8 qf[2][4]; f32x4 wq[2][4];
#pragma unroll
        for (int qg = 0; qg < 2; ++qg) {
#pragma unroll
            for (int d0 = 0; d0 < 4; ++d0) qf[qg][d0] = *(const bf16x8*)(F.IQ + (row0 + 8 * qg + qq) * 256 + hd * 64 + d0 * 16 + hi * 8);
#pragma unroll
            for (int k4 = 0; k4 < 4; ++k4) wq[qg][k4] = *(const f32x4*)(F.IW + (row0 + 8 * qg + 2 * k4 + hi) * 4); }
        LAS unsigned* srA = sc + F.wave * SCP; LAS unsigned* srB = sc + (F.wave + 8) * SCP;
        int ll = lane; asm volatile("" : "+v"(ll));
        unsigned* mgA = mg + F.wave; unsigned* mgB = mg + F.wave + 8;
        if (nw <= 32) {
            idx_scores16(F.IK, sc, b, 0, nt, F.wave, lane, qf, wq);
            __syncthreads();
            if (nw <= 16) {
                { unsigned k[16];
#pragma unroll
                  for (int i = 0; i < 16; ++i) k[i] = srA[i * 64 + ll];
                  asm volatile("" ::: "memory");
#pragma unroll
                  for (int i = 0; i < 16; ++i) k[i] = (i < nw) ? k[i] : 0u;
                  idx_select_row<16>(k, nw, mst, srA, mgA, ll); }
                { unsigned k[16];
#pragma unroll
                  for (int i = 0; i < 16; ++i) k[i] = srB[i * 64 + ll];
                  asm volatile("" ::: "memory");
#pragma unroll
                  for (int i = 0; i < 16; ++i) k[i] = (i < nw) ? k[i] : 0u;
                  idx_select_row<16>(k, nw, mst, srB, mgB, ll); }
            } else {
                { unsigned k[32];
#pragma unroll
                  for (int i = 0; i < 32; ++i) k[i] = srA[i * 64 + ll];
                  asm volatile("" ::: "memory");
#pragma unroll
                  for (int i = 0; i < 32; ++i) k[i] = (i < nw) ? k[i] : 0u;
                  idx_select_row<32>(k, nw, mst, srA, mgA, ll); }
                { unsigned k[32];
#pragma unroll
                  for (int i = 0; i < 32; ++i) k[i] = srB[i * 64 + ll];
                  asm volatile("" ::: "memory");
#pragma unroll
                  for (int i = 0; i < 32; ++i) k[i] = (i < nw) ? k[i] : 0u;
                  idx_select_row<32>(k, nw, mst, srB, mgB, ll); }
            }
            __syncthreads();
        } else {
            idx_scores16(F.IK, sc, b, 0, 64, F.wave, lane, qf, wq);
            __syncthreads();
            unsigned ka[32], kb_[32];
#pragma unroll
            for (int i = 0; i < 32; ++i) { ka[i] = srA[i * 64 + ll]; kb_[i] = srB[i * 64 + ll]; }
            __syncthreads();
            idx_scores16(F.IK, sc, b, 64, nt, F.wave, lane, qf, wq);
            __syncthreads();
            const int nw2 = nw - 32;
            if (nw <= 48) {
                { unsigned k[48];
#pragma unroll
                  for (int i = 0; i < 32; ++i) k[i] = ka[i];
#pragma unroll
                  for (int i = 0; i < 16; ++i) k[32 + i] = srA[i * 64 + ll];
                  asm volatile("" ::: "memory");
#pragma unroll
                  for (int i = 0; i < 16; ++i) k[32 + i] = (i < nw2) ? k[32 + i] : 0u;
                  idx_select_row<48>(k, nw, mst, srA, mgA, ll); }
                { unsigned k[48];
#pragma unroll
                  for (int i = 0; i < 32; ++i) k[i] = kb_[i];
#pragma unroll
                  for (int i = 0; i < 16; ++i) k[32 + i] = srB[i * 64 + ll];
                  asm volatile("" ::: "memory");
#pragma unroll
                  for (int i = 0; i < 16; ++i) k[32 + i] = (i < nw2) ? k[32 + i] : 0u;
                  idx_select_row<48>(k, nw, mst, srB, mgB, ll); }
            } else {
                { unsigned k[64];
#pragma unroll
                  for (int i = 0; i < 32; ++i) k[i] = ka[i];
#pragma unroll
                  for (int i = 0; i < 32; ++i) k[32 + i] = srA[i * 64 + ll];
                  asm volatile("" ::: "memory");
#pragma unroll
                  for (int i = 0; i < 32; ++i) k[32 + i] = (i < nw2) ? k[32 + i] : 0u;
                  idx_select_row<64>(k, nw, mst, srA, mgA, ll); }
                { unsigned k[64];
#pragma unroll
                  for (int i = 0; i < 32; ++i) k[i] = kb_[i];
#pragma unroll
                  for (int i = 0; i < 32; ++i) k[32 + i] = srB[i * 64 + ll];
                  asm volatile("" ::: "memory");
#pragma unroll
                  for (int i = 0; i < 32; ++i) k[32 + i] = (i < nw2) ? k[32 + i] : 0u;
                  idx_select_row<64>(k, nw, mst, srB, mgB, ll); }
            }
            __syncthreads();
        }
    }
}

typedef float f32x4v __attribute__((ext_vector_type(4)));
template <int SH> __device__ __forceinline__ float dpp_shr(float v, float ident) {
    return __builtin_bit_cast(float, __builtin_amdgcn_update_dpp(__builtin_bit_cast(int, ident), __builtin_bit_cast(int, v), 0x110 + SH, 0xF, 0xF, false));
}
__device__ __forceinline__ float row_last(float v, int lane) { return shfl_from(v, (lane & 48) | 15); }
struct LruIn { bf16x8 x3[2]; uint2 u3; uint2 cyw; };
__device__ __forceinline__ void lru_load(LruIn& I, const bf16* CX, const bf16* CY, size_t brow, int t0, int g, int q4, int lane) {
    const int tk = lane & 15, lg = lane >> 4; const int t = t0 + tk;
#pragma unroll
    for (int hf = 0; hf < 2; ++hf) I.x3[hf] = *(const bf16x8*)(CX + (brow + t) * 512 + g * 64 + 32 * hf + 8 * lg);
    I.u3 = *(const uint2*)(CX + (brow + t) * 512 + g * 64 + 16 * q4 + 4 * lg);
    I.cyw = *(const uint2*)(CY + (brow + t) * 512 + g * 64 + 16 * q4 + 4 * lg);
}
template <int N> __device__ __forceinline__ unsigned tap_shift(unsigned cur, unsigned prev) {
    const int a = __builtin_amdgcn_update_dpp(0, (int)prev, 0x120 + N, 0xF, 0xF, false);
    return (unsigned)__builtin_amdgcn_update_dpp(a, (int)cur, 0x110 + N, 0xF, 0xF, false);
}
template <int N> __device__ __forceinline__ bf16x8 tap_shift8(const bf16x8& cur, const bf16x8& prev) {
    const v4u c = __builtin_bit_cast(v4u, cur), p = __builtin_bit_cast(v4u, prev); v4u r;
    r.x = tap_shift<N>(c.x, p.x); r.y = tap_shift<N>(c.y, p.y); r.z = tap_shift<N>(c.z, p.z); r.w = tap_shift<N>(c.w, p.w); return __builtin_bit_cast(bf16x8, r);
}
__device__ __forceinline__ void lru_subtile(const LruIn& I, const LruIn& P, bf16* Y0, bf16* Y1, size_t brow, int t0, int g, int q4, int lane,
        const bf16x8 (&Awa)[8], const bf16x8 (&Awx)[8], const float (&cw)[4][4], const float (&cb)[4], const float (&ca)[4], const float (&cx_)[4], const float (&sp)[4],
        float (&Arun)[4], float (&hc)[4]) {
    const int tk = lane & 15, lg = lane >> 4; const int t = t0 + tk;
    f32x4v accA = {0.f, 0.f, 0.f, 0.f}, accX = {0.f, 0.f, 0.f, 0.f};
    bf16x8 bx[8]; uint2 uw[4];
#pragma unroll
    for (int hf = 0; hf < 2; ++hf) { bx[0 + hf] = tap_shift8<3>(I.x3[hf], P.x3[hf]); bx[2 + hf] = tap_shift8<2>(I.x3[hf], P.x3[hf]); bx[4 + hf] = tap_shift8<1>(I.x3[hf], P.x3[hf]); bx[6 + hf] = I.x3[hf]; }
    uw[0].x = tap_shift<3>(I.u3.x, P.u3.x); uw[0].y = tap_shift<3>(I.u3.y, P.u3.y); uw[1].x = tap_shift<2>(I.u3.x, P.u3.x); uw[1].y = tap_shift<2>(I.u3.y, P.u3.y);
    uw[2].x = tap_shift<1>(I.u3.x, P.u3.x); uw[2].y = tap_shift<1>(I.u3.y, P.u3.y); uw[3] = I.u3;
#pragma unroll
    for (int ks = 0; ks < 8; ++ks) { accA = __builtin_amdgcn_mfma_f32_16x16x32_bf16(Awa[ks], bx[ks], accA, 0, 0, 0); accX = __builtin_amdgcn_mfma_f32_16x16x32_bf16(Awx[ks], bx[ks], accX, 0, 0, 0); }
    float u[4] = {cb[0], cb[1], cb[2], cb[3]};
#pragma unroll
    for (int q = 0; q < 4; ++q) { const uint2 w = uw[q];
        u[0] += cw[q][0] * bflo(w.x); u[1] += cw[q][1] * bfhi(w.x); u[2] += cw[q][2] * bflo(w.y); u[3] += cw[q][3] * bfhi(w.y); }
    const uint2 cyw = I.cyw;
    const float cy[4] = {bflo(cyw.x), bfhi(cyw.x), bflo(cyw.y), bfhi(cyw.y)};
    float A[4], B[4];
#pragma unroll
    for (int r = 0; r < 4; ++r) { const float rg = __builtin_amdgcn_rcpf(1.f + __expf(-(accA[r] + ca[r]))), ig = __builtin_amdgcn_rcpf(1.f + __expf(-(accX[r] + cx_[r])));
        const float la = -8.f * rg * sp[r]; const float y2 = 2.f * la; A[r] = __expf(la);
        const float om = (y2 > -0.3f) ? -y2 * (1.f + y2 * (0.5f + y2 * (0.16666667f + y2 * 0.041666668f))) : 1.f - A[r] * A[r];
        B[r] = __builtin_amdgcn_sqrtf(om) * (ig * u[r]); }
#pragma unroll
    for (int r = 0; r < 4; ++r) {
        { const float ap = dpp_shr<1>(A[r], 1.f), bp = dpp_shr<1>(B[r], 0.f); B[r] = A[r] * bp + B[r]; A[r] *= ap; }
        { const float ap = dpp_shr<2>(A[r], 1.f), bp = dpp_shr<2>(B[r], 0.f); B[r] = A[r] * bp + B[r]; A[r] *= ap; }
        { const float ap = dpp_shr<4>(A[r], 1.f), bp = dpp_shr<4>(B[r], 0.f); B[r] = A[r] * bp + B[r]; A[r] *= ap; }
        { const float ap = dpp_shr<8>(A[r], 1.f), bp = dpp_shr<8>(B[r], 0.f); B[r] = A[r] * bp + B[r]; A[r] *= ap; }
    }
    float y0[4], y1[4];
#pragma unroll
    for (int r = 0; r < 4; ++r) { const float h = B[r] + A[r] * hc[r], ap = A[r] * Arun[r]; const float z = 0.7978845608028654f * (cy[r] + 0.044715f * cy[r] * cy[r] * cy[r]);
        const float gl = cy[r] * __builtin_amdgcn_rcpf(1.f + __expf(-2.f * z)); y0[r] = h * gl; y1[r] = ap * gl; hc[r] = row_last(h, lane); Arun[r] = row_last(ap, lane); }
    const size_t off = (brow + t) * 512 + g * 64 + 16 * q4 + 4 * lg, off0 = (brow + t) * 1024 + g * 64 + 16 * q4 + 4 * lg;
    uint2 o; o.x = cvtpk(y0[0], y0[1]); o.y = cvtpk(y0[2], y0[3]); *(uint2*)(Y0 + off0) = o;
    o.x = cvtpk(y1[0], y1[1]); o.y = cvtpk(y1[2], y1[3]); *(uint2*)(Y1 + off) = o;
}
__device__ __forceinline__ void phase_lru(Frame& F, int l) {
    LAS float* agg = (LAS float*)(F.lds + 36864);
    const int lane = F.lane, tk = lane & 15, lg = lane >> 4;
    bf16* Y1 = F.YC; bf16* Y0 = F.YCAT + 512;
    for (int u = blockIdx.x; u < 256; u += F.G) {
        const int b = u & 7, g = u >> 5, q4 = (u >> 3) & 3; const size_t brow = (size_t)b * SEQ;
        const float* wa = F.lru_wa + (size_t)(l * 8 + g) * 4096; const float* wx = F.lru_wx + (size_t)(l * 8 + g) * 4096; const float* cwp = F.conv_w + (size_t)l * 4 * 512 + g * 64; const float* cbp = F.conv_b + l * 512 + g * 64;
        bf16x8 Awa[8], Awx[8];
#pragma unroll
        for (int ks = 0; ks < 8; ++ks) { const int q = ks >> 1; v4u pa, px; unsigned wsa[4], wsx[4];
#pragma unroll
            for (int j2 = 0; j2 < 4; ++j2) { const int i0 = 32 * (ks & 1) + 8 * lg + 2 * j2, oc = 16 * q4 + tk;
                const float c0 = cwp[q * 512 + i0], c1 = cwp[q * 512 + i0 + 1];
                wsa[j2] = cvtpk(c0 * wa[i0 * 64 + oc], c1 * wa[(i0 + 1) * 64 + oc]); wsx[j2] = cvtpk(c0 * wx[i0 * 64 + oc], c1 * wx[(i0 + 1) * 64 + oc]); }
            pa.x = wsa[0]; pa.y = wsa[1]; pa.z = wsa[2]; pa.w = wsa[3]; px.x = wsx[0]; px.y = wsx[1]; px.z = wsx[2]; px.w = wsx[3];
            Awa[ks] = __builtin_bit_cast(bf16x8, pa); Awx[ks] = __builtin_bit_cast(bf16x8, px); }
        float cw[4][4], cb[4], ca[4], cx_[4], sp[4];
#pragma unroll
        for (int r = 0; r < 4; ++r) { const int oc = 16 * q4 + 4 * lg + r, cg = g * 64 + oc;
#pragma unroll
            for (int q = 0; q < 4; ++q) cw[q][r] = cwp[q * 512 + oc];
            cb[r] = cbp[oc]; float sa = 0.f, sx = 0.f;
#pragma unroll
            for (int i4 = 0; i4 < 4; ++i4) { const int i = tk + 16 * i4; const float bi = cbp[i]; sa += bi * wa[i * 64 + oc]; sx += bi * wx[i * 64 + oc]; }
#pragma unroll
            for (int o = 1; o < 16; o <<= 1) { sa += shflx(sa, o); sx += shflx(sx, o); }
            ca[r] = sa + F.lru_ba[l * 512 + cg]; cx_[r] = sx + F.lru_bx[l * 512 + cg]; sp[r] = log1pf(expf(-F.lru_lambda[l * 512 + cg])); }
        float Arun[4] = {1.f, 1.f, 1.f, 1.f}, hc[4] = {0.f, 0.f, 0.f, 0.f};
        const int tseg = F.wave * 512;
        LruIn cur, prv; lru_load(cur, F.CX, F.CY, brow, tseg, g, q4, lane);
        lru_load(prv, F.CX, F.CY, brow, tseg >= 16 ? tseg - 16 : 0, g, q4, lane);
        if (tseg == 0) { prv.x3[0] = (bf16x8){0, 0, 0, 0, 0, 0, 0, 0}; prv.x3[1] = (bf16x8){0, 0, 0, 0, 0, 0, 0, 0}; prv.u3 = (uint2){0u, 0u}; }
#pragma unroll 2
        for (int s = 0; s < 32; ++s) { LruIn nxt;
            lru_load(nxt, F.CX, F.CY, brow, tseg + 16 * (s + 1 < 32 ? s + 1 : s), g, q4, lane);
            asm volatile("" ::: "memory");
            lru_subtile(cur, prv, Y0, Y1, brow, tseg + 16 * s, g, q4, lane, Awa, Awx, cw, cb, ca, cx_, sp, Arun, hc);
            prv = cur; cur = nxt; }
        __syncthreads();
        if (tk == 0) {
#pragma unroll
            for (int r = 0; r < 4; ++r) { agg[F.wave * 32 + 4 * lg + r] = Arun[r]; agg[F.wave * 32 + 16 + 4 * lg + r] = hc[r]; } }
        __syncthreads();
        float hin[4] = {0.f, 0.f, 0.f, 0.f};
        for (int w = 0; w < F.wave; ++w) {
#pragma unroll
            for (int r = 0; r < 4; ++r) hin[r] = agg[w * 32 + 4 * lg + r] * hin[r] + agg[w * 32 + 16 + 4 * lg + r]; }
        if (F.wave > 0) {
            asm volatile("s_waitcnt vmcnt(0)" ::: "memory");
#pragma unroll 1
            for (int s8 = 0; s8 < 32; s8 += 8) { uint2 a0[8], a1[8];
#pragma unroll
                for (int j = 0; j < 8; ++j) { const size_t row = brow + tseg + 16 * (s8 + j) + tk; a0[j] = *(const uint2*)(Y0 + row * 1024 + g * 64 + 16 * q4 + 4 * lg); a1[j] = *(const uint2*)(Y1 + row * 512 + g * 64 + 16 * q4 + 4 * lg); }
#pragma unroll
                for (int j = 0; j < 8; ++j) { const size_t row = brow + tseg + 16 * (s8 + j) + tk; uint2 o;
                    o.x = cvtpk(bflo(a0[j].x) + bflo(a1[j].x) * hin[0], bfhi(a0[j].x) + bfhi(a1[j].x) * hin[1]); o.y = cvtpk(bflo(a0[j].y) + bflo(a1[j].y) * hin[2], bfhi(a0[j].y) + bfhi(a1[j].y) * hin[3]);
                    *(uint2*)(Y0 + row * 1024 + g * 64 + 16 * q4 + 4 * lg) = o; } }
        }
    }
}

struct Args { const float* in[20]; float* out; unsigned char* ws; int l_lo, l_hi, ph_lo, ph_hi; };
__device__ __forceinline__ void make_frame(Frame& F, const Args& args, unsigned char* lds_) {
    int tid = wg_tid(); asm volatile("" : "+v"(tid));
    const __attribute__((address_space(4))) unsigned char* ka = (const __attribute__((address_space(4))) unsigned char*)__builtin_amdgcn_kernarg_segment_ptr(); asm volatile("" : "+s"(ka));
#define KARG(k) ((const float*)(GAS const float*)(*(const unsigned long long __attribute__((address_space(4)))*)(ka + 8 * (k))))
    GAS unsigned char* wsg = (GAS unsigned char*)(*(const unsigned long long __attribute__((address_space(4)))*)(ka + 168)); unsigned char* ws = (unsigned char*)wsg;
    F.lds = (LAS unsigned char*)lds_; F.MISC = (volatile LAS unsigned*)(F.lds + MISC_OFF);
    F.tid = tid; F.lane = tid & 63; F.wave = __builtin_amdgcn_readfirstlane(tid >> 6); F.G = gridDim.x;
    F.ctl = (gu32*)(ws + WS_CTL);
    F.x = KARG(0); F.g_mix = KARG(1); F.w_in = KARG(2); F.qk_gain_a = KARG(3); F.rel_bias = KARG(4); F.qk_gain_b = KARG(5); F.g_idx_k = KARG(6);
    F.conv_w = KARG(7); F.conv_b = KARG(8); F.lru_wa = KARG(9); F.lru_ba = KARG(10); F.lru_wx = KARG(11); F.lru_bx = KARG(12); F.lru_lambda = KARG(13);
    F.b_gate = KARG(14); F.w_branch = KARG(15); F.w_out = KARG(16); F.g_ffn = KARG(17); F.w_ffn_in = KARG(18); F.w_ffn_out = KARG(19); F.out = (float*)KARG(20);
#undef KARG
    F.rcos = (float*)(ws + WS_ROPE); F.rsin = F.rcos + SEQ * 32; F.SS = (float*)(ws + WS_SS);
    F.W = (bf16*)(ws + WS_W); F.W2a = (bf16*)(ws + 462 * MiB); F.W2b = (bf16*)((unsigned char*)F.out + 32 * MiB); F.H = (bf16*)(ws + WS_H); F.YC = (bf16*)F.out; F.YCAT = (bf16*)F.out + (size_t)32 * 1024 * 1024;
    F.QA = (bf16*)(ws + WS_QA); F.QB = (bf16*)(ws + WS_QB); F.KA = (bf16*)(ws + WS_KA); F.VA = (bf16*)(ws + WS_VA); F.KB = (bf16*)(ws + WS_KB); F.VB = (bf16*)(ws + WS_VB);
    F.IQ = (bf16*)(ws + WS_IQ); F.IK = (bf16*)(ws + WS_IK); F.IW = (float*)(ws + WS_IW); F.CX = (bf16*)(ws + WS_CX); F.CY = (bf16*)(ws + WS_CY);
    F.GT = (bf16*)(ws + WS_GT); F.ACT = (bf16*)(ws + WS_ACT); F.MG = (bf16*)(ws + WS_MG); F.MASK = (u64*)(ws + WS_MASK);
}
template <int PHM> __global__ void __launch_bounds__(NWAVES * 64, 2) fwd(Args args) {
    { LAS unsigned char* l3 = (LAS unsigned char*)lds; for (int u = threadIdx.x; u < (LDS_BYTES - LDSCTL_OFF) / 4; u += NWAVES * 64) ((LAS unsigned*)(l3 + LDSCTL_OFF))[u] = 0u; }
    __syncthreads();
    static_assert(WGT_LDS_OFF == MISC_OFF + 256 && WGT_LDS_OFF + 256 <= LDS_BYTES, "wave-index table inside the LDS control area");
    if ((threadIdx.x & 63) == 0) ((LAS unsigned*)((LAS unsigned char*)lds + WGT_LDS_OFF))[wgt_slot()] = threadIdx.x >> 6;
    __syncthreads();
    XcdBarrier bar; bar.bar = (unsigned*)(args.ws + WS_CTL) + CW_BAR; bar.x = 0; bar.st = nullptr;
    if (!MK_PER_PHASE) bar = xcd_barrier_post((unsigned*)(args.ws + WS_CTL) + CW_BAR, (volatile LAS unsigned*)((LAS unsigned char*)lds + MISC_OFF) + 8);
#define GRID_BAR() do { if (!MK_PER_PHASE) xcd_barrier(bar); } while (0)
    const int plo = args.ph_lo, phi = args.ph_hi; (void)plo; (void)phi;
#ifndef PHMASK
#define PHMASK 0x1ff
#endif
#if MK_PER_PHASE
#define IN(k) (((PHMASK >> (k)) & 1) && ((PHM >> (k)) & 1) && plo <= (k) && (k) < phi)
#else
#define IN(k) (((PHMASK >> (k)) & 1) && ((PHM >> (k)) & 1))
#endif
    bool first = true;
    for (int l = MK_PER_PHASE ? args.l_lo : 0; l < (MK_PER_PHASE ? args.l_hi : DEPTH); ++l) {
        if (IN(0) && (MK_PER_PHASE || l == 0)) { if (!first) GRID_BAR(); first = false; Frame F; make_frame(F, args, lds); phase_weights(F, l); if (l == 0) phase_xb0(F, F.x, F.SS); }
        if (IN(1)) { if (!first) GRID_BAR(); first = false; Frame F; make_frame(F, args, lds);
            pg8::Gemm g{F.H, wset(F, l).in, M, NIN, D}; pg8::StaticOrder S; S.init(M, NIN, F.G, (int)blockIdx.x);
            pg8::EpiIn E{F.QA, F.KA, F.VA, F.QB, F.KB, F.VB, F.IQ, F.IK, F.IW, F.CX, F.CY, F.GT, F.qk_gain_a + l * 128, F.qk_gain_b + l * 128, F.g_idx_k + l * 64, F.b_gate + l * 3072, F.rcos, F.rsin, F.SS + (size_t)(2 * l) * M * 16, (LAS float*)(F.lds + XTRA_OFF)};
            pg8::gemm_phase<pg8::EpiIn, pg8::StaticOrder, PG8_ALIGN, PG8_SP2>(F.lds + RING_OFF, g, S, E); }
        if (IN(2)) { if (!first) GRID_BAR(); first = false; { Frame F0; make_frame(F0, args, lds); phase_lru(F0, l); } __syncthreads(); Frame F; make_frame(F, args, lds); phase_attn_a(F, l); __syncthreads(); phase_idx(F);
            if (F.G == 256) { asm volatile("s_waitcnt vmcnt(0)" ::: "memory"); __syncthreads(); } else GRID_BAR();
            { Frame F2; make_frame(F2, args, lds); phase_attn_b(F2, l); }
            if (!MK_PER_PHASE && l + 1 < DEPTH) { __syncthreads();
                Frame F3; make_frame(F3, args, lds); phase_weights(F3, l + 1, (unsigned*)(args.ws + WS_CTL) + 64 + l); } }
        if (IN(4)) { if (!first) GRID_BAR(); first = false; Frame F; make_frame(F, args, lds);
#ifndef DBG_HALF
#define DBG_HALF 0
#endif
#ifndef DBG_SKIP_BR
#define DBG_SKIP_BR 0
#endif
            pg8::Gemm g{F.YCAT, wset(F, l).ba, M, D, D}; pg8::StaticOrder S; S.init(M, D, F.G, (int)blockIdx.x); pg8::EpiGateCat E{F.MG, F.GT};
            pg8::gemm_phase<pg8::EpiGateCat, pg8::StaticOrder, PG8_ALIGN, PG8_SP2, true>(F.lds + RING_OFF, g, S, E); }
        if (IN(5)) { if (!first) GRID_BAR(); first = false; Frame F; make_frame(F, args, lds);
            pg8::Gemm g{F.MG, wset(F, l).out, M, D, D}; pg8::StaticOrder S; S.init(M, D, F.G, (int)blockIdx.x); pg8::EpiResidB E{F.H, F.SS + (size_t)(2 * l + 1) * M * 16, nullptr};
            pg8::gemm_phase<pg8::EpiResidB, pg8::StaticOrder, PG8_ALIGN, PG8_SP2>(F.lds + RING_OFF, g, S, E); }
        if (IN(7)) { if (!first) GRID_BAR(); first = false; Frame F; make_frame(F, args, lds);
            pg8::Gemm g{F.H, wset(F, l).f1, M, NF1, D}; pg8::StaticOrder S; S.init(M, NF1, F.G, (int)blockIdx.x); pg8::EpiSwiGLU E{F.ACT, F.SS + (size_t)(2 * l + 1) * M * 16, (LAS float*)(F.lds + XTRA_OFF)};
            pg8::gemm_phase<pg8::EpiSwiGLU, pg8::StaticOrder, PG8_ALIGN, PG8_SP2>(F.lds + RING_OFF, g, S, E); }
        if (IN(8)) { if (!first) GRID_BAR(); first = false; Frame F; make_frame(F, args, lds);
            pg8::Gemm g{F.ACT, wset(F, l).f2, M, D, FF}; pg8::StaticOrder S; S.init(M, D, F.G, (int)blockIdx.x); pg8::EpiResidB E{F.H, F.SS + (size_t)(2 * l + 2 < 2 * DEPTH ? 2 * l + 2 : 0) * M * 16, (l + 1 < DEPTH) ? (float*)nullptr : F.out};
            pg8::gemm_phase<pg8::EpiResidB, pg8::StaticOrder, PG8_ALIGN, PG8_SP2>(F.lds + RING_OFF, g, S, E); }
    }
#undef IN
}

extern "C" void kernel_launch(void* const* d_in, const int* in_sizes, int n_in, void* d_out, int out_size, void* d_ws, size_t ws_size, hipStream_t stream) {
    static int grid = 0;
    if (grid == 0) {
        if (n_in != 20 || in_sizes[0] != M * D || out_size != M * D || ws_size < WS_END) { fprintf(stderr, "kernel_launch: unexpected problem shape / workspace (n_in %d, ws %zu); nothing launched\n", n_in, ws_size); grid = -1; return; }
        int dev = 0, cus = 0, per_cu = 0;
        if (hipGetDevice(&dev) != hipSuccess || hipDeviceGetAttribute(&cus, hipDeviceAttributeMultiprocessorCount, dev) != hipSuccess) { grid = -1; return; }
#if MK_PER_PHASE
        const void* fns[NPH] = {(const void*)fwd<1>, (const void*)fwd<2>, (const void*)fwd<4>, (const void*)fwd<8>, (const void*)fwd<16>, (const void*)fwd<32>, (const void*)fwd<64>, (const void*)fwd<128>, (const void*)fwd<256>};
        for (int i = 0; i < NPH; ++i) if (hipFuncSetAttribute(fns[i], hipFuncAttributeMaxDynamicSharedMemorySize, LDS_BYTES) != hipSuccess) { fprintf(stderr, "kernel_launch: hipFuncSetAttribute failed\n"); grid = -1; return; }
#else
        if (hipFuncSetAttribute((const void*)fwd<0x1ff>, hipFuncAttributeMaxDynamicSharedMemorySize, LDS_BYTES) != hipSuccess) { fprintf(stderr, "kernel_launch: hipFuncSetAttribute failed\n"); grid = -1; return; }
        if (hipOccupancyMaxActiveBlocksPerMultiprocessor(&per_cu, (const void*)fwd<0x1ff>, NWAVES * 64, LDS_BYTES) != hipSuccess || per_cu < 1) fprintf(stderr, "kernel_launch: occupancy query reports %d workgroups per CU\n", per_cu);
#endif
        (void)hipGetLastError(); (void)per_cu;
        grid = cus;
    }
    if (grid < 0) return;
    if (hipMemsetAsync((char*)d_ws + WS_CTL, 0, CTL_ZERO_BYTES, stream) != hipSuccess) return;
    Args a{};
    for (int i = 0; i < 20; ++i) a.in[i] = (const float*)d_in[i];
    a.out = (float*)d_out; a.ws = (unsigned char*)d_ws;
#if MK_PER_PHASE
    for (int l = 0; l < DEPTH; ++l) for (int p = 0; p < NPH; ++p) { a.l_lo = l; a.l_hi = l + 1; a.ph_lo = p; a.ph_hi = p + 1;
        switch (p) {
            case 0: hipLaunchKernelGGL(fwd<1>, dim3(grid), dim3(NWAVES * 64), LDS_BYTES, stream, a); break;
            case 1: hipLaunchKernelGGL(fwd<2>, dim3(grid), dim3(NWAVES * 64), LDS_BYTES, stream, a); break;
            case 2: hipLaunchKernelGGL(fwd<4>, dim3(grid), dim3(NWAVES * 64), LDS_BYTES, stream, a); break;
            case 3: hipLaunchKernelGGL(fwd<8>, dim3(grid), dim3(NWAVES * 64), LDS_BYTES, stream, a); break;
            case 4: hipLaunchKernelGGL(fwd<16>, dim3(grid), dim3(NWAVES * 64), LDS_BYTES, stream, a); break;
            case 5: hipLaunchKernelGGL(fwd<32>, dim3(grid), dim3(NWAVES * 64), LDS_BYTES, stream, a); break;
            case 6: hipLaunchKernelGGL(fwd<64>, dim3(grid), dim3(NWAVES * 64), LDS_BYTES, stream, a); break;
            case 7: hipLaunchKernelGGL(fwd<128>, dim3(grid), dim3(NWAVES * 64), LDS_BYTES, stream, a); break;
            default: hipLaunchKernelGGL(fwd<256>, dim3(grid), dim3(NWAVES * 64), LDS_BYTES, stream, a); break;
        } }
#else
    a.l_lo = 0; a.l_hi = DEPTH; a.ph_lo = 0; a.ph_hi = NPH;
    hipLaunchKernelGGL(fwd<0x1ff>, dim3(grid), dim3(NWAVES * 64), LDS_BYTES, stream, a);
#endif
}
```

```cpp
#include <hip/hip_runtime.h>
#include <cstdio>
#include <cstdint>

#define WGT_LDS_OFF 139840
extern __shared__ __attribute__((aligned(16))) unsigned char lds[];
__device__ __forceinline__ unsigned wgt_slot() { return (unsigned)__builtin_amdgcn_s_getreg((5 << 11) | 4) & 63u; }
__device__ __forceinline__ int wg_lane() { int l; asm volatile("v_mbcnt_lo_u32_b32 %0, -1, 0\n\tv_mbcnt_hi_u32_b32 %0, -1, %0" : "=v"(l)); return l; }
__device__ __forceinline__ int wg_wave() { const volatile __attribute__((address_space(3))) unsigned* tab = (const volatile __attribute__((address_space(3))) unsigned*)((__attribute__((address_space(3))) unsigned char*)lds + WGT_LDS_OFF);
    return __builtin_amdgcn_readfirstlane((int)tab[wgt_slot()]); }
__device__ __forceinline__ int wg_tid() { return wg_wave() * 64 + wg_lane(); }
__device__ __forceinline__ float shflx(float v, int m) { return __builtin_bit_cast(float, __builtin_amdgcn_ds_bpermute((wg_lane() ^ m) << 2, __builtin_bit_cast(int, v))); }
__device__ __forceinline__ float shfl_from(float v, int src) { return __builtin_bit_cast(float, __builtin_amdgcn_ds_bpermute(src << 2, __builtin_bit_cast(int, v))); }
namespace pg8 {
#define PG8_LAS __attribute__((address_space(3)))
typedef unsigned short bf16_t;
typedef short bf16x8 __attribute__((ext_vector_type(8)));
typedef float f32x4 __attribute__((ext_vector_type(4)));
typedef unsigned u32x4 __attribute__((ext_vector_type(4)));
constexpr int BM = 256, BK = 64, HALF = 128, HTB = HALF * BK * 2  , STAGE_BYTES = 8 * HTB, NXCD = 8, WGM = 8;

__host__ __device__ __forceinline__ int lds_byte(int r, int c) { const int st = (r >> 4) * 2 + (c >> 5), rr = r & 15, cc = c & 31, ob = rr * 64 + cc * 2; return st * 1024 + (ob ^ (((ob >> 9) & 1) << 5)); }
__host__ __device__ __forceinline__ void stage_rc(int b, int& R, int& C) { const int st = b / 1024, sb = b % 1024, swz = sb ^ (((sb >> 9) & 1) << 5); R = (st >> 1) * 16 + swz / 64; C = (st & 1) * 32 + (swz % 64) / 2; }
__host__ __device__ __forceinline__ int perm32(int rho) { const int n = rho >> 4, i = rho & 15; return 8 * (i >> 2) + 4 * n + (i & 3); }

struct Unit { int pm, pn; };
struct Gemm { const bf16_t* A; const bf16_t* Bt; int M, N, K; };

struct StaticOrder {
    int nM, nN, nwg, G, c;
    __host__ __device__ void init(int M, int N, int G_, int c_) { nM = M / BM; nN = N / BM; nwg = nM * nN; G = G_; c = c_; }
    __host__ __device__ bool next(int i, Unit& u) const {
        const long L = (long)i * G + c; if (L >= nwg) return false;
        int wgid = (int)L; { const int q = nwg / NXCD, r = nwg % NXCD, xcd = wgid % NXCD, off = wgid / NXCD; wgid = (xcd < r ? xcd * (q + 1) : r * (q + 1) + (xcd - r) * q) + off; }
        const int nig = WGM * nN, gid = wgid / nig, fm = gid * WGM, gsz = (nM - fm) < WGM ? (nM - fm) : WGM;
        u.pm = fm + ((wgid % nig) % gsz); u.pn = (wgid % nig) / gsz; return true;
    }
    __device__ __forceinline__ void a_ready(const Unit&) const {}
    __device__ __forceinline__ void done(const Unit&) const {}
};


typedef float f32x2_t __attribute__((ext_vector_type(2))); typedef __bf16 bf16x2_t __attribute__((ext_vector_type(2)));
__device__ __forceinline__ unsigned cvt_pk_bf16(float lo, float hi) { const f32x2_t v = {lo, hi}; const bf16x2_t b = __builtin_convertvector(v, bf16x2_t); return __builtin_bit_cast(unsigned, b); }
__device__ __forceinline__ u32x4 pack8(const f32x4 a, const f32x4 b) { u32x4 w; w.x = cvt_pk_bf16(a[0], a[1]); w.y = cvt_pk_bf16(a[2], a[3]); w.z = cvt_pk_bf16(b[0], b[1]); w.w = cvt_pk_bf16(b[2], b[3]); return w; }
__device__ __forceinline__ float bflo(unsigned w) { return __builtin_bit_cast(float, w << 16); }
__device__ __forceinline__ float bfhi(unsigned w) { return __builtin_bit_cast(float, w & 0xffff0000u); }
__device__ __forceinline__ float fast_sigmoid(float x) { return __builtin_amdgcn_rcpf(1.f + __expf(-x)); }

__device__ __forceinline__ float row_rs(const float* ssp, int row) { const f32x4* q = (const f32x4*)(ssp + (size_t)row * 16); const f32x4 a = q[0], b = q[1], c = q[2], d = q[3];
    const f32x4 s = (a + b) + (c + d); return __builtin_amdgcn_rsqf(((s[0] + s[1]) + (s[2] + s[3])) * (1.f / 1024.f) + 1e-6f); }
__device__ __forceinline__ const PG8_LAS float* unit_row_scales(const float* ssp, PG8_LAS float* rsl, const Unit& u, int wr, int wc, int fr, int fq) {
    const int lane = fr + 16 * fq;
    PG8_LAS float* mine = rsl + (wr * 4 + wc) * 128;
    mine[lane] = row_rs(ssp, u.pm * BM + wr * 64 + lane); mine[64 + lane] = row_rs(ssp, u.pm * BM + HALF + wr * 64 + lane);
    asm volatile("s_waitcnt lgkmcnt(0)" ::: "memory");
    return mine;
}
constexpr float QSCALE = 0.125f * 1.4426950408889634f;

struct EpiIn {
    static constexpr bool PERM = true, AFTER_DRAIN = false;
    bf16_t *QA, *KA, *VA, *QB, *KB, *VB, *IQ, *IK; float* IW; bf16_t *CX, *CY, *GT;
    const float *gain_a, *gain_b, *gain_ik, *bgate, *rcos, *rsin;
    const float* ss;
    PG8_LAS float* rsl;
    __device__ __forceinline__ void operator()(const f32x4 (&acc)[2][2][4][2], const Unit& u, int wr, int wc, int fr, int fq) const {
        const int pn = u.pn; int row0 = u.pm * BM + wr * 64 + fr; asm volatile("" : "+v"(row0));
        const PG8_LAS float* rsw = unit_row_scales(ss, rsl, u, wr, wc, fr, fq) + fr;
        if (pn >= 12) {
            const int gi = (pn - 12) >> 2, ct = ((pn - 12) & 3) * BM; unsigned char* base = (unsigned char*)GT + (size_t)gi * 32768 * 1024;
            const int col0 = ct + wc * 32 + 8 * fq; const float* bp = bgate + gi * 1024 + col0;
            f32x4 bv[2][2];
#pragma unroll
            for (int bj = 0; bj < 2; ++bj)
#pragma unroll
                for (int n = 0; n < 2; ++n) bv[bj][n] = *(const f32x4*)(bp + bj * HALF + 4 * n);
#pragma unroll
            for (int ai = 0; ai < 2; ++ai)
#pragma unroll
                for (int m = 0; m < 4; ++m) { unsigned char* rowp = base + (size_t)(row0 + ai * HALF + m * 16) * 1024 + col0; const float rs = rsw[ai * 64 + m * 16];
#pragma unroll
                    for (int bj = 0; bj < 2; ++bj) { f32x4 v0 = acc[ai][bj][m][0] * rs + bv[bj][0], v1 = acc[ai][bj][m][1] * rs + bv[bj][1];
                        unsigned w0 = 0u, w1 = 0u;
#pragma unroll
                        for (int e = 0; e < 4; ++e) { w0 = __builtin_amdgcn_cvt_pk_u8_f32(fmaxf(__builtin_rintf(fast_sigmoid(v0[e]) * 255.f), 1.f), e, w0); w1 = __builtin_amdgcn_cvt_pk_u8_f32(fmaxf(__builtin_rintf(fast_sigmoid(v1[e]) * 255.f), 1.f), e, w1); }
                        uint2 wv; wv.x = w0; wv.y = w1; *(uint2*)(rowp + bj * HALF) = wv; }
                    asm volatile("" ::: "memory"); }
            return;
        }
        if (pn >= 8) {
            bf16_t* base = (pn < 10) ? CX : CY; const int col0 = ((pn - 8) & 1) * BM + wc * 32 + 8 * fq;
#pragma unroll
            for (int ai = 0; ai < 2; ++ai)
#pragma unroll
                for (int m = 0; m < 4; ++m) { bf16_t* rowp = base + (size_t)(row0 + ai * HALF + m * 16) * 512 + col0; const float rs = rsw[ai * 64 + m * 16];
#pragma unroll
                    for (int bj = 0; bj < 2; ++bj) *(u32x4*)(rowp + bj * HALF) = pack8(acc[ai][bj][m][0] * rs, acc[ai][bj][m][1] * rs);
                    asm volatile("" ::: "memory"); }
            return;
        }
        bf16_t* dst; const float* gain = nullptr; bool do_norm = false, do_rope = false; float scale = 1.f; int pitch = 256;
        switch (pn) {
            case 0: dst = QA; gain = gain_a; do_norm = true; scale = QSCALE; break;
            case 1: dst = KA; gain = gain_a + 64; do_norm = true; break;
            case 2: dst = VA; break;
            case 3: dst = QB; gain = gain_b; do_norm = true; do_rope = true; scale = QSCALE; break;
            case 4: dst = KB; gain = gain_b + 64; do_norm = true; do_rope = true; break;
            case 5: dst = VB; break;
            case 6: dst = IQ; do_rope = true; break;
            default: dst = IK; gain = gain_ik; do_norm = true; do_rope = true; pitch = 64; break;
        }
        if (pn == 7) {
            if (wc == 1) {
                if (fq == 0) {
#pragma unroll
                    for (int ai = 0; ai < 2; ++ai)
#pragma unroll
                        for (int m = 0; m < 4; ++m) { const int row = row0 + ai * HALF + m * 16; *(f32x4*)(IW + (size_t)row * 4) = acc[ai][0][m][0] * (0.0625f * rsw[ai * 64 + m * 16]); }
                }
                return;
            }
            if (wc != 0) return;
        }
        f32x4 g[2][2];
#pragma unroll
        for (int bj = 0; bj < 2; ++bj)
#pragma unroll
            for (int n = 0; n < 2; ++n) g[bj][n] = do_norm ? *(const f32x4*)(gain + bj * 32 + 8 * fq + 4 * n) * scale : (f32x4){scale, scale, scale, scale};
        const int colb = (pn == 7 ? 0 : wc * 64) + 8 * fq;
#pragma unroll
        for (int ai = 0; ai < 2; ++ai)
#pragma unroll
            for (int m = 0; m < 4; ++m) {
                const int row = row0 + ai * HALF + m * 16;
                const float rsx = rsw[ai * 64 + m * 16];
                f32x4 lo0 = acc[ai][0][m][0] * rsx, lo1 = acc[ai][0][m][1] * rsx, hi0 = acc[ai][1][m][0] * rsx, hi1 = acc[ai][1][m][1] * rsx;
                if (do_norm) {
                    f32x4 s4 = lo0 * lo0 + lo1 * lo1 + hi0 * hi0 + hi1 * hi1; float ss = (s4[0] + s4[1]) + (s4[2] + s4[3]);
                    ss += shflx(ss, 16); ss += shflx(ss, 32);
                    const float rs = __builtin_amdgcn_rsqf(ss * (1.f / 64.f) + 1e-6f);
                    lo0 = lo0 * rs; lo1 = lo1 * rs; hi0 = hi0 * rs; hi1 = hi1 * rs;
                }
                lo0 = lo0 * g[0][0]; lo1 = lo1 * g[0][1]; hi0 = hi0 * g[1][0]; hi1 = hi1 * g[1][1];
                if (do_rope) {
                    const int t = row & 4095; const float* cp = rcos + t * 32 + 8 * fq; const float* sp = rsin + t * 32 + 8 * fq;
                    const f32x4 c0 = *(const f32x4*)cp, c1 = *(const f32x4*)(cp + 4), s0 = *(const f32x4*)sp, s1 = *(const f32x4*)(sp + 4);
                    const f32x4 a0 = lo0 * c0 - hi0 * s0, a1 = lo1 * c1 - hi1 * s1, b0 = hi0 * c0 + lo0 * s0, b1 = hi1 * c1 + lo1 * s1;
                    lo0 = a0; lo1 = a1; hi0 = b0; hi1 = b1;
                }
                if (pn == 7) {
                    bf16_t* tp = dst + (size_t)(row >> 5) * 2048 + (fq >> 1) * 512 + ((fq & 1) * 32 + (row & 31)) * 8;
                    *(u32x4*)(tp) = pack8(lo0, lo1); *(u32x4*)(tp + 1024) = pack8(hi0, hi1);
                } else if (pn == 1 || pn == 4) {
                    bf16_t* tp = dst + ((size_t)(row >> 5) * 4 + wc) * 2048 + (fq >> 1) * 512 + ((fq & 1) * 32 + (row & 31)) * 8;
                    *(u32x4*)(tp) = pack8(lo0, lo1); *(u32x4*)(tp + 1024) = pack8(hi0, hi1);
                } else {
                    bf16_t* rowp = dst + (size_t)row * pitch + colb;
                    *(u32x4*)(rowp) = pack8(lo0, lo1); *(u32x4*)(rowp + 32) = pack8(hi0, hi1); }
                asm volatile("" ::: "memory");
            }
    }
};

struct EpiGate {
    static constexpr bool PERM = true, AFTER_DRAIN = false;
    bf16_t* MG; const bf16_t* G; bool first;
    __device__ __forceinline__ void operator()(const f32x4 (&acc)[2][2][4][2], const Unit& u, int wr, int wc, int fr, int fq) const {
        int row0 = u.pm * BM + wr * 64 + fr; const int col0 = u.pn * BM + wc * 32 + 8 * fq; asm volatile("" : "+v"(row0));
#pragma unroll
        for (int ai = 0; ai < 2; ++ai)
#pragma unroll
            for (int m = 0; m < 4; ++m) { const size_t off = (size_t)(row0 + ai * HALF + m * 16) * 1024 + col0;
#pragma unroll
                for (int bj = 0; bj < 2; ++bj) { const u32x4 gw = *(const u32x4*)(G + off + bj * HALF);
                    f32x4 v0 = acc[ai][bj][m][0], v1 = acc[ai][bj][m][1];
                    v0[0] *= bflo(gw.x); v0[1] *= bfhi(gw.x); v0[2] *= bflo(gw.y); v0[3] *= bfhi(gw.y); v1[0] *= bflo(gw.z); v1[1] *= bfhi(gw.z); v1[2] *= bflo(gw.w); v1[3] *= bfhi(gw.w);
                    if (!first) { const u32x4 ow = *(const u32x4*)(MG + off + bj * HALF);
                        v0[0] += bflo(ow.x); v0[1] += bfhi(ow.x); v0[2] += bflo(ow.y); v0[3] += bfhi(ow.y); v1[0] += bflo(ow.z); v1[1] += bfhi(ow.z); v1[2] += bflo(ow.w); v1[3] += bfhi(ow.w); }
                    *(u32x4*)(MG + off + bj * HALF) = pack8(v0, v1); asm volatile("" ::: "memory"); } }
    }
};

struct EpiResid {
    static constexpr bool PERM = true, AFTER_DRAIN = false;
    const float* xin; float* out; bf16_t* XB; float* ss;
    __device__ __forceinline__ void operator()(const f32x4 (&acc)[2][2][4][2], const Unit& u, int wr, int wc, int fr, int fq) const {
        int row0 = u.pm * BM + wr * 64 + fr; const int col0 = u.pn * BM + wc * 32 + 8 * fq; asm volatile("" : "+v"(row0));
#pragma unroll
        for (int ai = 0; ai < 2; ++ai)
#pragma unroll
            for (int m = 0; m < 4; ++m) { const int row = row0 + ai * HALF + m * 16; const size_t off = (size_t)row * 1024 + col0; float sq = 0.f;
#pragma unroll
                for (int bj = 0; bj < 2; ++bj) { const f32x4 r0 = *(const f32x4*)(xin + off + bj * HALF) + acc[ai][bj][m][0], r1 = *(const f32x4*)(xin + off + bj * HALF + 4) + acc[ai][bj][m][1];
                    *(f32x4*)(out + off + bj * HALF) = r0; *(f32x4*)(out + off + bj * HALF + 4) = r1;
                    if (XB) { *(u32x4*)(XB + off + bj * HALF) = pack8(r0, r1); const f32x4 q = r0 * r0 + r1 * r1; sq += (q[0] + q[1]) + (q[2] + q[3]); } }
                if (XB) { sq += shflx(sq, 16); sq += shflx(sq, 32); if (fq == 0) ss[(size_t)row * 16 + u.pn * 4 + wc] = sq; }
                asm volatile("" ::: "memory"); }
    }
};

struct EpiGateCat {
    static constexpr bool PERM = true, AFTER_DRAIN = false;
    bf16_t* MG; const bf16_t* G;
    __device__ __forceinline__ void mid(f32x4 (&acc)[2][2][4][2], const Unit& u, int kdone, int wr, int wc, int fr, int fq) const {
        if (kdone != 4 && kdone != 8) return;
        const unsigned char* Gp = (const unsigned char*)G + (size_t)(kdone == 4 ? 0 : 1) * 32768 * 1024; const unsigned char* Gn = Gp + (size_t)32768 * 1024;
        int row0 = u.pm * BM + wr * 64 + fr; const int col0 = u.pn * BM + wc * 32 + 8 * fq; asm volatile("" : "+v"(row0));
        {
            uint2 ga[2][4][2], gb[2][4][2];
#pragma unroll
            for (int ai = 0; ai < 2; ++ai)
#pragma unroll
                for (int mm = 0; mm < 4; ++mm)
#pragma unroll
                    for (int bj = 0; bj < 2; ++bj) { const size_t off = (size_t)(row0 + ai * HALF + mm * 16) * 1024 + col0 + bj * HALF; ga[ai][mm][bj] = *(const uint2*)(Gp + off); gb[ai][mm][bj] = *(const uint2*)(Gn + off); }
            asm volatile("" ::: "memory");
#pragma unroll
            for (int ai = 0; ai < 2; ++ai)
#pragma unroll
                for (int mm = 0; mm < 4; ++mm)
#pragma unroll
                    for (int bj = 0; bj < 2; ++bj) { const int m = mm; const uint2 a = ga[ai][mm][bj], b = gb[ai][mm][bj]; f32x4 r0, r1;
#pragma unroll
                        for (int e = 0; e < 4; ++e) { r0[e] = (float)((a.x >> (8 * e)) & 255u) * __builtin_amdgcn_rcpf((float)((b.x >> (8 * e)) & 255u)); r1[e] = (float)((a.y >> (8 * e)) & 255u) * __builtin_amdgcn_rcpf((float)((b.y >> (8 * e)) & 255u)); }
                        acc[ai][bj][m][0] = acc[ai][bj][m][0] * r0; acc[ai][bj][m][1] = acc[ai][bj][m][1] * r1; }
            asm volatile("" ::: "memory");
        }
    }
    __device__ __forceinline__ void operator()(const f32x4 (&acc)[2][2][4][2], const Unit& u, int wr, int wc, int fr, int fq) const {
        const unsigned char* G2 = (const unsigned char*)G + (size_t)2 * 32768 * 1024;
        int row0 = u.pm * BM + wr * 64 + fr; const int col0 = u.pn * BM + wc * 32 + 8 * fq; asm volatile("" : "+v"(row0));
#pragma unroll
        for (int ai = 0; ai < 2; ++ai) {
            uint2 gw[4][2];
#pragma unroll
            for (int m = 0; m < 4; ++m)
#pragma unroll
                for (int bj = 0; bj < 2; ++bj) gw[m][bj] = *(const uint2*)(G2 + (size_t)(row0 + ai * HALF + m * 16) * 1024 + col0 + bj * HALF);
            asm volatile("" ::: "memory");
#pragma unroll
            for (int m = 0; m < 4; ++m) { const size_t off = (size_t)(row0 + ai * HALF + m * 16) * 1024 + col0;
#pragma unroll
                for (int bj = 0; bj < 2; ++bj) { const uint2 g = gw[m][bj];
                    f32x4 v0 = acc[ai][bj][m][0], v1 = acc[ai][bj][m][1];
#pragma unroll
                    for (int e = 0; e < 4; ++e) { v0[e] *= (float)((g.x >> (8 * e)) & 255u) * (1.f / 255.f); v1[e] *= (float)((g.y >> (8 * e)) & 255u) * (1.f / 255.f); }
                    *(u32x4*)(MG + off + bj * HALF) = pack8(v0, v1); } }
            asm volatile("" ::: "memory"); }
    }
};

struct EpiResidB {
    static constexpr bool PERM = true, AFTER_DRAIN = false;
    bf16_t* XB; float* ss; float* out32;
    __device__ __forceinline__ void operator()(const f32x4 (&acc)[2][2][4][2], const Unit& u, int wr, int wc, int fr, int fq) const {
        int row0 = u.pm * BM + wr * 64 + fr; const int col0 = u.pn * BM + wc * 32 + 8 * fq; asm volatile("" : "+v"(row0));
#pragma unroll
        for (int ai = 0; ai < 2; ++ai) {
            u32x4 xw[4][2];
#pragma unroll
            for (int m = 0; m < 4; ++m)
#pragma unroll
                for (int bj = 0; bj < 2; ++bj) xw[m][bj] = *(const u32x4*)(XB + (size_t)(row0 + ai * HALF + m * 16) * 1024 + col0 + bj * HALF);
            asm volatile("" ::: "memory");
#pragma unroll
            for (int m = 0; m < 4; ++m) { const int row = row0 + ai * HALF + m * 16; const size_t off = (size_t)row * 1024 + col0; float sq = 0.f;
#pragma unroll
                for (int bj = 0; bj < 2; ++bj) { const u32x4 w = xw[m][bj];
                    f32x4 r0 = acc[ai][bj][m][0], r1 = acc[ai][bj][m][1];
                    r0[0] += bflo(w.x); r0[1] += bfhi(w.x); r0[2] += bflo(w.y); r0[3] += bfhi(w.y); r1[0] += bflo(w.z); r1[1] += bfhi(w.z); r1[2] += bflo(w.w); r1[3] += bfhi(w.w);
                    if (out32) { *(f32x4*)(out32 + off + bj * HALF) = r0; *(f32x4*)(out32 + off + bj * HALF + 4) = r1; }
                    else { *(u32x4*)(XB + off + bj * HALF) = pack8(r0, r1); const f32x4 q = r0 * r0 + r1 * r1; sq += (q[0] + q[1]) + (q[2] + q[3]); } }
                if (!out32) { sq += shflx(sq, 16); sq += shflx(sq, 32); if (fq == 0) ss[(size_t)row * 16 + u.pn * 4 + wc] = sq; } }
            asm volatile("" ::: "memory"); }
    }
};

struct EpiSwiGLU {
    static constexpr bool PERM = true, AFTER_DRAIN = false;
    bf16_t* ACT; const float* ss; PG8_LAS float* rsl;
    __device__ __forceinline__ void operator()(const f32x4 (&acc)[2][2][4][2], const Unit& u, int wr, int wc, int fr, int fq) const {
        int row0 = u.pm * BM + wr * 64 + fr; const int col0 = u.pn * HALF + wc * 32 + 8 * fq; asm volatile("" : "+v"(row0));
        const PG8_LAS float* rsw = unit_row_scales(ss, rsl, u, wr, wc, fr, fq) + fr;
#pragma unroll
        for (int ai = 0; ai < 2; ++ai)
#pragma unroll
            for (int m = 0; m < 4; ++m) { f32x4 o[2]; const float rs = rsw[ai * 64 + m * 16];
#pragma unroll
                for (int n = 0; n < 2; ++n) { const f32x4 gv = acc[ai][0][m][n] * rs, uv = acc[ai][1][m][n] * rs;
#pragma unroll
                    for (int e = 0; e < 4; ++e) o[n][e] = gv[e] * fast_sigmoid(gv[e]) * uv[e]; }
                *(u32x4*)(ACT + (size_t)(row0 + ai * HALF + m * 16) * 2816 + col0) = pack8(o[0], o[1]); asm volatile("" ::: "memory"); }
    }
};

template <class Epi, class Sched, bool ALIGN_EPI = false, bool SP2 = false, bool MIDHOOK = false>
__device__ __forceinline__ void gemm_phase(PG8_LAS unsigned char* lds, const Gemm g, const Sched& S, const Epi& E) {
    int tid_ = wg_tid(); asm volatile("" : "+v"(tid_));
    const int tid = tid_, wid = __builtin_amdgcn_readfirstlane(tid >> 6), lane = tid & 63, wr = wid >> 2, wc = wid & 3, fr = lane & 15, fq = lane >> 4;
    const int K = g.K, nt = K / BK;
    unsigned voffA[2], voffB[2];
#pragma unroll
    for (int i = 0; i < 2; ++i) { int R, C; stage_rc(tid * 16 + i * 8192, R, C); const int Rb = Epi::PERM ? ((R & ~31) + perm32(R & 31)) : R;
        voffA[i] = (unsigned)(R * K + C) * 2u; voffB[i] = (unsigned)(Rb * K + C) * 2u; }
    const size_t kstep = (size_t)(BK * 2);
    const size_t hstep = (size_t)HALF * K * 2;
    const size_t tstep = 2 * hstep;
    const unsigned ldsw = (unsigned)wid * 1024u;
    const int aoff = lds_byte(wr * 64 + fr, fq * 8), boff = lds_byte(wc * 32 + fr, fq * 8);
#define PG8_SA(b, h) (((b) * 2 + (h)) * HTB)
#define PG8_SB(b, h) ((4 + (b) * 2 + (h)) * HTB)
#define PG8_STAGE(bufoff, gbase, voff) do { _Pragma("unroll") for (int _i = 0; _i < 2; ++_i) \
        __builtin_amdgcn_global_load_lds((const unsigned*)((const char*)(gbase) + (voff)[_i]), (PG8_LAS unsigned*)(lds + (bufoff) + ldsw + _i * 8192), 16, 0, 0); } while (0)
#define PG8_LDA(dst, b, h) do { _Pragma("unroll") for (int m = 0; m < 4; ++m) _Pragma("unroll") for (int k = 0; k < 2; ++k) dst[m][k] = *(const PG8_LAS bf16x8*)(lds + PG8_SA(b, h) + aoff + m * 2048 + k * 1024); } while (0)
#define PG8_LDB(dst, b, h) do { _Pragma("unroll") for (int n = 0; n < 2; ++n) _Pragma("unroll") for (int k = 0; k < 2; ++k) dst[n][k] = *(const PG8_LAS bf16x8*)(lds + PG8_SB(b, h) + boff + n * 2048 + k * 1024); } while (0)
#define PG8_MMA(ai, bj, At, Bt) do { __builtin_amdgcn_s_setprio(1); _Pragma("unroll") for (int m = 0; m < 4; ++m) _Pragma("unroll") for (int n = 0; n < 2; ++n) _Pragma("unroll") for (int k = 0; k < 2; ++k) \
        acc[ai][bj][m][n] = __builtin_amdgcn_mfma_f32_16x16x32_bf16(Bt[n][k], At[m][k], acc[ai][bj][m][n], 0, 0, 0); __builtin_amdgcn_s_setprio(0); } while (0)
#define PG8_WAIT_V(n) asm volatile("s_waitcnt vmcnt(" #n ")" ::: "memory")
#define PG8_WAIT_L(n) asm volatile("s_waitcnt lgkmcnt(" #n ")" ::: "memory")
#define PG8_BAR __builtin_amdgcn_s_barrier()
#define PG8_SCHED __builtin_amdgcn_sched_barrier(0)
    Unit cur, nxt; int ui = 0;
    if (!S.next(0, cur)) return;
    f32x4 acc[2][2][4][2];
#pragma unroll
    for (int a = 0; a < 2; ++a)
#pragma unroll
        for (int b = 0; b < 2; ++b)
#pragma unroll
            for (int m = 0; m < 4; ++m)
#pragma unroll
                for (int n = 0; n < 2; ++n) acc[a][b][m][n] = (f32x4){0.f, 0.f, 0.f, 0.f};
    bf16x8 At[4][2], B0[2][2], B1[2][2];
    const char* cA = (const char*)g.A + (size_t)cur.pm * tstep; const char* cB = (const char*)g.Bt + (size_t)cur.pn * tstep;
    S.a_ready(cur);
    if constexpr (SP2) {
        PG8_STAGE(PG8_SB(0, 0), cB, voffB); PG8_STAGE(PG8_SB(0, 1), cB + hstep, voffB); PG8_STAGE(PG8_SA(0, 0), cA, voffA); PG8_STAGE(PG8_SA(0, 1), cA + hstep, voffA);
        if (wr == 1) PG8_BAR;
        PG8_WAIT_V(2); PG8_BAR;
        PG8_STAGE(PG8_SB(1, 0), cB + kstep, voffB); PG8_STAGE(PG8_SA(1, 0), cA + kstep, voffA); PG8_STAGE(PG8_SB(1, 1), cB + hstep + kstep, voffB);
        PG8_WAIT_V(6); PG8_BAR;
    } else {
        PG8_STAGE(PG8_SB(0, 0), cB, voffB); PG8_STAGE(PG8_SA(0, 0), cA, voffA); PG8_STAGE(PG8_SB(0, 1), cB + hstep, voffB); PG8_STAGE(PG8_SA(0, 1), cA + hstep, voffA);
        if (wr == 1) PG8_BAR;
        PG8_WAIT_V(4); PG8_BAR;
        PG8_STAGE(PG8_SB(1, 0), cB + kstep, voffB); PG8_STAGE(PG8_SA(1, 0), cA + kstep, voffA); PG8_STAGE(PG8_SB(1, 1), cB + hstep + kstep, voffB);
        PG8_WAIT_V(6); PG8_BAR;
    }
    for (;;) {
        const bool has_next = S.next(ui + 1, nxt);
        const char* nA = has_next ? (const char*)g.A + (size_t)nxt.pm * tstep : cA; const char* nB = has_next ? (const char*)g.Bt + (size_t)nxt.pn * tstep : cB;
        for (int t = 0; t < nt; t += 2) {
            const bool last = (t == nt - 2);
            const char* a1 = cA + (size_t)(t + 1) * kstep;
            const char* a2 = last ? nA : cA + (size_t)(t + 2) * kstep; const char* b2 = last ? nB : cB + (size_t)(t + 2) * kstep;
            const char* a3 = a2 + kstep; const char* b3 = b2 + kstep;
            if (last && has_next) S.a_ready(nxt);
            if constexpr (SP2) {
            PG8_LDB(B0, 0, 0); PG8_LDB(B1, 0, 1); PG8_SCHED; PG8_LDA(At, 0, 0); PG8_STAGE(PG8_SA(1, 1), a1 + hstep, voffA);
            PG8_WAIT_V(8); PG8_WAIT_L(0); PG8_BAR; PG8_MMA(0, 0, At, B0); PG8_MMA(0, 1, At, B1); PG8_BAR; PG8_SCHED;
            PG8_LDA(At, 0, 1); PG8_STAGE(PG8_SB(0, 0), b2, voffB); PG8_STAGE(PG8_SB(0, 1), b2 + hstep, voffB); PG8_STAGE(PG8_SA(0, 0), a2, voffA);
            PG8_WAIT_V(8); PG8_WAIT_L(0); PG8_BAR; PG8_MMA(1, 0, At, B0); PG8_MMA(1, 1, At, B1); PG8_BAR; PG8_SCHED;
            PG8_LDB(B0, 1, 0); PG8_LDB(B1, 1, 1); PG8_SCHED; PG8_LDA(At, 1, 0); PG8_STAGE(PG8_SA(0, 1), a2 + hstep, voffA);
            PG8_WAIT_V(8); PG8_WAIT_L(0); PG8_BAR; PG8_MMA(0, 0, At, B0); PG8_MMA(0, 1, At, B1); PG8_BAR; PG8_SCHED;
            PG8_LDA(At, 1, 1); PG8_STAGE(PG8_SB(1, 0), b3, voffB); PG8_STAGE(PG8_SB(1, 1), b3 + hstep, voffB); PG8_STAGE(PG8_SA(1, 0), a3, voffA);
            PG8_WAIT_V(8); PG8_WAIT_L(0); PG8_BAR; PG8_MMA(1, 0, At, B0); PG8_MMA(1, 1, At, B1); PG8_BAR; PG8_SCHED;
            } else {
            PG8_LDB(B0, 0, 0); PG8_SCHED; PG8_LDA(At, 0, 0); PG8_STAGE(PG8_SA(1, 1), a1 + hstep, voffA);
            PG8_WAIT_L(8); PG8_BAR; PG8_WAIT_L(0); PG8_MMA(0, 0, At, B0); PG8_BAR; PG8_SCHED;
            PG8_LDB(B1, 0, 1); PG8_STAGE(PG8_SB(0, 0), b2, voffB);
            PG8_BAR; PG8_WAIT_L(0); PG8_MMA(0, 1, At, B1); PG8_BAR;
            PG8_LDA(At, 0, 1); PG8_STAGE(PG8_SA(0, 0), a2, voffA);
            PG8_BAR; PG8_WAIT_L(0); PG8_MMA(1, 0, At, B0); PG8_BAR; PG8_SCHED;
            PG8_STAGE(PG8_SB(0, 1), b2 + hstep, voffB);
            PG8_WAIT_V(6); PG8_BAR; PG8_MMA(1, 1, At, B1); PG8_BAR;
            PG8_LDB(B0, 1, 0); PG8_SCHED; PG8_LDA(At, 1, 0); PG8_STAGE(PG8_SA(0, 1), a2 + hstep, voffA);
            PG8_WAIT_L(8); PG8_BAR; PG8_WAIT_L(0); PG8_MMA(0, 0, At, B0); PG8_BAR; PG8_SCHED;
            PG8_LDB(B1, 1, 1); PG8_STAGE(PG8_SB(1, 0), b3, voffB);
            PG8_BAR; PG8_WAIT_L(0); PG8_MMA(0, 1, At, B1); PG8_BAR;
            PG8_LDA(At, 1, 1); PG8_STAGE(PG8_SA(1, 0), a3, voffA);
            PG8_BAR; PG8_WAIT_L(0); PG8_MMA(1, 0, At, B0); PG8_BAR; PG8_SCHED;
            PG8_STAGE(PG8_SB(1, 1), b3 + hstep, voffB);
            PG8_WAIT_V(6); PG8_BAR; PG8_MMA(1, 1, At, B1); PG8_BAR;
            }
            if constexpr (MIDHOOK) E.mid(acc, cur, t + 2, wr, wc, fr, fq);
        }
        if constexpr (ALIGN_EPI) { if (wr == 0) PG8_BAR; }
        if constexpr (!Epi::AFTER_DRAIN) { E(acc, cur, wr, wc, fr, fq); S.done(cur); }
        if (!has_next) break;
#pragma unroll
        for (int a = 0; a < 2; ++a)
#pragma unroll
            for (int b = 0; b < 2; ++b)
#pragma unroll
                for (int m = 0; m < 4; ++m)
#pragma unroll
                    for (int n = 0; n < 2; ++n) acc[a][b][m][n] = (f32x4){0.f, 0.f, 0.f, 0.f};
        cur = nxt; cA = nA; cB = nB; ++ui;
        if constexpr (ALIGN_EPI) { if (wr == 1) PG8_BAR; }
    }
    PG8_WAIT_V(0);
    if constexpr (!ALIGN_EPI) { if (wr == 0) PG8_BAR; }
    PG8_BAR;
    if constexpr (Epi::AFTER_DRAIN) { E.fused(acc, cur, wr, wc, fr, fq, lds, wid, lane); S.done(cur); }
#undef PG8_SA
#undef PG8_SB
#undef PG8_STAGE
#undef PG8_LDA
#undef PG8_LDB
#undef PG8_MMA
#undef PG8_WAIT_V
#undef PG8_WAIT_L
#undef PG8_BAR
#undef PG8_SCHED
}
}

constexpr int NWAVES = 8;
#ifndef MK_PER_PHASE
#define MK_PER_PHASE 0
#endif
#ifndef PG8_SP2
#define PG8_SP2 true
#endif
#ifndef PG8_ALIGN
#define PG8_ALIGN true
#endif

constexpr int BATCH = 8, SEQ = 4096, D = 1024, DEPTH = 4, M = BATCH * SEQ;
constexpr int NIN = 6144, DIN = 5956, FF = 2816, NF1 = 2 * FF;
constexpr int NPH = 9;
constexpr float EPS = 1e-6f, LOG2E = 1.4426950408889634f;

constexpr size_t MiB = 1u << 20;
constexpr size_t WS_CTL = 0, CTL_ZERO_BYTES = 1 * MiB;
constexpr size_t WS_ROPE = 1 * MiB;
constexpr size_t WS_SS = 494 * MiB;
constexpr size_t WS_W = 4 * MiB;
constexpr size_t WO_IN = 0, WO_BA = 12 * MiB, WO_BB = WO_BA + MiB / 2, WO_BC = WO_BB + MiB / 2, WO_OUT = WO_BC + MiB, WO_F1 = WO_OUT + 2 * MiB, WO_F2 = WO_F1 + 11 * MiB;
constexpr size_t WS_H = 40 * MiB;
constexpr size_t WS_YC = WS_H;
constexpr size_t WS_QA = 104 * MiB, WS_QB = 120 * MiB, WS_KA = 136 * MiB, WS_VA = 152 * MiB, WS_KB = 168 * MiB, WS_VB = 184 * MiB, WS_IQ = 200 * MiB;
constexpr size_t WS_MG = WS_KA;
constexpr size_t WS_IK = 216 * MiB, WS_IW = 220 * MiB;
constexpr size_t WS_CX = 222 * MiB, WS_CY = 254 * MiB;
constexpr size_t WS_GT = 286 * MiB;
constexpr size_t WS_ACT = WS_GT;
constexpr size_t WS_MASK = 478 * MiB;
constexpr size_t WS_END = 510 * MiB;
constexpr int CW_TMO = 0, CW_CODE = 1, CW_BAR = 4096;

constexpr int RING_OFF = 0, RING_BYTES = 131072;
constexpr int XTRA_OFF = RING_BYTES, XTRA_BYTES = 8192;
constexpr int LDSCTL_OFF = XTRA_OFF + XTRA_BYTES, MISC_OFF = LDSCTL_OFF + 320;
constexpr int LDS_BYTES = 147456;
static_assert(MISC_OFF + 128 <= LDS_BYTES, "LDS map");

#define GAS __attribute__((address_space(1)))
#define LAS __attribute__((address_space(3)))
typedef unsigned short bf16;
typedef unsigned v4u __attribute__((ext_vector_type(4)));
typedef float f32x4 __attribute__((ext_vector_type(4)));
typedef short bf16x8 __attribute__((ext_vector_type(8)));
typedef GAS unsigned gu32;
typedef unsigned long long u64;
#define RLX_AGENT __ATOMIC_RELAXED, __HIP_MEMORY_SCOPE_AGENT
#define LDS_WAIT() asm volatile("s_waitcnt lgkmcnt(0)" ::: "memory")
#define VM_WAIT() asm volatile("s_waitcnt vmcnt(0)" ::: "memory")
__device__ __forceinline__ unsigned f2bf(float f) { unsigned u = __builtin_bit_cast(unsigned, f); return (u + 0x7fffu + ((u >> 16) & 1u)) >> 16; }
__device__ __forceinline__ unsigned pk2(float lo, float hi) { return f2bf(lo) | (f2bf(hi) << 16); }
__device__ __forceinline__ float bf2f(bf16 v) { return __builtin_bit_cast(float, (unsigned)v << 16); }
__device__ __forceinline__ float bflo(unsigned w) { return __builtin_bit_cast(float, w << 16); }
__device__ __forceinline__ float bfhi(unsigned w) { return __builtin_bit_cast(float, w & 0xffff0000u); }
__device__ __forceinline__ float wave_sum(float v) {
#pragma unroll
    for (int o = 1; o < 64; o <<= 1) v += shflx(v, o);
    return v;
}
__device__ __forceinline__ float wave_max(float v) {
#pragma unroll
    for (int o = 1; o < 64; o <<= 1) v = fmaxf(v, shflx(v, o));
    return v;
}
#define XB_TMO      128
#define XB_XCNT(j)  (256  + 64 * (j))
#define XB_XSUB(j)  (1280 + 64 * (j))
#define XB_XGEN(j)  (2304 + 64 * (j))
#define XB_TOP      3328
#define XB_TOPGEN   3392
#define XCD_BAR_WORDS 3456
#define XB_SPIN_CAP (1u << 27)

__device__ __forceinline__ unsigned xb_ld(unsigned* p)              { return __hip_atomic_load(p, __ATOMIC_RELAXED, __HIP_MEMORY_SCOPE_AGENT); }
__device__ __forceinline__ unsigned xb_add(unsigned* p, unsigned v) { return __hip_atomic_fetch_add(p, v, __ATOMIC_RELAXED, __HIP_MEMORY_SCOPE_AGENT); }
__device__ __forceinline__ unsigned xb_xcc_id() { return (unsigned)__builtin_amdgcn_s_getreg((3 << 11) | 20) & 0xFu; }
#define XB_SPIN(cond, bar) do { unsigned _sp = 0; while (cond) { __builtin_amdgcn_s_sleep(1); \
    if ((++_sp & 255u) == 0u) { if (xb_ld(&(bar)[XB_TMO])) break; if (_sp > XB_SPIN_CAP) { atomicAdd(&(bar)[XB_TMO], 1u); break; } } } } while (0)

struct XcdBarrier {
    unsigned* bar; unsigned x;
    volatile LAS unsigned* st;
};

__device__ __forceinline__ XcdBarrier xcd_barrier_post(unsigned* bar, volatile LAS unsigned* st) {
    XcdBarrier b; b.bar = bar; b.x = xb_xcc_id(); b.st = st;
    if (wg_tid() == 0) (void)xb_add(&bar[XB_XCNT(b.x)], 1u);
    return b;
}
__device__ __forceinline__ void xcd_barrier_complete(unsigned* bar, unsigned x, unsigned& nloc, unsigned& nx) {
    const unsigned G = gridDim.x * gridDim.y * gridDim.z;
    unsigned sum, cnt, mine, sp = 0u;
    for (;;) {
        sum = 0u; cnt = 0u; mine = 0u;
#pragma unroll
        for (unsigned j = 0; j < 16; ++j) { const unsigned c = xb_ld(&bar[XB_XCNT(j)]); sum += c; cnt += (c > 0u) ? 1u : 0u; mine = (j == x) ? c : mine; }
        if (sum == G) break;
        __builtin_amdgcn_s_sleep(1);
        if ((++sp & 255u) == 0u) { if (xb_ld(&bar[XB_TMO])) break; if (sp > XB_SPIN_CAP) { atomicAdd(&bar[XB_TMO], 1u); break; } }
    }
    nloc = mine > 0u ? mine : 1u; nx = cnt > 0u ? cnt : 1u;
}

__device__ __forceinline__ void xcd_barrier(const XcdBarrier& b) {
    asm volatile("s_waitcnt vmcnt(0)" ::: "memory");
    __syncthreads();
    if (wg_tid() == 0) {
        unsigned* bar = b.bar;
        __builtin_amdgcn_s_waitcnt(0);
        unsigned nloc = b.st[0], nx = b.st[1];
        if (nloc == 0u) { xcd_barrier_complete(bar, b.x, nloc, nx); b.st[0] = nloc; b.st[1] = nx; }
        const unsigned old = xb_add(&bar[XB_XSUB(b.x)], 1u);
        const unsigned gen = old / nloc;
        if (old + 1u == (gen + 1u) * nloc) {
            __builtin_amdgcn_fence(__ATOMIC_RELEASE, "agent");
            asm volatile("s_waitcnt vmcnt(0)" ::: "memory");
            const unsigned og = xb_add(&bar[XB_TOP], 1u);
            const unsigned tg = og / nx;
            if (og + 1u == (tg + 1u) * nx) xb_add(&bar[XB_TOPGEN], 1u);
            else XB_SPIN(xb_ld(&bar[XB_TOPGEN]) == tg, bar);
            __builtin_amdgcn_fence(__ATOMIC_ACQUIRE, "agent");
            xb_add(&bar[XB_XGEN(b.x)], 1u);
            asm volatile("s_waitcnt vmcnt(0)" ::: "memory");
        } else {
            XB_SPIN(xb_ld(&bar[XB_XGEN(b.x)]) == gen, bar);
            __builtin_amdgcn_fence(__ATOMIC_ACQUIRE, "agent");
            asm volatile("s_waitcnt vmcnt(0)" ::: "memory");
        }
    }
    __syncthreads();
}

struct Frame {
    LAS unsigned char* lds;
    volatile LAS unsigned* MISC;
    gu32* ctl;
    int tid, lane, wave, G;
    const float* x; float* out;
    const float *g_mix, *w_in, *qk_gain_a, *rel_bias, *qk_gain_b, *g_idx_k, *conv_w, *conv_b, *lru_wa, *lru_ba, *lru_wx, *lru_bx, *lru_lambda, *b_gate, *w_branch, *w_out, *g_ffn, *w_ffn_in, *w_ffn_out;
    float *rcos, *rsin, *SS;
    bf16 *W, *H, *YC, *YCAT, *QA, *QB, *KA, *VA, *KB, *VB, *IQ, *IK, *CX, *CY, *GT, *ACT, *MG; float* IW; u64* MASK;
    bf16 *W2a, *W2b;
};
struct WSet { bf16 *in, *ba, *out, *f1, *f2; };
__device__ __forceinline__ WSet wset(const Frame& F, int l) {
    WSet w;
    if (l & 1) { w.in = F.W + WO_IN / 2; w.ba = F.W + WO_BA / 2; w.out = F.W + WO_OUT / 2; w.f1 = F.W + WO_F1 / 2; w.f2 = F.W + WO_F2 / 2; }
    else { w.in = F.W2a; w.ba = F.W2a + (12 * MiB) / 2; w.out = F.W2a + (14 * MiB) / 2; w.f1 = F.W2b; w.f2 = F.W2b + (11 * MiB) / 2; }
    return w;
}

__device__ __forceinline__ void cvt_item(const float* W, int ldw, int k0, int n_src0, int nvalid, bf16* WT, int dpitch, int drow0, LAS float* scr, int lane, const float* gk = nullptr) {
    { const int col4 = (lane & 7) * 4; f32x4 v[8];
#pragma unroll
      for (int i = 0; i < 8; ++i) { const int kk = 8 * i + (lane >> 3); v[i] = (col4 < nvalid) ? *(const GAS f32x4*)(W + (size_t)(k0 + kk) * ldw + n_src0 + col4) : (f32x4){0.f, 0.f, 0.f, 0.f}; }
#pragma unroll
      for (int i = 0; i < 8; ++i) { const int kk = 8 * i + (lane >> 3); LAS float* d = scr + kk * 33 + col4; const float gg = gk ? gk[k0 + kk] : 1.f; d[0] = v[i].x * gg; d[1] = v[i].y * gg; d[2] = v[i].z * gg; d[3] = v[i].w * gg; } }
    LDS_WAIT(); asm volatile("" ::: "memory");
    const int c = lane & 7;
#pragma unroll
    for (int j = 0; j < 4; ++j) { const int n = (lane >> 3) + 8 * j; const LAS float* s = scr + (8 * c) * 33 + n;
        v4u o; o.x = pk2(s[0 * 33], s[1 * 33]); o.y = pk2(s[2 * 33], s[3 * 33]); o.z = pk2(s[4 * 33], s[5 * 33]); o.w = pk2(s[6 * 33], s[7 * 33]);
        *(GAS v4u*)(WT + (size_t)(drow0 + n) * dpitch + k0 + 8 * c) = o; }
    LDS_WAIT(); asm volatile("" ::: "memory");
}
__device__ __forceinline__ void phase_xb0(Frame& F, const float* xin, float* ss) {
    const int gw = blockIdx.x * NWAVES + F.wave, NGW = F.G * NWAVES;
    for (int m = gw; m < M; m += NGW) { const GAS f32x4* xr = (const GAS f32x4*)(xin + (size_t)m * D) + F.lane; f32x4 v[4]; float s = 0.f;
#pragma unroll
        for (int j = 0; j < 4; ++j) { v[j] = xr[64 * j]; s += (v[j].x * v[j].x + v[j].y * v[j].y) + (v[j].z * v[j].z + v[j].w * v[j].w); }
        s = wave_sum(s); if (F.lane < 16) ss[(size_t)m * 16 + F.lane] = (F.lane == 0) ? s : 0.f;
        GAS u64* o8 = (GAS u64*)(F.H + (size_t)m * D) + F.lane;
#pragma unroll
        for (int j = 0; j < 4; ++j) o8[64 * j] = (u64)pk2(v[j].x, v[j].y) | ((u64)pk2(v[j].z, v[j].w) << 32); }
}
__device__ __forceinline__ void phase_weights(Frame& F, int l, unsigned* queue = nullptr) {
    LAS float* scr = (LAS float*)(F.lds + RING_OFF + F.wave * 16384);
    const int gw = blockIdx.x * NWAVES + F.wave, NGW = F.G * NWAVES;
    const float* w_in = F.w_in + (size_t)l * D * DIN; const float* w_br = F.w_branch + (size_t)l * D * D; const float* w_out = F.w_out + (size_t)l * D * D;
    const float* w_f1 = F.w_ffn_in + (size_t)l * D * NF1; const float* w_f2 = F.w_ffn_out + (size_t)l * FF * D;
    const WSet WS = wset(F, l);
    constexpr int I_IN = 16 * 192, I_BA = 4 * 32, I_BB = 4 * 32, I_BC = 8 * 32, I_OUT = 16 * 32, I_F1 = 16 * 176, I_F2 = 44 * 32;
    constexpr int NITEMS = I_IN + I_BA + I_BB + I_BC + I_OUT + I_F1 + I_F2;
    for (int it0 = gw;; it0 += NGW) {
        int it = it0;
        if (queue) { unsigned v = 0u; if (F.lane == 0) v = __hip_atomic_fetch_add(queue, 1u, __ATOMIC_RELAXED, __HIP_MEMORY_SCOPE_AGENT); it = __builtin_amdgcn_readfirstlane((int)v); }
        if (it >= NITEMS) break;
        int r = it;
        if (r < I_IN) { const int kb = r / 192, ng = r % 192, pn = ng >> 3, grp = ng & 7, bj = grp >> 2, hh = grp & 3; int src = 0, nv = 32;
            if (pn < 7) src = pn * 256 + 64 * hh + 32 * bj;
            else if (pn == 7) { if (hh == 0) src = 1792 + 32 * bj; else if (grp == 1) { src = 1856; nv = 4; } else nv = 0; }
            else if (pn < 12) src = 1860 + (pn - 8) * 256 + grp * 32;
            else src = 2884 + (pn - 12) * 256 + grp * 32;
            cvt_item(w_in, DIN, kb * 64, src, nv, WS.in, D, ng * 32, scr, F.lane, F.g_mix + l * D); continue; } r -= I_IN;
        if (r < I_BA + I_BB + I_BC) { const int kb = r / 32, ng = r % 32; cvt_item(w_br, D, kb * 64, ng * 32, 32, WS.ba, D, ng * 32, scr, F.lane); continue; } r -= I_BA + I_BB + I_BC;
        if (r < I_OUT) { const int kb = r / 32, ng = r % 32; cvt_item(w_out, D, kb * 64, ng * 32, 32, WS.out, D, ng * 32, scr, F.lane); continue; } r -= I_OUT;
        if (r < I_F1) { const int kb = r / 176, ng = r % 176, pn = ng >> 3, grp = ng & 7, bj = grp >> 2; const int src = FF * bj + 128 * pn + (grp & 3) * 32;
            cvt_item(w_f1, NF1, kb * 64, src, 32, WS.f1, D, ng * 32, scr, F.lane, F.g_ffn + l * D); continue; } r -= I_F1;
        { const int kb = r / 32, ng = r % 32; cvt_item(w_f2, D, kb * 64, ng * 32, 32, WS.f2, FF, ng * 32, scr, F.lane); }
    }
    if (l == 0) {
        for (int i = blockIdx.x * 512 + F.tid; i < SEQ * 32; i += F.G * 512) { const int pos = i >> 5, k = i & 31;
            const float inv = exp2f(-(float)k * 0.41524101186092029f); const float ang = (float)pos * inv;
            F.rcos[i] = cosf(ang); F.rsin[i] = sinf(ang); }
    }
}

__device__ __forceinline__ void naive_attn_a(Frame& F, int l) {
    LAS float* bias_s = (LAS float*)F.lds;
    LAS float* qs = (LAS float*)F.lds + 320 + F.wave * 640;
    LAS float* ps = qs + 64;
    const int lane = F.lane;
    for (int u = blockIdx.x; u < BATCH * 4 * 64; u += F.G) {
        const int c = u & 63, h = (u >> 6) & 3, b = u >> 8;
        __syncthreads();
        for (int i = F.tid; i < 257; i += 512) bias_s[i] = F.rel_bias[(l * 4 + h) * 257 + i] * LOG2E;
        __syncthreads();
        const int kc0 = (c - 8 > 0) ? c - 8 : 0; const int nk = (c - kc0 + 1) * 64;
        for (int qi = 0; qi < 8; ++qi) {
            const int t = c * 64 + F.wave * 8 + qi; const size_t row = (size_t)b * SEQ + t;
            qs[lane] = bf2f(F.QA[row * 256 + h * 64 + lane]);
            LDS_WAIT();
            float s[9]; float mx = -INFINITY;
#pragma unroll
            for (int jj = 0; jj < 9; ++jj) { const int j = jj * 64 + lane; s[jj] = -INFINITY;
                if (j < nk) { const size_t krow = (size_t)b * SEQ + kc0 * 64 + j; const v4u* kp = (const v4u*)(F.KA + krow * 256 + h * 64); float dot = 0.f;
#pragma unroll
                    for (int i8 = 0; i8 < 8; ++i8) { const v4u kw = kp[i8]; const LAS float* q = qs + i8 * 8;
                        dot += q[0] * bflo(kw.x) + q[1] * bfhi(kw.x) + q[2] * bflo(kw.y) + q[3] * bfhi(kw.y) + q[4] * bflo(kw.z) + q[5] * bfhi(kw.z) + q[6] * bflo(kw.w) + q[7] * bfhi(kw.w); }
                    int rel = t - (kc0 * 64 + j); rel = rel < -128 ? -128 : (rel > 128 ? 128 : rel);
                    s[jj] = dot + bias_s[rel + 128]; }
                mx = fmaxf(mx, s[jj]); }
            mx = wave_max(mx); float sum = 0.f;
#pragma unroll
            for (int jj = 0; jj < 9; ++jj) { const int j = jj * 64 + lane; if (j < nk) { const float p = exp2f(s[jj] - mx); sum += p; ps[j] = p; } }
            sum = wave_sum(sum);
            LDS_WAIT();
            float o = 0.f; const bf16* vp = F.VA + ((size_t)b * SEQ + kc0 * 64) * 256 + h * 64 + lane;
            for (int j = 0; j < nk; ++j) o += ps[j] * bf2f(vp[(size_t)j * 256]);
            F.QA[row * 256 + h * 64 + lane] = (bf16)f2bf(o / sum);
            LDS_WAIT();
        }
    }
}
__device__ __forceinline__ unsigned fkey(float f) { const unsigned u = __builtin_bit_cast(unsigned, f); return (u & 0x80000000u) ? ~u : (u | 0x80000000u); }
__device__ __forceinline__ void naive_idx(Frame& F) {
    LAS float* sc = (LAS float*)F.lds + F.wave * 4096;
    LAS float* qs = (LAS float*)(F.lds + XTRA_OFF) + F.wave * 256;
    const int lane = F.lane;
    for (int u = blockIdx.x; u < BATCH * 512; u += F.G) {
        const int b = u >> 9, t = (u & 511) * 8 + F.wave; const size_t row = (size_t)b * SEQ + t; const int nw = (t >> 6) + 1;
        { const unsigned* qp = (const unsigned*)(F.IQ + row * 256) + lane * 2; const unsigned w0 = qp[0], w1 = qp[1];
          qs[4 * lane] = bflo(w0); qs[4 * lane + 1] = bfhi(w0); qs[4 * lane + 2] = bflo(w1); qs[4 * lane + 3] = bfhi(w1); }
        const f32x4 wv = *(const f32x4*)(F.IW + row * 4);
        LDS_WAIT();
        for (int jj = 0; jj < nw; ++jj) { const int j = jj * 64 + lane; const v4u* kp = (const v4u*)(F.IK + ((size_t)b * SEQ + j) * 64);
            float d0 = 0.f, d1 = 0.f, d2 = 0.f, d3 = 0.f;
#pragma unroll
            for (int i8 = 0; i8 < 8; ++i8) { const v4u kw = kp[i8]; float kf[8] = {bflo(kw.x), bfhi(kw.x), bflo(kw.y), bfhi(kw.y), bflo(kw.z), bfhi(kw.z), bflo(kw.w), bfhi(kw.w)};
#pragma unroll
                for (int e = 0; e < 8; ++e) { const int d = i8 * 8 + e; d0 += qs[d] * kf[e]; d1 += qs[64 + d] * kf[e]; d2 += qs[128 + d] * kf[e]; d3 += qs[192 + d] * kf[e]; } }
            float s = 0.f; s += wv[0] * fmaxf(d0, 0.f); s += wv[1] * fmaxf(d1, 0.f); s += wv[2] * fmaxf(d2, 0.f); s += wv[3] * fmaxf(d3, 0.f); s += 0.0f;
            sc[j] = s; }
        LDS_WAIT();
        u64* mrow = F.MASK + row * 64;
        if (nw <= 4) { if (lane < nw) { unsigned o1 = ~0u, o2 = ~0u; asm volatile("" : "+v"(o1), "+v"(o2)); ((unsigned*)mrow)[2 * lane] = o1; ((unsigned*)mrow)[2 * lane + 1] = o2; } }
        else {
            unsigned prefix = 0u;
            for (int bit = 31; bit >= 0; --bit) { const unsigned cand = prefix | (1u << bit); int cnt = 0;
                for (int jj = 0; jj < nw; ++jj) cnt += __popcll(__ballot(fkey(sc[jj * 64 + lane]) >= cand));
                if (cnt >= 256) prefix = cand; }
            int n_gt = 0;
            for (int jj = 0; jj < nw; ++jj) n_gt += __popcll(__ballot(fkey(sc[jj * 64 + lane]) > prefix));
            const int allowed = 256 - n_gt; int running = 0; const u64 lt = (1ull << lane) - 1ull;
            for (int jj = 0; jj < nw; ++jj) { const unsigned key = fkey(sc[jj * 64 + lane]); const bool gt = key > prefix, eq = key == prefix; const u64 eqb = __ballot(eq);
                const int rank = running + __popcll(eqb & lt); const bool sel = gt || (eq && rank < allowed); running += __popcll(eqb);
                const u64 w = __ballot(sel); if (lane == 0) mrow[jj] = w; }
        }
        LDS_WAIT();
    }
}
__device__ __forceinline__ void naive_sparse(Frame& F) {
    LAS int* list = (LAS int*)F.lds + F.wave * 256;
    LAS float* ps = (LAS float*)F.lds + 2048 + F.wave * 256;
    LAS float* qs = (LAS float*)F.lds + 4096 + F.wave * 64;
    const int lane = F.lane; const u64 lt = (1ull << lane) - 1ull;
    for (int u = blockIdx.x; u < BATCH * 512; u += F.G) {
        const int b = u >> 9, t = (u & 511) * 8 + F.wave; const size_t row = (size_t)b * SEQ + t; const int nw = (t >> 6) + 1;
        int running = 0;
        for (int jj = 0; jj < nw; ++jj) { const u64 w = F.MASK[row * 64 + jj]; if ((w >> lane) & 1ull) list[running + __popcll(w & lt)] = jj * 64 + lane; running += __popcll(w); }
        const int nsel = running < 256 ? running : 256;
        LDS_WAIT();
        for (int h = 0; h < 4; ++h) {
            qs[lane] = bf2f(F.QB[row * 256 + h * 64 + lane]);
            LDS_WAIT();
            float s[4]; float mx = -INFINITY;
#pragma unroll
            for (int e = 0; e < 4; ++e) { const int idx = e * 64 + lane; s[e] = -INFINITY;
                if (idx < nsel) { const int j = list[idx]; const v4u* kp = (const v4u*)(F.KB + ((size_t)b * SEQ + j) * 256 + h * 64); float dot = 0.f;
#pragma unroll
                    for (int i8 = 0; i8 < 8; ++i8) { const v4u kw = kp[i8]; const LAS float* q = qs + i8 * 8;
                        dot += q[0] * bflo(kw.x) + q[1] * bfhi(kw.x) + q[2] * bflo(kw.y) + q[3] * bfhi(kw.y) + q[4] * bflo(kw.z) + q[5] * bfhi(kw.z) + q[6] * bflo(kw.w) + q[7] * bfhi(kw.w); }
                    s[e] = dot; }
                mx = fmaxf(mx, s[e]); }
            mx = wave_max(mx); float sum = 0.f;
#pragma unroll
            for (int e = 0; e < 4; ++e) { const int idx = e * 64 + lane; if (idx < nsel) { const float p = exp2f(s[e] - mx); sum += p; ps[idx] = p; } }
            sum = wave_sum(sum);
            LDS_WAIT();
            float o = 0.f;
            for (int i = 0; i < nsel; ++i) o += ps[i] * bf2f(F.VB[((size_t)b * SEQ + list[i]) * 256 + h * 64 + lane]);
            F.QB[row * 256 + h * 64 + lane] = (bf16)f2bf(o / sum);
            LDS_WAIT();
        }
    }
}
__device__ __forceinline__ float gelu_tanh(float x) { return 0.5f * x * (1.f + tanhf(0.7978845608028654f * (x + 0.044715f * x * x * x))); }
__device__ __forceinline__ void naive_lru(Frame& F, int l) {
    LAS float* wa_s = (LAS float*)F.lds; LAS float* wx_s = wa_s + 4096; LAS float* us = wx_s + 4096; LAS float* as = us + 64 * 65; LAS float* gs = as + 4096;
    const int tid = F.tid, lane = F.lane;
    for (int u = blockIdx.x; u < 64; u += F.G) {
        const int b = u >> 3, g = u & 7;
        __syncthreads();
        for (int i = tid; i < 4096; i += 512) { wa_s[i] = F.lru_wa[(size_t)(l * 8 + g) * 4096 + i]; wx_s[i] = F.lru_wx[(size_t)(l * 8 + g) * 4096 + i]; }
        float h = 0.f;
        for (int tile = 0; tile < 64; ++tile) {
            __syncthreads();
            { const int tok = tid >> 3, t = tile * 64 + tok;
#pragma unroll
              for (int e = 0; e < 8; ++e) { const int ch = (tid & 7) * 8 + e, cg = g * 64 + ch; float acc = F.conv_b[l * 512 + cg];
#pragma unroll
                  for (int j = 0; j < 4; ++j) { const int tt = t - 3 + j; if (tt >= 0) acc += F.conv_w[(l * 4 + j) * 512 + cg] * bf2f(F.CX[((size_t)b * SEQ + tt) * 512 + cg]); }
                  us[tok * 65 + ch] = acc; } }
            __syncthreads();
            { const int tok = tid & 63, og = tid >> 6;
              for (int o = 0; o < 8; ++o) { const int cc = 8 * og + o, cg = g * 64 + cc; float ra = 0.f, rx = 0.f;
                  for (int k = 0; k < 64; ++k) { const float uv = us[tok * 65 + k]; ra += uv * wa_s[k * 64 + cc]; rx += uv * wx_s[k * 64 + cc]; }
                  const float r = 1.f / (1.f + expf(-(ra + F.lru_ba[l * 512 + cg]))), ig = 1.f / (1.f + expf(-(rx + F.lru_bx[l * 512 + cg])));
                  const float sp = log1pf(expf(-F.lru_lambda[l * 512 + cg])); const float log_a = -8.0f * r * sp;
                  as[tok * 64 + cc] = expf(log_a); gs[tok * 64 + cc] = sqrtf(-expm1f(2.f * log_a)) * (ig * us[tok * 65 + cc]); } }
            __syncthreads();
            if (F.wave == 0) {
                for (int tok = 0; tok < 64; ++tok) { h = as[tok * 64 + lane] * h + gs[tok * 64 + lane]; const size_t row = (size_t)b * SEQ + tile * 64 + tok;
                    const float cy = bf2f(F.CY[row * 512 + g * 64 + lane]); F.YC[row * 512 + g * 64 + lane] = (bf16)f2bf(h * gelu_tanh(cy)); }
            }
        }
    }
}


typedef float f32x16 __attribute__((ext_vector_type(16)));
typedef short s16x4 __attribute__((ext_vector_type(4)));
typedef float f32x2v __attribute__((ext_vector_type(2)));
typedef __bf16 bf16x2v __attribute__((ext_vector_type(2)));
__device__ __forceinline__ unsigned cvtpk(float lo, float hi) { const f32x2v v = {lo, hi}; const bf16x2v b = __builtin_convertvector(v, bf16x2v); return __builtin_bit_cast(unsigned, b); }
__device__ __forceinline__ int crow(int r, int hi) { return (r & 3) + 8 * (r >> 2) + 4 * hi; }
__device__ __forceinline__ s16x4 vtr(const LAS unsigned char* p) { return __builtin_bit_cast(s16x4, __builtin_amdgcn_ds_read_tr16_b64_v4i16((LAS s16x4*)p)); }

template <int MODE> __device__ __forceinline__ void flash_wave(int b, int h, int qblk, const bf16* Q, const bf16* K, const bf16* V, bf16* Y, LAS unsigned char* vl, const LAS float* bias_s, const u64* MASK, int lane) {
    asm volatile("" : "+v"(lane));
    const int r32 = lane & 31, hi = lane >> 5; const size_t row0 = (size_t)b * SEQ + (size_t)qblk * 32; const int c = qblk >> 1;
    bf16x8 qr[4];
#pragma unroll
    for (int d0 = 0; d0 < 4; ++d0) qr[d0] = *(const bf16x8*)(Q + (row0 + r32) * 256 + h * 64 + d0 * 16 + hi * 8);
    const int kb_lo = (MODE == 0) ? ((c > 8 ? c - 8 : 0) * 2) : 0, kb_hi = (c + 1) * 2;
    f32x16 o0, o1;
#pragma unroll
    for (int r = 0; r < 16; ++r) { o0[r] = 0.f; o1[r] = 0.f; }
    float m = -1e30f, lsum = 0.f; const int tq = qblk * 32 + r32;
    const LAS unsigned char* vrd = vl + ((lane >> 4) & 1) * 32 + (lane & 3) * 8 + (4 * hi + ((lane & 15) >> 2)) * 64;
    unsigned mword = 0, mnext = 0;
    const unsigned* M32 = (const unsigned*)MASK + (size_t)(b * 64 + c) * (128 * 64) + (qblk & 1) * 32 + r32;
    const bf16* Kt = K + ((size_t)b * 128 * 4 + h) * 2048 + lane * 8;
    bf16x8 kfn[4]; v4u vvn[4];
    { const size_t krow0 = (size_t)b * SEQ + (size_t)kb_lo * 32;
#pragma unroll
      for (int d0 = 0; d0 < 4; ++d0) kfn[d0] = *(const bf16x8*)(Kt + (size_t)kb_lo * 8192 + d0 * 512);
#pragma unroll
      for (int i = 0; i < 4; ++i) { const int c16 = i * 64 + lane, key = c16 >> 3, dch = c16 & 7; vvn[i] = *(const v4u*)(V + (krow0 + key) * 256 + h * 64 + dch * 8); }
      if (MODE == 1) mnext = M32[kb_lo * 64]; }
    for (int kb = kb_lo; kb < kb_hi; ++kb) {
        bf16x8 kf[4]; v4u vv[4];
#pragma unroll
        for (int d0 = 0; d0 < 4; ++d0) kf[d0] = kfn[d0];
#pragma unroll
        for (int i = 0; i < 4; ++i) vv[i] = vvn[i];
        if (MODE == 1) mword = mnext;
        if (kb + 1 < kb_hi) { const size_t krow1 = (size_t)b * SEQ + (size_t)(kb + 1) * 32;
#pragma unroll
            for (int d0 = 0; d0 < 4; ++d0) kfn[d0] = *(const bf16x8*)(Kt + (size_t)(kb + 1) * 8192 + d0 * 512);
#pragma unroll
            for (int i = 0; i < 4; ++i) { const int c16 = i * 64 + lane, key = c16 >> 3, dch = c16 & 7; vvn[i] = *(const v4u*)(V + (krow1 + key) * 256 + h * 64 + dch * 8); }
            if (MODE == 1) mnext = M32[(kb + 1) * 64]; }
#pragma unroll
        for (int i = 0; i < 4; ++i) { const int c16 = i * 64 + lane, key = c16 >> 3, dch = c16 & 7; *(LAS v4u*)(vl + (dch >> 2) * 2048 + (key >> 4) * 1024 + (key & 15) * 64 + (dch & 3) * 16) = vv[i]; }
        f32x16 p;
#pragma unroll
        for (int r = 0; r < 16; ++r) p[r] = 0.f;
#pragma unroll
        for (int d0 = 0; d0 < 4; ++d0) p = __builtin_amdgcn_mfma_f32_32x32x16_bf16(kf[d0], qr[d0], p, 0, 0, 0);
        if (MODE == 0) {
#pragma unroll
            for (int r = 0; r < 16; ++r) { int rel = tq - (kb * 32 + crow(r, hi)); rel = rel < -128 ? -128 : (rel > 128 ? 128 : rel); p[r] += bias_s[rel + 128]; }
        } else {
            const unsigned bits = mword >> (4 * hi);
#pragma unroll
            for (int r = 0; r < 16; ++r) p[r] = ((bits >> ((r & 3) + 8 * (r >> 2))) & 1u) ? p[r] : -INFINITY;
        }
        float bm = p[0];
#pragma unroll
        for (int r = 1; r < 16; ++r) bm = fmaxf(bm, p[r]);
        bm = fmaxf(bm, shflx(bm, 32));
        const float mn = fmaxf(m, bm), alpha = exp2f(m - mn); m = mn;
        float rs = 0.f;
#pragma unroll
        for (int r = 0; r < 16; ++r) { p[r] = exp2f(p[r] - mn); rs += p[r]; }
        lsum = lsum * alpha + rs;
#pragma unroll
        for (int r = 0; r < 16; ++r) { o0[r] *= alpha; o1[r] *= alpha; }
        bf16x8 pa[2];
#pragma unroll
        for (int s = 0; s < 2; ++s) { v4u w; w.x = cvtpk(p[8 * s], p[8 * s + 1]); w.y = cvtpk(p[8 * s + 2], p[8 * s + 3]); w.z = cvtpk(p[8 * s + 4], p[8 * s + 5]); w.w = cvtpk(p[8 * s + 6], p[8 * s + 7]); pa[s] = __builtin_bit_cast(bf16x8, w); }
#pragma unroll
        for (int s = 0; s < 2; ++s) {
            const s16x4 a_lo = vtr(vrd + s * 1024), a_hi = vtr(vrd + s * 1024 + 512), b_lo = vtr(vrd + 2048 + s * 1024), b_hi = vtr(vrd + 2048 + s * 1024 + 512);
            const bf16x8 va = {a_lo[0], a_lo[1], a_lo[2], a_lo[3], a_hi[0], a_hi[1], a_hi[2], a_hi[3]}, vb = {b_lo[0], b_lo[1], b_lo[2], b_lo[3], b_hi[0], b_hi[1], b_hi[2], b_hi[3]};
            o0 = __builtin_amdgcn_mfma_f32_32x32x16_bf16(va, pa[s], o0, 0, 0, 0); o1 = __builtin_amdgcn_mfma_f32_32x32x16_bf16(vb, pa[s], o1, 0, 0, 0);
        }
    }
    lsum += shflx(lsum, 32); const float inv = 1.f / lsum;
    bf16* yrow = Y + (row0 + r32) * 1024 + h * 64 + 4 * hi;
#pragma unroll
    for (int g4 = 0; g4 < 4; ++g4) {
        uint2 w0, w1; w0.x = cvtpk(o0[4 * g4] * inv, o0[4 * g4 + 1] * inv); w0.y = cvtpk(o0[4 * g4 + 2] * inv, o0[4 * g4 + 3] * inv); w1.x = cvtpk(o1[4 * g4] * inv, o1[4 * g4 + 1] * inv); w1.y = cvtpk(o1[4 * g4 + 2] * inv, o1[4 * g4 + 3] * inv);
        *(uint2*)(yrow + 8 * g4) = w0; *(uint2*)(yrow + 32 + 8 * g4) = w1; }
}

template <int MODE, bool FIXM, bool SPLIT = false> __device__ __forceinline__ void flash_wave2(int b, int h, int c, const bf16* Q, const bf16* K, const bf16* V, bf16* Y, LAS unsigned char* vl, const LAS float* bias_s, const u64* MASK, int lane, float mfix,
        int kb0 = -1, int kb1 = -1, int part = 0, LAS float* cmb = nullptr) {
    asm volatile("" : "+v"(lane));
    const int r32 = lane & 31, hi = lane >> 5; const size_t row0 = (size_t)b * SEQ + (size_t)c * 64;
    bf16x8 qr[2][4];
#pragma unroll
    for (int z = 0; z < 2; ++z)
#pragma unroll
        for (int d0 = 0; d0 < 4; ++d0) qr[z][d0] = *(const bf16x8*)(Q + (row0 + 32 * z + r32) * 256 + h * 64 + d0 * 16 + hi * 8);
    const int kb_lo = SPLIT ? kb0 : ((MODE == 0) ? ((c > 8 ? c - 8 : 0) * 2) : 0), kb_hi = SPLIT ? kb1 : (c + 1) * 2;
    f32x16 o[2][2];
#pragma unroll
    for (int z = 0; z < 2; ++z)
#pragma unroll
        for (int r = 0; r < 16; ++r) { o[z][0][r] = 0.f; o[z][1][r] = 0.f; }
    float m[2] = {-1e30f, -1e30f}, lsum[2] = {0.f, 0.f};
    const LAS unsigned char* vrd = vl + ((lane >> 4) & 1) * 32 + (lane & 3) * 8 + (4 * hi + ((lane & 15) >> 2)) * 64;
    unsigned mword[2] = {0, 0}, mnext[2] = {0, 0};
    constexpr int KSTEP = SPLIT ? 2 : 1;
    const unsigned* M32 = (const unsigned*)MASK + (size_t)(b * 64 + c) * (128 * 64) + r32;
    const bf16* Kt = K + ((size_t)b * 128 * 4 + h) * 2048 + lane * 8;
    if (MODE == 1) { mword[0] = M32[kb_lo * 64]; mword[1] = M32[kb_lo * 64 + 32]; }
    const int kb_last = kb_lo + ((kb_hi - 1 - kb_lo) / KSTEP) * KSTEP;
    bf16x8 kfn[4], kfn2[4];
    { const int k1 = kb_lo + KSTEP <= kb_last ? kb_lo + KSTEP : kb_last;
#pragma unroll
      for (int d0 = 0; d0 < 4; ++d0) kfn[d0] = *(const bf16x8*)(Kt + (size_t)kb_lo * 8192 + d0 * 512);
#pragma unroll
      for (int d0 = 0; d0 < 4; ++d0) kfn2[d0] = *(const bf16x8*)(Kt + (size_t)k1 * 8192 + d0 * 512); }
    if (__builtin_amdgcn_readfirstlane((int)((unsigned)(size_t)vl >> 14)) != 0) __builtin_amdgcn_s_sleep(12);
    for (int kb = kb_lo; kb < kb_hi; kb += KSTEP) {
        bf16x8 kf[4]; v4u vv[4];
#pragma unroll
        for (int d0 = 0; d0 < 4; ++d0) { kf[d0] = kfn[d0]; kfn[d0] = kfn2[d0]; }
        const bool mfetch = (MODE == 1) && kb + KSTEP < kb_hi;
        if (mfetch) { mnext[0] = M32[(kb + KSTEP) * 64]; mnext[1] = M32[(kb + KSTEP) * 64 + 32]; }
        { const int k2 = kb + 2 * KSTEP <= kb_last ? kb + 2 * KSTEP : kb_last;
          const size_t krowc = (size_t)b * SEQ + (size_t)kb * 32;
#pragma unroll
          for (int i = 0; i < 4; ++i) { const int c16 = i * 64 + lane, key = c16 >> 3, dch = c16 & 7; vv[i] = *(const v4u*)(V + (krowc + key) * 256 + h * 64 + dch * 8); }
#pragma unroll
          for (int d0 = 0; d0 < 4; ++d0) kfn2[d0] = *(const bf16x8*)(Kt + (size_t)k2 * 8192 + d0 * 512); }
        bf16x8 pa[2][2];
#pragma unroll
        for (int z = 0; z < 2; ++z) {
            f32x16 p;
#pragma unroll
            for (int r = 0; r < 16; ++r) p[r] = FIXM ? -mfix : 0.f;
#pragma unroll
            for (int d0 = 0; d0 < 4; ++d0) p = __builtin_amdgcn_mfma_f32_32x32x16_bf16(kf[d0], qr[z][d0], p, 0, 0, 0);
            if (MODE == 0) { const int tq = c * 64 + 32 * z + r32;
#pragma unroll
                for (int r = 0; r < 16; ++r) { int rel = tq - (kb * 32 + crow(r, hi)); rel = rel < -128 ? -128 : (rel > 128 ? 128 : rel); p[r] += bias_s[rel + 128]; }
            }
            const unsigned bits = (MODE == 1) ? (mword[z] >> (4 * hi)) : 0u;
            float rs = 0.f;
            if (FIXM) {
#pragma unroll
                for (int r = 0; r < 16; ++r) { const float e = __builtin_amdgcn_exp2f(p[r]); p[r] = (MODE == 1) ? (((bits >> ((r & 3) + 8 * (r >> 2))) & 1u) ? e : 0.f) : e; rs += p[r]; }
            } else {
                if (MODE == 1) {
#pragma unroll
                    for (int r = 0; r < 16; ++r) p[r] = ((bits >> ((r & 3) + 8 * (r >> 2))) & 1u) ? p[r] : -INFINITY;
                }
                float bm = p[0];
#pragma unroll
                for (int r = 1; r < 16; ++r) bm = fmaxf(bm, p[r]);
                bm = fmaxf(bm, shflx(bm, 32));
                const float mn = fmaxf(m[z], bm);
                if (__any(mn != m[z])) {
                    const float alpha = __builtin_amdgcn_exp2f(m[z] - mn); lsum[z] *= alpha;
#pragma unroll
                    for (int r = 0; r < 16; ++r) { o[z][0][r] *= alpha; o[z][1][r] *= alpha; }
                    m[z] = mn; }
#pragma unroll
                for (int r = 0; r < 16; ++r) { p[r] = __builtin_amdgcn_exp2f(p[r] - mn); rs += p[r]; }
            }
            lsum[z] += rs;
#pragma unroll
            for (int s = 0; s < 2; ++s) { v4u w; w.x = cvtpk(p[8 * s], p[8 * s + 1]); w.y = cvtpk(p[8 * s + 2], p[8 * s + 3]); w.z = cvtpk(p[8 * s + 4], p[8 * s + 5]); w.w = cvtpk(p[8 * s + 6], p[8 * s + 7]); pa[z][s] = __builtin_bit_cast(bf16x8, w); }
        }
        asm volatile("" : "+v"(pa[0][0]), "+v"(pa[0][1]), "+v"(pa[1][0]), "+v"(pa[1][1]) :: "memory");
#pragma unroll
        for (int i = 0; i < 4; ++i) { const int c16 = i * 64 + lane, key = c16 >> 3, dch = c16 & 7; *(LAS v4u*)(vl + (dch >> 2) * 2048 + (key >> 4) * 1024 + (key & 15) * 64 + (dch & 3) * 16) = vv[i]; }
#pragma unroll
        for (int s = 0; s < 2; ++s) {
            const s16x4 a_lo = vtr(vrd + s * 1024), a_hi = vtr(vrd + s * 1024 + 512), b_lo = vtr(vrd + 2048 + s * 1024), b_hi = vtr(vrd + 2048 + s * 1024 + 512);
            const bf16x8 va = {a_lo[0], a_lo[1], a_lo[2], a_lo[3], a_hi[0], a_hi[1], a_hi[2], a_hi[3]}, vb = {b_lo[0], b_lo[1], b_lo[2], b_lo[3], b_hi[0], b_hi[1], b_hi[2], b_hi[3]};
#pragma unroll
            for (int z = 0; z < 2; ++z) { o[z][0] = __builtin_amdgcn_mfma_f32_32x32x16_bf16(va, pa[z][s], o[z][0], 0, 0, 0); o[z][1] = __builtin_amdgcn_mfma_f32_32x32x16_bf16(vb, pa[z][s], o[z][1], 0, 0, 0); }
        }
        if (mfetch) { mword[0] = mnext[0]; mword[1] = mnext[1]; }
    }
    if constexpr (SPLIT) {
        if (part == 1) {
#pragma unroll
            for (int z = 0; z < 2; ++z) {
#pragma unroll
                for (int r = 0; r < 16; ++r) { cmb[((z * 2 + 0) * 16 + r) * 64 + lane] = o[z][0][r]; cmb[((z * 2 + 1) * 16 + r) * 64 + lane] = o[z][1][r]; }
                cmb[4096 + z * 64 + lane] = lsum[z]; } }
        __syncthreads();
        if (part == 2) {
#pragma unroll
            for (int z = 0; z < 2; ++z) {
#pragma unroll
                for (int r = 0; r < 16; ++r) { o[z][0][r] += cmb[((z * 2 + 0) * 16 + r) * 64 + lane]; o[z][1][r] += cmb[((z * 2 + 1) * 16 + r) * 64 + lane]; }
                lsum[z] += cmb[4096 + z * 64 + lane]; } }
        __syncthreads();
        if (part == 1) return;
    }
#pragma unroll
    for (int z = 0; z < 2; ++z) {
        const float lt = lsum[z] + shflx(lsum[z], 32); const float inv = 1.f / lt;
        bf16* yrow = Y + (row0 + 32 * z + r32) * 1024 + h * 64 + 4 * hi;
#pragma unroll
        for (int g4 = 0; g4 < 4; ++g4) {
            uint2 w0, w1; w0.x = cvtpk(o[z][0][4 * g4] * inv, o[z][0][4 * g4 + 1] * inv); w0.y = cvtpk(o[z][0][4 * g4 + 2] * inv, o[z][0][4 * g4 + 3] * inv); w1.x = cvtpk(o[z][1][4 * g4] * inv, o[z][1][4 * g4 + 1] * inv); w1.y = cvtpk(o[z][1][4 * g4 + 2] * inv, o[z][1][4 * g4 + 3] * inv);
            *(uint2*)(yrow + 8 * g4) = w0; *(uint2*)(yrow + 32 + 8 * g4) = w1; }
    }
}
__device__ __forceinline__ void phase_attn_a(Frame& F, int l) {
    LAS float* bias_s = (LAS float*)(F.lds + 32768);
    LAS unsigned char* vl = F.lds + F.wave * 4096;
    __syncthreads();
    for (int i = F.tid; i < 4 * 257; i += 512) bias_s[(i / 257) * 260 + (i % 257)] = F.rel_bias[(size_t)l * 4 * 257 + i] * LOG2E;
    __syncthreads();
    for (int u = blockIdx.x * 8 + F.wave; u < BATCH * 4 * 64; u += F.G * 8) { const int wgi = u >> 3; const int b = wgi & 7, h = (wgi >> 3) & 3, c = (wgi >> 5) * 8 + (u & 7);
        flash_wave2<0, false>(b, h, c, F.QA, F.KA, F.VA, F.YCAT, vl, bias_s + h * 260, nullptr, F.lane, 0.f); }
}
__device__ __forceinline__ void phase_attn_b(Frame& F, int l) {
    LAS unsigned char* vl = F.lds + F.wave * 4096;
    __syncthreads();
    float gq = fabsf(F.qk_gain_b[l * 128 + F.lane]), gk = fabsf(F.qk_gain_b[l * 128 + 64 + F.lane]); gq = wave_max(gq); gk = wave_max(gk);
    const float mfix = 64.f * gq * gk * pg8::QSCALE; const bool fixm = mfix < 40.f;
    for (int wg = blockIdx.x; wg < 256; wg += F.G) { const int b = wg & 7, jc = wg >> 3, w = F.wave; const int h = w & 3;
        if (fixm) {
            LAS float* cmb = (LAS float*)(F.lds + 32768) + h * 4224;
#pragma unroll 1
            for (int ci = 0; ci < 2; ++ci) { const int c = ci ? jc : 63 - jc, half = w >> 2;
                flash_wave2<1, true, true>(b, h, c, F.QB, F.KB, F.VB, F.YCAT + 256, vl, nullptr, F.MASK, F.lane, mfix, half, 2 * (c + 1), half ? 1 : 2, cmb); }
        } else { const int c = (w & 4) ? 63 - jc : jc;
#pragma unroll 1
            for (int z = 0; z < 2; ++z) flash_wave<1>(b, h, 2 * c + z, F.QB, F.KB, F.VB, F.YCAT + 256, vl, nullptr, F.MASK, F.lane); } }
}

__device__ __forceinline__ float dpp_quad_sum(float v) {
    int x = __builtin_bit_cast(int, v); float a = v + __builtin_bit_cast(float, __builtin_amdgcn_update_dpp(0, x, 0xB1, 0xF, 0xF, false));
    x = __builtin_bit_cast(int, a); return a + __builtin_bit_cast(float, __builtin_amdgcn_update_dpp(0, x, 0x4E, 0xF, 0xF, false));
}
__device__ __forceinline__ int wave_sum_dpp(int x) {
    x += __builtin_amdgcn_update_dpp(0, x, 0x111, 0xF, 0xF, true); x += __builtin_amdgcn_update_dpp(0, x, 0x112, 0xF, 0xF, true);
    x += __builtin_amdgcn_update_dpp(0, x, 0x114, 0xF, 0xF, true); x += __builtin_amdgcn_update_dpp(0, x, 0x118, 0xF, 0xF, true);
    x += __builtin_amdgcn_update_dpp(0, x, 0x142, 0xA, 0xF, false); x += __builtin_amdgcn_update_dpp(0, x, 0x143, 0xC, 0xF, false);
    return __builtin_amdgcn_readlane(x, 63);
}
__device__ __forceinline__ int wave_scan_dpp(int x) {
    x += __builtin_amdgcn_update_dpp(0, x, 0x111, 0xF, 0xF, true); x += __builtin_amdgcn_update_dpp(0, x, 0x112, 0xF, 0xF, true);
    x += __builtin_amdgcn_update_dpp(0, x, 0x114, 0xF, 0xF, true); x += __builtin_amdgcn_update_dpp(0, x, 0x118, 0xF, 0xF, true);
    x += __builtin_amdgcn_update_dpp(0, x, 0x142, 0xA, 0xF, false); x += __builtin_amdgcn_update_dpp(0, x, 0x143, 0xC, 0xF, false);
    return x;
}
#define TK_CNT1(acc, key, cand) asm("v_cmp_ge_u32 vcc, %1, %2\n\tv_addc_co_u32 %0, vcc, 0, %0, vcc" : "+v"(acc) : "v"(key), "v"(cand) : "vcc")
template <int N> __device__ __forceinline__ int lane_count_ge(const unsigned (&k)[N], unsigned cand) {
    int c0 = 0, c1 = 0, c2 = 0, c3 = 0;
#pragma unroll
    for (int i = 0; i < N; ++i) { if ((i & 3) == 0) TK_CNT1(c0, k[i], cand); else if ((i & 3) == 1) TK_CNT1(c1, k[i], cand); else if ((i & 3) == 2) TK_CNT1(c2, k[i], cand); else TK_CNT1(c3, k[i], cand); }
    return (c0 + c1) + (c2 + c3);
}
__device__ __forceinline__ unsigned wave_max_dpp(unsigned x) {
    x = max(x, (unsigned)__builtin_amdgcn_update_dpp(0, (int)x, 0x111, 0xF, 0xF, true)); x = max(x, (unsigned)__builtin_amdgcn_update_dpp(0, (int)x, 0x112, 0xF, 0xF, true));
    x = max(x, (unsigned)__builtin_amdgcn_update_dpp(0, (int)x, 0x114, 0xF, 0xF, true)); x = max(x, (unsigned)__builtin_amdgcn_update_dpp(0, (int)x, 0x118, 0xF, 0xF, true));
    x = max(x, (unsigned)__builtin_amdgcn_update_dpp((int)x, (int)x, 0x142, 0xA, 0xF, false)); x = max(x, (unsigned)__builtin_amdgcn_update_dpp((int)x, (int)x, 0x143, 0xC, 0xF, false));
    return (unsigned)__builtin_amdgcn_readlane((int)x, 63);
}
template <int N> __device__ __forceinline__ void bisect_keys(const unsigned (&k)[N], int target, unsigned& prefix, bool& exact, unsigned prefix0 = 0u, int bit0 = 31) {
    prefix = prefix0; exact = false;
    for (int bit = bit0; bit >= 0; --bit) { const unsigned cand = prefix | (1u << bit);
        const int cnt = wave_sum_dpp(lane_count_ge<N>(k, cand));
        if (cnt >= target) { prefix = cand; if (cnt == target) { exact = true; break; } } }
}
template <int NR> __device__ __forceinline__ void topk_core(const unsigned (&k)[NR], int nw, LAS unsigned* mrow, int lane, LAS unsigned* cbuf) {
    unsigned prefix = 0u; bool exact = false, have = false;
    if constexpr (NR >= 32) {
        constexpr int NS = NR / 8; unsigned ks[NS];
#pragma unroll
        for (int j = 0; j < NS; ++j) ks[j] = k[4 + 8 * j];
        const int ns = (nw + 3) >> 3, rs = (352 * ns + nw - 1) / nw;
        unsigned L; bool exs; bisect_keys<NS>(ks, rs, L, exs);
        const int cl = lane_count_ge<NR>(k, L), incl = wave_scan_dpp(cl), C = __builtin_amdgcn_readlane(incl, 63);
        if (C >= 256 && C <= 512) {
            int off = incl - cl;
#pragma unroll
            for (int i = 0; i < NR; ++i) { const bool in = k[i] >= L; cbuf[in ? off : 512 + lane] = k[i]; off += in ? 1 : 0; }
            unsigned kc[8];
#pragma unroll
            for (int j = 0; j < 8; ++j) kc[j] = cbuf[j * 64 + lane];
            asm volatile("" ::: "memory");
#pragma unroll
            for (int j = 0; j < 8; ++j) kc[j] = (j * 64 + lane < C) ? kc[j] : 0u;
            unsigned kmx = kc[0];
#pragma unroll
            for (int j = 1; j < 8; ++j) kmx = max(kmx, kc[j]);
            kmx = wave_max_dpp(kmx);
            const unsigned dx = L ^ kmx; const int hb = dx ? 31 - __builtin_clz(dx) : -1;
            bisect_keys<8>(kc, 256, prefix, exact, hb >= 31 ? 0u : ((L >> (hb + 1)) << (hb + 1)), hb);
            if (exact && prefix < L) prefix = L;
            have = true;
        }
    }
    if (!have) bisect_keys<NR>(k, 256, prefix, exact);
    if (exact) {
#pragma unroll
        for (int i = 0; i < NR; ++i) { const u64 w = __ballot(k[i] >= prefix); if (i < nw && lane == 0) { mrow[2 * i] = (unsigned)w; mrow[2 * i + 1] = (unsigned)(w >> 32); } }
    } else {
        int n_gt = 0;
#pragma unroll
        for (int i = 0; i < NR; ++i) n_gt += __popcll(__ballot(k[i] > prefix));
        const int allowed = 256 - n_gt; int running = 0; const u64 lt = (1ull << lane) - 1ull;
#pragma unroll
        for (int i = 0; i < NR; ++i) { const bool gt = k[i] > prefix, eq = k[i] == prefix; const u64 eqb = __ballot(eq); const int rank = running + __popcll(eqb & lt); running += __popcll(eqb);
            const u64 w = __ballot(gt || (eq && rank < allowed)); if (i < nw && lane == 0) { mrow[2 * i] = (unsigned)w; mrow[2 * i + 1] = (unsigned)(w >> 32); } }
    }
}
constexpr int SCP = 2052;
__device__ __forceinline__ void idx_scores16(const bf16* IK, LAS unsigned* sc, int b, int t_lo, int t_hi, int wave, int lane, const bf16x8 (&qf)[2][4], const f32x4 (&wq)[2][4]) {
    asm volatile("" : "+v"(lane));
    const int r32 = lane & 31, hi = lane >> 5;
    const bf16* kbase = IK + (size_t)b * (SEQ * 64) + lane * 8;
    bf16x8 kn[2][4];
#pragma unroll
    for (int g = 0; g < 2; ++g) { const int tt = t_lo + wave + 8 * g, tc = tt < t_hi ? tt : t_hi - 1;
#pragma unroll
        for (int d0 = 0; d0 < 4; ++d0) kn[g][d0] = *(const bf16x8*)(kbase + tc * 2048 + d0 * 512); }
    for (int t = t_lo + wave; t < t_hi; t += 16) {
        bf16x8 kf[2][4];
#pragma unroll
        for (int g = 0; g < 2; ++g)
#pragma unroll
            for (int d0 = 0; d0 < 4; ++d0) kf[g][d0] = kn[g][d0];
        if (t + 16 < t_hi) {
#pragma unroll
            for (int g = 0; g < 2; ++g) { const int tt = t + 16 + 8 * g, tc = tt < t_hi ? tt : t_hi - 1;
#pragma unroll
                for (int d0 = 0; d0 < 4; ++d0) kn[g][d0] = *(const bf16x8*)(kbase + tc * 2048 + d0 * 512); } }
#pragma unroll
        for (int g = 0; g < 2; ++g) { const int tt = t + 8 * g;
            if (tt < t_hi) {
#pragma unroll
                for (int qg = 0; qg < 2; ++qg) {
                    f32x16 d;
#pragma unroll
                    for (int r = 0; r < 16; ++r) d[r] = 0.f;
#pragma unroll
                    for (int d0 = 0; d0 < 4; ++d0) d = __builtin_amdgcn_mfma_f32_32x32x16_bf16(qf[qg][d0], kf[g][d0], d, 0, 0, 0);
#pragma unroll
                    for (int k4 = 0; k4 < 4; ++k4) { float sv = 0.f;
#pragma unroll
                        for (int e = 0; e < 4; ++e) sv += wq[qg][k4][e] * __builtin_amdgcn_fmed3f(d[4 * k4 + e], 0.f, INFINITY);
                        sc[(8 * qg + 2 * k4 + hi) * SCP + (tt - t_lo) * 32 + r32] = fkey(sv + 0.0f); }
                }
            }
        }
    }
}
template <int NR> __device__ __forceinline__ void idx_select_row(const unsigned (&k)[NR], int nw, LAS unsigned* mrow, LAS unsigned* cbuf, unsigned* mg_row, int lane) {
    topk_core<NR>(k, nw, mrow, lane, cbuf);
    const int nt = 2 * nw;
    for (int kb = lane; kb < nt; kb += 64) mg_row[kb * 64] = mrow[kb];
}
__device__ __forceinline__ void phase_idx(Frame& F) {
    LAS unsigned* sc = (LAS unsigned*)F.lds;
    constexpr int MST = 136; LAS unsigned* mst = (LAS unsigned*)(F.lds + 16 * SCP * 4) + F.wave * MST;
    const int lane = F.lane, r32 = lane & 31, hi = lane >> 5, qq = r32 >> 2, hd = r32 & 3;
    __syncthreads();
    for (int u = blockIdx.x; u < BATCH * 256; u += F.G) {
        const int wgv = u & 255, i8 = u >> 8; const int b = wgv & 7, jc = wgv >> 3; const int chunk = (i8 & 4) ? 63 - jc : jc; const int q0 = chunk * 64 + (i8 & 3) * 16;
        const size_t row0 = (size_t)b * SEQ + q0; const int c = q0 >> 6, nw = c + 1, nt = 2 * nw;
        unsigned* mg = (unsigned*)F.MASK + (size_t)(b * 64 + c) * (128 * 64) + (q0 & 63);
        if (nw <= 4) { int tidl = F.tid; asm volatile("" : "+v"(tidl)); const int kbq = tidl >> 4, r16 = tidl & 15; if (kbq < nt) mg[kbq * 64 + r16] = ~0u; continue; }
        bf16x8 qf[2][4]; f32x4 wq[2][4];
#pragma unroll
        for (int qg = 0; qg < 2; ++qg) {
#pragma unroll
            for (int d0 = 0; d0 < 4; ++d0) qf[qg][d0] = *(const bf16x8*)(F.IQ + (row0 + 8 * qg + qq) * 256 + hd * 64 + d0 * 16 + hi * 8);
#pragma unroll
            for (int k4 = 0; k4 < 4; ++k4) wq[qg][k4] = *(const f32x4*)(F.IW + (row0 + 8 * qg + 2 * k4 + hi) * 4); }
        LAS unsigned* srA = sc + F.wave * SCP; LAS unsigned* srB = sc + (F.wave + 8) * SCP;
        unsigned* mgA = mg + F.wave; unsigned* mgB = mg + F.wave + 8;
        if (nw <= 32) {
            idx_scores16(F.IK, sc, b, 0, nt, F.wave, lane, qf, wq);
            __syncthreads();
            if (nw <= 16) {
                { unsigned k[16];
#pragma unroll
                  for (int i = 0; i < 16; ++i) k[i] = srA[i * 64 + lane];
                  asm volatile("" ::: "memory");
#pragma unroll
                  for (int i = 0; i < 16; ++i) k[i] = (i < nw) ? k[i] : 0u;
                  idx_select_row<16>(k, nw, mst, srA, mgA, lane); }
                { unsigned k[16];
#pragma unroll
                  for (int i = 0; i < 16; ++i) k[i] = srB[i * 64 + lane];
                  asm volatile("" ::: "memory");
#pragma unroll
                  for (int i = 0; i < 16; ++i) k[i] = (i < nw) ? k[i] : 0u;
                  idx_select_row<16>(k, nw, mst, srB, mgB, lane); }
            } else {
                { unsigned k[32];
#pragma unroll
                  for (int i = 0; i < 32; ++i) k[i] = srA[i * 64 + lane];
                  asm volatile("" ::: "memory");
#pragma unroll
                  for (int i = 0; i < 32; ++i) k[i] = (i < nw) ? k[i] : 0u;
                  idx_select_row<32>(k, nw, mst, srA, mgA, lane); }
                { unsigned k[32];
#pragma unroll
                  for (int i = 0; i < 32; ++i) k[i] = srB[i * 64 + lane];
                  asm volatile("" ::: "memory");
#pragma unroll
                  for (int i = 0; i < 32; ++i) k[i] = (i < nw) ? k[i] : 0u;
                  idx_select_row<32>(k, nw, mst, srB, mgB, lane); }
            }
            __syncthreads();
        } else {
            idx_scores16(F.IK, sc, b, 0, 64, F.wave, lane, qf, wq);
            __syncthreads();
            unsigned ka[32], kb_[32];
#pragma unroll
            for (int i = 0; i < 32; ++i) { ka[i] = srA[i * 64 + lane]; kb_[i] = srB[i * 64 + lane]; }
            __syncthreads();
            idx_scores16(F.IK, sc, b, 64, nt, F.wave, lane, qf, wq);
            __syncthreads();
            const int nw2 = nw - 32;
            if (nw <= 48) {
                { unsigned k[48];
#pragma unroll
                  for (int i = 0; i < 32; ++i) k[i] = ka[i];
#pragma unroll
                  for (int i = 0; i < 16; ++i) k[32 + i] = srA[i * 64 + lane];
                  asm volatile("" ::: "memory");
#pragma unroll
                  for (int i = 0; i < 16; ++i) k[32 + i] = (i < nw2) ? k[32 + i] : 0u;
                  idx_select_row<48>(k, nw, mst, srA, mgA, lane); }
                { unsigned k[48];
#pragma unroll
                  for (int i = 0; i < 32; ++i) k[i] = kb_[i];
#pragma unroll
                  for (int i = 0; i < 16; ++i) k[32 + i] = srB[i * 64 + lane];
                  asm volatile("" ::: "memory");
#pragma unroll
                  for (int i = 0; i < 16; ++i) k[32 + i] = (i < nw2) ? k[32 + i] : 0u;
                  idx_select_row<48>(k, nw, mst, srB, mgB, lane); }
            } else {
                { unsigned k[64];
#pragma unroll
                  for (int i = 0; i < 32; ++i) k[i] = ka[i];
#pragma unroll
                  for (int i = 0; i < 32; ++i) k[32 + i] = srA[i * 64 + lane];
                  asm volatile("" ::: "memory");
#pragma unroll
                  for (int i = 0; i < 32; ++i) k[32 + i] = (i < nw2) ? k[32 + i] : 0u;
                  idx_select_row<64>(k, nw, mst, srA, mgA, lane); }
                { unsigned k[64];
#pragma unroll
                  for (int i = 0; i < 32; ++i) k[i] = kb_[i];
#pragma unroll
                  for (int i = 0; i < 32; ++i) k[32 + i] = srB[i * 64 + lane];
                  asm volatile("" ::: "memory");
#pragma unroll
                  for (int i = 0; i < 32; ++i) k[32 + i] = (i < nw2) ? k[32 + i] : 0u;
                  idx_select_row<64>(k, nw, mst, srB, mgB, lane); }
            }
            __syncthreads();
        }
    }
}

typedef float f32x4v __attribute__((ext_vector_type(4)));
template <int SH> __device__ __forceinline__ float dpp_shr(float v, float ident) {
    return __builtin_bit_cast(float, __builtin_amdgcn_update_dpp(__builtin_bit_cast(int, ident), __builtin_bit_cast(int, v), 0x110 + SH, 0xF, 0xF, false));
}
__device__ __forceinline__ float row_last(float v, int lane) { return shfl_from(v, (lane & 48) | 15); }
struct LruIn { bf16x8 x3[2]; uint2 u3; uint2 cyw; };
__device__ __forceinline__ void lru_load(LruIn& I, const bf16* CX, const bf16* CY, size_t brow, int t0, int g, int q4, int lane) {
    const int tk = lane & 15, lg = lane >> 4; const int t = t0 + tk;
#pragma unroll
    for (int hf = 0; hf < 2; ++hf) I.x3[hf] = *(const bf16x8*)(CX + (brow + t) * 512 + g * 64 + 32 * hf + 8 * lg);
    I.u3 = *(const uint2*)(CX + (brow + t) * 512 + g * 64 + 16 * q4 + 4 * lg);
    I.cyw = *(const uint2*)(CY + (brow + t) * 512 + g * 64 + 16 * q4 + 4 * lg);
}
template <int N> __device__ __forceinline__ unsigned tap_shift(unsigned cur, unsigned prev) {
    const int a = __builtin_amdgcn_update_dpp(0, (int)prev, 0x120 + N, 0xF, 0xF, false);
    return (unsigned)__builtin_amdgcn_update_dpp(a, (int)cur, 0x110 + N, 0xF, 0xF, false);
}
template <int N> __device__ __forceinline__ bf16x8 tap_shift8(const bf16x8& cur, const bf16x8& prev) {
    const v4u c = __builtin_bit_cast(v4u, cur), p = __builtin_bit_cast(v4u, prev); v4u r;
    r.x = tap_shift<N>(c.x, p.x); r.y = tap_shift<N>(c.y, p.y); r.z = tap_shift<N>(c.z, p.z); r.w = tap_shift<N>(c.w, p.w); return __builtin_bit_cast(bf16x8, r);
}
__device__ __forceinline__ void lru_subtile(const LruIn& I, const LruIn& P, bf16* Y0, bf16* Y1, size_t brow, int t0, int g, int q4, int lane,
        const bf16x8 (&Awa)[8], const bf16x8 (&Awx)[8], const float (&cw)[4][4], const float (&cb)[4], const float (&ca)[4], const float (&cx_)[4], const float (&sp)[4],
        float (&Arun)[4], float (&hc)[4]) {
    const int tk = lane & 15, lg = lane >> 4; const int t = t0 + tk;
    f32x4v accA = {0.f, 0.f, 0.f, 0.f}, accX = {0.f, 0.f, 0.f, 0.f};
    bf16x8 bx[8]; uint2 uw[4];
#pragma unroll
    for (int hf = 0; hf < 2; ++hf) { bx[0 + hf] = tap_shift8<3>(I.x3[hf], P.x3[hf]); bx[2 + hf] = tap_shift8<2>(I.x3[hf], P.x3[hf]); bx[4 + hf] = tap_shift8<1>(I.x3[hf], P.x3[hf]); bx[6 + hf] = I.x3[hf]; }
    uw[0].x = tap_shift<3>(I.u3.x, P.u3.x); uw[0].y = tap_shift<3>(I.u3.y, P.u3.y); uw[1].x = tap_shift<2>(I.u3.x, P.u3.x); uw[1].y = tap_shift<2>(I.u3.y, P.u3.y);
    uw[2].x = tap_shift<1>(I.u3.x, P.u3.x); uw[2].y = tap_shift<1>(I.u3.y, P.u3.y); uw[3] = I.u3;
#pragma unroll
    for (int ks = 0; ks < 8; ++ks) { accA = __builtin_amdgcn_mfma_f32_16x16x32_bf16(Awa[ks], bx[ks], accA, 0, 0, 0); accX = __builtin_amdgcn_mfma_f32_16x16x32_bf16(Awx[ks], bx[ks], accX, 0, 0, 0); }
    float u[4] = {cb[0], cb[1], cb[2], cb[3]};
#pragma unroll
    for (int q = 0; q < 4; ++q) { const uint2 w = uw[q];
        u[0] += cw[q][0] * bflo(w.x); u[1] += cw[q][1] * bfhi(w.x); u[2] += cw[q][2] * bflo(w.y); u[3] += cw[q][3] * bfhi(w.y); }
    const uint2 cyw = I.cyw;
    const float cy[4] = {bflo(cyw.x), bfhi(cyw.x), bflo(cyw.y), bfhi(cyw.y)};
    float A[4], B[4];
#pragma unroll
    for (int r = 0; r < 4; ++r) { const float rg = __builtin_amdgcn_rcpf(1.f + __expf(-(accA[r] + ca[r]))), ig = __builtin_amdgcn_rcpf(1.f + __expf(-(accX[r] + cx_[r])));
        const float la = -8.f * rg * sp[r]; const float y2 = 2.f * la; A[r] = __expf(la);
        const float om = (y2 > -0.3f) ? -y2 * (1.f + y2 * (0.5f + y2 * (0.16666667f + y2 * 0.041666668f))) : 1.f - A[r] * A[r];
        B[r] = __builtin_amdgcn_sqrtf(om) * (ig * u[r]); }
#pragma unroll
    for (int r = 0; r < 4; ++r) {
        { const float ap = dpp_shr<1>(A[r], 1.f), bp = dpp_shr<1>(B[r], 0.f); B[r] = A[r] * bp + B[r]; A[r] *= ap; }
        { const float ap = dpp_shr<2>(A[r], 1.f), bp = dpp_shr<2>(B[r], 0.f); B[r] = A[r] * bp + B[r]; A[r] *= ap; }
        { const float ap = dpp_shr<4>(A[r], 1.f), bp = dpp_shr<4>(B[r], 0.f); B[r] = A[r] * bp + B[r]; A[r] *= ap; }
        { const float ap = dpp_shr<8>(A[r], 1.f), bp = dpp_shr<8>(B[r], 0.f); B[r] = A[r] * bp + B[r]; A[r] *= ap; }
    }
    float y0[4], y1[4];
#pragma unroll
    for (int r = 0; r < 4; ++r) { const float h = B[r] + A[r] * hc[r], ap = A[r] * Arun[r]; const float z = 0.7978845608028654f * (cy[r] + 0.044715f * cy[r] * cy[r] * cy[r]);
        const float gl = cy[r] * __builtin_amdgcn_rcpf(1.f + __expf(-2.f * z)); y0[r] = h * gl; y1[r] = ap * gl; hc[r] = row_last(h, lane); Arun[r] = row_last(ap, lane); }
    const size_t off = (brow + t) * 512 + g * 64 + 16 * q4 + 4 * lg, off0 = (brow + t) * 1024 + g * 64 + 16 * q4 + 4 * lg;
    uint2 o; o.x = cvtpk(y0[0], y0[1]); o.y = cvtpk(y0[2], y0[3]); *(uint2*)(Y0 + off0) = o;
    o.x = cvtpk(y1[0], y1[1]); o.y = cvtpk(y1[2], y1[3]); *(uint2*)(Y1 + off) = o;
}
__device__ __forceinline__ void phase_lru(Frame& F, int l) {
    LAS float* agg = (LAS float*)(F.lds + 36864);
    const int lane = F.lane, tk = lane & 15, lg = lane >> 4;
    bf16* Y1 = F.YC; bf16* Y0 = F.YCAT + 512;
    for (int u = blockIdx.x; u < 256; u += F.G) {
        const int b = u & 7, g = u >> 5, q4 = (u >> 3) & 3; const size_t brow = (size_t)b * SEQ;
        const float* wa = F.lru_wa + (size_t)(l * 8 + g) * 4096; const float* wx = F.lru_wx + (size_t)(l * 8 + g) * 4096; const float* cwp = F.conv_w + (size_t)l * 4 * 512 + g * 64; const float* cbp = F.conv_b + l * 512 + g * 64;
        bf16x8 Awa[8], Awx[8];
#pragma unroll
        for (int ks = 0; ks < 8; ++ks) { const int q = ks >> 1; v4u pa, px; unsigned wsa[4], wsx[4];
#pragma unroll
            for (int j2 = 0; j2 < 4; ++j2) { const int i0 = 32 * (ks & 1) + 8 * lg + 2 * j2, oc = 16 * q4 + tk;
                const float c0 = cwp[q * 512 + i0], c1 = cwp[q * 512 + i0 + 1];
                wsa[j2] = cvtpk(c0 * wa[i0 * 64 + oc], c1 * wa[(i0 + 1) * 64 + oc]); wsx[j2] = cvtpk(c0 * wx[i0 * 64 + oc], c1 * wx[(i0 + 1) * 64 + oc]); }
            pa.x = wsa[0]; pa.y = wsa[1]; pa.z = wsa[2]; pa.w = wsa[3]; px.x = wsx[0]; px.y = wsx[1]; px.z = wsx[2]; px.w = wsx[3];
            Awa[ks] = __builtin_bit_cast(bf16x8, pa); Awx[ks] = __builtin_bit_cast(bf16x8, px); }
        float cw[4][4], cb[4], ca[4], cx_[4], sp[4];
#pragma unroll
        for (int r = 0; r < 4; ++r) { const int oc = 16 * q4 + 4 * lg + r, cg = g * 64 + oc;
#pragma unroll
            for (int q = 0; q < 4; ++q) cw[q][r] = cwp[q * 512 + oc];
            cb[r] = cbp[oc]; float sa = 0.f, sx = 0.f;
#pragma unroll
            for (int i4 = 0; i4 < 4; ++i4) { const int i = tk + 16 * i4; const float bi = cbp[i]; sa += bi * wa[i * 64 + oc]; sx += bi * wx[i * 64 + oc]; }
#pragma unroll
            for (int o = 1; o < 16; o <<= 1) { sa += shflx(sa, o); sx += shflx(sx, o); }
            ca[r] = sa + F.lru_ba[l * 512 + cg]; cx_[r] = sx + F.lru_bx[l * 512 + cg]; sp[r] = log1pf(expf(-F.lru_lambda[l * 512 + cg])); }
        float Arun[4] = {1.f, 1.f, 1.f, 1.f}, hc[4] = {0.f, 0.f, 0.f, 0.f};
        const int tseg = F.wave * 512;
        LruIn cur, prv; lru_load(cur, F.CX, F.CY, brow, tseg, g, q4, lane);
        lru_load(prv, F.CX, F.CY, brow, tseg >= 16 ? tseg - 16 : 0, g, q4, lane);
        if (tseg == 0) { prv.x3[0] = (bf16x8){0, 0, 0, 0, 0, 0, 0, 0}; prv.x3[1] = (bf16x8){0, 0, 0, 0, 0, 0, 0, 0}; prv.u3 = (uint2){0u, 0u}; }
#pragma unroll 2
        for (int s = 0; s < 32; ++s) { LruIn nxt;
            lru_load(nxt, F.CX, F.CY, brow, tseg + 16 * (s + 1 < 32 ? s + 1 : s), g, q4, lane);
            asm volatile("" ::: "memory");
            lru_subtile(cur, prv, Y0, Y1, brow, tseg + 16 * s, g, q4, lane, Awa, Awx, cw, cb, ca, cx_, sp, Arun, hc);
            prv = cur; cur = nxt; }
        __syncthreads();
        if (tk == 0) {
#pragma unroll
            for (int r = 0; r < 4; ++r) { agg[F.wave * 32 + 4 * lg + r] = Arun[r]; agg[F.wave * 32 + 16 + 4 * lg + r] = hc[r]; } }
        __syncthreads();
        float hin[4] = {0.f, 0.f, 0.f, 0.f};
        for (int w = 0; w < F.wave; ++w) {
#pragma unroll
            for (int r = 0; r < 4; ++r) hin[r] = agg[w * 32 + 4 * lg + r] * hin[r] + agg[w * 32 + 16 + 4 * lg + r]; }
        if (F.wave > 0) {
            asm volatile("s_waitcnt vmcnt(0)" ::: "memory");
#pragma unroll 1
            for (int s8 = 0; s8 < 32; s8 += 8) { uint2 a0[8], a1[8];
#pragma unroll
                for (int j = 0; j < 8; ++j) { const size_t row = brow + tseg + 16 * (s8 + j) + tk; a0[j] = *(const uint2*)(Y0 + row * 1024 + g * 64 + 16 * q4 + 4 * lg); a1[j] = *(const uint2*)(Y1 + row * 512 + g * 64 + 16 * q4 + 4 * lg); }
#pragma unroll
                for (int j = 0; j < 8; ++j) { const size_t row = brow + tseg + 16 * (s8 + j) + tk; uint2 o;
                    o.x = cvtpk(bflo(a0[j].x) + bflo(a1[j].x) * hin[0], bfhi(a0[j].x) + bfhi(a1[j].x) * hin[1]); o.y = cvtpk(bflo(a0[j].y) + bflo(a1[j].y) * hin[2], bfhi(a0[j].y) + bfhi(a1[j].y) * hin[3]);
                    *(uint2*)(Y0 + row * 1024 + g * 64 + 16 * q4 + 4 * lg) = o; } }
        }
    }
}

struct Args { const float* in[20]; float* out; unsigned char* ws; int l_lo, l_hi, ph_lo, ph_hi; };
__device__ __forceinline__ void make_frame(Frame& F, const Args& args, unsigned char* lds_) {
    int tid = wg_tid(); asm volatile("" : "+v"(tid));
    const __attribute__((address_space(4))) unsigned char* ka = (const __attribute__((address_space(4))) unsigned char*)__builtin_amdgcn_kernarg_segment_ptr(); asm volatile("" : "+s"(ka));
#define KARG(k) ((const float*)(GAS const float*)(*(const unsigned long long __attribute__((address_space(4)))*)(ka + 8 * (k))))
    GAS unsigned char* wsg = (GAS unsigned char*)(*(const unsigned long long __attribute__((address_space(4)))*)(ka + 168)); unsigned char* ws = (unsigned char*)wsg;
    F.lds = (LAS unsigned char*)lds_; F.MISC = (volatile LAS unsigned*)(F.lds + MISC_OFF);
    F.tid = tid; F.lane = tid & 63; F.wave = __builtin_amdgcn_readfirstlane(tid >> 6); F.G = gridDim.x;
    F.ctl = (gu32*)(ws + WS_CTL);
    F.x = KARG(0); F.g_mix = KARG(1); F.w_in = KARG(2); F.qk_gain_a = KARG(3); F.rel_bias = KARG(4); F.qk_gain_b = KARG(5); F.g_idx_k = KARG(6);
    F.conv_w = KARG(7); F.conv_b = KARG(8); F.lru_wa = KARG(9); F.lru_ba = KARG(10); F.lru_wx = KARG(11); F.lru_bx = KARG(12); F.lru_lambda = KARG(13);
    F.b_gate = KARG(14); F.w_branch = KARG(15); F.w_out = KARG(16); F.g_ffn = KARG(17); F.w_ffn_in = KARG(18); F.w_ffn_out = KARG(19); F.out = (float*)KARG(20);
#undef KARG
    F.rcos = (float*)(ws + WS_ROPE); F.rsin = F.rcos + SEQ * 32; F.SS = (float*)(ws + WS_SS);
    F.W = (bf16*)(ws + WS_W); F.W2a = (bf16*)(ws + 462 * MiB); F.W2b = (bf16*)((unsigned char*)F.out + 32 * MiB); F.H = (bf16*)(ws + WS_H); F.YC = (bf16*)F.out; F.YCAT = (bf16*)F.out + (size_t)32 * 1024 * 1024;
    F.QA = (bf16*)(ws + WS_QA); F.QB = (bf16*)(ws + WS_QB); F.KA = (bf16*)(ws + WS_KA); F.VA = (bf16*)(ws + WS_VA); F.KB = (bf16*)(ws + WS_KB); F.VB = (bf16*)(ws + WS_VB);
    F.IQ = (bf16*)(ws + WS_IQ); F.IK = (bf16*)(ws + WS_IK); F.IW = (float*)(ws + WS_IW); F.CX = (bf16*)(ws + WS_CX); F.CY = (bf16*)(ws + WS_CY);
    F.GT = (bf16*)(ws + WS_GT); F.ACT = (bf16*)(ws + WS_ACT); F.MG = (bf16*)(ws + WS_MG); F.MASK = (u64*)(ws + WS_MASK);
}
template <int PHM> __global__ void __launch_bounds__(NWAVES * 64, 2) fwd(Args args) {
    { LAS unsigned char* l3 = (LAS unsigned char*)lds; for (int u = threadIdx.x; u < (LDS_BYTES - LDSCTL_OFF) / 4; u += NWAVES * 64) ((LAS unsigned*)(l3 + LDSCTL_OFF))[u] = 0u; }
    __syncthreads();
    static_assert(WGT_LDS_OFF == MISC_OFF + 256 && WGT_LDS_OFF + 256 <= LDS_BYTES, "wave-index table inside the LDS control area");
    if ((threadIdx.x & 63) == 0) ((LAS unsigned*)((LAS unsigned char*)lds + WGT_LDS_OFF))[wgt_slot()] = threadIdx.x >> 6;
    __syncthreads();
    XcdBarrier bar; bar.bar = (unsigned*)(args.ws + WS_CTL) + CW_BAR; bar.x = 0; bar.st = nullptr;
    if (!MK_PER_PHASE) bar = xcd_barrier_post((unsigned*)(args.ws + WS_CTL) + CW_BAR, (volatile LAS unsigned*)((LAS unsigned char*)lds + MISC_OFF) + 8);
#define GRID_BAR() do { if (!MK_PER_PHASE) xcd_barrier(bar); } while (0)
    const int plo = args.ph_lo, phi = args.ph_hi; (void)plo; (void)phi;
#ifndef PHMASK
#define PHMASK 0x1ff
#endif
#if MK_PER_PHASE
#define IN(k) (((PHMASK >> (k)) & 1) && ((PHM >> (k)) & 1) && plo <= (k) && (k) < phi)
#else
#define IN(k) (((PHMASK >> (k)) & 1) && ((PHM >> (k)) & 1))
#endif
    bool first = true;
    for (int l = MK_PER_PHASE ? args.l_lo : 0; l < (MK_PER_PHASE ? args.l_hi : DEPTH); ++l) {
        if (IN(0) && (MK_PER_PHASE || l == 0)) { if (!first) GRID_BAR(); first = false; Frame F; make_frame(F, args, lds); phase_weights(F, l); if (l == 0) phase_xb0(F, F.x, F.SS); }
        if (IN(1)) { if (!first) GRID_BAR(); first = false; Frame F; make_frame(F, args, lds);
            pg8::Gemm g{F.H, wset(F, l).in, M, NIN, D}; pg8::StaticOrder S; S.init(M, NIN, F.G, (int)blockIdx.x);
            pg8::EpiIn E{F.QA, F.KA, F.VA, F.QB, F.KB, F.VB, F.IQ, F.IK, F.IW, F.CX, F.CY, F.GT, F.qk_gain_a + l * 128, F.qk_gain_b + l * 128, F.g_idx_k + l * 64, F.b_gate + l * 3072, F.rcos, F.rsin, F.SS + (size_t)(2 * l) * M * 16, (LAS float*)(F.lds + XTRA_OFF)};
            pg8::gemm_phase<pg8::EpiIn, pg8::StaticOrder, PG8_ALIGN, PG8_SP2>(F.lds + RING_OFF, g, S, E); }
        if (IN(2)) { if (!first) GRID_BAR(); first = false; { Frame F0; make_frame(F0, args, lds); phase_lru(F0, l); } __syncthreads(); Frame F; make_frame(F, args, lds); phase_attn_a(F, l); __syncthreads(); phase_idx(F);
            if (F.G == 256) { asm volatile("s_waitcnt vmcnt(0)" ::: "memory"); __syncthreads(); } else GRID_BAR();
            { Frame F2; make_frame(F2, args, lds); phase_attn_b(F2, l); }
            if (!MK_PER_PHASE && l + 1 < DEPTH) { __syncthreads();
                Frame F3; make_frame(F3, args, lds); phase_weights(F3, l + 1, (unsigned*)(args.ws + WS_CTL) + 64 + l); } }
        if (IN(4)) { if (!first) GRID_BAR(); first = false; Frame F; make_frame(F, args, lds);
#ifndef DBG_HALF
#define DBG_HALF 0
#endif
#ifndef DBG_SKIP_BR
#define DBG_SKIP_BR 0
#endif
            pg8::Gemm g{F.YCAT, wset(F, l).ba, M, D, D}; pg8::StaticOrder S; S.init(M, D, F.G, (int)blockIdx.x); pg8::EpiGateCat E{F.MG, F.GT};
            pg8::gemm_phase<pg8::EpiGateCat, pg8::StaticOrder, PG8_ALIGN, PG8_SP2, true>(F.lds + RING_OFF, g, S, E); }
        if (IN(5)) { if (!first) GRID_BAR(); first = false; Frame F; make_frame(F, args, lds);
            pg8::Gemm g{F.MG, wset(F, l).out, M, D, D}; pg8::StaticOrder S; S.init(M, D, F.G, (int)blockIdx.x); pg8::EpiResidB E{F.H, F.SS + (size_t)(2 * l + 1) * M * 16, nullptr};
            pg8::gemm_phase<pg8::EpiResidB, pg8::StaticOrder, PG8_ALIGN, PG8_SP2>(F.lds + RING_OFF, g, S, E); }
        if (IN(7)) { if (!first) GRID_BAR(); first = false; Frame F; make_frame(F, args, lds);
            pg8::Gemm g{F.H, wset(F, l).f1, M, NF1, D}; pg8::StaticOrder S; S.init(M, NF1, F.G, (int)blockIdx.x); pg8::EpiSwiGLU E{F.ACT, F.SS + (size_t)(2 * l + 1) * M * 16, (LAS float*)(F.lds + XTRA_OFF)};
            pg8::gemm_phase<pg8::EpiSwiGLU, pg8::StaticOrder, PG8_ALIGN, PG8_SP2>(F.lds + RING_OFF, g, S, E); }
        if (IN(8)) { if (!first) GRID_BAR(); first = false; Frame F; make_frame(F, args, lds);
            pg8::Gemm g{F.ACT, wset(F, l).f2, M, D, FF}; pg8::StaticOrder S; S.init(M, D, F.G, (int)blockIdx.x); pg8::EpiResidB E{F.H, F.SS + (size_t)(2 * l + 2 < 2 * DEPTH ? 2 * l + 2 : 0) * M * 16, (l + 1 < DEPTH) ? (float*)nullptr : F.out};
            pg8::gemm_phase<pg8::EpiResidB, pg8::StaticOrder, PG8_ALIGN, PG8_SP2>(F.lds + RING_OFF, g, S, E); }
    }
#undef IN
}

extern "C" void kernel_launch(void* const* d_in, const int* in_sizes, int n_in, void* d_out, int out_size, void* d_ws, size_t ws_size, hipStream_t stream) {
    static int grid = 0;
    if (grid == 0) {
        if (n_in != 20 || in_sizes[0] != M * D || out_size != M * D || ws_size < WS_END) { fprintf(stderr, "kernel_launch: unexpected problem shape / workspace (n_in %d, ws %zu); nothing launched\n", n_in, ws_size); grid = -1; return; }
        int dev = 0, cus = 0, per_cu = 0;
        if (hipGetDevice(&dev) != hipSuccess || hipDeviceGetAttribute(&cus, hipDeviceAttributeMultiprocessorCount, dev) != hipSuccess) { grid = -1; return; }
#if MK_PER_PHASE
        const void* fns[NPH] = {(const void*)fwd<1>, (const void*)fwd<2>, (const void*)fwd<4>, (const void*)fwd<8>, (const void*)fwd<16>, (const void*)fwd<32>, (const void*)fwd<64>, (const void*)fwd<128>, (const void*)fwd<256>};
        for (int i = 0; i < NPH; ++i) if (hipFuncSetAttribute(fns[i], hipFuncAttributeMaxDynamicSharedMemorySize, LDS_BYTES) != hipSuccess) { fprintf(stderr, "kernel_launch: hipFuncSetAttribute failed\n"); grid = -1; return; }
#else
        if (hipFuncSetAttribute((const void*)fwd<0x1ff>, hipFuncAttributeMaxDynamicSharedMemorySize, LDS_BYTES) != hipSuccess) { fprintf(stderr, "kernel_launch: hipFuncSetAttribute failed\n"); grid = -1; return; }
        if (hipOccupancyMaxActiveBlocksPerMultiprocessor(&per_cu, (const void*)fwd<0x1ff>, NWAVES * 64, LDS_BYTES) != hipSuccess || per_cu < 1) fprintf(stderr, "kernel_launch: occupancy query reports %d workgroups per CU\n", per_cu);
#endif
        (void)hipGetLastError(); (void)per_cu;
        grid = cus;
    }
    if (grid < 0) return;
    if (hipMemsetAsync((char*)d_ws + WS_CTL, 0, CTL_ZERO_BYTES, stream) != hipSuccess) return;
    Args a{};
    for (int i = 0; i < 20; ++i) a.in[i] = (const float*)d_in[i];
    a.out = (float*)d_out; a.ws = (unsigned char*)d_ws;
#if MK_PER_PHASE
    for (int l = 0; l < DEPTH; ++l) for (int p = 0; p < NPH; ++p) { a.l_lo = l; a.l_hi = l + 1; a.ph_lo = p; a.ph_hi = p + 1;
        switch (p) {
            case 0: hipLaunchKernelGGL(fwd<1>, dim3(grid), dim3(NWAVES * 64), LDS_BYTES, stream, a); break;
            case 1: hipLaunchKernelGGL(fwd<2>, dim3(grid), dim3(NWAVES * 64), LDS_BYTES, stream, a); break;
            case 2: hipLaunchKernelGGL(fwd<4>, dim3(grid), dim3(NWAVES * 64), LDS_BYTES, stream, a); break;
            case 3: hipLaunchKernelGGL(fwd<8>, dim3(grid), dim3(NWAVES * 64), LDS_BYTES, stream, a); break;
            case 4: hipLaunchKernelGGL(fwd<16>, dim3(grid), dim3(NWAVES * 64), LDS_BYTES, stream, a); break;
            case 5: hipLaunchKernelGGL(fwd<32>, dim3(grid), dim3(NWAVES * 64), LDS_BYTES, stream, a); break;
            case 6: hipLaunchKernelGGL(fwd<64>, dim3(grid), dim3(NWAVES * 64), LDS_BYTES, stream, a); break;
            case 7: hipLaunchKernelGGL(fwd<128>, dim3(grid), dim3(NWAVES * 64), LDS_BYTES, stream, a); break;
            default: hipLaunchKernelGGL(fwd<256>, dim3(grid), dim3(NWAVES * 64), LDS_BYTES, stream, a); break;
        } }
#else
    a.l_lo = 0; a.l_hi = DEPTH; a.ph_lo = 0; a.ph_hi = NPH;
    hipLaunchKernelGGL(fwd<0x1ff>, dim3(grid), dim3(NWAVES * 64), LDS_BYTES, stream, a);
#endif
}
```

```cpp
#include <hip/hip_runtime.h>
#include <cstdio>
#include <cstdint>

#define WGT_LDS_OFF 139840
extern __shared__ __attribute__((aligned(16))) unsigned char lds[];
__device__ __forceinline__ unsigned wgt_slot() { return (unsigned)__builtin_amdgcn_s_getreg((5 << 11) | 4) & 63u; }
__device__ __forceinline__ int wg_lane() { int l; asm volatile("v_mbcnt_lo_u32_b32 %0, -1, 0\n\tv_mbcnt_hi_u32_b32 %0, -1, %0" : "=v"(l)); return l; }
__device__ __forceinline__ int wg_wave() { const volatile __attribute__((address_space(3))) unsigned* tab = (const volatile __attribute__((address_space(3))) unsigned*)((__attribute__((address_space(3))) unsigned char*)lds + WGT_LDS_OFF);
    return __builtin_amdgcn_readfirstlane((int)tab[wgt_slot()]); }
__device__ __forceinline__ int wg_tid() { return wg_wave() * 64 + wg_lane(); }
__device__ __forceinline__ float shflx(float v, int m) { return __builtin_bit_cast(float, __builtin_amdgcn_ds_bpermute((wg_lane() ^ m) << 2, __builtin_bit_cast(int, v))); }
__device__ __forceinline__ float shfl_from(float v, int src) { return __builtin_bit_cast(float, __builtin_amdgcn_ds_bpermute(src << 2, __builtin_bit_cast(int, v))); }
namespace pg8 {
#define PG8_LAS __attribute__((address_space(3)))
typedef unsigned short bf16_t;
typedef short bf16x8 __attribute__((ext_vector_type(8)));
typedef float f32x4 __attribute__((ext_vector_type(4)));
typedef unsigned u32x4 __attribute__((ext_vector_type(4)));
constexpr int BM = 256, BK = 64, HALF = 128, HTB = HALF * BK * 2  , STAGE_BYTES = 8 * HTB, NXCD = 8, WGM = 8;

__host__ __device__ __forceinline__ int lds_byte(int r, int c) { const int st = (r >> 4) * 2 + (c >> 5), rr = r & 15, cc = c & 31, ob = rr * 64 + cc * 2; return st * 1024 + (ob ^ (((ob >> 9) & 1) << 5)); }
__host__ __device__ __forceinline__ void stage_rc(int b, int& R, int& C) { const int st = b / 1024, sb = b % 1024, swz = sb ^ (((sb >> 9) & 1) << 5); R = (st >> 1) * 16 + swz / 64; C = (st & 1) * 32 + (swz % 64) / 2; }
__host__ __device__ __forceinline__ int perm32(int rho) { const int n = rho >> 4, i = rho & 15; return 8 * (i >> 2) + 4 * n + (i & 3); }

struct Unit { int pm, pn; };
struct Gemm { const bf16_t* A; const bf16_t* Bt; int M, N, K; };

struct StaticOrder {
    int nM, nN, nwg, G, c;
    __host__ __device__ void init(int M, int N, int G_, int c_) { nM = M / BM; nN = N / BM; nwg = nM * nN; G = G_; c = c_; }
    __host__ __device__ bool next(int i, Unit& u) const {
        const long L = (long)i * G + c; if (L >= nwg) return false;
        int wgid = (int)L; { const int q = nwg / NXCD, r = nwg % NXCD, xcd = wgid % NXCD, off = wgid / NXCD; wgid = (xcd < r ? xcd * (q + 1) : r * (q + 1) + (xcd - r) * q) + off; }
        const int nig = WGM * nN, gid = wgid / nig, fm = gid * WGM, gsz = (nM - fm) < WGM ? (nM - fm) : WGM;
        u.pm = fm + ((wgid % nig) % gsz); u.pn = (wgid % nig) / gsz; return true;
    }
    __device__ __forceinline__ void a_ready(const Unit&) const {}
    __device__ __forceinline__ void done(const Unit&) const {}
};


typedef float f32x2_t __attribute__((ext_vector_type(2))); typedef __bf16 bf16x2_t __attribute__((ext_vector_type(2)));
__device__ __forceinline__ unsigned cvt_pk_bf16(float lo, float hi) { const f32x2_t v = {lo, hi}; const bf16x2_t b = __builtin_convertvector(v, bf16x2_t); return __builtin_bit_cast(unsigned, b); }
__device__ __forceinline__ u32x4 pack8(const f32x4 a, const f32x4 b) { u32x4 w; w.x = cvt_pk_bf16(a[0], a[1]); w.y = cvt_pk_bf16(a[2], a[3]); w.z = cvt_pk_bf16(b[0], b[1]); w.w = cvt_pk_bf16(b[2], b[3]); return w; }
__device__ __forceinline__ float bflo(unsigned w) { return __builtin_bit_cast(float, w << 16); }
__device__ __forceinline__ float bfhi(unsigned w) { return __builtin_bit_cast(float, w & 0xffff0000u); }
__device__ __forceinline__ float fast_sigmoid(float x) { return __builtin_amdgcn_rcpf(1.f + __expf(-x)); }

__device__ __forceinline__ float row_rs(const float* ssp, int row) { const f32x4* q = (const f32x4*)(ssp + (size_t)row * 16); const f32x4 a = q[0], b = q[1], c = q[2], d = q[3];
    const f32x4 s = (a + b) + (c + d); return __builtin_amdgcn_rsqf(((s[0] + s[1]) + (s[2] + s[3])) * (1.f / 1024.f) + 1e-6f); }
__device__ __forceinline__ const PG8_LAS float* unit_row_scales(const float* ssp, PG8_LAS float* rsl, const Unit& u, int wr, int wc, int fr, int fq) {
    const int lane = fr + 16 * fq;
    PG8_LAS float* mine = rsl + (wr * 4 + wc) * 128;
    mine[lane] = row_rs(ssp, u.pm * BM + wr * 64 + lane); mine[64 + lane] = row_rs(ssp, u.pm * BM + HALF + wr * 64 + lane);
    asm volatile("s_waitcnt lgkmcnt(0)" ::: "memory");
    return mine;
}
constexpr float QSCALE = 0.125f * 1.4426950408889634f;

struct EpiIn {
    static constexpr bool PERM = true, AFTER_DRAIN = false;
    bf16_t *QA, *KA, *VA, *QB, *KB, *VB, *IQ, *IK; float* IW; bf16_t *CX, *CY, *GT;
    const float *gain_a, *gain_b, *gain_ik, *bgate, *rcos, *rsin;
    const float* ss;
    PG8_LAS float* rsl;
    __device__ __forceinline__ void operator()(const f32x4 (&acc)[2][2][4][2], const Unit& u, int wr, int wc, int fr, int fq) const {
        const int pn = u.pn; int row0 = u.pm * BM + wr * 64 + fr; asm volatile("" : "+v"(row0));
        const PG8_LAS float* rsw = unit_row_scales(ss, rsl, u, wr, wc, fr, fq) + fr;
        if (pn >= 12) {
            const int gi = (pn - 12) >> 2, ct = ((pn - 12) & 3) * BM; unsigned char* base = (unsigned char*)GT + (size_t)gi * 32768 * 1024;
            const int col0 = ct + wc * 32 + 8 * fq; const float* bp = bgate + gi * 1024 + col0;
            f32x4 bv[2][2];
#pragma unroll
            for (int bj = 0; bj < 2; ++bj)
#pragma unroll
                for (int n = 0; n < 2; ++n) bv[bj][n] = *(const f32x4*)(bp + bj * HALF + 4 * n);
#pragma unroll
            for (int ai = 0; ai < 2; ++ai)
#pragma unroll
                for (int m = 0; m < 4; ++m) { unsigned char* rowp = base + (size_t)(row0 + ai * HALF + m * 16) * 1024 + col0; const float rs = rsw[ai * 64 + m * 16];
#pragma unroll
                    for (int bj = 0; bj < 2; ++bj) { f32x4 v0 = acc[ai][bj][m][0] * rs + bv[bj][0], v1 = acc[ai][bj][m][1] * rs + bv[bj][1];
                        unsigned w0 = 0u, w1 = 0u;
#pragma unroll
                        for (int e = 0; e < 4; ++e) { w0 = __builtin_amdgcn_cvt_pk_u8_f32(fmaxf(__builtin_rintf(fast_sigmoid(v0[e]) * 255.f), 1.f), e, w0); w1 = __builtin_amdgcn_cvt_pk_u8_f32(fmaxf(__builtin_rintf(fast_sigmoid(v1[e]) * 255.f), 1.f), e, w1); }
                        uint2 wv; wv.x = w0; wv.y = w1; *(uint2*)(rowp + bj * HALF) = wv; }
                    asm volatile("" ::: "memory"); }
            return;
        }
        if (pn >= 8) {
            bf16_t* base = (pn < 10) ? CX : CY; const int col0 = ((pn - 8) & 1) * BM + wc * 32 + 8 * fq;
#pragma unroll
            for (int ai = 0; ai < 2; ++ai)
#pragma unroll
                for (int m = 0; m < 4; ++m) { bf16_t* rowp = base + (size_t)(row0 + ai * HALF + m * 16) * 512 + col0; const float rs = rsw[ai * 64 + m * 16];
#pragma unroll
                    for (int bj = 0; bj < 2; ++bj) *(u32x4*)(rowp + bj * HALF) = pack8(acc[ai][bj][m][0] * rs, acc[ai][bj][m][1] * rs);
                    asm volatile("" ::: "memory"); }
            return;
        }
        bf16_t* dst; const float* gain = nullptr; bool do_norm = false, do_rope = false; float scale = 1.f; int pitch = 256;
        switch (pn) {
            case 0: dst = QA; gain = gain_a; do_norm = true; scale = QSCALE; break;
            case 1: dst = KA; gain = gain_a + 64; do_norm = true; break;
            case 2: dst = VA; break;
            case 3: dst = QB; gain = gain_b; do_norm = true; do_rope = true; scale = QSCALE; break;
            case 4: dst = KB; gain = gain_b + 64; do_norm = true; do_rope = true; break;
            case 5: dst = VB; break;
            case 6: dst = IQ; do_rope = true; break;
            default: dst = IK; gain = gain_ik; do_norm = true; do_rope = true; pitch = 64; break;
        }
        if (pn == 7) {
            if (wc == 1) {
                if (fq == 0) {
#pragma unroll
                    for (int ai = 0; ai < 2; ++ai)
#pragma unroll
                        for (int m = 0; m < 4; ++m) { const int row = row0 + ai * HALF + m * 16; *(f32x4*)(IW + (size_t)row * 4) = acc[ai][0][m][0] * (0.0625f * rsw[ai * 64 + m * 16]); }
                }
                return;
            }
            if (wc != 0) return;
        }
        f32x4 g[2][2];
#pragma unroll
        for (int bj = 0; bj < 2; ++bj)
#pragma unroll
            for (int n = 0; n < 2; ++n) g[bj][n] = do_norm ? *(const f32x4*)(gain + bj * 32 + 8 * fq + 4 * n) * scale : (f32x4){scale, scale, scale, scale};
        const int colb = (pn == 7 ? 0 : wc * 64) + 8 * fq;
#pragma unroll
        for (int ai = 0; ai < 2; ++ai)
#pragma unroll
            for (int m = 0; m < 4; ++m) {
                const int row = row0 + ai * HALF + m * 16;
                const float rsx = rsw[ai * 64 + m * 16];
                f32x4 lo0 = acc[ai][0][m][0] * rsx, lo1 = acc[ai][0][m][1] * rsx, hi0 = acc[ai][1][m][0] * rsx, hi1 = acc[ai][1][m][1] * rsx;
                if (do_norm) {
                    f32x4 s4 = lo0 * lo0 + lo1 * lo1 + hi0 * hi0 + hi1 * hi1; float ss = (s4[0] + s4[1]) + (s4[2] + s4[3]);
                    ss += shflx(ss, 16); ss += shflx(ss, 32);
                    const float rs = __builtin_amdgcn_rsqf(ss * (1.f / 64.f) + 1e-6f);
                    lo0 = lo0 * rs; lo1 = lo1 * rs; hi0 = hi0 * rs; hi1 = hi1 * rs;
                }
                lo0 = lo0 * g[0][0]; lo1 = lo1 * g[0][1]; hi0 = hi0 * g[1][0]; hi1 = hi1 * g[1][1];
                if (do_rope) {
                    const int t = row & 4095; const float* cp = rcos + t * 32 + 8 * fq; const float* sp = rsin + t * 32 + 8 * fq;
                    const f32x4 c0 = *(const f32x4*)cp, c1 = *(const f32x4*)(cp + 4), s0 = *(const f32x4*)sp, s1 = *(const f32x4*)(sp + 4);
                    const f32x4 a0 = lo0 * c0 - hi0 * s0, a1 = lo1 * c1 - hi1 * s1, b0 = hi0 * c0 + lo0 * s0, b1 = hi1 * c1 + lo1 * s1;
                    lo0 = a0; lo1 = a1; hi0 = b0; hi1 = b1;
                }
                if (pn == 7) {
                    bf16_t* tp = dst + (size_t)(row >> 5) * 2048 + (fq >> 1) * 512 + ((fq & 1) * 32 + (row & 31)) * 8;
                    *(u32x4*)(tp) = pack8(lo0, lo1); *(u32x4*)(tp + 1024) = pack8(hi0, hi1);
                } else if (pn == 1 || pn == 4) {
                    bf16_t* tp = dst + ((size_t)(row >> 5) * 4 + wc) * 2048 + (fq >> 1) * 512 + ((fq & 1) * 32 + (row & 31)) * 8;
                    *(u32x4*)(tp) = pack8(lo0, lo1); *(u32x4*)(tp + 1024) = pack8(hi0, hi1);
                } else {
                    bf16_t* rowp = dst + (size_t)row * pitch + colb;
                    *(u32x4*)(rowp) = pack8(lo0, lo1); *(u32x4*)(rowp + 32) = pack8(hi0, hi1); }
                asm volatile("" ::: "memory");
            }
    }
};

struct EpiGate {
    static constexpr bool PERM = true, AFTER_DRAIN = false;
    bf16_t* MG; const bf16_t* G; bool first;
    __device__ __forceinline__ void operator()(const f32x4 (&acc)[2][2][4][2], const Unit& u, int wr, int wc, int fr, int fq) const {
        int row0 = u.pm * BM + wr * 64 + fr; const int col0 = u.pn * BM + wc * 32 + 8 * fq; asm volatile("" : "+v"(row0));
#pragma unroll
        for (int ai = 0; ai < 2; ++ai)
#pragma unroll
            for (int m = 0; m < 4; ++m) { const size_t off = (size_t)(row0 + ai * HALF + m * 16) * 1024 + col0;
#pragma unroll
                for (int bj = 0; bj < 2; ++bj) { const u32x4 gw = *(const u32x4*)(G + off + bj * HALF);
                    f32x4 v0 = acc[ai][bj][m][0], v1 = acc[ai][bj][m][1];
                    v0[0] *= bflo(gw.x); v0[1] *= bfhi(gw.x); v0[2] *= bflo(gw.y); v0[3] *= bfhi(gw.y); v1[0] *= bflo(gw.z); v1[1] *= bfhi(gw.z); v1[2] *= bflo(gw.w); v1[3] *= bfhi(gw.w);
                    if (!first) { const u32x4 ow = *(const u32x4*)(MG + off + bj * HALF);
                        v0[0] += bflo(ow.x); v0[1] += bfhi(ow.x); v0[2] += bflo(ow.y); v0[3] += bfhi(ow.y); v1[0] += bflo(ow.z); v1[1] += bfhi(ow.z); v1[2] += bflo(ow.w); v1[3] += bfhi(ow.w); }
                    *(u32x4*)(MG + off + bj * HALF) = pack8(v0, v1); asm volatile("" ::: "memory"); } }
    }
};

struct EpiResid {
    static constexpr bool PERM = true, AFTER_DRAIN = false;
    const float* xin; float* out; bf16_t* XB; float* ss;
    __device__ __forceinline__ void operator()(const f32x4 (&acc)[2][2][4][2], const Unit& u, int wr, int wc, int fr, int fq) const {
        int row0 = u.pm * BM + wr * 64 + fr; const int col0 = u.pn * BM + wc * 32 + 8 * fq; asm volatile("" : "+v"(row0));
#pragma unroll
        for (int ai = 0; ai < 2; ++ai)
#pragma unroll
            for (int m = 0; m < 4; ++m) { const int row = row0 + ai * HALF + m * 16; const size_t off = (size_t)row * 1024 + col0; float sq = 0.f;
#pragma unroll
                for (int bj = 0; bj < 2; ++bj) { const f32x4 r0 = *(const f32x4*)(xin + off + bj * HALF) + acc[ai][bj][m][0], r1 = *(const f32x4*)(xin + off + bj * HALF + 4) + acc[ai][bj][m][1];
                    *(f32x4*)(out + off + bj * HALF) = r0; *(f32x4*)(out + off + bj * HALF + 4) = r1;
                    if (XB) { *(u32x4*)(XB + off + bj * HALF) = pack8(r0, r1); const f32x4 q = r0 * r0 + r1 * r1; sq += (q[0] + q[1]) + (q[2] + q[3]); } }
                if (XB) { sq += shflx(sq, 16); sq += shflx(sq, 32); if (fq == 0) ss[(size_t)row * 16 + u.pn * 4 + wc] = sq; }
                asm volatile("" ::: "memory"); }
    }
};

struct EpiGateCat {
    static constexpr bool PERM = true, AFTER_DRAIN = false;
    bf16_t* MG; const bf16_t* G;
    __device__ __forceinline__ void mid(f32x4 (&acc)[2][2][4][2], const Unit& u, int kdone, int wr, int wc, int fr, int fq) const {
        if (kdone != 4 && kdone != 8) return;
        const unsigned char* Gp = (const unsigned char*)G + (size_t)(kdone == 4 ? 0 : 1) * 32768 * 1024; const unsigned char* Gn = Gp + (size_t)32768 * 1024;
        int row0 = u.pm * BM + wr * 64 + fr; const int col0 = u.pn * BM + wc * 32 + 8 * fq; asm volatile("" : "+v"(row0));
        {
            uint2 ga[2][4][2], gb[2][4][2];
#pragma unroll
            for (int ai = 0; ai < 2; ++ai)
#pragma unroll
                for (int mm = 0; mm < 4; ++mm)
#pragma unroll
                    for (int bj = 0; bj < 2; ++bj) { const size_t off = (size_t)(row0 + ai * HALF + mm * 16) * 1024 + col0 + bj * HALF; ga[ai][mm][bj] = *(const uint2*)(Gp + off); gb[ai][mm][bj] = *(const uint2*)(Gn + off); }
            asm volatile("" ::: "memory");
#pragma unroll
            for (int ai = 0; ai < 2; ++ai)
#pragma unroll
                for (int mm = 0; mm < 4; ++mm)
#pragma unroll
                    for (int bj = 0; bj < 2; ++bj) { const int m = mm; const uint2 a = ga[ai][mm][bj], b = gb[ai][mm][bj]; f32x4 r0, r1;
#pragma unroll
                        for (int e = 0; e < 4; ++e) { r0[e] = (float)((a.x >> (8 * e)) & 255u) * __builtin_amdgcn_rcpf((float)((b.x >> (8 * e)) & 255u)); r1[e] = (float)((a.y >> (8 * e)) & 255u) * __builtin_amdgcn_rcpf((float)((b.y >> (8 * e)) & 255u)); }
                        acc[ai][bj][m][0] = acc[ai][bj][m][0] * r0; acc[ai][bj][m][1] = acc[ai][bj][m][1] * r1; }
            asm volatile("" ::: "memory");
        }
    }
    __device__ __forceinline__ void operator()(const f32x4 (&acc)[2][2][4][2], const Unit& u, int wr, int wc, int fr, int fq) const {
        const unsigned char* G2 = (const unsigned char*)G + (size_t)2 * 32768 * 1024;
        int row0 = u.pm * BM + wr * 64 + fr; const int col0 = u.pn * BM + wc * 32 + 8 * fq; asm volatile("" : "+v"(row0));
#pragma unroll
        for (int ai = 0; ai < 2; ++ai) {
            uint2 gw[4][2];
#pragma unroll
            for (int m = 0; m < 4; ++m)
#pragma unroll
                for (int bj = 0; bj < 2; ++bj) gw[m][bj] = *(const uint2*)(G2 + (size_t)(row0 + ai * HALF + m * 16) * 1024 + col0 + bj * HALF);
            asm volatile("" ::: "memory");
#pragma unroll
            for (int m = 0; m < 4; ++m) { const size_t off = (size_t)(row0 + ai * HALF + m * 16) * 1024 + col0;
#pragma unroll
                for (int bj = 0; bj < 2; ++bj) { const uint2 g = gw[m][bj];
                    f32x4 v0 = acc[ai][bj][m][0], v1 = acc[ai][bj][m][1];
#pragma unroll
                    for (int e = 0; e < 4; ++e) { v0[e] *= (float)((g.x >> (8 * e)) & 255u) * (1.f / 255.f); v1[e] *= (float)((g.y >> (8 * e)) & 255u) * (1.f / 255.f); }
                    *(u32x4*)(MG + off + bj * HALF) = pack8(v0, v1); } }
            asm volatile("" ::: "memory"); }
    }
};

struct EpiResidB {
    static constexpr bool PERM = true, AFTER_DRAIN = false;
    bf16_t* XB; float* ss; float* out32;
    __device__ __forceinline__ void operator()(const f32x4 (&acc)[2][2][4][2], const Unit& u, int wr, int wc, int fr, int fq) const {
        int row0 = u.pm * BM + wr * 64 + fr; const int col0 = u.pn * BM + wc * 32 + 8 * fq; asm volatile("" : "+v"(row0));
#pragma unroll
        for (int ai = 0; ai < 2; ++ai) {
            u32x4 xw[4][2];
#pragma unroll
            for (int m = 0; m < 4; ++m)
#pragma unroll
                for (int bj = 0; bj < 2; ++bj) xw[m][bj] = *(const u32x4*)(XB + (size_t)(row0 + ai * HALF + m * 16) * 1024 + col0 + bj * HALF);
            asm volatile("" ::: "memory");
#pragma unroll
            for (int m = 0; m < 4; ++m) { const int row = row0 + ai * HALF + m * 16; const size_t off = (size_t)row * 1024 + col0; float sq = 0.f;
#pragma unroll
                for (int bj = 0; bj < 2; ++bj) { const u32x4 w = xw[m][bj];
                    f32x4 r0 = acc[ai][bj][m][0], r1 = acc[ai][bj][m][1];
                    r0[0] += bflo(w.x); r0[1] += bfhi(w.x); r0[2] += bflo(w.y); r0[3] += bfhi(w.y); r1[0] += bflo(w.z); r1[1] += bfhi(w.z); r1[2] += bflo(w.w); r1[3] += bfhi(w.w);
                    if (out32) { *(f32x4*)(out32 + off + bj * HALF) = r0; *(f32x4*)(out32 + off + bj * HALF + 4) = r1; }
                    else { *(u32x4*)(XB + off + bj * HALF) = pack8(r0, r1); const f32x4 q = r0 * r0 + r1 * r1; sq += (q[0] + q[1]) + (q[2] + q[3]); } }
                if (!out32) { sq += shflx(sq, 16); sq += shflx(sq, 32); if (fq == 0) ss[(size_t)row * 16 + u.pn * 4 + wc] = sq; } }
            asm volatile("" ::: "memory"); }
    }
};

struct EpiSwiGLU {
    static constexpr bool PERM = true, AFTER_DRAIN = false;
    bf16_t* ACT; const float* ss; PG8_LAS float* rsl;
    __device__ __forceinline__ void operator()(const f32x4 (&acc)[2][2][4][2], const Unit& u, int wr, int wc, int fr, int fq) const {
        int row0 = u.pm * BM + wr * 64 + fr; const int col0 = u.pn * HALF + wc * 32 + 8 * fq; asm volatile("" : "+v"(row0));
        const PG8_LAS float* rsw = unit_row_scales(ss, rsl, u, wr, wc, fr, fq) + fr;
#pragma unroll
        for (int ai = 0; ai < 2; ++ai)
#pragma unroll
            for (int m = 0; m < 4; ++m) { f32x4 o[2]; const float rs = rsw[ai * 64 + m * 16];
#pragma unroll
                for (int n = 0; n < 2; ++n) { const f32x4 gv = acc[ai][0][m][n] * rs, uv = acc[ai][1][m][n] * rs;
#pragma unroll
                    for (int e = 0; e < 4; ++e) o[n][e] = gv[e] * fast_sigmoid(gv[e]) * uv[e]; }
                *(u32x4*)(ACT + (size_t)(row0 + ai * HALF + m * 16) * 2816 + col0) = pack8(o[0], o[1]); asm volatile("" ::: "memory"); }
    }
};

template <class Epi, class Sched, bool ALIGN_EPI = false, bool SP2 = false, bool MIDHOOK = false>
__device__ __forceinline__ void gemm_phase(PG8_LAS unsigned char* lds, const Gemm g, const Sched& S, const Epi& E) {
    int tid_ = wg_tid(); asm volatile("" : "+v"(tid_));
    const int tid = tid_, wid = __builtin_amdgcn_readfirstlane(tid >> 6), lane = tid & 63, wr = wid >> 2, wc = wid & 3, fr = lane & 15, fq = lane >> 4;
    const int K = g.K, nt = K / BK;
    unsigned voffA[2], voffB[2];
#pragma unroll
    for (int i = 0; i < 2; ++i) { int R, C; stage_rc(tid * 16 + i * 8192, R, C); const int Rb = Epi::PERM ? ((R & ~31) + perm32(R & 31)) : R;
        voffA[i] = (unsigned)(R * K + C) * 2u; voffB[i] = (unsigned)(Rb * K + C) * 2u; }
    const size_t kstep = (size_t)(BK * 2);
    const size_t hstep = (size_t)HALF * K * 2;
    const size_t tstep = 2 * hstep;
    const unsigned ldsw = (unsigned)wid * 1024u;
    const int aoff = lds_byte(wr * 64 + fr, fq * 8), boff = lds_byte(wc * 32 + fr, fq * 8);
#define PG8_SA(b, h) (((b) * 2 + (h)) * HTB)
#define PG8_SB(b, h) ((4 + (b) * 2 + (h)) * HTB)
#define PG8_STAGE(bufoff, gbase, voff) do { _Pragma("unroll") for (int _i = 0; _i < 2; ++_i) \
        __builtin_amdgcn_global_load_lds((const unsigned*)((const char*)(gbase) + (voff)[_i]), (PG8_LAS unsigned*)(lds + (bufoff) + ldsw + _i * 8192), 16, 0, 0); } while (0)
#define PG8_LDA(dst, b, h) do { _Pragma("unroll") for (int m = 0; m < 4; ++m) _Pragma("unroll") for (int k = 0; k < 2; ++k) dst[m][k] = *(const PG8_LAS bf16x8*)(lds + PG8_SA(b, h) + aoff + m * 2048 + k * 1024); } while (0)
#define PG8_LDB(dst, b, h) do { _Pragma("unroll") for (int n = 0; n < 2; ++n) _Pragma("unroll") for (int k = 0; k < 2; ++k) dst[n][k] = *(const PG8_LAS bf16x8*)(lds + PG8_SB(b, h) + boff + n * 2048 + k * 1024); } while (0)
#define PG8_MMA(ai, bj, At, Bt) do { __builtin_amdgcn_s_setprio(1); _Pragma("unroll") for (int m = 0; m < 4; ++m) _Pragma("unroll") for (int n = 0; n < 2; ++n) _Pragma("unroll") for (int k = 0; k < 2; ++k) \
        acc[ai][bj][m][n] = __builtin_amdgcn_mfma_f32_16x16x32_bf16(Bt[n][k], At[m][k], acc[ai][bj][m][n], 0, 0, 0); __builtin_amdgcn_s_setprio(0); } while (0)
#define PG8_WAIT_V(n) asm volatile("s_waitcnt vmcnt(" #n ")" ::: "memory")
#define PG8_WAIT_L(n) asm volatile("s_waitcnt lgkmcnt(" #n ")" ::: "memory")
#define PG8_BAR __builtin_amdgcn_s_barrier()
#define PG8_SCHED __builtin_amdgcn_sched_barrier(0)
    Unit cur, nxt; int ui = 0;
    if (!S.next(0, cur)) return;
    f32x4 acc[2][2][4][2];
#pragma unroll
    for (int a = 0; a < 2; ++a)
#pragma unroll
        for (int b = 0; b < 2; ++b)
#pragma unroll
            for (int m = 0; m < 4; ++m)
#pragma unroll
                for (int n = 0; n < 2; ++n) acc[a][b][m][n] = (f32x4){0.f, 0.f, 0.f, 0.f};
    bf16x8 At[4][2], B0[2][2], B1[2][2];
    const char* cA = (const char*)g.A + (size_t)cur.pm * tstep; const char* cB = (const char*)g.Bt + (size_t)cur.pn * tstep;
    S.a_ready(cur);
    if constexpr (SP2) {
        PG8_STAGE(PG8_SB(0, 0), cB, voffB); PG8_STAGE(PG8_SB(0, 1), cB + hstep, voffB); PG8_STAGE(PG8_SA(0, 0), cA, voffA); PG8_STAGE(PG8_SA(0, 1), cA + hstep, voffA);
        if (wr == 1) PG8_BAR;
        PG8_WAIT_V(2); PG8_BAR;
        PG8_STAGE(PG8_SB(1, 0), cB + kstep, voffB); PG8_STAGE(PG8_SA(1, 0), cA + kstep, voffA); PG8_STAGE(PG8_SB(1, 1), cB + hstep + kstep, voffB);
        PG8_WAIT_V(6); PG8_BAR;
    } else {
        PG8_STAGE(PG8_SB(0, 0), cB, voffB); PG8_STAGE(PG8_SA(0, 0), cA, voffA); PG8_STAGE(PG8_SB(0, 1), cB + hstep, voffB); PG8_STAGE(PG8_SA(0, 1), cA + hstep, voffA);
        if (wr == 1) PG8_BAR;
        PG8_WAIT_V(4); PG8_BAR;
        PG8_STAGE(PG8_SB(1, 0), cB + kstep, voffB); PG8_STAGE(PG8_SA(1, 0), cA + kstep, voffA); PG8_STAGE(PG8_SB(1, 1), cB + hstep + kstep, voffB);
        PG8_WAIT_V(6); PG8_BAR;
    }
    for (;;) {
        const bool has_next = S.next(ui + 1, nxt);
        const char* nA = has_next ? (const char*)g.A + (size_t)nxt.pm * tstep : cA; const char* nB = has_next ? (const char*)g.Bt + (size_t)nxt.pn * tstep : cB;
        for (int t = 0; t < nt; t += 2) {
            const bool last = (t == nt - 2);
            const char* a1 = cA + (size_t)(t + 1) * kstep;
            const char* a2 = last ? nA : cA + (size_t)(t + 2) * kstep; const char* b2 = last ? nB : cB + (size_t)(t + 2) * kstep;
            const char* a3 = a2 + kstep; const char* b3 = b2 + kstep;
            if (last && has_next) S.a_ready(nxt);
            if constexpr (SP2) {
            PG8_LDB(B0, 0, 0); PG8_LDB(B1, 0, 1); PG8_SCHED; PG8_LDA(At, 0, 0); PG8_STAGE(PG8_SA(1, 1), a1 + hstep, voffA);
            PG8_WAIT_V(8); PG8_WAIT_L(0); PG8_BAR; PG8_MMA(0, 0, At, B0); PG8_MMA(0, 1, At, B1); PG8_BAR; PG8_SCHED;
            PG8_LDA(At, 0, 1); PG8_STAGE(PG8_SB(0, 0), b2, voffB); PG8_STAGE(PG8_SB(0, 1), b2 + hstep, voffB); PG8_STAGE(PG8_SA(0, 0), a2, voffA);
            PG8_WAIT_V(8); PG8_WAIT_L(0); PG8_BAR; PG8_MMA(1, 0, At, B0); PG8_MMA(1, 1, At, B1); PG8_BAR; PG8_SCHED;
            PG8_LDB(B0, 1, 0); PG8_LDB(B1, 1, 1); PG8_SCHED; PG8_LDA(At, 1, 0); PG8_STAGE(PG8_SA(0, 1), a2 + hstep, voffA);
            PG8_WAIT_V(8); PG8_WAIT_L(0); PG8_BAR; PG8_MMA(0, 0, At, B0); PG8_MMA(0, 1, At, B1); PG8_BAR; PG8_SCHED;
            PG8_LDA(At, 1, 1); PG8_STAGE(PG8_SB(1, 0), b3, voffB); PG8_STAGE(PG8_SB(1, 1), b3 + hstep, voffB); PG8_STAGE(PG8_SA(1, 0), a3, voffA);
            PG8_WAIT_V(8); PG8_WAIT_L(0); PG8_BAR; PG8_MMA(1, 0, At, B0); PG8_MMA(1, 1, At, B1); PG8_BAR; PG8_SCHED;
            } else {
            PG8_LDB(B0, 0, 0); PG8_SCHED; PG8_LDA(At, 0, 0); PG8_STAGE(PG8_SA(1, 1), a1 + hstep, voffA);
            PG8_WAIT_L(8); PG8_BAR; PG8_WAIT_L(0); PG8_MMA(0, 0, At, B0); PG8_BAR; PG8_SCHED;
            PG8_LDB(B1, 0, 1); PG8_STAGE(PG8_SB(0, 0), b2, voffB);
            PG8_BAR; PG8_WAIT_L(0); PG8_MMA(0, 1, At, B1); PG8_BAR;
            PG8_LDA(At, 0, 1); PG8_STAGE(PG8_SA(0, 0), a2, voffA);
            PG8_BAR; PG8_WAIT_L(0); PG8_MMA(1, 0, At, B0); PG8_BAR; PG8_SCHED;
            PG8_STAGE(PG8_SB(0, 1), b2 + hstep, voffB);
            PG8_WAIT_V(6); PG8_BAR; PG8_MMA(1, 1, At, B1); PG8_BAR;
            PG8_LDB(B0, 1, 0); PG8_SCHED; PG8_LDA(At, 1, 0); PG8_STAGE(PG8_SA(0, 1), a2 + hstep, voffA);
            PG8_WAIT_L(8); PG8_BAR; PG8_WAIT_L(0); PG8_MMA(0, 0, At, B0); PG8_BAR; PG8_SCHED;
            PG8_LDB(B1, 1, 1); PG8_STAGE(PG8_SB(1, 0), b3, voffB);
            PG8_BAR; PG8_WAIT_L(0); PG8_MMA(0, 1, At, B1); PG8_BAR;
            PG8_LDA(At, 1, 1); PG8_STAGE(PG8_SA(1, 0), a3, voffA);
            PG8_BAR; PG8_WAIT_L(0); PG8_MMA(1, 0, At, B0); PG8_BAR; PG8_SCHED;
            PG8_STAGE(PG8_SB(1, 1), b3 + hstep, voffB);
            PG8_WAIT_V(6); PG8_BAR; PG8_MMA(1, 1, At, B1); PG8_BAR;
            }
            if constexpr (MIDHOOK) E.mid(acc, cur, t + 2, wr, wc, fr, fq);
        }
        if constexpr (ALIGN_EPI) { if (wr == 0) PG8_BAR; }
        if constexpr (!Epi::AFTER_DRAIN) { E(acc, cur, wr, wc, fr, fq); S.done(cur); }
        if (!has_next) break;
#pragma unroll
        for (int a = 0; a < 2; ++a)
#pragma unroll
            for (int b = 0; b < 2; ++b)
#pragma unroll
                for (int m = 0; m < 4; ++m)
#pragma unroll
                    for (int n = 0; n < 2; ++n) acc[a][b][m][n] = (f32x4){0.f, 0.f, 0.f, 0.f};
        cur = nxt; cA = nA; cB = nB; ++ui;
        if constexpr (ALIGN_EPI) { if (wr == 1) PG8_BAR; }
    }
    PG8_WAIT_V(0);
    if constexpr (!ALIGN_EPI) { if (wr == 0) PG8_BAR; }
    PG8_BAR;
    if constexpr (Epi::AFTER_DRAIN) { E.fused(acc, cur, wr, wc, fr, fq, lds, wid, lane); S.done(cur); }
#undef PG8_SA
#undef PG8_SB
#undef PG8_STAGE
#undef PG8_LDA
#undef PG8_LDB
#undef PG8_MMA
#undef PG8_WAIT_V
#undef PG8_WAIT_L
#undef PG8_BAR
#undef PG8_SCHED
}
}

constexpr int NWAVES = 8;
#ifndef MK_PER_PHASE
#define MK_PER_PHASE 0
#endif
#ifndef PG8_SP2
#define PG8_SP2 true
#endif
#ifndef PG8_ALIGN
#define PG8_ALIGN true
#endif

constexpr int BATCH = 8, SEQ = 4096, D = 1024, DEPTH = 4, M = BATCH * SEQ;
constexpr int NIN = 6144, DIN = 5956, FF = 2816, NF1 = 2 * FF;
constexpr int NPH = 9;
constexpr float EPS = 1e-6f, LOG2E = 1.4426950408889634f;

constexpr size_t MiB = 1u << 20;
constexpr size_t WS_CTL = 0, CTL_ZERO_BYTES = 1 * MiB;
constexpr size_t WS_ROPE = 1 * MiB;
constexpr size_t WS_SS = 494 * MiB;
constexpr size_t WS_W = 4 * MiB;
constexpr size_t WO_IN = 0, WO_BA = 12 * MiB, WO_BB = WO_BA + MiB / 2, WO_BC = WO_BB + MiB / 2, WO_OUT = WO_BC + MiB, WO_F1 = WO_OUT + 2 * MiB, WO_F2 = WO_F1 + 11 * MiB;
constexpr size_t WS_H = 40 * MiB;
constexpr size_t WS_YC = WS_H;
constexpr size_t WS_QA = 104 * MiB, WS_QB = 120 * MiB, WS_KA = 136 * MiB, WS_VA = 152 * MiB, WS_KB = 168 * MiB, WS_VB = 184 * MiB, WS_IQ = 200 * MiB;
constexpr size_t WS_MG = WS_KA;
constexpr size_t WS_IK = 216 * MiB, WS_IW = 220 * MiB;
constexpr size_t WS_CX = 222 * MiB, WS_CY = 254 * MiB;
constexpr size_t WS_GT = 286 * MiB;
constexpr size_t WS_ACT = WS_GT;
constexpr size_t WS_MASK = 478 * MiB;
constexpr size_t WS_END = 510 * MiB;
constexpr int CW_TMO = 0, CW_CODE = 1, CW_BAR = 4096;

constexpr int RING_OFF = 0, RING_BYTES = 131072;
constexpr int XTRA_OFF = RING_BYTES, XTRA_BYTES = 8192;
constexpr int LDSCTL_OFF = XTRA_OFF + XTRA_BYTES, MISC_OFF = LDSCTL_OFF + 320;
constexpr int LDS_BYTES = 147456;
static_assert(MISC_OFF + 128 <= LDS_BYTES, "LDS map");

#define GAS __attribute__((address_space(1)))
#define LAS __attribute__((address_space(3)))
typedef unsigned short bf16;
typedef unsigned v4u __attribute__((ext_vector_type(4)));
typedef float f32x4 __attribute__((ext_vector_type(4)));
typedef short bf16x8 __attribute__((ext_vector_type(8)));
typedef GAS unsigned gu32;
typedef unsigned long long u64;
#define RLX_AGENT __ATOMIC_RELAXED, __HIP_MEMORY_SCOPE_AGENT
#define LDS_WAIT() asm volatile("s_waitcnt lgkmcnt(0)" ::: "memory")
#define VM_WAIT() asm volatile("s_waitcnt vmcnt(0)" ::: "memory")
__device__ __forceinline__ unsigned f2bf(float f) { unsigned u = __builtin_bit_cast(unsigned, f); return (u + 0x7fffu + ((u >> 16) & 1u)) >> 16; }
__device__ __forceinline__ unsigned pk2(float lo, float hi) { return f2bf(lo) | (f2bf(hi) << 16); }
__device__ __forceinline__ float bf2f(bf16 v) { return __builtin_bit_cast(float, (unsigned)v << 16); }
__device__ __forceinline__ float bflo(unsigned w) { return __builtin_bit_cast(float, w << 16); }
__device__ __forceinline__ float bfhi(unsigned w) { return __builtin_bit_cast(float, w & 0xffff0000u); }
__device__ __forceinline__ float wave_sum(float v) {
#pragma unroll
    for (int o = 1; o < 64; o <<= 1) v += shflx(v, o);
    return v;
}
__device__ __forceinline__ float wave_max(float v) {
#pragma unroll
    for (int o = 1; o < 64; o <<= 1) v = fmaxf(v, shflx(v, o));
    return v;
}
#define XB_TMO      128
#define XB_XCNT(j)  (256  + 64 * (j))
#define XB_XSUB(j)  (1280 + 64 * (j))
#define XB_XGEN(j)  (2304 + 64 * (j))
#define XB_TOP      3328
#define XB_TOPGEN   3392
#define XCD_BAR_WORDS 3456
#define XB_SPIN_CAP (1u << 27)

__device__ __forceinline__ unsigned xb_ld(unsigned* p)              { return __hip_atomic_load(p, __ATOMIC_RELAXED, __HIP_MEMORY_SCOPE_AGENT); }
__device__ __forceinline__ unsigned xb_add(unsigned* p, unsigned v) { return __hip_atomic_fetch_add(p, v, __ATOMIC_RELAXED, __HIP_MEMORY_SCOPE_AGENT); }
__device__ __forceinline__ unsigned xb_xcc_id() { return (unsigned)__builtin_amdgcn_s_getreg((3 << 11) | 20) & 0xFu; }
#define XB_SPIN(cond, bar) do { unsigned _sp = 0; while (cond) { __builtin_amdgcn_s_sleep(1); \
    if ((++_sp & 255u) == 0u) { if (xb_ld(&(bar)[XB_TMO])) break; if (_sp > XB_SPIN_CAP) { atomicAdd(&(bar)[XB_TMO], 1u); break; } } } } while (0)

struct XcdBarrier {
    unsigned* bar; unsigned x;
    volatile LAS unsigned* st;
};

__device__ __forceinline__ XcdBarrier xcd_barrier_post(unsigned* bar, volatile LAS unsigned* st) {
    XcdBarrier b; b.bar = bar; b.x = xb_xcc_id(); b.st = st;
    if (wg_tid() == 0) (void)xb_add(&bar[XB_XCNT(b.x)], 1u);
    return b;
}
__device__ __forceinline__ void xcd_barrier_complete(unsigned* bar, unsigned x, unsigned& nloc, unsigned& nx) {
    const unsigned G = gridDim.x * gridDim.y * gridDim.z;
    unsigned sum, cnt, mine, sp = 0u;
    for (;;) {
        sum = 0u; cnt = 0u; mine = 0u;
#pragma unroll
        for (unsigned j = 0; j < 16; ++j) { const unsigned c = xb_ld(&bar[XB_XCNT(j)]); sum += c; cnt += (c > 0u) ? 1u : 0u; mine = (j == x) ? c : mine; }
        if (sum == G) break;
        __builtin_amdgcn_s_sleep(1);
        if ((++sp & 255u) == 0u) { if (xb_ld(&bar[XB_TMO])) break; if (sp > XB_SPIN_CAP) { atomicAdd(&bar[XB_TMO], 1u); break; } }
    }
    nloc = mine > 0u ? mine : 1u; nx = cnt > 0u ? cnt : 1u;
}

__device__ __forceinline__ void xcd_barrier(const XcdBarrier& b) {
    asm volatile("s_waitcnt vmcnt(0)" ::: "memory");
    __syncthreads();
    if (wg_tid() == 0) {
        unsigned* bar = b.bar;
        __builtin_amdgcn_s_waitcnt(0);
        unsigned nloc = b.st[0], nx = b.st[1];
        if (nloc == 0u) { xcd_barrier_complete(bar, b.x, nloc, nx); b.st[0] = nloc; b.st[1] = nx; }
        const unsigned old = xb_add(&bar[XB_XSUB(b.x)], 1u);
        const unsigned gen = old / nloc;
        if (old + 1u == (gen + 1u) * nloc) {
            __builtin_amdgcn_fence(__ATOMIC_RELEASE, "agent");
            asm volatile("s_waitcnt vmcnt(0)" ::: "memory");
            const unsigned og = xb_add(&bar[XB_TOP], 1u);
            const unsigned tg = og / nx;
            if (og + 1u == (tg + 1u) * nx) xb_add(&bar[XB_TOPGEN], 1u);
            else XB_SPIN(xb_ld(&bar[XB_TOPGEN]) == tg, bar);
            __builtin_amdgcn_fence(__ATOMIC_ACQUIRE, "agent");
            xb_add(&bar[XB_XGEN(b.x)], 1u);
            asm volatile("s_waitcnt vmcnt(0)" ::: "memory");
        } else {
            XB_SPIN(xb_ld(&bar[XB_XGEN(b.x)]) == gen, bar);
            __builtin_amdgcn_fence(__ATOMIC_ACQUIRE, "agent");
            asm volatile("s_waitcnt vmcnt(0)" ::: "memory");
        }
    }
    __syncthreads();
}

struct Frame {
    LAS unsigned char* lds;
    volatile LAS unsigned* MISC;
    gu32* ctl;
    int tid, lane, wave, G;
    const float* x; float* out;
    const float *g_mix, *w_in, *qk_gain_a, *rel_bias, *qk_gain_b, *g_idx_k, *conv_w, *conv_b, *lru_wa, *lru_ba, *lru_wx, *lru_bx, *lru_lambda, *b_gate, *w_branch, *w_out, *g_ffn, *w_ffn_in, *w_ffn_out;
    float *rcos, *rsin, *SS;
    bf16 *W, *H, *YC, *YCAT, *QA, *QB, *KA, *VA, *KB, *VB, *IQ, *IK, *CX, *CY, *GT, *ACT, *MG; float* IW; u64* MASK;
    bf16 *W2a, *W2b;
};
struct WSet { bf16 *in, *ba, *out, *f1, *f2; };
__device__ __forceinline__ WSet wset(const Frame& F, int l) {
    WSet w;
    if (l & 1) { w.in = F.W + WO_IN / 2; w.ba = F.W + WO_BA / 2; w.out = F.W + WO_OUT / 2; w.f1 = F.W + WO_F1 / 2; w.f2 = F.W + WO_F2 / 2; }
    else { w.in = F.W2a; w.ba = F.W2a + (12 * MiB) / 2; w.out = F.W2a + (14 * MiB) / 2; w.f1 = F.W2b; w.f2 = F.W2b + (11 * MiB) / 2; }
    return w;
}

__device__ __forceinline__ void cvt_item(const float* W, int ldw, int k0, int n_src0, int nvalid, bf16* WT, int dpitch, int drow0, LAS float* scr, int lane, const float* gk = nullptr) {
    { const int col4 = (lane & 7) * 4; f32x4 v[8];
#pragma unroll
      for (int i = 0; i < 8; ++i) { const int kk = 8 * i + (lane >> 3); v[i] = (col4 < nvalid) ? *(const GAS f32x4*)(W + (size_t)(k0 + kk) * ldw + n_src0 + col4) : (f32x4){0.f, 0.f, 0.f, 0.f}; }
#pragma unroll
      for (int i = 0; i < 8; ++i) { const int kk = 8 * i + (lane >> 3); LAS float* d = scr + kk * 33 + col4; const float gg = gk ? gk[k0 + kk] : 1.f; d[0] = v[i].x * gg; d[1] = v[i].y * gg; d[2] = v[i].z * gg; d[3] = v[i].w * gg; } }
    LDS_WAIT(); asm volatile("" ::: "memory");
    const int c = lane & 7;
#pragma unroll
    for (int j = 0; j < 4; ++j) { const int n = (lane >> 3) + 8 * j; const LAS float* s = scr + (8 * c) * 33 + n;
        v4u o; o.x = pk2(s[0 * 33], s[1 * 33]); o.y = pk2(s[2 * 33], s[3 * 33]); o.z = pk2(s[4 * 33], s[5 * 33]); o.w = pk2(s[6 * 33], s[7 * 33]);
        *(GAS v4u*)(WT + (size_t)(drow0 + n) * dpitch + k0 + 8 * c) = o; }
    LDS_WAIT(); asm volatile("" ::: "memory");
}
__device__ __forceinline__ void phase_xb0(Frame& F, const float* xin, float* ss) {
    const int gw = blockIdx.x * NWAVES + F.wave, NGW = F.G * NWAVES;
    for (int m = gw; m < M; m += NGW) { const GAS f32x4* xr = (const GAS f32x4*)(xin + (size_t)m * D) + F.lane; f32x4 v[4]; float s = 0.f;
#pragma unroll
        for (int j = 0; j < 4; ++j) { v[j] = xr[64 * j]; s += (v[j].x * v[j].x + v[j].y * v[j].y) + (v[j].z * v[j].z + v[j].w * v[j].w); }
        s = wave_sum(s); if (F.lane < 16) ss[(size_t)m * 16 + F.lane] = (F.lane == 0) ? s : 0.f;
        GAS u64* o8 = (GAS u64*)(F.H + (size_t)m * D) + F.lane;
#pragma unroll
        for (int j = 0; j < 4; ++j) o8[64 * j] = (u64)pk2(v[j].x, v[j].y) | ((u64)pk2(v[j].z, v[j].w) << 32); }
}
__device__ __forceinline__ void phase_weights(Frame& F, int l, unsigned* queue = nullptr) {
    LAS float* scr = (LAS float*)(F.lds + RING_OFF + F.wave * 16384);
    const int gw = blockIdx.x * NWAVES + F.wave, NGW = F.G * NWAVES;
    const float* w_in = F.w_in + (size_t)l * D * DIN; const float* w_br = F.w_branch + (size_t)l * D * D; const float* w_out = F.w_out + (size_t)l * D * D;
    const float* w_f1 = F.w_ffn_in + (size_t)l * D * NF1; const float* w_f2 = F.w_ffn_out + (size_t)l * FF * D;
    const WSet WS = wset(F, l);
    constexpr int I_IN = 16 * 192, I_BA = 4 * 32, I_BB = 4 * 32, I_BC = 8 * 32, I_OUT = 16 * 32, I_F1 = 16 * 176, I_F2 = 44 * 32;
    constexpr int NITEMS = I_IN + I_BA + I_BB + I_BC + I_OUT + I_F1 + I_F2;
    for (int it0 = gw;; it0 += NGW) {
        int it = it0;
        if (queue) { unsigned v = 0u; if (F.lane == 0) v = __hip_atomic_fetch_add(queue, 1u, __ATOMIC_RELAXED, __HIP_MEMORY_SCOPE_AGENT); it = __builtin_amdgcn_readfirstlane((int)v); }
        if (it >= NITEMS) break;
        int r = it;
        if (r < I_IN) { const int kb = r / 192, ng = r % 192, pn = ng >> 3, grp = ng & 7, bj = grp >> 2, hh = grp & 3; int src = 0, nv = 32;
            if (pn < 7) src = pn * 256 + 64 * hh + 32 * bj;
            else if (pn == 7) { if (hh == 0) src = 1792 + 32 * bj; else if (grp == 1) { src = 1856; nv = 4; } else nv = 0; }
            else if (pn < 12) src = 1860 + (pn - 8) * 256 + grp * 32;
            else src = 2884 + (pn - 12) * 256 + grp * 32;
            cvt_item(w_in, DIN, kb * 64, src, nv, WS.in, D, ng * 32, scr, F.lane, F.g_mix + l * D); continue; } r -= I_IN;
        if (r < I_BA + I_BB + I_BC) { const int kb = r / 32, ng = r % 32; cvt_item(w_br, D, kb * 64, ng * 32, 32, WS.ba, D, ng * 32, scr, F.lane); continue; } r -= I_BA + I_BB + I_BC;
        if (r < I_OUT) { const int kb = r / 32, ng = r % 32; cvt_item(w_out, D, kb * 64, ng * 32, 32, WS.out, D, ng * 32, scr, F.lane); continue; } r -= I_OUT;
        if (r < I_F1) { const int kb = r / 176, ng = r % 176, pn = ng >> 3, grp = ng & 7, bj = grp >> 2; const int src = FF * bj + 128 * pn + (grp & 3) * 32;
            cvt_item(w_f1, NF1, kb * 64, src, 32, WS.f1, D, ng * 32, scr, F.lane, F.g_ffn + l * D); continue; } r -= I_F1;
        { const int kb = r / 32, ng = r % 32; cvt_item(w_f2, D, kb * 64, ng * 32, 32, WS.f2, FF, ng * 32, scr, F.lane); }
    }
    if (l == 0) {
        for (int i = blockIdx.x * 512 + F.tid; i < SEQ * 32; i += F.G * 512) { const int pos = i >> 5, k = i & 31;
            const float inv = exp2f(-(float)k * 0.41524101186092029f); const float ang = (float)pos * inv;
            F.rcos[i] = cosf(ang); F.rsin[i] = sinf(ang); }
    }
}

__device__ __forceinline__ void naive_attn_a(Frame& F, int l) {
    LAS float* bias_s = (LAS float*)F.lds;
    LAS float* qs = (LAS float*)F.lds + 320 + F.wave * 640;
    LAS float* ps = qs + 64;
    const int lane = F.lane;
    for (int u = blockIdx.x; u < BATCH * 4 * 64; u += F.G) {
        const int c = u & 63, h = (u >> 6) & 3, b = u >> 8;
        __syncthreads();
        for (int i = F.tid; i < 257; i += 512) bias_s[i] = F.rel_bias[(l * 4 + h) * 257 + i] * LOG2E;
        __syncthreads();
        const int kc0 = (c - 8 > 0) ? c - 8 : 0; const int nk = (c - kc0 + 1) * 64;
        for (int qi = 0; qi < 8; ++qi) {
            const int t = c * 64 + F.wave * 8 + qi; const size_t row = (size_t)b * SEQ + t;
            qs[lane] = bf2f(F.QA[row * 256 + h * 64 + lane]);
            LDS_WAIT();
            float s[9]; float mx = -INFINITY;
#pragma unroll
            for (int jj = 0; jj < 9; ++jj) { const int j = jj * 64 + lane; s[jj] = -INFINITY;
                if (j < nk) { const size_t krow = (size_t)b * SEQ + kc0 * 64 + j; const v4u* kp = (const v4u*)(F.KA + krow * 256 + h * 64); float dot = 0.f;
#pragma unroll
                    for (int i8 = 0; i8 < 8; ++i8) { const v4u kw = kp[i8]; const LAS float* q = qs + i8 * 8;
                        dot += q[0] * bflo(kw.x) + q[1] * bfhi(kw.x) + q[2] * bflo(kw.y) + q[3] * bfhi(kw.y) + q[4] * bflo(kw.z) + q[5] * bfhi(kw.z) + q[6] * bflo(kw.w) + q[7] * bfhi(kw.w); }
                    int rel = t - (kc0 * 64 + j); rel = rel < -128 ? -128 : (rel > 128 ? 128 : rel);
                    s[jj] = dot + bias_s[rel + 128]; }
                mx = fmaxf(mx, s[jj]); }
            mx = wave_max(mx); float sum = 0.f;
#pragma unroll
            for (int jj = 0; jj < 9; ++jj) { const int j = jj * 64 + lane; if (j < nk) { const float p = exp2f(s[jj] - mx); sum += p; ps[j] = p; } }
            sum = wave_sum(sum);
            LDS_WAIT();
            float o = 0.f; const bf16* vp = F.VA + ((size_t)b * SEQ + kc0 * 64) * 256 + h * 64 + lane;
            for (int j = 0; j < nk; ++j) o += ps[j] * bf2f(vp[(size_t)j * 256]);
            F.QA[row * 256 + h * 64 + lane] = (bf16)f2bf(o / sum);
            LDS_WAIT();
        }
    }
}
__device__ __forceinline__ unsigned fkey(float f) { const unsigned u = __builtin_bit_cast(unsigned, f); return (u & 0x80000000u) ? ~u : (u | 0x80000000u); }
__device__ __forceinline__ void naive_idx(Frame& F) {
    LAS float* sc = (LAS float*)F.lds + F.wave * 4096;
    LAS float* qs = (LAS float*)(F.lds + XTRA_OFF) + F.wave * 256;
    const int lane = F.lane;
    for (int u = blockIdx.x; u < BATCH * 512; u += F.G) {
        const int b = u >> 9, t = (u & 511) * 8 + F.wave; const size_t row = (size_t)b * SEQ + t; const int nw = (t >> 6) + 1;
        { const unsigned* qp = (const unsigned*)(F.IQ + row * 256) + lane * 2; const unsigned w0 = qp[0], w1 = qp[1];
          qs[4 * lane] = bflo(w0); qs[4 * lane + 1] = bfhi(w0); qs[4 * lane + 2] = bflo(w1); qs[4 * lane + 3] = bfhi(w1); }
        const f32x4 wv = *(const f32x4*)(F.IW + row * 4);
        LDS_WAIT();
        for (int jj = 0; jj < nw; ++jj) { const int j = jj * 64 + lane; const v4u* kp = (const v4u*)(F.IK + ((size_t)b * SEQ + j) * 64);
            float d0 = 0.f, d1 = 0.f, d2 = 0.f, d3 = 0.f;
#pragma unroll
            for (int i8 = 0; i8 < 8; ++i8) { const v4u kw = kp[i8]; float kf[8] = {bflo(kw.x), bfhi(kw.x), bflo(kw.y), bfhi(kw.y), bflo(kw.z), bfhi(kw.z), bflo(kw.w), bfhi(kw.w)};
#pragma unroll
                for (int e = 0; e < 8; ++e) { const int d = i8 * 8 + e; d0 += qs[d] * kf[e]; d1 += qs[64 + d] * kf[e]; d2 += qs[128 + d] * kf[e]; d3 += qs[192 + d] * kf[e]; } }
            float s = 0.f; s += wv[0] * fmaxf(d0, 0.f); s += wv[1] * fmaxf(d1, 0.f); s += wv[2] * fmaxf(d2, 0.f); s += wv[3] * fmaxf(d3, 0.f); s += 0.0f;
            sc[j] = s; }
        LDS_WAIT();
        u64* mrow = F.MASK + row * 64;
        if (nw <= 4) { if (lane < nw) { unsigned o1 = ~0u, o2 = ~0u; asm volatile("" : "+v"(o1), "+v"(o2)); ((unsigned*)mrow)[2 * lane] = o1; ((unsigned*)mrow)[2 * lane + 1] = o2; } }
        else {
            unsigned prefix = 0u;
            for (int bit = 31; bit >= 0; --bit) { const unsigned cand = prefix | (1u << bit); int cnt = 0;
                for (int jj = 0; jj < nw; ++jj) cnt += __popcll(__ballot(fkey(sc[jj * 64 + lane]) >= cand));
                if (cnt >= 256) prefix = cand; }
            int n_gt = 0;
            for (int jj = 0; jj < nw; ++jj) n_gt += __popcll(__ballot(fkey(sc[jj * 64 + lane]) > prefix));
            const int allowed = 256 - n_gt; int running = 0; const u64 lt = (1ull << lane) - 1ull;
            for (int jj = 0; jj < nw; ++jj) { const unsigned key = fkey(sc[jj * 64 + lane]); const bool gt = key > prefix, eq = key == prefix; const u64 eqb = __ballot(eq);
                const int rank = running + __popcll(eqb & lt); const bool sel = gt || (eq && rank < allowed); running += __popcll(eqb);
                const u64 w = __ballot(sel); if (lane == 0) mrow[jj] = w; }
        }
        LDS_WAIT();
    }
}
__device__ __forceinline__ void naive_sparse(Frame& F) {
    LAS int* list = (LAS int*)F.lds + F.wave * 256;
    LAS float* ps = (LAS float*)F.lds + 2048 + F.wave * 256;
    LAS float* qs = (LAS float*)F.lds + 4096 + F.wave * 64;
    const int lane = F.lane; const u64 lt = (1ull << lane) - 1ull;
    for (int u = blockIdx.x; u < BATCH * 512; u += F.G) {
        const int b = u >> 9, t = (u & 511) * 8 + F.wave; const size_t row = (size_t)b * SEQ + t; const int nw = (t >> 6) + 1;
        int running = 0;
        for (int jj = 0; jj < nw; ++jj) { const u64 w = F.MASK[row * 64 + jj]; if ((w >> lane) & 1ull) list[running + __popcll(w & lt)] = jj * 64 + lane; running += __popcll(w); }
        const int nsel = running < 256 ? running : 256;
        LDS_WAIT();
        for (int h = 0; h < 4; ++h) {
            qs[lane] = bf2f(F.QB[row * 256 + h * 64 + lane]);
            LDS_WAIT();
            float s[4]; float mx = -INFINITY;
#pragma unroll
            for (int e = 0; e < 4; ++e) { const int idx = e * 64 + lane; s[e] = -INFINITY;
                if (idx < nsel) { const int j = list[idx]; const v4u* kp = (const v4u*)(F.KB + ((size_t)b * SEQ + j) * 256 + h * 64); float dot = 0.f;
#pragma unroll
                    for (int i8 = 0; i8 < 8; ++i8) { const v4u kw = kp[i8]; const LAS float* q = qs + i8 * 8;
                        dot += q[0] * bflo(kw.x) + q[1] * bfhi(kw.x) + q[2] * bflo(kw.y) + q[3] * bfhi(kw.y) + q[4] * bflo(kw.z) + q[5] * bfhi(kw.z) + q[6] * bflo(kw.w) + q[7] * bfhi(kw.w); }
                    s[e] = dot; }
                mx = fmaxf(mx, s[e]); }
            mx = wave_max(mx); float sum = 0.f;
#pragma unroll
            for (int e = 0; e < 4; ++e) { const int idx = e * 64 + lane; if (idx < nsel) { const float p = exp2f(s[e] - mx); sum += p; ps[idx] = p; } }
            sum = wave_sum(sum);
            LDS_WAIT();
            float o = 0.f;
            for (int i = 0; i < nsel; ++i) o += ps[i] * bf2f(F.VB[((size_t)b * SEQ + list[i]) * 256 + h * 64 + lane]);
            F.QB[row * 256 + h * 64 + lane] = (bf16)f2bf(o / sum);
            LDS_WAIT();
        }
    }
}
__device__ __forceinline__ float gelu_tanh(float x) { return 0.5f * x * (1.f + tanhf(0.7978845608028654f * (x + 0.044715f * x * x * x))); }
__device__ __forceinline__ void naive_lru(Frame& F, int l) {
    LAS float* wa_s = (LAS float*)F.lds; LAS float* wx_s = wa_s + 4096; LAS float* us = wx_s + 4096; LAS float* as = us + 64 * 65; LAS float* gs = as + 4096;
    const int tid = F.tid, lane = F.lane;
    for (int u = blockIdx.x; u < 64; u += F.G) {
        const int b = u >> 3, g = u & 7;
        __syncthreads();
        for (int i = tid; i < 4096; i += 512) { wa_s[i] = F.lru_wa[(size_t)(l * 8 + g) * 4096 + i]; wx_s[i] = F.lru_wx[(size_t)(l * 8 + g) * 4096 + i]; }
        float h = 0.f;
        for (int tile = 0; tile < 64; ++tile) {
            __syncthreads();
            { const int tok = tid >> 3, t = tile * 64 + tok;
#pragma unroll
              for (int e = 0; e < 8; ++e) { const int ch = (tid & 7) * 8 + e, cg = g * 64 + ch; float acc = F.conv_b[l * 512 + cg];
#pragma unroll
                  for (int j = 0; j < 4; ++j) { const int tt = t - 3 + j; if (tt >= 0) acc += F.conv_w[(l * 4 + j) * 512 + cg] * bf2f(F.CX[((size_t)b * SEQ + tt) * 512 + cg]); }
                  us[tok * 65 + ch] = acc; } }
            __syncthreads();
            { const int tok = tid & 63, og = tid >> 6;
              for (int o = 0; o < 8; ++o) { const int cc = 8 * og + o, cg = g * 64 + cc; float ra = 0.f, rx = 0.f;
                  for (int k = 0; k < 64; ++k) { const float uv = us[tok * 65 + k]; ra += uv * wa_s[k * 64 + cc]; rx += uv * wx_s[k * 64 + cc]; }
                  const float r = 1.f / (1.f + expf(-(ra + F.lru_ba[l * 512 + cg]))), ig = 1.f / (1.f + expf(-(rx + F.lru_bx[l * 512 + cg])));
                  const float sp = log1pf(expf(-F.lru_lambda[l * 512 + cg])); const float log_a = -8.0f * r * sp;
                  as[tok * 64 + cc] = expf(log_a); gs[tok * 64 + cc] = sqrtf(-expm1f(2.f * log_a)) * (ig * us[tok * 65 + cc]); } }
            __syncthreads();
            if (F.wave == 0) {
                for (int tok = 0; tok < 64; ++tok) { h = as[tok * 64 + lane] * h + gs[tok * 64 + lane]; const size_t row = (size_t)b * SEQ + tile * 64 + tok;
                    const float cy = bf2f(F.CY[row * 512 + g * 64 + lane]); F.YC[row * 512 + g * 64 + lane] = (bf16)f2bf(h * gelu_tanh(cy)); }
            }
        }
    }
}


typedef float f32x16 __attribute__((ext_vector_type(16)));
typedef short s16x4 __attribute__((ext_vector_type(4)));
typedef float f32x2v __attribute__((ext_vector_type(2)));
typedef __bf16 bf16x2v __attribute__((ext_vector_type(2)));
__device__ __forceinline__ unsigned cvtpk(float lo, float hi) { const f32x2v v = {lo, hi}; const bf16x2v b = __builtin_convertvector(v, bf16x2v); return __builtin_bit_cast(unsigned, b); }
__device__ __forceinline__ int crow(int r, int hi) { return (r & 3) + 8 * (r >> 2) + 4 * hi; }
__device__ __forceinline__ s16x4 vtr(const LAS unsigned char* p) { return __builtin_bit_cast(s16x4, __builtin_amdgcn_ds_read_tr16_b64_v4i16((LAS s16x4*)p)); }

template <int MODE> __device__ __forceinline__ void flash_wave(int b, int h, int qblk, const bf16* Q, const bf16* K, const bf16* V, bf16* Y, LAS unsigned char* vl, const LAS float* bias_s, const u64* MASK, int lane) {
    asm volatile("" : "+v"(lane));
    const int r32 = lane & 31, hi = lane >> 5; const size_t row0 = (size_t)b * SEQ + (size_t)qblk * 32; const int c = qblk >> 1;
    bf16x8 qr[4];
#pragma unroll
    for (int d0 = 0; d0 < 4; ++d0) qr[d0] = *(const bf16x8*)(Q + (row0 + r32) * 256 + h * 64 + d0 * 16 + hi * 8);
    const int kb_lo = (MODE == 0) ? ((c > 8 ? c - 8 : 0) * 2) : 0, kb_hi = (c + 1) * 2;
    f32x16 o0, o1;
#pragma unroll
    for (int r = 0; r < 16; ++r) { o0[r] = 0.f; o1[r] = 0.f; }
    float m = -1e30f, lsum = 0.f; const int tq = qblk * 32 + r32;
    const LAS unsigned char* vrd = vl + ((lane >> 4) & 1) * 32 + (lane & 3) * 8 + (4 * hi + ((lane & 15) >> 2)) * 64;
    unsigned mword = 0, mnext = 0;
    const unsigned* M32 = (const unsigned*)MASK + (size_t)(b * 64 + c) * (128 * 64) + (qblk & 1) * 32 + r32;
    const bf16* Kt = K + ((size_t)b * 128 * 4 + h) * 2048 + lane * 8;
    bf16x8 kfn[4]; v4u vvn[4];
    { const size_t krow0 = (size_t)b * SEQ + (size_t)kb_lo * 32;
#pragma unroll
      for (int d0 = 0; d0 < 4; ++d0) kfn[d0] = *(const bf16x8*)(Kt + (size_t)kb_lo * 8192 + d0 * 512);
#pragma unroll
      for (int i = 0; i < 4; ++i) { const int c16 = i * 64 + lane, key = c16 >> 3, dch = c16 & 7; vvn[i] = *(const v4u*)(V + (krow0 + key) * 256 + h * 64 + dch * 8); }
      if (MODE == 1) mnext = M32[kb_lo * 64]; }
    for (int kb = kb_lo; kb < kb_hi; ++kb) {
        bf16x8 kf[4]; v4u vv[4];
#pragma unroll
        for (int d0 = 0; d0 < 4; ++d0) kf[d0] = kfn[d0];
#pragma unroll
        for (int i = 0; i < 4; ++i) vv[i] = vvn[i];
        if (MODE == 1) mword = mnext;
        if (kb + 1 < kb_hi) { const size_t krow1 = (size_t)b * SEQ + (size_t)(kb + 1) * 32;
#pragma unroll
            for (int d0 = 0; d0 < 4; ++d0) kfn[d0] = *(const bf16x8*)(Kt + (size_t)(kb + 1) * 8192 + d0 * 512);
#pragma unroll
            for (int i = 0; i < 4; ++i) { const int c16 = i * 64 + lane, key = c16 >> 3, dch = c16 & 7; vvn[i] = *(const v4u*)(V + (krow1 + key) * 256 + h * 64 + dch * 8); }
            if (MODE == 1) mnext = M32[(kb + 1) * 64]; }
#pragma unroll
        for (int i = 0; i < 4; ++i) { const int c16 = i * 64 + lane, key = c16 >> 3, dch = c16 & 7; *(LAS v4u*)(vl + (dch >> 2) * 2048 + (key >> 4) * 1024 + (key & 15) * 64 + (dch & 3) * 16) = vv[i]; }
        f32x16 p;
#pragma unroll
        for (int r = 0; r < 16; ++r) p[r] = 0.f;
#pragma unroll
        for (int d0 = 0; d0 < 4; ++d0) p = __builtin_amdgcn_mfma_f32_32x32x16_bf16(kf[d0], qr[d0], p, 0, 0, 0);
        if (MODE == 0) {
#pragma unroll
            for (int r = 0; r < 16; ++r) { int rel = tq - (kb * 32 + crow(r, hi)); rel = rel < -128 ? -128 : (rel > 128 ? 128 : rel); p[r] += bias_s[rel + 128]; }
        } else {
            const unsigned bits = mword >> (4 * hi);
#pragma unroll
            for (int r = 0; r < 16; ++r) p[r] = ((bits >> ((r & 3) + 8 * (r >> 2))) & 1u) ? p[r] : -INFINITY;
        }
        float bm = p[0];
#pragma unroll
        for (int r = 1; r < 16; ++r) bm = fmaxf(bm, p[r]);
        bm = fmaxf(bm, shflx(bm, 32));
        const float mn = fmaxf(m, bm), alpha = exp2f(m - mn); m = mn;
        float rs = 0.f;
#pragma unroll
        for (int r = 0; r < 16; ++r) { p[r] = exp2f(p[r] - mn); rs += p[r]; }
        lsum = lsum * alpha + rs;
#pragma unroll
        for (int r = 0; r < 16; ++r) { o0[r] *= alpha; o1[r] *= alpha; }
        bf16x8 pa[2];
#pragma unroll
        for (int s = 0; s < 2; ++s) { v4u w; w.x = cvtpk(p[8 * s], p[8 * s + 1]); w.y = cvtpk(p[8 * s + 2], p[8 * s + 3]); w.z = cvtpk(p[8 * s + 4], p[8 * s + 5]); w.w = cvtpk(p[8 * s + 6], p[8 * s + 7]); pa[s] = __builtin_bit_cast(bf16x8, w); }
#pragma unroll
        for (int s = 0; s < 2; ++s) {
            const s16x4 a_lo = vtr(vrd + s * 1024), a_hi = vtr(vrd + s * 1024 + 512), b_lo = vtr(vrd + 2048 + s * 1024), b_hi = vtr(vrd + 2048 + s * 1024 + 512);
            const bf16x8 va = {a_lo[0], a_lo[1], a_lo[2], a_lo[3], a_hi[0], a_hi[1], a_hi[2], a_hi[3]}, vb = {b_lo[0], b_lo[1], b_lo[2], b_lo[3], b_hi[0], b_hi[1], b_hi[2], b_hi[3]};
            o0 = __builtin_amdgcn_mfma_f32_32x32x16_bf16(va, pa[s], o0, 0, 0, 0); o1 = __builtin_amdgcn_mfma_f32_32x32x16_bf16(vb, pa[s], o1, 0, 0, 0);
        }
    }
    lsum += shflx(lsum, 32); const float inv = 1.f / lsum;
    bf16* yrow = Y + (row0 + r32) * 1024 + h * 64 + 4 * hi;
#pragma unroll
    for (int g4 = 0; g4 < 4; ++g4) {
        uint2 w0, w1; w0.x = cvtpk(o0[4 * g4] * inv, o0[4 * g4 + 1] * inv); w0.y = cvtpk(o0[4 * g4 + 2] * inv, o0[4 * g4 + 3] * inv); w1.x = cvtpk(o1[4 * g4] * inv, o1[4 * g4 + 1] * inv); w1.y = cvtpk(o1[4 * g4 + 2] * inv, o1[4 * g4 + 3] * inv);
        *(uint2*)(yrow + 8 * g4) = w0; *(uint2*)(yrow + 32 + 8 * g4) = w1; }
}

template <int MODE, bool FIXM, bool SPLIT = false> __device__ __forceinline__ void flash_wave2(int b, int h, int c, const bf16* Q, const bf16* K, const bf16* V, bf16* Y, LAS unsigned char* vl, const LAS float* bias_s, const u64* MASK, int lane, float mfix,
        int kb0 = -1, int kb1 = -1, int part = 0, LAS float* cmb = nullptr) {
    asm volatile("" : "+v"(lane));
    const int r32 = lane & 31, hi = lane >> 5; const size_t row0 = (size_t)b * SEQ + (size_t)c * 64;
    bf16x8 qr[2][4];
#pragma unroll
    for (int z = 0; z < 2; ++z)
#pragma unroll
        for (int d0 = 0; d0 < 4; ++d0) qr[z][d0] = *(const bf16x8*)(Q + (row0 + 32 * z + r32) * 256 + h * 64 + d0 * 16 + hi * 8);
    const int kb_lo = SPLIT ? kb0 : ((MODE == 0) ? ((c > 8 ? c - 8 : 0) * 2) : 0), kb_hi = SPLIT ? kb1 : (c + 1) * 2;
    f32x16 o[2][2];
#pragma unroll
    for (int z = 0; z < 2; ++z)
#pragma unroll
        for (int r = 0; r < 16; ++r) { o[z][0][r] = 0.f; o[z][1][r] = 0.f; }
    float m[2] = {-1e30f, -1e30f}, lsum[2] = {0.f, 0.f};
    const LAS unsigned char* vrd = vl + ((lane >> 4) & 1) * 32 + (lane & 3) * 8 + (4 * hi + ((lane & 15) >> 2)) * 64;
    unsigned mword[2] = {0, 0}, mnext[2] = {0, 0};
    constexpr int KSTEP = SPLIT ? 2 : 1;
    const unsigned* M32 = (const unsigned*)MASK + (size_t)(b * 64 + c) * (128 * 64) + r32;
    const bf16* Kt = K + ((size_t)b * 128 * 4 + h) * 2048 + lane * 8;
    if (MODE == 1) { mword[0] = M32[kb_lo * 64]; mword[1] = M32[kb_lo * 64 + 32]; }
    const int kb_last = kb_lo + ((kb_hi - 1 - kb_lo) / KSTEP) * KSTEP;
    bf16x8 kfn[4], kfn2[4];
    { const int k1 = kb_lo + KSTEP <= kb_last ? kb_lo + KSTEP : kb_last;
#pragma unroll
      for (int d0 = 0; d0 < 4; ++d0) kfn[d0] = *(const bf16x8*)(Kt + (size_t)kb_lo * 8192 + d0 * 512);
#pragma unroll
      for (int d0 = 0; d0 < 4; ++d0) kfn2[d0] = *(const bf16x8*)(Kt + (size_t)k1 * 8192 + d0 * 512); }
    for (int kb = kb_lo; kb < kb_hi; kb += KSTEP) {
        bf16x8 kf[4]; v4u vv[4];
#pragma unroll
        for (int d0 = 0; d0 < 4; ++d0) { kf[d0] = kfn[d0]; kfn[d0] = kfn2[d0]; }
        const bool mfetch = (MODE == 1) && kb + KSTEP < kb_hi;
        if (mfetch) { mnext[0] = M32[(kb + KSTEP) * 64]; mnext[1] = M32[(kb + KSTEP) * 64 + 32]; }
        { const int k2 = kb + 2 * KSTEP <= kb_last ? kb + 2 * KSTEP : kb_last;
          const size_t krowc = (size_t)b * SEQ + (size_t)kb * 32;
#pragma unroll
          for (int i = 0; i < 4; ++i) { const int c16 = i * 64 + lane, key = c16 >> 3, dch = c16 & 7; vv[i] = *(const v4u*)(V + (krowc + key) * 256 + h * 64 + dch * 8); }
#pragma unroll
          for (int d0 = 0; d0 < 4; ++d0) kfn2[d0] = *(const bf16x8*)(Kt + (size_t)k2 * 8192 + d0 * 512); }
        bf16x8 pa[2][2];
#pragma unroll
        for (int z = 0; z < 2; ++z) {
            f32x16 p;
#pragma unroll
            for (int r = 0; r < 16; ++r) p[r] = FIXM ? -mfix : 0.f;
#pragma unroll
            for (int d0 = 0; d0 < 4; ++d0) p = __builtin_amdgcn_mfma_f32_32x32x16_bf16(kf[d0], qr[z][d0], p, 0, 0, 0);
            if (MODE == 0) { const int tq = c * 64 + 32 * z + r32;
#pragma unroll
                for (int r = 0; r < 16; ++r) { int rel = tq - (kb * 32 + crow(r, hi)); rel = rel < -128 ? -128 : (rel > 128 ? 128 : rel); p[r] += bias_s[rel + 128]; }
            }
            const unsigned bits = (MODE == 1) ? (mword[z] >> (4 * hi)) : 0u;
            float rs = 0.f;
            if (FIXM) {
#pragma unroll
                for (int r = 0; r < 16; ++r) { const float e = __builtin_amdgcn_exp2f(p[r]); p[r] = (MODE == 1) ? (((bits >> ((r & 3) + 8 * (r >> 2))) & 1u) ? e : 0.f) : e; rs += p[r]; }
            } else {
                if (MODE == 1) {
#pragma unroll
                    for (int r = 0; r < 16; ++r) p[r] = ((bits >> ((r & 3) + 8 * (r >> 2))) & 1u) ? p[r] : -INFINITY;
                }
                float bm = p[0];
#pragma unroll
                for (int r = 1; r < 16; ++r) bm = fmaxf(bm, p[r]);
                bm = fmaxf(bm, shflx(bm, 32));
                const float mn = fmaxf(m[z], bm);
                if (__any(mn != m[z])) {
                    const float alpha = __builtin_amdgcn_exp2f(m[z] - mn); lsum[z] *= alpha;
#pragma unroll
                    for (int r = 0; r < 16; ++r) { o[z][0][r] *= alpha; o[z][1][r] *= alpha; }
                    m[z] = mn; }
#pragma unroll
                for (int r = 0; r < 16; ++r) { p[r] = __builtin_amdgcn_exp2f(p[r] - mn); rs += p[r]; }
            }
            lsum[z] += rs;
#pragma unroll
            for (int s = 0; s < 2; ++s) { v4u w; w.x = cvtpk(p[8 * s], p[8 * s + 1]); w.y = cvtpk(p[8 * s + 2], p[8 * s + 3]); w.z = cvtpk(p[8 * s + 4], p[8 * s + 5]); w.w = cvtpk(p[8 * s + 6], p[8 * s + 7]); pa[z][s] = __builtin_bit_cast(bf16x8, w); }
        }
        asm volatile("" : "+v"(pa[0][0]), "+v"(pa[0][1]), "+v"(pa[1][0]), "+v"(pa[1][1]) :: "memory");
#pragma unroll
        for (int i = 0; i < 4; ++i) { const int c16 = i * 64 + lane, key = c16 >> 3, dch = c16 & 7; *(LAS v4u*)(vl + (dch >> 2) * 2048 + (key >> 4) * 1024 + (key & 15) * 64 + (dch & 3) * 16) = vv[i]; }
#pragma unroll
        for (int s = 0; s < 2; ++s) {
            const s16x4 a_lo = vtr(vrd + s * 1024), a_hi = vtr(vrd + s * 1024 + 512), b_lo = vtr(vrd + 2048 + s * 1024), b_hi = vtr(vrd + 2048 + s * 1024 + 512);
            const bf16x8 va = {a_lo[0], a_lo[1], a_lo[2], a_lo[3], a_hi[0], a_hi[1], a_hi[2], a_hi[3]}, vb = {b_lo[0], b_lo[1], b_lo[2], b_lo[3], b_hi[0], b_hi[1], b_hi[2], b_hi[3]};
#pragma unroll
            for (int z = 0; z < 2; ++z) { o[z][0] = __builtin_amdgcn_mfma_f32_32x32x16_bf16(va, pa[z][s], o[z][0], 0, 0, 0); o[z][1] = __builtin_amdgcn_mfma_f32_32x32x16_bf16(vb, pa[z][s], o[z][1], 0, 0, 0); }
        }
        if (mfetch) { mword[0] = mnext[0]; mword[1] = mnext[1]; }
    }
    if constexpr (SPLIT) {
        if (part == 1) {
#pragma unroll
            for (int z = 0; z < 2; ++z) {
#pragma unroll
                for (int r = 0; r < 16; ++r) { cmb[((z * 2 + 0) * 16 + r) * 64 + lane] = o[z][0][r]; cmb[((z * 2 + 1) * 16 + r) * 64 + lane] = o[z][1][r]; }
                cmb[4096 + z * 64 + lane] = lsum[z]; } }
        __syncthreads();
        if (part == 2) {
#pragma unroll
            for (int z = 0; z < 2; ++z) {
#pragma unroll
                for (int r = 0; r < 16; ++r) { o[z][0][r] += cmb[((z * 2 + 0) * 16 + r) * 64 + lane]; o[z][1][r] += cmb[((z * 2 + 1) * 16 + r) * 64 + lane]; }
                lsum[z] += cmb[4096 + z * 64 + lane]; } }
        __syncthreads();
        if (part == 1) return;
    }
#pragma unroll
    for (int z = 0; z < 2; ++z) {
        const float lt = lsum[z] + shflx(lsum[z], 32); const float inv = 1.f / lt;
        bf16* yrow = Y + (row0 + 32 * z + r32) * 1024 + h * 64 + 4 * hi;
#pragma unroll
        for (int g4 = 0; g4 < 4; ++g4) {
            uint2 w0, w1; w0.x = cvtpk(o[z][0][4 * g4] * inv, o[z][0][4 * g4 + 1] * inv); w0.y = cvtpk(o[z][0][4 * g4 + 2] * inv, o[z][0][4 * g4 + 3] * inv); w1.x = cvtpk(o[z][1][4 * g4] * inv, o[z][1][4 * g4 + 1] * inv); w1.y = cvtpk(o[z][1][4 * g4 + 2] * inv, o[z][1][4 * g4 + 3] * inv);
            *(uint2*)(yrow + 8 * g4) = w0; *(uint2*)(yrow + 32 + 8 * g4) = w1; }
    }
}
__device__ __forceinline__ void phase_attn_a(Frame& F, int l) {
    LAS float* bias_s = (LAS float*)(F.lds + 32768);
    LAS unsigned char* vl = F.lds + F.wave * 4096;
    __syncthreads();
    for (int i = F.tid; i < 4 * 257; i += 512) bias_s[(i / 257) * 260 + (i % 257)] = F.rel_bias[(size_t)l * 4 * 257 + i] * LOG2E;
    __syncthreads();
    for (int u = blockIdx.x * 8 + F.wave; u < BATCH * 4 * 64; u += F.G * 8) { const int wgi = u >> 3; const int b = wgi & 7, h = (wgi >> 3) & 3, c = (wgi >> 5) * 8 + (u & 7);
        flash_wave2<0, false>(b, h, c, F.QA, F.KA, F.VA, F.YCAT, vl, bias_s + h * 260, nullptr, F.lane, 0.f); }
}
__device__ __forceinline__ void phase_attn_b(Frame& F, int l) {
    LAS unsigned char* vl = F.lds + F.wave * 4096;
    __syncthreads();
    float gq = fabsf(F.qk_gain_b[l * 128 + F.lane]), gk = fabsf(F.qk_gain_b[l * 128 + 64 + F.lane]); gq = wave_max(gq); gk = wave_max(gk);
    const float mfix = 64.f * gq * gk * pg8::QSCALE; const bool fixm = mfix < 40.f;
    for (int wg = blockIdx.x; wg < 256; wg += F.G) { const int b = wg & 7, jc = wg >> 3, w = F.wave; const int h = w & 3;
        if (fixm) {
            LAS float* cmb = (LAS float*)(F.lds + 32768) + h * 4224;
#pragma unroll 1
            for (int ci = 0; ci < 2; ++ci) { const int c = ci ? jc : 63 - jc, half = w >> 2;
                flash_wave2<1, true, true>(b, h, c, F.QB, F.KB, F.VB, F.YCAT + 256, vl, nullptr, F.MASK, F.lane, mfix, half, 2 * (c + 1), half ? 1 : 2, cmb); }
        } else { const int c = (w & 4) ? 63 - jc : jc;
#pragma unroll 1
            for (int z = 0; z < 2; ++z) flash_wave<1>(b, h, 2 * c + z, F.QB, F.KB, F.VB, F.YCAT + 256, vl, nullptr, F.MASK, F.lane); } }
}

__device__ __forceinline__ float dpp_quad_sum(float v) {
    int x = __builtin_bit_cast(int, v); float a = v + __builtin_bit_cast(float, __builtin_amdgcn_update_dpp(0, x, 0xB1, 0xF, 0xF, false));
    x = __builtin_bit_cast(int, a); return a + __builtin_bit_cast(float, __builtin_amdgcn_update_dpp(0, x, 0x4E, 0xF, 0xF, false));
}
__device__ __forceinline__ int wave_sum_dpp(int x) {
    x += __builtin_amdgcn_update_dpp(0, x, 0x111, 0xF, 0xF, true); x += __builtin_amdgcn_update_dpp(0, x, 0x112, 0xF, 0xF, true);
    x += __builtin_amdgcn_update_dpp(0, x, 0x114, 0xF, 0xF, true); x += __builtin_amdgcn_update_dpp(0, x, 0x118, 0xF, 0xF, true);
    x += __builtin_amdgcn_update_dpp(0, x, 0x142, 0xA, 0xF, false); x += __builtin_amdgcn_update_dpp(0, x, 0x143, 0xC, 0xF, false);
    return __builtin_amdgcn_readlane(x, 63);
}
__device__ __forceinline__ int wave_scan_dpp(int x) {
    x += __builtin_amdgcn_update_dpp(0, x, 0x111, 0xF, 0xF, true); x += __builtin_amdgcn_update_dpp(0, x, 0x112, 0xF, 0xF, true);
    x += __builtin_amdgcn_update_dpp(0, x, 0x114, 0xF, 0xF, true); x += __builtin_amdgcn_update_dpp(0, x, 0x118, 0xF, 0xF, true);
    x += __builtin_amdgcn_update_dpp(0, x, 0x142, 0xA, 0xF, false); x += __builtin_amdgcn_update_dpp(0, x, 0x143, 0xC, 0xF, false);
    return x;
}
#define TK_CNT1(acc, key, cand) asm("v_cmp_ge_u32 vcc, %1, %2\n\tv_addc_co_u32 %0, vcc, 0, %0, vcc" : "+v"(acc) : "v"(key), "v"(cand) : "vcc")
template <int N> __device__ __forceinline__ int lane_count_ge(const unsigned (&k)[N], unsigned cand) {
    int c0 = 0, c1 = 0, c2 = 0, c3 = 0;
#pragma unroll
    for (int i = 0; i < N; ++i) { if ((i & 3) == 0) TK_CNT1(c0, k[i], cand); else if ((i & 3) == 1) TK_CNT1(c1, k[i], cand); else if ((i & 3) == 2) TK_CNT1(c2, k[i], cand); else TK_CNT1(c3, k[i], cand); }
    return (c0 + c1) + (c2 + c3);
}
__device__ __forceinline__ unsigned wave_max_dpp(unsigned x) {
    x = max(x, (unsigned)__builtin_amdgcn_update_dpp(0, (int)x, 0x111, 0xF, 0xF, true)); x = max(x, (unsigned)__builtin_amdgcn_update_dpp(0, (int)x, 0x112, 0xF, 0xF, true));
    x = max(x, (unsigned)__builtin_amdgcn_update_dpp(0, (int)x, 0x114, 0xF, 0xF, true)); x = max(x, (unsigned)__builtin_amdgcn_update_dpp(0, (int)x, 0x118, 0xF, 0xF, true));
    x = max(x, (unsigned)__builtin_amdgcn_update_dpp((int)x, (int)x, 0x142, 0xA, 0xF, false)); x = max(x, (unsigned)__builtin_amdgcn_update_dpp((int)x, (int)x, 0x143, 0xC, 0xF, false));
    return (unsigned)__builtin_amdgcn_readlane((int)x, 63);
}
template <int N> __device__ __forceinline__ void bisect_keys(const unsigned (&k)[N], int target, unsigned& prefix, bool& exact, unsigned prefix0 = 0u, int bit0 = 31) {
    prefix = prefix0; exact = false;
    for (int bit = bit0; bit >= 0; --bit) { const unsigned cand = prefix | (1u << bit);
        const int cnt = wave_sum_dpp(lane_count_ge<N>(k, cand));
        if (cnt >= target) { prefix = cand; if (cnt == target) { exact = true; break; } } }
}
template <int NR> __device__ __forceinline__ void topk_core(const unsigned (&k)[NR], int nw, unsigned* mrow, int lane, LAS unsigned* cbuf) {
    unsigned prefix = 0u; bool exact = false, have = false;
    if constexpr (NR >= 32) {
        constexpr int NS = NR / 8; unsigned ks[NS];
#pragma unroll
        for (int j = 0; j < NS; ++j) ks[j] = k[4 + 8 * j];
        const int ns = (nw + 3) >> 3, rs = (352 * ns + nw - 1) / nw;
        unsigned L; bool exs; bisect_keys<NS>(ks, rs, L, exs);
        const int cl = lane_count_ge<NR>(k, L), incl = wave_scan_dpp(cl), C = __builtin_amdgcn_readlane(incl, 63);
        if (C >= 256 && C <= 512) {
            int off = incl - cl;
#pragma unroll
            for (int i = 0; i < NR; ++i) { const bool in = k[i] >= L; cbuf[in ? off : 512 + lane] = k[i]; off += in ? 1 : 0; }
            unsigned kc[8];
#pragma unroll
            for (int j = 0; j < 8; ++j) kc[j] = cbuf[j * 64 + lane];
            asm volatile("" ::: "memory");
#pragma unroll
            for (int j = 0; j < 8; ++j) kc[j] = (j * 64 + lane < C) ? kc[j] : 0u;
            unsigned kmx = kc[0];
#pragma unroll
            for (int j = 1; j < 8; ++j) kmx = max(kmx, kc[j]);
            kmx = wave_max_dpp(kmx);
            const unsigned dx = L ^ kmx; const int hb = dx ? 31 - __builtin_clz(dx) : -1;
            bisect_keys<8>(kc, 256, prefix, exact, hb >= 31 ? 0u : ((L >> (hb + 1)) << (hb + 1)), hb);
            if (exact && prefix < L) prefix = L;
            have = true;
        }
    }
    if (!have) bisect_keys<NR>(k, 256, prefix, exact);
    int wlo = 0, whi = 0;
    if (exact) {
#pragma unroll
        for (int i = 0; i < NR; ++i) { const u64 w = __ballot(k[i] >= prefix); asm("s_nop 1\n\tv_writelane_b32 %0, %2, %4\n\tv_writelane_b32 %1, %3, %4" : "+v"(wlo), "+v"(whi) : "s"((unsigned)w), "s"((unsigned)(w >> 32)), "n"(i)); }
    } else {
        int n_gt = 0;
#pragma unroll
        for (int i = 0; i < NR; ++i) n_gt += __popcll(__ballot(k[i] > prefix));
        const int allowed = 256 - n_gt; int running = 0; const u64 lt = (1ull << lane) - 1ull;
#pragma unroll
        for (int i = 0; i < NR; ++i) { const bool gt = k[i] > prefix, eq = k[i] == prefix; const u64 eqb = __ballot(eq); const int rank = running + __popcll(eqb & lt); running += __popcll(eqb);
            const u64 w = __ballot(gt || (eq && rank < allowed)); asm("s_nop 1\n\tv_writelane_b32 %0, %2, %4\n\tv_writelane_b32 %1, %3, %4" : "+v"(wlo), "+v"(whi) : "s"((unsigned)w), "s"((unsigned)(w >> 32)), "n"(i)); }
    }
    if (lane < nw) { mrow[(2 * lane) * 64] = (unsigned)wlo; mrow[(2 * lane + 1) * 64] = (unsigned)whi; }
}
constexpr int SCP = 2052;
__device__ __forceinline__ void idx_scores16(const bf16* IK, LAS unsigned* sc, int b, int t_lo, int t_hi, int wave, int lane, const bf16x8 (&qf)[2][4], const f32x4 (&wq)[2][4]) {
    asm volatile("" : "+v"(lane));
    const int r32 = lane & 31, hi = lane >> 5;
    const bf16* kbase = IK + (size_t)b * (SEQ * 64) + lane * 8;
    bf16x8 kn[2][4];
#pragma unroll
    for (int g = 0; g < 2; ++g) { const int tt = t_lo + wave + 8 * g, tc = tt < t_hi ? tt : t_hi - 1;
#pragma unroll
        for (int d0 = 0; d0 < 4; ++d0) kn[g][d0] = *(const bf16x8*)(kbase + tc * 2048 + d0 * 512); }
    for (int t = t_lo + wave; t < t_hi; t += 16) {
        bf16x8 kf[2][4];
#pragma unroll
        for (int g = 0; g < 2; ++g)
#pragma unroll
            for (int d0 = 0; d0 < 4; ++d0) kf[g][d0] = kn[g][d0];
        if (t + 16 < t_hi) {
#pragma unroll
            for (int g = 0; g < 2; ++g) { const int tt = t + 16 + 8 * g, tc = tt < t_hi ? tt : t_hi - 1;
#pragma unroll
                for (int d0 = 0; d0 < 4; ++d0) kn[g][d0] = *(const bf16x8*)(kbase + tc * 2048 + d0 * 512); } }
#pragma unroll
        for (int g = 0; g < 2; ++g) { const int tt = t + 8 * g;
            if (tt < t_hi) {
#pragma unroll
                for (int qg = 0; qg < 2; ++qg) {
                    f32x16 d;
#pragma unroll
                    for (int r = 0; r < 16; ++r) d[r] = 0.f;
#pragma unroll
                    for (int d0 = 0; d0 < 4; ++d0) d = __builtin_amdgcn_mfma_f32_32x32x16_bf16(qf[qg][d0], kf[g][d0], d, 0, 0, 0);
#pragma unroll
                    for (int k4 = 0; k4 < 4; ++k4) { float sv = 0.f;
#pragma unroll
                        for (int e = 0; e < 4; ++e) sv += wq[qg][k4][e] * __builtin_amdgcn_fmed3f(d[4 * k4 + e], 0.f, INFINITY);
                        sc[(8 * qg + 2 * k4 + hi) * SCP + (tt - t_lo) * 32 + r32] = fkey(sv + 0.0f); }
                }
            }
        }
    }
}
template <int NR> __device__ __forceinline__ void idx_select_row(const unsigned (&k)[NR], int nw, LAS unsigned* mrow, LAS unsigned* cbuf, unsigned* mg_row, int lane) {
    (void)mrow; topk_core<NR>(k, nw, mg_row, lane, cbuf);
}
__device__ __forceinline__ void phase_idx(Frame& F) {
    LAS unsigned* sc = (LAS unsigned*)F.lds;
    constexpr int MST = 136; LAS unsigned* mst = (LAS unsigned*)(F.lds + 16 * SCP * 4) + F.wave * MST;
    const int lane = F.lane, r32 = lane & 31, hi = lane >> 5, qq = r32 >> 2, hd = r32 & 3;
    __syncthreads();
    for (int u = blockIdx.x; u < BATCH * 256; u += F.G) {
        const int wgv = u & 255, i8 = u >> 8; const int b = wgv & 7, jc = wgv >> 3; const int chunk = (i8 & 4) ? 63 - jc : jc; const int q0 = chunk * 64 + (i8 & 3) * 16;
        const size_t row0 = (size_t)b * SEQ + q0; const int c = q0 >> 6, nw = c + 1, nt = 2 * nw;
        unsigned* mg = (unsigned*)F.MASK + (size_t)(b * 64 + c) * (128 * 64) + (q0 & 63);
        if (nw <= 4) { int tidl = F.tid; asm volatile("" : "+v"(tidl)); const int kbq = tidl >> 4, r16 = tidl & 15; if (kbq < nt) mg[kbq * 64 + r16] = ~0u; continue; }
        bf16x8 qf[2][4]; f32x4 wq[2][4];
#pragma unroll
        for (int qg = 0; qg < 2; ++qg) {
#pragma unroll
            for (int d0 = 0; d0 < 4; ++d0) qf[qg][d0] = *(const bf16x8*)(F.IQ + (row0 + 8 * qg + qq) * 256 + hd * 64 + d0 * 16 + hi * 8);
#pragma unroll
            for (int k4 = 0; k4 < 4; ++k4) wq[qg][k4] = *(const f32x4*)(F.IW + (row0 + 8 * qg + 2 * k4 + hi) * 4); }
        LAS unsigned* srA = sc + F.wave * SCP; LAS unsigned* srB = sc + (F.wave + 8) * SCP;
        int ll = lane; asm volatile("" : "+v"(ll));
        unsigned* mgA = mg + F.wave; unsigned* mgB = mg + F.wave + 8;
        if (nw <= 32) {
            idx_scores16(F.IK, sc, b, 0, nt, F.wave, lane, qf, wq);
            __syncthreads();
            if (nw <= 16) {
                { unsigned k[16];
#pragma unroll
                  for (int i = 0; i < 16; ++i) k[i] = srA[i * 64 + ll];
                  asm volatile("" ::: "memory");
#pragma unroll
                  for (int i = 0; i < 16; ++i) k[i] = (i < nw) ? k[i] : 0u;
                  idx_select_row<16>(k, nw, mst, srA, mgA, ll); }
                { unsigned k[16];
#pragma unroll
                  for (int i = 0; i < 16; ++i) k[i] = srB[i * 64 + ll];
                  asm volatile("" ::: "memory");
#pragma unroll
                  for (int i = 0; i < 16; ++i) k[i] = (i < nw) ? k[i] : 0u;
                  idx_select_row<16>(k, nw, mst, srB, mgB, ll); }
            } else {
                { unsigned k[32];
#pragma unroll
                  for (int i = 0; i < 32; ++i) k[i] = srA[i * 64 + ll];
                  asm volatile("" ::: "memory");
#pragma unroll
                  for (int i = 0; i < 32; ++i) k[i] = (i < nw) ? k[i] : 0u;
                  idx_select_row<32>(k, nw, mst, srA, mgA, ll); }
                { unsigned k[32];
#pragma unroll
                  for (int i = 0; i < 32; ++i) k[i] = srB[i * 64 + ll];
                  asm volatile("" ::: "memory");
#pragma unroll
                  for (int i = 0; i < 32; ++i) k[i] = (i < nw) ? k[i] : 0u;
                  idx_select_row<32>(k, nw, mst, srB, mgB, ll); }
            }
            __syncthreads();
        } else {
            idx_scores16(F.IK, sc, b, 0, 64, F.wave, lane, qf, wq);
            __syncthreads();
            unsigned ka[32], kb_[32];
#pragma unroll
            for (int i = 0; i < 32; ++i) { ka[i] = srA[i * 64 + ll]; kb_[i] = srB[i * 64 + ll]; }
            __syncthreads();
            idx_scores16(F.IK, sc, b, 64, nt, F.wave, lane, qf, wq);
            __syncthreads();
            const int nw2 = nw - 32;
            if (nw <= 48) {
                { unsigned k[48];
#pragma unroll
                  for (int i = 0; i < 32; ++i) k[i] = ka[i];
#pragma unroll
                  for (int i = 0; i < 16; ++i) k[32 + i] = srA[i * 64 + ll];
                  asm volatile("" ::: "memory");
#pragma unroll
                  for (int i = 0; i < 16; ++i) k[32 + i] = (i < nw2) ? k[32 + i] : 0u;
                  idx_select_row<48>(k, nw, mst, srA, mgA, ll); }
                { unsigned k[48];
#pragma unroll
                  for (int i = 0; i < 32; ++i) k[i] = kb_[i];
#pragma unroll
                  for (int i = 0; i < 16; ++i) k[32 + i] = srB[i * 64 + ll];
                  asm volatile("" ::: "memory");
#pragma unroll
                  for (int i = 0; i < 16; ++i) k[32 + i] = (i < nw2) ? k[32 + i] : 0u;
                  idx_select_row<48>(k, nw, mst, srB, mgB, ll); }
            } else {
                { unsigned k[64];
#pragma unroll
                  for (int i = 0; i < 32; ++i) k[i] = ka[i];
#pragma unroll
                  for (int i = 0; i < 32; ++i) k[32 + i] = srA[i * 64 + ll];
                  asm volatile("" ::: "memory");
#pragma unroll
                  for (int i = 0; i < 32; ++i) k[32 + i] = (i < nw2) ? k[32 + i] : 0u;
                  idx_select_row<64>(k, nw, mst, srA, mgA, ll); }
                { unsigned k[64];
#pragma unroll
                  for (int i = 0; i < 32; ++i) k[i] = kb_[i];
#pragma unroll
                  for (int i = 0; i < 32; ++i) k[32 + i] = srB[i * 64 + ll];
                  asm volatile("" ::: "memory");
#pragma unroll
                  for (int i = 0; i < 32; ++i) k[32 + i] = (i < nw2) ? k[32 + i] : 0u;
                  idx_select_row<64>(k, nw, mst, srB, mgB, ll); }
            }
            __syncthreads();
        }
    }
}

typedef float f32x4v __attribute__((ext_vector_type(4)));
template <int SH> __device__ __forceinline__ float dpp_shr(float v, float ident) {
    return __builtin_bit_cast(float, __builtin_amdgcn_update_dpp(__builtin_bit_cast(int, ident), __builtin_bit_cast(int, v), 0x110 + SH, 0xF, 0xF, false));
}
__device__ __forceinline__ float row_last(float v, int lane) { return shfl_from(v, (lane & 48) | 15); }
struct LruIn { bf16x8 x3[2]; uint2 u3; uint2 cyw; };
__device__ __forceinline__ void lru_load(LruIn& I, const bf16* CX, const bf16* CY, size_t brow, int t0, int g, int q4, int lane) {
    const int tk = lane & 15, lg = lane >> 4; const int t = t0 + tk;
#pragma unroll
    for (int hf = 0; hf < 2; ++hf) I.x3[hf] = *(const bf16x8*)(CX + (brow + t) * 512 + g * 64 + 32 * hf + 8 * lg);
    I.u3 = *(const uint2*)(CX + (brow + t) * 512 + g * 64 + 16 * q4 + 4 * lg);
    I.cyw = *(const uint2*)(CY + (brow + t) * 512 + g * 64 + 16 * q4 + 4 * lg);
}
template <int N> __device__ __forceinline__ unsigned tap_shift(unsigned cur, unsigned prev) {
    const int a = __builtin_amdgcn_update_dpp(0, (int)prev, 0x120 + N, 0xF, 0xF, false);
    return (unsigned)__builtin_amdgcn_update_dpp(a, (int)cur, 0x110 + N, 0xF, 0xF, false);
}
template <int N> __device__ __forceinline__ bf16x8 tap_shift8(const bf16x8& cur, const bf16x8& prev) {
    const v4u c = __builtin_bit_cast(v4u, cur), p = __builtin_bit_cast(v4u, prev); v4u r;
    r.x = tap_shift<N>(c.x, p.x); r.y = tap_shift<N>(c.y, p.y); r.z = tap_shift<N>(c.z, p.z); r.w = tap_shift<N>(c.w, p.w); return __builtin_bit_cast(bf16x8, r);
}
__device__ __forceinline__ void lru_subtile(const LruIn& I, const LruIn& P, bf16* Y0, bf16* Y1, size_t brow, int t0, int g, int q4, int lane,
        const bf16x8 (&Awa)[8], const bf16x8 (&Awx)[8], const float (&cw)[4][4], const float (&cb)[4], const float (&ca)[4], const float (&cx_)[4], const float (&sp)[4],
        float (&Arun)[4], float (&hc)[4]) {
    const int tk = lane & 15, lg = lane >> 4; const int t = t0 + tk;
    f32x4v accA = {0.f, 0.f, 0.f, 0.f}, accX = {0.f, 0.f, 0.f, 0.f};
    bf16x8 bx[8]; uint2 uw[4];
#pragma unroll
    for (int hf = 0; hf < 2; ++hf) { bx[0 + hf] = tap_shift8<3>(I.x3[hf], P.x3[hf]); bx[2 + hf] = tap_shift8<2>(I.x3[hf], P.x3[hf]); bx[4 + hf] = tap_shift8<1>(I.x3[hf], P.x3[hf]); bx[6 + hf] = I.x3[hf]; }
    uw[0].x = tap_shift<3>(I.u3.x, P.u3.x); uw[0].y = tap_shift<3>(I.u3.y, P.u3.y); uw[1].x = tap_shift<2>(I.u3.x, P.u3.x); uw[1].y = tap_shift<2>(I.u3.y, P.u3.y);
    uw[2].x = tap_shift<1>(I.u3.x, P.u3.x); uw[2].y = tap_shift<1>(I.u3.y, P.u3.y); uw[3] = I.u3;
#pragma unroll
    for (int ks = 0; ks < 8; ++ks) { accA = __builtin_amdgcn_mfma_f32_16x16x32_bf16(Awa[ks], bx[ks], accA, 0, 0, 0); accX = __builtin_amdgcn_mfma_f32_16x16x32_bf16(Awx[ks], bx[ks], accX, 0, 0, 0); }
    float u[4] = {cb[0], cb[1], cb[2], cb[3]};
#pragma unroll
    for (int q = 0; q < 4; ++q) { const uint2 w = uw[q];
        u[0] += cw[q][0] * bflo(w.x); u[1] += cw[q][1] * bfhi(w.x); u[2] += cw[q][2] * bflo(w.y); u[3] += cw[q][3] * bfhi(w.y); }
    const uint2 cyw = I.cyw;
    const float cy[4] = {bflo(cyw.x), bfhi(cyw.x), bflo(cyw.y), bfhi(cyw.y)};
    float A[4], B[4];
#pragma unroll
    for (int r = 0; r < 4; ++r) { const float rg = __builtin_amdgcn_rcpf(1.f + __expf(-(accA[r] + ca[r]))), ig = __builtin_amdgcn_rcpf(1.f + __expf(-(accX[r] + cx_[r])));
        const float la = -8.f * rg * sp[r]; const float y2 = 2.f * la; A[r] = __expf(la);
        const float om = (y2 > -0.3f) ? -y2 * (1.f + y2 * (0.5f + y2 * (0.16666667f + y2 * 0.041666668f))) : 1.f - A[r] * A[r];
        B[r] = __builtin_amdgcn_sqrtf(om) * (ig * u[r]); }
#pragma unroll
    for (int r = 0; r < 4; ++r) {
        { const float ap = dpp_shr<1>(A[r], 1.f), bp = dpp_shr<1>(B[r], 0.f); B[r] = A[r] * bp + B[r]; A[r] *= ap; }
        { const float ap = dpp_shr<2>(A[r], 1.f), bp = dpp_shr<2>(B[r], 0.f); B[r] = A[r] * bp + B[r]; A[r] *= ap; }
        { const float ap = dpp_shr<4>(A[r], 1.f), bp = dpp_shr<4>(B[r], 0.f); B[r] = A[r] * bp + B[r]; A[r] *= ap; }
        { const float ap = dpp_shr<8>(A[r], 1.f), bp = dpp_shr<8>(B[r], 0.f); B[r] = A[r] * bp + B[r]; A[r] *= ap; }
    }
    float y0[4], y1[4];
#pragma unroll
    for (int r = 0; r < 4; ++r) { const float h = B[r] + A[r] * hc[r], ap = A[r] * Arun[r]; const float z = 0.7978845608028654f * (cy[r] + 0.044715f * cy[r] * cy[r] * cy[r]);
        const float gl = cy[r] * __builtin_amdgcn_rcpf(1.f + __expf(-2.f * z)); y0[r] = h * gl; y1[r] = ap * gl; hc[r] = row_last(h, lane); Arun[r] = row_last(ap, lane); }
    const size_t off = (brow + t) * 512 + g * 64 + 16 * q4 + 4 * lg, off0 = (brow + t) * 1024 + g * 64 + 16 * q4 + 4 * lg;
    uint2 o; o.x = cvtpk(y0[0], y0[1]); o.y = cvtpk(y0[2], y0[3]); *(uint2*)(Y0 + off0) = o;
    o.x = cvtpk(y1[0], y1[1]); o.y = cvtpk(y1[2], y1[3]); *(uint2*)(Y1 + off) = o;
}
__device__ __forceinline__ void phase_lru(Frame& F, int l) {
    LAS float* agg = (LAS float*)(F.lds + 36864);
    const int lane = F.lane, tk = lane & 15, lg = lane >> 4;
    bf16* Y1 = F.YC; bf16* Y0 = F.YCAT + 512;
    for (int u = blockIdx.x; u < 256; u += F.G) {
        const int b = u & 7, g = u >> 5, q4 = (u >> 3) & 3; const size_t brow = (size_t)b * SEQ;
        const float* wa = F.lru_wa + (size_t)(l * 8 + g) * 4096; const float* wx = F.lru_wx + (size_t)(l * 8 + g) * 4096; const float* cwp = F.conv_w + (size_t)l * 4 * 512 + g * 64; const float* cbp = F.conv_b + l * 512 + g * 64;
        bf16x8 Awa[8], Awx[8];
#pragma unroll
        for (int ks = 0; ks < 8; ++ks) { const int q = ks >> 1; v4u pa, px; unsigned wsa[4], wsx[4];
#pragma unroll
            for (int j2 = 0; j2 < 4; ++j2) { const int i0 = 32 * (ks & 1) + 8 * lg + 2 * j2, oc = 16 * q4 + tk;
                const float c0 = cwp[q * 512 + i0], c1 = cwp[q * 512 + i0 + 1];
                wsa[j2] = cvtpk(c0 * wa[i0 * 64 + oc], c1 * wa[(i0 + 1) * 64 + oc]); wsx[j2] = cvtpk(c0 * wx[i0 * 64 + oc], c1 * wx[(i0 + 1) * 64 + oc]); }
            pa.x = wsa[0]; pa.y = wsa[1]; pa.z = wsa[2]; pa.w = wsa[3]; px.x = wsx[0]; px.y = wsx[1]; px.z = wsx[2]; px.w = wsx[3];
            Awa[ks] = __builtin_bit_cast(bf16x8, pa); Awx[ks] = __builtin_bit_cast(bf16x8, px); }
        float cw[4][4], cb[4], ca[4], cx_[4], sp[4];
#pragma unroll
        for (int r = 0; r < 4; ++r) { const int oc = 16 * q4 + 4 * lg + r, cg = g * 64 + oc;
#pragma unroll
            for (int q = 0; q < 4; ++q) cw[q][r] = cwp[q * 512 + oc];
            cb[r] = cbp[oc]; float sa = 0.f, sx = 0.f;
#pragma unroll
            for (int i4 = 0; i4 < 4; ++i4) { const int i = tk + 16 * i4; const float bi = cbp[i]; sa += bi * wa[i * 64 + oc]; sx += bi * wx[i * 64 + oc]; }
#pragma unroll
            for (int o = 1; o < 16; o <<= 1) { sa += shflx(sa, o); sx += shflx(sx, o); }
            ca[r] = sa + F.lru_ba[l * 512 + cg]; cx_[r] = sx + F.lru_bx[l * 512 + cg]; sp[r] = log1pf(expf(-F.lru_lambda[l * 512 + cg])); }
        float Arun[4] = {1.f, 1.f, 1.f, 1.f}, hc[4] = {0.f, 0.f, 0.f, 0.f};
        const int tseg = F.wave * 512;
        LruIn cur, prv; lru_load(cur, F.CX, F.CY, brow, tseg, g, q4, lane);
        lru_load(prv, F.CX, F.CY, brow, tseg >= 16 ? tseg - 16 : 0, g, q4, lane);
        if (tseg == 0) { prv.x3[0] = (bf16x8){0, 0, 0, 0, 0, 0, 0, 0}; prv.x3[1] = (bf16x8){0, 0, 0, 0, 0, 0, 0, 0}; prv.u3 = (uint2){0u, 0u}; }
#pragma unroll 2
        for (int s = 0; s < 32; ++s) { LruIn nxt;
            lru_load(nxt, F.CX, F.CY, brow, tseg + 16 * (s + 1 < 32 ? s + 1 : s), g, q4, lane);
            asm volatile("" ::: "memory");
            lru_subtile(cur, prv, Y0, Y1, brow, tseg + 16 * s, g, q4, lane, Awa, Awx, cw, cb, ca, cx_, sp, Arun, hc);
            prv = cur; cur = nxt; }
        __syncthreads();
        if (tk == 0) {
#pragma unroll
            for (int r = 0; r < 4; ++r) { agg[F.wave * 32 + 4 * lg + r] = Arun[r]; agg[F.wave * 32 + 16 + 4 * lg + r] = hc[r]; } }
        __syncthreads();
        float hin[4] = {0.f, 0.f, 0.f, 0.f};
        for (int w = 0; w < F.wave; ++w) {
#pragma unroll
            for (int r = 0; r < 4; ++r) hin[r] = agg[w * 32 + 4 * lg + r] * hin[r] + agg[w * 32 + 16 + 4 * lg + r]; }
        if (F.wave > 0) {
            asm volatile("s_waitcnt vmcnt(0)" ::: "memory");
#pragma unroll 1
            for (int s8 = 0; s8 < 32; s8 += 8) { uint2 a0[8], a1[8];
#pragma unroll
                for (int j = 0; j < 8; ++j) { const size_t row = brow + tseg + 16 * (s8 + j) + tk; a0[j] = *(const uint2*)(Y0 + row * 1024 + g * 64 + 16 * q4 + 4 * lg); a1[j] = *(const uint2*)(Y1 + row * 512 + g * 64 + 16 * q4 + 4 * lg); }
#pragma unroll
                for (int j = 0; j < 8; ++j) { const size_t row = brow + tseg + 16 * (s8 + j) + tk; uint2 o;
                    o.x = cvtpk(bflo(a0[j].x) + bflo(a1[j].x) * hin[0], bfhi(a0[j].x) + bfhi(a1[j].x) * hin[1]); o.y = cvtpk(bflo(a0[j].y) + bflo(a1[j].y) * hin[2], bfhi(a0[j].y) + bfhi(a1[j].y) * hin[3]);
                    *(uint2*)(Y0 + row * 1024 + g * 64 + 16 * q4 + 4 * lg) = o; } }
        }
    }
}

struct Args { const float* in[20]; float* out; unsigned char* ws; int l_lo, l_hi, ph_lo, ph_hi; };
__device__ __forceinline__ void make_frame(Frame& F, const Args& args, unsigned char* lds_) {
    int tid = wg_tid(); asm volatile("" : "+v"(tid));
    const __attribute__((address_space(4))) unsigned char* ka = (const __attribute__((address_space(4))) unsigned char*)__builtin_amdgcn_kernarg_segment_ptr(); asm volatile("" : "+s"(ka));
#define KARG(k) ((const float*)(GAS const float*)(*(const unsigned long long __attribute__((address_space(4)))*)(ka + 8 * (k))))
    GAS unsigned char* wsg = (GAS unsigned char*)(*(const unsigned long long __attribute__((address_space(4)))*)(ka + 168)); unsigned char* ws = (unsigned char*)wsg;
    F.lds = (LAS unsigned char*)lds_; F.MISC = (volatile LAS unsigned*)(F.lds + MISC_OFF);
    F.tid = tid; F.lane = tid & 63; F.wave = __builtin_amdgcn_readfirstlane(tid >> 6); F.G = gridDim.x;
    F.ctl = (gu32*)(ws + WS_CTL);
    F.x = KARG(0); F.g_mix = KARG(1); F.w_in = KARG(2); F.qk_gain_a = KARG(3); F.rel_bias = KARG(4); F.qk_gain_b = KARG(5); F.g_idx_k = KARG(6);
    F.conv_w = KARG(7); F.conv_b = KARG(8); F.lru_wa = KARG(9); F.lru_ba = KARG(10); F.lru_wx = KARG(11); F.lru_bx = KARG(12); F.lru_lambda = KARG(13);
    F.b_gate = KARG(14); F.w_branch = KARG(15); F.w_out = KARG(16); F.g_ffn = KARG(17); F.w_ffn_in = KARG(18); F.w_ffn_out = KARG(19); F.out = (float*)KARG(20);
#undef KARG
    F.rcos = (float*)(ws + WS_ROPE); F.rsin = F.rcos + SEQ * 32; F.SS = (float*)(ws + WS_SS);
    F.W = (bf16*)(ws + WS_W); F.W2a = (bf16*)(ws + 462 * MiB); F.W2b = (bf16*)((unsigned char*)F.out + 32 * MiB); F.H = (bf16*)(ws + WS_H); F.YC = (bf16*)F.out; F.YCAT = (bf16*)F.out + (size_t)32 * 1024 * 1024;
    F.QA = (bf16*)(ws + WS_QA); F.QB = (bf16*)(ws + WS_QB); F.KA = (bf16*)(ws + WS_KA); F.VA = (bf16*)(ws + WS_VA); F.KB = (bf16*)(ws + WS_KB); F.VB = (bf16*)(ws + WS_VB);
    F.IQ = (bf16*)(ws + WS_IQ); F.IK = (bf16*)(ws + WS_IK); F.IW = (float*)(ws + WS_IW); F.CX = (bf16*)(ws + WS_CX); F.CY = (bf16*)(ws + WS_CY);
    F.GT = (bf16*)(ws + WS_GT); F.ACT = (bf16*)(ws + WS_ACT); F.MG = (bf16*)(ws + WS_MG); F.MASK = (u64*)(ws + WS_MASK);
}
template <int PHM> __global__ void __launch_bounds__(NWAVES * 64, 2) fwd(Args args) {
    { LAS unsigned char* l3 = (LAS unsigned char*)lds; for (int u = threadIdx.x; u < (LDS_BYTES - LDSCTL_OFF) / 4; u += NWAVES * 64) ((LAS unsigned*)(l3 + LDSCTL_OFF))[u] = 0u; }
    __syncthreads();
    static_assert(WGT_LDS_OFF == MISC_OFF + 256 && WGT_LDS_OFF + 256 <= LDS_BYTES, "wave-index table inside the LDS control area");
    if ((threadIdx.x & 63) == 0) ((LAS unsigned*)((LAS unsigned char*)lds + WGT_LDS_OFF))[wgt_slot()] = threadIdx.x >> 6;
    __syncthreads();
    XcdBarrier bar; bar.bar = (unsigned*)(args.ws + WS_CTL) + CW_BAR; bar.x = 0; bar.st = nullptr;
    if (!MK_PER_PHASE) bar = xcd_barrier_post((unsigned*)(args.ws + WS_CTL) + CW_BAR, (volatile LAS unsigned*)((LAS unsigned char*)lds + MISC_OFF) + 8);
#define GRID_BAR() do { if (!MK_PER_PHASE) xcd_barrier(bar); } while (0)
    const int plo = args.ph_lo, phi = args.ph_hi; (void)plo; (void)phi;
#ifndef PHMASK
#define PHMASK 0x1ff
#endif
#if MK_PER_PHASE
#define IN(k) (((PHMASK >> (k)) & 1) && ((PHM >> (k)) & 1) && plo <= (k) && (k) < phi)
#else
#define IN(k) (((PHMASK >> (k)) & 1) && ((PHM >> (k)) & 1))
#endif
    bool first = true;
    for (int l = MK_PER_PHASE ? args.l_lo : 0; l < (MK_PER_PHASE ? args.l_hi : DEPTH); ++l) {
        if (IN(0) && (MK_PER_PHASE || l == 0)) { if (!first) GRID_BAR(); first = false; Frame F; make_frame(F, args, lds); phase_weights(F, l); if (l == 0) phase_xb0(F, F.x, F.SS); }
        if (IN(1)) { if (!first) GRID_BAR(); first = false; Frame F; make_frame(F, args, lds);
            pg8::Gemm g{F.H, wset(F, l).in, M, NIN, D}; pg8::StaticOrder S; S.init(M, NIN, F.G, (int)blockIdx.x);
            pg8::EpiIn E{F.QA, F.KA, F.VA, F.QB, F.KB, F.VB, F.IQ, F.IK, F.IW, F.CX, F.CY, F.GT, F.qk_gain_a + l * 128, F.qk_gain_b + l * 128, F.g_idx_k + l * 64, F.b_gate + l * 3072, F.rcos, F.rsin, F.SS + (size_t)(2 * l) * M * 16, (LAS float*)(F.lds + XTRA_OFF)};
            pg8::gemm_phase<pg8::EpiIn, pg8::StaticOrder, PG8_ALIGN, PG8_SP2>(F.lds + RING_OFF, g, S, E); }
        if (IN(2)) { if (!first) GRID_BAR(); first = false; { Frame F0; make_frame(F0, args, lds); phase_lru(F0, l); } __syncthreads(); Frame F; make_frame(F, args, lds); phase_attn_a(F, l); __syncthreads(); phase_idx(F);
            if (F.G == 256) { asm volatile("s_waitcnt vmcnt(0)" ::: "memory"); __syncthreads(); } else GRID_BAR();
            { Frame F2; make_frame(F2, args, lds); phase_attn_b(F2, l); }
            if (!MK_PER_PHASE && l + 1 < DEPTH) { __syncthreads();
                Frame F3; make_frame(F3, args, lds); phase_weights(F3, l + 1, (unsigned*)(args.ws + WS_CTL) + 64 + l); } }
        if (IN(4)) { if (!first) GRID_BAR(); first = false; Frame F; make_frame(F, args, lds);
#ifndef DBG_HALF
#define DBG_HALF 0
#endif
#ifndef DBG_SKIP_BR
#define DBG_SKIP_BR 0
#endif
            pg8::Gemm g{F.YCAT, wset(F, l).ba, M, D, D}; pg8::StaticOrder S; S.init(M, D, F.G, (int)blockIdx.x); pg8::EpiGateCat E{F.MG, F.GT};
            pg8::gemm_phase<pg8::EpiGateCat, pg8::StaticOrder, PG8_ALIGN, PG8_SP2, true>(F.lds + RING_OFF, g, S, E); }
        if (IN(5)) { if (!first) GRID_BAR(); first = false; Frame F; make_frame(F, args, lds);
            pg8::Gemm g{F.MG, wset(F, l).out, M, D, D}; pg8::StaticOrder S; S.init(M, D, F.G, (int)blockIdx.x); pg8::EpiResidB E{F.H, F.SS + (size_t)(2 * l + 1) * M * 16, nullptr};
            pg8::gemm_phase<pg8::EpiResidB, pg8::StaticOrder, PG8_ALIGN, PG8_SP2>(F.lds + RING_OFF, g, S, E); }
        if (IN(7)) { if (!first) GRID_BAR(); first = false; Frame F; make_frame(F, args, lds);
            pg8::Gemm g{F.H, wset(F, l).f1, M, NF1, D}; pg8::StaticOrder S; S.init(M, NF1, F.G, (int)blockIdx.x); pg8::EpiSwiGLU E{F.ACT, F.SS + (size_t)(2 * l + 1) * M * 16, (LAS float*)(F.lds + XTRA_OFF)};
            pg8::gemm_phase<pg8::EpiSwiGLU, pg8::StaticOrder, PG8_ALIGN, PG8_SP2>(F.lds + RING_OFF, g, S, E); }
        if (IN(8)) { if (!first) GRID_BAR(); first = false; Frame F; make_frame(F, args, lds);
            pg8::Gemm g{F.ACT, wset(F, l).f2, M, D, FF}; pg8::StaticOrder S; S.init(M, D, F.G, (int)blockIdx.x); pg8::EpiResidB E{F.H, F.SS + (size_t)(2 * l + 2 < 2 * DEPTH ? 2 * l + 2 : 0) * M * 16, (l + 1 < DEPTH) ? (float*)nullptr : F.out};
            pg8::gemm_phase<pg8::EpiResidB, pg8::StaticOrder, PG8_ALIGN, PG8_SP2>(F.lds + RING_OFF, g, S, E); }
    }
#undef IN
}

extern "C" void kernel_launch(void* const* d_in, const int* in_sizes, int n_in, void* d_out, int out_size, void* d_ws, size_t ws_size, hipStream_t stream) {
    static int grid = 0;
    if (grid == 0) {
        if (n_in != 20 || in_sizes[0] != M * D || out_size != M * D || ws_size < WS_END) { fprintf(stderr, "kernel_launch: unexpected problem shape / workspace (n_in %d, ws %zu); nothing launched\n", n_in, ws_size); grid = -1; return; }
        int dev = 0, cus = 0, per_cu = 0;
        if (hipGetDevice(&dev) != hipSuccess || hipDeviceGetAttribute(&cus, hipDeviceAttributeMultiprocessorCount, dev) != hipSuccess) { grid = -1; return; }
#if MK_PER_PHASE
        const void* fns[NPH] = {(const void*)fwd<1>, (const void*)fwd<2>, (const void*)fwd<4>, (const void*)fwd<8>, (const void*)fwd<16>, (const void*)fwd<32>, (const void*)fwd<64>, (const void*)fwd<128>, (const void*)fwd<256>};
        for (int i = 0; i < NPH; ++i) if (hipFuncSetAttribute(fns[i], hipFuncAttributeMaxDynamicSharedMemorySize, LDS_BYTES) != hipSuccess) { fprintf(stderr, "kernel_launch: hipFuncSetAttribute failed\n"); grid = -1; return; }
#else
        if (hipFuncSetAttribute((const void*)fwd<0x1ff>, hipFuncAttributeMaxDynamicSharedMemorySize, LDS_BYTES) != hipSuccess) { fprintf(stderr, "kernel_launch: hipFuncSetAttribute failed\n"); grid = -1; return; }
        if (hipOccupancyMaxActiveBlocksPerMultiprocessor(&per_cu, (const void*)fwd<0x1ff>, NWAVES * 64, LDS_BYTES) != hipSuccess || per_cu < 1) fprintf(stderr, "kernel_launch: occupancy query reports %d workgroups per CU\n", per_cu);
#endif
        (void)hipGetLastError(); (void)per_cu;
        grid = cus;
    }
    if (grid < 0) return;
    if (hipMemsetAsync((char*)d_ws + WS_CTL, 0, CTL_ZERO_BYTES, stream) != hipSuccess) return;
    Args a{};
    for (int i = 0; i < 20; ++i) a.in[i] = (const float*)d_in[i];
    a.out = (float*)d_out; a.ws = (unsigned char*)d_ws;
#if MK_PER_PHASE
    for (int l = 0; l < DEPTH; ++l) for (int p = 0; p < NPH; ++p) { a.l_lo = l; a.l_hi = l + 1; a.ph_lo = p; a.ph_hi = p + 1;
        switch (p) {
            case 0: hipLaunchKernelGGL(fwd<1>, dim3(grid), dim3(NWAVES * 64), LDS_BYTES, stream, a); break;
            case 1: hipLaunchKernelGGL(fwd<2>, dim3(grid), dim3(NWAVES * 64), LDS_BYTES, stream, a); break;
            case 2: hipLaunchKernelGGL(fwd<4>, dim3(grid), dim3(NWAVES * 64), LDS_BYTES, stream, a); break;
            case 3: hipLaunchKernelGGL(fwd<8>, dim3(grid), dim3(NWAVES * 64), LDS_BYTES, stream, a); break;
            case 4: hipLaunchKernelGGL(fwd<16>, dim3(grid), dim3(NWAVES * 64), LDS_BYTES, stream, a); break;
            case 5: hipLaunchKernelGGL(fwd<32>, dim3(grid), dim3(NWAVES * 64), LDS_BYTES, stream, a); break;
            case 6: hipLaunchKernelGGL(fwd<64>, dim3(grid), dim3(NWAVES * 64), LDS_BYTES, stream, a); break;
            case 7: hipLaunchKernelGGL(fwd<128>, dim3(grid), dim3(NWAVES * 64), LDS_BYTES, stream, a); break;
            default: hipLaunchKernelGGL(fwd<256>, dim3(grid), dim3(NWAVES * 64), LDS_BYTES, stream, a); break;
        } }
#else
    a.l_lo = 0; a.l_hi = DEPTH; a.ph_lo = 0; a.ph_hi = NPH;
    hipLaunchKernelGGL(fwd<0x1ff>, dim3(grid), dim3(NWAVES * 64), LDS_BYTES, stream, a);
#endif
}
```

```cpp
#include <hip/hip_runtime.h>
#include <cstdio>
#include <cstdint>

#define WGT_LDS_OFF 139840
extern __shared__ __attribute__((aligned(16))) unsigned char lds[];
__device__ __forceinline__ unsigned wgt_slot() { return (unsigned)__builtin_amdgcn_s_getreg((5 << 11) | 4) & 63u; }
__device__ __forceinline__ int wg_lane() { int l; asm volatile("v_mbcnt_lo_u32_b32 %0, -1, 0\n\tv_mbcnt_hi_u32_b32 %0, -1, %0" : "=v"(l)); return l; }
__device__ __forceinline__ int wg_wave() { const volatile __attribute__((address_space(3))) unsigned* tab = (const volatile __attribute__((address_space(3))) unsigned*)((__attribute__((address_space(3))) unsigned char*)lds + WGT_LDS_OFF);
    return __builtin_amdgcn_readfirstlane((int)tab[wgt_slot()]); }
__device__ __forceinline__ int wg_tid() { return wg_wave() * 64 + wg_lane(); }
__device__ __forceinline__ float shflx(float v, int m) { return __builtin_bit_cast(float, __builtin_amdgcn_ds_bpermute((wg_lane() ^ m) << 2, __builtin_bit_cast(int, v))); }
__device__ __forceinline__ float shfl_from(float v, int src) { return __builtin_bit_cast(float, __builtin_amdgcn_ds_bpermute(src << 2, __builtin_bit_cast(int, v))); }
namespace pg8 {
#define PG8_LAS __attribute__((address_space(3)))
typedef unsigned short bf16_t;
typedef short bf16x8 __attribute__((ext_vector_type(8)));
typedef float f32x4 __attribute__((ext_vector_type(4)));
typedef unsigned u32x4 __attribute__((ext_vector_type(4)));
constexpr int BM = 256, BK = 64, HALF = 128, HTB = HALF * BK * 2  , STAGE_BYTES = 8 * HTB, NXCD = 8, WGM = 8;

__host__ __device__ __forceinline__ int lds_byte(int r, int c) { const int st = (r >> 4) * 2 + (c >> 5), rr = r & 15, cc = c & 31, ob = rr * 64 + cc * 2; return st * 1024 + (ob ^ (((ob >> 9) & 1) << 5)); }
__host__ __device__ __forceinline__ void stage_rc(int b, int& R, int& C) { const int st = b / 1024, sb = b % 1024, swz = sb ^ (((sb >> 9) & 1) << 5); R = (st >> 1) * 16 + swz / 64; C = (st & 1) * 32 + (swz % 64) / 2; }
__host__ __device__ __forceinline__ int perm32(int rho) { const int n = rho >> 4, i = rho & 15; return 8 * (i >> 2) + 4 * n + (i & 3); }

struct Unit { int pm, pn; };
struct Gemm { const bf16_t* A; const bf16_t* Bt; int M, N, K; };

struct StaticOrder {
    int nM, nN, nwg, G, c;
    __host__ __device__ void init(int M, int N, int G_, int c_) { nM = M / BM; nN = N / BM; nwg = nM * nN; G = G_; c = c_; }
    __host__ __device__ bool next(int i, Unit& u) const {
        const long L = (long)i * G + c; if (L >= nwg) return false;
        int wgid = (int)L; { const int q = nwg / NXCD, r = nwg % NXCD, xcd = wgid % NXCD, off = wgid / NXCD; wgid = (xcd < r ? xcd * (q + 1) : r * (q + 1) + (xcd - r) * q) + off; }
        const int nig = WGM * nN, gid = wgid / nig, fm = gid * WGM, gsz = (nM - fm) < WGM ? (nM - fm) : WGM;
        u.pm = fm + ((wgid % nig) % gsz); u.pn = (wgid % nig) / gsz; return true;
    }
    __device__ __forceinline__ void a_ready(const Unit&) const {}
    __device__ __forceinline__ void done(const Unit&) const {}
};


typedef float f32x2_t __attribute__((ext_vector_type(2))); typedef __bf16 bf16x2_t __attribute__((ext_vector_type(2)));
__device__ __forceinline__ unsigned cvt_pk_bf16(float lo, float hi) { const f32x2_t v = {lo, hi}; const bf16x2_t b = __builtin_convertvector(v, bf16x2_t); return __builtin_bit_cast(unsigned, b); }
__device__ __forceinline__ u32x4 pack8(const f32x4 a, const f32x4 b) { u32x4 w; w.x = cvt_pk_bf16(a[0], a[1]); w.y = cvt_pk_bf16(a[2], a[3]); w.z = cvt_pk_bf16(b[0], b[1]); w.w = cvt_pk_bf16(b[2], b[3]); return w; }
__device__ __forceinline__ float bflo(unsigned w) { return __builtin_bit_cast(float, w << 16); }
__device__ __forceinline__ float bfhi(unsigned w) { return __builtin_bit_cast(float, w & 0xffff0000u); }
__device__ __forceinline__ float fast_sigmoid(float x) { return __builtin_amdgcn_rcpf(1.f + __expf(-x)); }

__device__ __forceinline__ float row_rs(const float* ssp, int row) { const f32x4* q = (const f32x4*)(ssp + (size_t)row * 16); const f32x4 a = q[0], b = q[1], c = q[2], d = q[3];
    const f32x4 s = (a + b) + (c + d); return __builtin_amdgcn_rsqf(((s[0] + s[1]) + (s[2] + s[3])) * (1.f / 1024.f) + 1e-6f); }
__device__ __forceinline__ const PG8_LAS float* unit_row_scales(const float* ssp, PG8_LAS float* rsl, const Unit& u, int wr, int wc, int fr, int fq, int& cached_pm) {
    const int lane = fr + 16 * fq;
    PG8_LAS float* mine = rsl + (wr * 4 + wc) * 128;
    if (u.pm != cached_pm) {
        mine[lane] = row_rs(ssp, u.pm * BM + wr * 64 + lane); mine[64 + lane] = row_rs(ssp, u.pm * BM + HALF + wr * 64 + lane);
        asm volatile("s_waitcnt lgkmcnt(0)" ::: "memory");
        cached_pm = u.pm; }
    return mine;
}
constexpr float QSCALE = 0.125f * 1.4426950408889634f;

struct EpiIn {
    static constexpr bool PERM = true, AFTER_DRAIN = false;
    bf16_t *QA, *KA, *VA, *QB, *KB, *VB, *IQ, *IK; float* IW; bf16_t *CX, *CY, *GT;
    const float *gain_a, *gain_b, *gain_ik, *bgate, *rcos, *rsin;
    const float* ss;
    PG8_LAS float* rsl;
    mutable int rs_pm = -1;
    __device__ __forceinline__ void operator()(const f32x4 (&acc)[2][2][4][2], const Unit& u, int wr, int wc, int fr, int fq) const {
        const int pn = u.pn; int row0 = u.pm * BM + wr * 64 + fr; asm volatile("" : "+v"(row0));
        const PG8_LAS float* rsw = unit_row_scales(ss, rsl, u, wr, wc, fr, fq, rs_pm) + fr;
        if (pn >= 12) {
            const int gi = (pn - 12) >> 2, ct = ((pn - 12) & 3) * BM; unsigned char* base = (unsigned char*)GT + (size_t)gi * 32768 * 1024;
            const int col0 = ct + wc * 64 + 16 * fq; const float* bp = bgate + gi * 1024 + col0;
            f32x4 bv[2][2];
#pragma unroll
            for (int bj = 0; bj < 2; ++bj)
#pragma unroll
                for (int n = 0; n < 2; ++n) bv[bj][n] = *(const f32x4*)(bp + 8 * bj + 4 * n) * -1.4426950408889634f;
#pragma unroll
            for (int ai = 0; ai < 2; ++ai)
#pragma unroll
                for (int m = 0; m < 4; ++m) { unsigned char* rowp = base + (size_t)(row0 + ai * HALF + m * 16) * 1024 + col0; const float rs = rsw[ai * 64 + m * 16] * -1.4426950408889634f; u32x4 wq;
                    typedef float f32x2 __attribute__((ext_vector_type(2)));
                    const f32x2 rs2 = {rs, rs}, one2 = {1.f, 1.f}, k255 = {255.f, 255.f};
#pragma unroll
                    for (int bj = 0; bj < 2; ++bj) { unsigned w[2] = {0u, 0u};
#pragma unroll
                        for (int n = 0; n < 2; ++n)
#pragma unroll
                            for (int h2 = 0; h2 < 2; ++h2) { const f32x4 a4 = acc[ai][bj][m][n], b4 = bv[bj][n];
                                const f32x2 a2 = {a4[2 * h2], a4[2 * h2 + 1]}, b2 = {b4[2 * h2], b4[2 * h2 + 1]};
                                const f32x2 t = a2 * rs2 + b2; f32x2 ex = {__builtin_amdgcn_exp2f(t[0]), __builtin_amdgcn_exp2f(t[1])};
                                const f32x2 dn = ex + one2; f32x2 rc2 = {__builtin_amdgcn_rcpf(dn[0]), __builtin_amdgcn_rcpf(dn[1])};
                                f32x2 q = rc2 * k255; q[0] = __builtin_rintf(q[0]); q[1] = __builtin_rintf(q[1]); q = __builtin_elementwise_max(q, one2);
                                w[n] = __builtin_amdgcn_cvt_pk_u8_f32(q[0], 2 * h2, w[n]); w[n] = __builtin_amdgcn_cvt_pk_u8_f32(q[1], 2 * h2 + 1, w[n]); }
                        if (bj == 0) { wq.x = w[0]; wq.y = w[1]; } else { wq.z = w[0]; wq.w = w[1]; } }
                    *(u32x4*)rowp = wq; asm volatile("" ::: "memory"); }
            return;
        }
        if (pn >= 8) {
            bf16_t* base = (pn < 10) ? CX : CY; const int col0 = ((pn - 8) & 1) * BM + wc * 32 + 8 * fq;
#pragma unroll
            for (int ai = 0; ai < 2; ++ai)
#pragma unroll
                for (int m = 0; m < 4; ++m) { bf16_t* rowp = base + (size_t)(row0 + ai * HALF + m * 16) * 512 + col0; const float rs = rsw[ai * 64 + m * 16];
#pragma unroll
                    for (int bj = 0; bj < 2; ++bj) *(u32x4*)(rowp + bj * HALF) = pack8(acc[ai][bj][m][0] * rs, acc[ai][bj][m][1] * rs);
                    asm volatile("" ::: "memory"); }
            return;
        }
        bf16_t* dst; const float* gain = nullptr; bool do_norm = false, do_rope = false; float scale = 1.f; int pitch = 256;
        switch (pn) {
            case 0: dst = QA; gain = gain_a; do_norm = true; scale = QSCALE; break;
            case 1: dst = KA; gain = gain_a + 64; do_norm = true; break;
            case 2: dst = VA; break;
            case 3: dst = QB; gain = gain_b; do_norm = true; do_rope = true; scale = QSCALE; break;
            case 4: dst = KB; gain = gain_b + 64; do_norm = true; do_rope = true; break;
            case 5: dst = VB; break;
            case 6: dst = IQ; do_rope = true; break;
            default: dst = IK; gain = gain_ik; do_norm = true; do_rope = true; pitch = 64; break;
        }
        if (pn == 7) {
            if (wc == 1) {
                if (fq == 0) {
#pragma unroll
                    for (int ai = 0; ai < 2; ++ai)
#pragma unroll
                        for (int m = 0; m < 4; ++m) { const int row = row0 + ai * HALF + m * 16; *(f32x4*)(IW + (size_t)row * 4) = acc[ai][0][m][0] * (0.0625f * rsw[ai * 64 + m * 16]); }
                }
                return;
            }
            if (wc != 0) return;
        }
        f32x4 g[2][2];
#pragma unroll
        for (int bj = 0; bj < 2; ++bj)
#pragma unroll
            for (int n = 0; n < 2; ++n) g[bj][n] = do_norm ? *(const f32x4*)(gain + bj * 32 + 8 * fq + 4 * n) * scale : (f32x4){scale, scale, scale, scale};
        const int colb = (pn == 7 ? 0 : wc * 64) + 8 * fq;
        f32x4 rc[4];
        if (do_rope) { const int t = row0 & 4095; const float* cp = rcos + t * 32 + 8 * fq; const float* sp = rsin + t * 32 + 8 * fq; rc[0] = *(const f32x4*)cp; rc[1] = *(const f32x4*)(cp + 4); rc[2] = *(const f32x4*)sp; rc[3] = *(const f32x4*)(sp + 4); }
#pragma unroll
        for (int ai = 0; ai < 2; ++ai)
#pragma unroll
            for (int m = 0; m < 4; ++m) {
                const int row = row0 + ai * HALF + m * 16;
                const float rsx = rsw[ai * 64 + m * 16];
                f32x4 lo0 = acc[ai][0][m][0] * rsx, lo1 = acc[ai][0][m][1] * rsx, hi0 = acc[ai][1][m][0] * rsx, hi1 = acc[ai][1][m][1] * rsx;
                if (do_norm) {
                    f32x4 s4 = lo0 * lo0 + lo1 * lo1 + hi0 * hi0 + hi1 * hi1; float ss = (s4[0] + s4[1]) + (s4[2] + s4[3]);
                    ss += shflx(ss, 16); ss += shflx(ss, 32);
                    const float rs = __builtin_amdgcn_rsqf(ss * (1.f / 64.f) + 1e-6f);
                    lo0 = lo0 * rs; lo1 = lo1 * rs; hi0 = hi0 * rs; hi1 = hi1 * rs;
                }
                lo0 = lo0 * g[0][0]; lo1 = lo1 * g[0][1]; hi0 = hi0 * g[1][0]; hi1 = hi1 * g[1][1];
                if (do_rope) {
                    const f32x4 c0 = rc[0], c1 = rc[1], s0 = rc[2], s1 = rc[3];
                    const f32x4 a0 = lo0 * c0 - hi0 * s0, a1 = lo1 * c1 - hi1 * s1, b0 = hi0 * c0 + lo0 * s0, b1 = hi1 * c1 + lo1 * s1;
                    lo0 = a0; lo1 = a1; hi0 = b0; hi1 = b1;
                    const int nx = ai * 4 + m + 1;
                    if (nx < 8) { asm volatile("" : "+v"(lo0), "+v"(lo1), "+v"(hi0), "+v"(hi1));
                        const int t = (row0 + (nx >> 2) * HALF + (nx & 3) * 16) & 4095; const float* cp = rcos + t * 32 + 8 * fq; const float* sp = rsin + t * 32 + 8 * fq;
                        rc[0] = *(const f32x4*)cp; rc[1] = *(const f32x4*)(cp + 4); rc[2] = *(const f32x4*)sp; rc[3] = *(const f32x4*)(sp + 4); }
                }
                if (pn == 7) {
                    bf16_t* tp = dst + (size_t)(row >> 5) * 2048 + (fq >> 1) * 512 + ((fq & 1) * 32 + (row & 31)) * 8;
                    *(u32x4*)(tp) = pack8(lo0, lo1); *(u32x4*)(tp + 1024) = pack8(hi0, hi1);
                } else if (pn == 1 || pn == 4) {
                    bf16_t* tp = dst + ((size_t)(row >> 5) * 4 + wc) * 2048 + (fq >> 1) * 512 + ((fq & 1) * 32 + (row & 31)) * 8;
                    *(u32x4*)(tp) = pack8(lo0, lo1); *(u32x4*)(tp + 1024) = pack8(hi0, hi1);
                } else {
                    bf16_t* rowp = dst + (size_t)row * pitch + colb;
                    *(u32x4*)(rowp) = pack8(lo0, lo1); *(u32x4*)(rowp + 32) = pack8(hi0, hi1); }
                asm volatile("" ::: "memory");
            }
    }
};

struct EpiGate {
    static constexpr bool PERM = true, AFTER_DRAIN = false;
    bf16_t* MG; const bf16_t* G; bool first;
    __device__ __forceinline__ void operator()(const f32x4 (&acc)[2][2][4][2], const Unit& u, int wr, int wc, int fr, int fq) const {
        int row0 = u.pm * BM + wr * 64 + fr; const int col0 = u.pn * BM + wc * 32 + 8 * fq; asm volatile("" : "+v"(row0));
#pragma unroll
        for (int ai = 0; ai < 2; ++ai)
#pragma unroll
            for (int m = 0; m < 4; ++m) { const size_t off = (size_t)(row0 + ai * HALF + m * 16) * 1024 + col0;
#pragma unroll
                for (int bj = 0; bj < 2; ++bj) { const u32x4 gw = *(const u32x4*)(G + off + bj * HALF);
                    f32x4 v0 = acc[ai][bj][m][0], v1 = acc[ai][bj][m][1];
                    v0[0] *= bflo(gw.x); v0[1] *= bfhi(gw.x); v0[2] *= bflo(gw.y); v0[3] *= bfhi(gw.y); v1[0] *= bflo(gw.z); v1[1] *= bfhi(gw.z); v1[2] *= bflo(gw.w); v1[3] *= bfhi(gw.w);
                    if (!first) { const u32x4 ow = *(const u32x4*)(MG + off + bj * HALF);
                        v0[0] += bflo(ow.x); v0[1] += bfhi(ow.x); v0[2] += bflo(ow.y); v0[3] += bfhi(ow.y); v1[0] += bflo(ow.z); v1[1] += bfhi(ow.z); v1[2] += bflo(ow.w); v1[3] += bfhi(ow.w); }
                    *(u32x4*)(MG + off + bj * HALF) = pack8(v0, v1); asm volatile("" ::: "memory"); } }
    }
};

struct EpiResid {
    static constexpr bool PERM = true, AFTER_DRAIN = false;
    const float* xin; float* out; bf16_t* XB; float* ss;
    __device__ __forceinline__ void operator()(const f32x4 (&acc)[2][2][4][2], const Unit& u, int wr, int wc, int fr, int fq) const {
        int row0 = u.pm * BM + wr * 64 + fr; const int col0 = u.pn * BM + wc * 32 + 8 * fq; asm volatile("" : "+v"(row0));
#pragma unroll
        for (int ai = 0; ai < 2; ++ai)
#pragma unroll
            for (int m = 0; m < 4; ++m) { const int row = row0 + ai * HALF + m * 16; const size_t off = (size_t)row * 1024 + col0; float sq = 0.f;
#pragma unroll
                for (int bj = 0; bj < 2; ++bj) { const f32x4 r0 = *(const f32x4*)(xin + off + bj * HALF) + acc[ai][bj][m][0], r1 = *(const f32x4*)(xin + off + bj * HALF + 4) + acc[ai][bj][m][1];
                    *(f32x4*)(out + off + bj * HALF) = r0; *(f32x4*)(out + off + bj * HALF + 4) = r1;
                    if (XB) { *(u32x4*)(XB + off + bj * HALF) = pack8(r0, r1); const f32x4 q = r0 * r0 + r1 * r1; sq += (q[0] + q[1]) + (q[2] + q[3]); } }
                if (XB) { sq += shflx(sq, 16); sq += shflx(sq, 32); if (fq == 0) ss[(size_t)row * 16 + u.pn * 4 + wc] = sq; }
                asm volatile("" ::: "memory"); }
    }
};

struct EpiGateCat {
    static constexpr bool PERM = true, AFTER_DRAIN = false;
    bf16_t* MG; const bf16_t* G;
    __device__ __forceinline__ void mid(f32x4 (&acc)[2][2][4][2], const Unit& u, int kdone, int wr, int wc, int fr, int fq) const {
        if (kdone != 4 && kdone != 8) return;
        const unsigned char* Gp = (const unsigned char*)G + (size_t)(kdone == 4 ? 0 : 1) * 32768 * 1024; const unsigned char* Gn = Gp + (size_t)32768 * 1024;
        int row0 = u.pm * BM + wr * 64 + fr; const int col0 = u.pn * BM + wc * 32 + 8 * fq; asm volatile("" : "+v"(row0));
        {
            uint2 ga[2][4][2], gb[2][4][2];
#pragma unroll
            for (int ai = 0; ai < 2; ++ai)
#pragma unroll
                for (int mm = 0; mm < 4; ++mm)
#pragma unroll
                    for (int bj = 0; bj < 2; ++bj) { const size_t off = (size_t)(row0 + ai * HALF + mm * 16) * 1024 + col0 + bj * HALF; ga[ai][mm][bj] = *(const uint2*)(Gp + off); gb[ai][mm][bj] = *(const uint2*)(Gn + off); }
            asm volatile("" ::: "memory");
#pragma unroll
            for (int ai = 0; ai < 2; ++ai)
#pragma unroll
                for (int mm = 0; mm < 4; ++mm)
#pragma unroll
                    for (int bj = 0; bj < 2; ++bj) { const int m = mm; const uint2 a = ga[ai][mm][bj], b = gb[ai][mm][bj]; f32x4 r0, r1;
#pragma unroll
                        for (int e = 0; e < 4; ++e) { r0[e] = (float)((a.x >> (8 * e)) & 255u) * __builtin_amdgcn_rcpf((float)((b.x >> (8 * e)) & 255u)); r1[e] = (float)((a.y >> (8 * e)) & 255u) * __builtin_amdgcn_rcpf((float)((b.y >> (8 * e)) & 255u)); }
                        acc[ai][bj][m][0] = acc[ai][bj][m][0] * r0; acc[ai][bj][m][1] = acc[ai][bj][m][1] * r1; }
            asm volatile("" ::: "memory");
        }
    }
    __device__ __forceinline__ void operator()(const f32x4 (&acc)[2][2][4][2], const Unit& u, int wr, int wc, int fr, int fq) const {
        const unsigned char* G2 = (const unsigned char*)G + (size_t)2 * 32768 * 1024;
        int row0 = u.pm * BM + wr * 64 + fr; const int col0 = u.pn * BM + wc * 32 + 8 * fq; asm volatile("" : "+v"(row0));
#pragma unroll
        for (int ai = 0; ai < 2; ++ai) {
            uint2 gw[4][2];
#pragma unroll
            for (int m = 0; m < 4; ++m)
#pragma unroll
                for (int bj = 0; bj < 2; ++bj) gw[m][bj] = *(const uint2*)(G2 + (size_t)(row0 + ai * HALF + m * 16) * 1024 + col0 + bj * HALF);
            asm volatile("" ::: "memory");
#pragma unroll
            for (int m = 0; m < 4; ++m) { const size_t off = (size_t)(row0 + ai * HALF + m * 16) * 1024 + col0;
#pragma unroll
                for (int bj = 0; bj < 2; ++bj) { const uint2 g = gw[m][bj];
                    f32x4 v0 = acc[ai][bj][m][0], v1 = acc[ai][bj][m][1];
#pragma unroll
                    for (int e = 0; e < 4; ++e) { v0[e] *= (float)((g.x >> (8 * e)) & 255u) * (1.f / 255.f); v1[e] *= (float)((g.y >> (8 * e)) & 255u) * (1.f / 255.f); }
                    *(u32x4*)(MG + off + bj * HALF) = pack8(v0, v1); } }
            asm volatile("" ::: "memory"); }
    }
};

struct EpiResidB {
    static constexpr bool PERM = true, AFTER_DRAIN = false;
    bf16_t* XB; float* ss; float* out32;
    __device__ __forceinline__ void operator()(const f32x4 (&acc)[2][2][4][2], const Unit& u, int wr, int wc, int fr, int fq) const {
        int row0 = u.pm * BM + wr * 64 + fr; const int col0 = u.pn * BM + wc * 32 + 8 * fq; asm volatile("" : "+v"(row0));
        u32x4 xw[4][2];
#pragma unroll
        for (int m = 0; m < 4; ++m)
#pragma unroll
            for (int bj = 0; bj < 2; ++bj) xw[m][bj] = *(const u32x4*)(XB + (size_t)(row0 + m * 16) * 1024 + col0 + bj * HALF);
        asm volatile("" ::: "memory");
#pragma unroll
        for (int ai = 0; ai < 2; ++ai) {
#pragma unroll
            for (int m = 0; m < 4; ++m) { const int row = row0 + ai * HALF + m * 16; const size_t off = (size_t)row * 1024 + col0; float sq = 0.f;
                f32x4 rr[2][2];
#pragma unroll
                for (int bj = 0; bj < 2; ++bj) { const u32x4 w = xw[m][bj];
                    f32x4 r0 = acc[ai][bj][m][0], r1 = acc[ai][bj][m][1];
                    r0[0] += bflo(w.x); r0[1] += bfhi(w.x); r0[2] += bflo(w.y); r0[3] += bfhi(w.y); r1[0] += bflo(w.z); r1[1] += bfhi(w.z); r1[2] += bflo(w.w); r1[3] += bfhi(w.w);
                    rr[bj][0] = r0; rr[bj][1] = r1; }
                if (ai == 0) { asm volatile("" : "+v"(rr[0][0]), "+v"(rr[0][1]), "+v"(rr[1][0]), "+v"(rr[1][1]));
#pragma unroll
                    for (int bj = 0; bj < 2; ++bj) xw[m][bj] = *(const u32x4*)(XB + (size_t)(row0 + HALF + m * 16) * 1024 + col0 + bj * HALF); }
#pragma unroll
                for (int bj = 0; bj < 2; ++bj) { const f32x4 r0 = rr[bj][0], r1 = rr[bj][1];
                    if (out32) { *(f32x4*)(out32 + off + bj * HALF) = r0; *(f32x4*)(out32 + off + bj * HALF + 4) = r1; }
                    else { *(u32x4*)(XB + off + bj * HALF) = pack8(r0, r1); const f32x4 q = r0 * r0 + r1 * r1; sq += (q[0] + q[1]) + (q[2] + q[3]); } }
                if (!out32) { sq += shflx(sq, 16); sq += shflx(sq, 32); if (fq == 0) ss[(size_t)row * 16 + u.pn * 4 + wc] = sq; }
                asm volatile("" ::: "memory"); }
        }
    }
};

struct EpiSwiGLU {
    static constexpr bool PERM = true, AFTER_DRAIN = false;
    bf16_t* ACT; const float* ss; PG8_LAS float* rsl;
    mutable int rs_pm = -1;
    __device__ __forceinline__ void operator()(const f32x4 (&acc)[2][2][4][2], const Unit& u, int wr, int wc, int fr, int fq) const {
        int row0 = u.pm * BM + wr * 64 + fr; const int col0 = u.pn * HALF + wc * 32 + 8 * fq; asm volatile("" : "+v"(row0));
        const PG8_LAS float* rsw = unit_row_scales(ss, rsl, u, wr, wc, fr, fq, rs_pm) + fr;
#pragma unroll
        for (int ai = 0; ai < 2; ++ai)
#pragma unroll
            for (int m = 0; m < 4; ++m) { f32x4 o[2]; const float rs = rsw[ai * 64 + m * 16];
                typedef float f32x2 __attribute__((ext_vector_type(2)));
                const f32x2 rs2 = {rs, rs}, nrs2 = {rs * -1.4426950408889634f, rs * -1.4426950408889634f}, one2 = {1.f, 1.f};
#pragma unroll
                for (int n = 0; n < 2; ++n)
#pragma unroll
                    for (int h2 = 0; h2 < 2; ++h2) { const f32x4 g4 = acc[ai][0][m][n], u4 = acc[ai][1][m][n];
                        const f32x2 ga = {g4[2 * h2], g4[2 * h2 + 1]}, ua = {u4[2 * h2], u4[2 * h2 + 1]};
                        const f32x2 t = ga * nrs2; const f32x2 ex = {__builtin_amdgcn_exp2f(t[0]), __builtin_amdgcn_exp2f(t[1])};
                        const f32x2 dn = ex + one2; const f32x2 rc2 = {__builtin_amdgcn_rcpf(dn[0]), __builtin_amdgcn_rcpf(dn[1])};
                        const f32x2 r = ((ga * rs2) * (ua * rs2)) * rc2; o[n][2 * h2] = r[0]; o[n][2 * h2 + 1] = r[1]; }
                *(u32x4*)(ACT + (size_t)(row0 + ai * HALF + m * 16) * 2816 + col0) = pack8(o[0], o[1]); asm volatile("" ::: "memory"); }
    }
};

template <class Epi, class Sched, bool ALIGN_EPI = false, bool SP2 = false, bool MIDHOOK = false>
__device__ __forceinline__ void gemm_phase(PG8_LAS unsigned char* lds, const Gemm g, const Sched& S, const Epi& E) {
    int tid_ = wg_tid(); asm volatile("" : "+v"(tid_));
    const int tid = tid_, wid = __builtin_amdgcn_readfirstlane(tid >> 6), lane = tid & 63, wr = wid >> 2, wc = wid & 3, fr = lane & 15, fq = lane >> 4;
    const int K = g.K, nt = K / BK;
    unsigned voffA[2], voffB[2];
#pragma unroll
    for (int i = 0; i < 2; ++i) { int R, C; stage_rc(tid * 16 + i * 8192, R, C); const int Rb = Epi::PERM ? ((R & ~31) + perm32(R & 31)) : R;
        voffA[i] = (unsigned)(R * K + C) * 2u; voffB[i] = (unsigned)(Rb * K + C) * 2u; }
    const size_t kstep = (size_t)(BK * 2);
    const size_t hstep = (size_t)HALF * K * 2;
    const size_t tstep = 2 * hstep;
    const unsigned ldsw = (unsigned)wid * 1024u;
    const int aoff = lds_byte(wr * 64 + fr, fq * 8), boff = lds_byte(wc * 32 + fr, fq * 8);
#define PG8_SA(b, h) (((b) * 2 + (h)) * HTB)
#define PG8_SB(b, h) ((4 + (b) * 2 + (h)) * HTB)
#define PG8_STAGE(bufoff, gbase, voff) do { _Pragma("unroll") for (int _i = 0; _i < 2; ++_i) \
        __builtin_amdgcn_global_load_lds((const unsigned*)((const char*)(gbase) + (voff)[_i]), (PG8_LAS unsigned*)(lds + (bufoff) + ldsw + _i * 8192), 16, 0, 0); } while (0)
#define PG8_LDA(dst, b, h) do { _Pragma("unroll") for (int m = 0; m < 4; ++m) _Pragma("unroll") for (int k = 0; k < 2; ++k) dst[m][k] = *(const PG8_LAS bf16x8*)(lds + PG8_SA(b, h) + aoff + m * 2048 + k * 1024); } while (0)
#define PG8_LDB(dst, b, h) do { _Pragma("unroll") for (int n = 0; n < 2; ++n) _Pragma("unroll") for (int k = 0; k < 2; ++k) dst[n][k] = *(const PG8_LAS bf16x8*)(lds + PG8_SB(b, h) + boff + n * 2048 + k * 1024); } while (0)
#define PG8_MMA(ai, bj, At, Bt) do { __builtin_amdgcn_s_setprio(1); _Pragma("unroll") for (int m = 0; m < 4; ++m) _Pragma("unroll") for (int n = 0; n < 2; ++n) _Pragma("unroll") for (int k = 0; k < 2; ++k) \
        acc[ai][bj][m][n] = __builtin_amdgcn_mfma_f32_16x16x32_bf16(Bt[n][k], At[m][k], acc[ai][bj][m][n], 0, 0, 0); __builtin_amdgcn_s_setprio(0); } while (0)
#define PG8_WAIT_V(n) asm volatile("s_waitcnt vmcnt(" #n ")" ::: "memory")
#define PG8_WAIT_L(n) asm volatile("s_waitcnt lgkmcnt(" #n ")" ::: "memory")
#define PG8_BAR __builtin_amdgcn_s_barrier()
#define PG8_SCHED __builtin_amdgcn_sched_barrier(0)
    Unit cur, nxt; int ui = 0;
    if (!S.next(0, cur)) return;
    f32x4 acc[2][2][4][2];
#pragma unroll
    for (int a = 0; a < 2; ++a)
#pragma unroll
        for (int b = 0; b < 2; ++b)
#pragma unroll
            for (int m = 0; m < 4; ++m)
#pragma unroll
                for (int n = 0; n < 2; ++n) acc[a][b][m][n] = (f32x4){0.f, 0.f, 0.f, 0.f};
    bf16x8 At[4][2], B0[2][2], B1[2][2];
    const char* cA = (const char*)g.A + (size_t)cur.pm * tstep; const char* cB = (const char*)g.Bt + (size_t)cur.pn * tstep;
    S.a_ready(cur);
    if constexpr (SP2) {
        PG8_STAGE(PG8_SB(0, 0), cB, voffB); PG8_STAGE(PG8_SB(0, 1), cB + hstep, voffB); PG8_STAGE(PG8_SA(0, 0), cA, voffA); PG8_STAGE(PG8_SA(0, 1), cA + hstep, voffA);
        if (wr == 1) PG8_BAR;
        PG8_WAIT_V(2); PG8_BAR;
        PG8_STAGE(PG8_SB(1, 0), cB + kstep, voffB); PG8_STAGE(PG8_SA(1, 0), cA + kstep, voffA); PG8_STAGE(PG8_SB(1, 1), cB + hstep + kstep, voffB);
        PG8_WAIT_V(6); PG8_BAR;
    } else {
        PG8_STAGE(PG8_SB(0, 0), cB, voffB); PG8_STAGE(PG8_SA(0, 0), cA, voffA); PG8_STAGE(PG8_SB(0, 1), cB + hstep, voffB); PG8_STAGE(PG8_SA(0, 1), cA + hstep, voffA);
        if (wr == 1) PG8_BAR;
        PG8_WAIT_V(4); PG8_BAR;
        PG8_STAGE(PG8_SB(1, 0), cB + kstep, voffB); PG8_STAGE(PG8_SA(1, 0), cA + kstep, voffA); PG8_STAGE(PG8_SB(1, 1), cB + hstep + kstep, voffB);
        PG8_WAIT_V(6); PG8_BAR;
    }
    for (;;) {
        const bool has_next = S.next(ui + 1, nxt);
        const char* nA = has_next ? (const char*)g.A + (size_t)nxt.pm * tstep : cA; const char* nB = has_next ? (const char*)g.Bt + (size_t)nxt.pn * tstep : cB;
        for (int t = 0; t < nt; t += 2) {
            const bool last = (t == nt - 2);
            const char* a1 = cA + (size_t)(t + 1) * kstep;
            const char* a2 = last ? nA : cA + (size_t)(t + 2) * kstep; const char* b2 = last ? nB : cB + (size_t)(t + 2) * kstep;
            const char* a3 = a2 + kstep; const char* b3 = b2 + kstep;
            if (last && has_next) S.a_ready(nxt);
            if constexpr (SP2) {
            PG8_LDB(B0, 0, 0); PG8_LDB(B1, 0, 1); PG8_SCHED; PG8_LDA(At, 0, 0); PG8_STAGE(PG8_SA(1, 1), a1 + hstep, voffA);
            PG8_WAIT_V(8); PG8_WAIT_L(0); PG8_BAR; PG8_MMA(0, 0, At, B0); PG8_MMA(0, 1, At, B1); PG8_BAR; PG8_SCHED;
            PG8_LDA(At, 0, 1); PG8_STAGE(PG8_SB(0, 0), b2, voffB); PG8_STAGE(PG8_SB(0, 1), b2 + hstep, voffB); PG8_STAGE(PG8_SA(0, 0), a2, voffA);
            PG8_WAIT_V(8); PG8_WAIT_L(0); PG8_BAR; PG8_MMA(1, 0, At, B0); PG8_MMA(1, 1, At, B1); PG8_BAR; PG8_SCHED;
            PG8_LDB(B0, 1, 0); PG8_LDB(B1, 1, 1); PG8_SCHED; PG8_LDA(At, 1, 0); PG8_STAGE(PG8_SA(0, 1), a2 + hstep, voffA);
            PG8_WAIT_V(8); PG8_WAIT_L(0); PG8_BAR; PG8_MMA(0, 0, At, B0); PG8_MMA(0, 1, At, B1); PG8_BAR; PG8_SCHED;
            PG8_LDA(At, 1, 1); PG8_STAGE(PG8_SB(1, 0), b3, voffB); PG8_STAGE(PG8_SB(1, 1), b3 + hstep, voffB); PG8_STAGE(PG8_SA(1, 0), a3, voffA);
            PG8_WAIT_V(8); PG8_WAIT_L(0); PG8_BAR; PG8_MMA(1, 0, At, B0); PG8_MMA(1, 1, At, B1); PG8_BAR; PG8_SCHED;
            } else {
            PG8_LDB(B0, 0, 0); PG8_SCHED; PG8_LDA(At, 0, 0); PG8_STAGE(PG8_SA(1, 1), a1 + hstep, voffA);
            PG8_WAIT_L(8); PG8_BAR; PG8_WAIT_L(0); PG8_MMA(0, 0, At, B0); PG8_BAR; PG8_SCHED;
            PG8_LDB(B1, 0, 1); PG8_STAGE(PG8_SB(0, 0), b2, voffB);
            PG8_BAR; PG8_WAIT_L(0); PG8_MMA(0, 1, At, B1); PG8_BAR;
            PG8_LDA(At, 0, 1); PG8_STAGE(PG8_SA(0, 0), a2, voffA);
            PG8_BAR; PG8_WAIT_L(0); PG8_MMA(1, 0, At, B0); PG8_BAR; PG8_SCHED;
            PG8_STAGE(PG8_SB(0, 1), b2 + hstep, voffB);
            PG8_WAIT_V(6); PG8_BAR; PG8_MMA(1, 1, At, B1); PG8_BAR;
            PG8_LDB(B0, 1, 0); PG8_SCHED; PG8_LDA(At, 1, 0); PG8_STAGE(PG8_SA(0, 1), a2 + hstep, voffA);
            PG8_WAIT_L(8); PG8_BAR; PG8_WAIT_L(0); PG8_MMA(0, 0, At, B0); PG8_BAR; PG8_SCHED;
            PG8_LDB(B1, 1, 1); PG8_STAGE(PG8_SB(1, 0), b3, voffB);
            PG8_BAR; PG8_WAIT_L(0); PG8_MMA(0, 1, At, B1); PG8_BAR;
            PG8_LDA(At, 1, 1); PG8_STAGE(PG8_SA(1, 0), a3, voffA);
            PG8_BAR; PG8_WAIT_L(0); PG8_MMA(1, 0, At, B0); PG8_BAR; PG8_SCHED;
            PG8_STAGE(PG8_SB(1, 1), b3 + hstep, voffB);
            PG8_WAIT_V(6); PG8_BAR; PG8_MMA(1, 1, At, B1); PG8_BAR;
            }
            if constexpr (MIDHOOK) E.mid(acc, cur, t + 2, wr, wc, fr, fq);
        }
        if constexpr (ALIGN_EPI) { if (wr == 0) PG8_BAR; }
        if constexpr (!Epi::AFTER_DRAIN) { E(acc, cur, wr, wc, fr, fq); S.done(cur); }
        if (!has_next) break;
#pragma unroll
        for (int a = 0; a < 2; ++a)
#pragma unroll
            for (int b = 0; b < 2; ++b)
#pragma unroll
                for (int m = 0; m < 4; ++m)
#pragma unroll
                    for (int n = 0; n < 2; ++n) acc[a][b][m][n] = (f32x4){0.f, 0.f, 0.f, 0.f};
        cur = nxt; cA = nA; cB = nB; ++ui;
        if constexpr (ALIGN_EPI) { if (wr == 1) PG8_BAR; }
    }
    PG8_WAIT_V(0);
    if constexpr (!ALIGN_EPI) { if (wr == 0) PG8_BAR; }
    PG8_BAR;
    if constexpr (Epi::AFTER_DRAIN) { E.fused(acc, cur, wr, wc, fr, fq, lds, wid, lane); S.done(cur); }
#undef PG8_SA
#undef PG8_SB
#undef PG8_STAGE
#undef PG8_LDA
#undef PG8_LDB
#undef PG8_MMA
#undef PG8_WAIT_V
#undef PG8_WAIT_L
#undef PG8_BAR
#undef PG8_SCHED
}
}

constexpr int NWAVES = 8;
#ifndef MK_PER_PHASE
#define MK_PER_PHASE 0
#endif
#ifndef PG8_SP2
#define PG8_SP2 true
#endif
#ifndef PG8_ALIGN
#define PG8_ALIGN true
#endif

constexpr int BATCH = 8, SEQ = 4096, D = 1024, DEPTH = 4, M = BATCH * SEQ;
constexpr int NIN = 6144, DIN = 5956, FF = 2816, NF1 = 2 * FF;
constexpr int NPH = 9;
constexpr float EPS = 1e-6f, LOG2E = 1.4426950408889634f;

constexpr size_t MiB = 1u << 20;
constexpr size_t WS_CTL = 0, CTL_ZERO_BYTES = 1 * MiB;
constexpr size_t WS_ROPE = 1 * MiB;
constexpr size_t WS_SS = 494 * MiB;
constexpr size_t WS_W = 4 * MiB;
constexpr size_t WO_IN = 0, WO_BA = 12 * MiB, WO_BB = WO_BA + MiB / 2, WO_BC = WO_BB + MiB / 2, WO_OUT = WO_BC + MiB, WO_F1 = WO_OUT + 2 * MiB, WO_F2 = WO_F1 + 11 * MiB;
constexpr size_t WS_H = 40 * MiB;
constexpr size_t WS_YC = WS_H;
constexpr size_t WS_QA = 104 * MiB, WS_QB = 120 * MiB, WS_KA = 136 * MiB, WS_VA = 152 * MiB, WS_KB = 168 * MiB, WS_VB = 184 * MiB, WS_IQ = 200 * MiB;
constexpr size_t WS_MG = WS_KA;
constexpr size_t WS_IK = 216 * MiB, WS_IW = 220 * MiB;
constexpr size_t WS_CX = 222 * MiB, WS_CY = 254 * MiB;
constexpr size_t WS_GT = 286 * MiB;
constexpr size_t WS_ACT = WS_GT;
constexpr size_t WS_MASK = 478 * MiB;
constexpr size_t WS_END = 510 * MiB;
constexpr int CW_TMO = 0, CW_CODE = 1, CW_BAR = 4096;

constexpr int RING_OFF = 0, RING_BYTES = 131072;
constexpr int XTRA_OFF = RING_BYTES, XTRA_BYTES = 8192;
constexpr int LDSCTL_OFF = XTRA_OFF + XTRA_BYTES, MISC_OFF = LDSCTL_OFF + 320;
constexpr int LDS_BYTES = 147456;
static_assert(MISC_OFF + 128 <= LDS_BYTES, "LDS map");

#define GAS __attribute__((address_space(1)))
#define LAS __attribute__((address_space(3)))
typedef unsigned short bf16;
typedef unsigned v4u __attribute__((ext_vector_type(4)));
typedef float f32x4 __attribute__((ext_vector_type(4)));
typedef short bf16x8 __attribute__((ext_vector_type(8)));
typedef GAS unsigned gu32;
typedef unsigned long long u64;
#define RLX_AGENT __ATOMIC_RELAXED, __HIP_MEMORY_SCOPE_AGENT
#define LDS_WAIT() asm volatile("s_waitcnt lgkmcnt(0)" ::: "memory")
#define VM_WAIT() asm volatile("s_waitcnt vmcnt(0)" ::: "memory")
__device__ __forceinline__ unsigned f2bf(float f) { unsigned u = __builtin_bit_cast(unsigned, f); return (u + 0x7fffu + ((u >> 16) & 1u)) >> 16; }
__device__ __forceinline__ unsigned pk2(float lo, float hi) { return f2bf(lo) | (f2bf(hi) << 16); }
__device__ __forceinline__ float bf2f(bf16 v) { return __builtin_bit_cast(float, (unsigned)v << 16); }
__device__ __forceinline__ float bflo(unsigned w) { return __builtin_bit_cast(float, w << 16); }
__device__ __forceinline__ float bfhi(unsigned w) { return __builtin_bit_cast(float, w & 0xffff0000u); }
__device__ __forceinline__ float wave_sum(float v) {
#pragma unroll
    for (int o = 1; o < 64; o <<= 1) v += shflx(v, o);
    return v;
}
__device__ __forceinline__ float wave_max(float v) {
#pragma unroll
    for (int o = 1; o < 64; o <<= 1) v = fmaxf(v, shflx(v, o));
    return v;
}
#define XB_TMO      128
#define XB_XCNT(j)  (256  + 64 * (j))
#define XB_XSUB(j)  (1280 + 64 * (j))
#define XB_XGEN(j)  (2304 + 64 * (j))
#define XB_TOP      3328
#define XB_TOPGEN   3392
#define XCD_BAR_WORDS 3456
#define XB_SPIN_CAP (1u << 27)

__device__ __forceinline__ unsigned xb_ld(unsigned* p)              { return __hip_atomic_load(p, __ATOMIC_RELAXED, __HIP_MEMORY_SCOPE_AGENT); }
__device__ __forceinline__ unsigned xb_add(unsigned* p, unsigned v) { return __hip_atomic_fetch_add(p, v, __ATOMIC_RELAXED, __HIP_MEMORY_SCOPE_AGENT); }
__device__ __forceinline__ unsigned xb_xcc_id() { return (unsigned)__builtin_amdgcn_s_getreg((3 << 11) | 20) & 0xFu; }
#define XB_SPIN(cond, bar) do { unsigned _sp = 0; while (cond) { __builtin_amdgcn_s_sleep(1); \
    if ((++_sp & 255u) == 0u) { if (xb_ld(&(bar)[XB_TMO])) break; if (_sp > XB_SPIN_CAP) { atomicAdd(&(bar)[XB_TMO], 1u); break; } } } } while (0)

struct XcdBarrier {
    unsigned* bar; unsigned x;
    volatile LAS unsigned* st;
};

__device__ __forceinline__ XcdBarrier xcd_barrier_post(unsigned* bar, volatile LAS unsigned* st) {
    XcdBarrier b; b.bar = bar; b.x = xb_xcc_id(); b.st = st;
    if (wg_tid() == 0) (void)xb_add(&bar[XB_XCNT(b.x)], 1u);
    return b;
}
__device__ __forceinline__ void xcd_barrier_complete(unsigned* bar, unsigned x, unsigned& nloc, unsigned& nx) {
    const unsigned G = gridDim.x * gridDim.y * gridDim.z;
    unsigned sum, cnt, mine, sp = 0u;
    for (;;) {
        sum = 0u; cnt = 0u; mine = 0u;
#pragma unroll
        for (unsigned j = 0; j < 16; ++j) { const unsigned c = xb_ld(&bar[XB_XCNT(j)]); sum += c; cnt += (c > 0u) ? 1u : 0u; mine = (j == x) ? c : mine; }
        if (sum == G) break;
        __builtin_amdgcn_s_sleep(1);
        if ((++sp & 255u) == 0u) { if (xb_ld(&bar[XB_TMO])) break; if (sp > XB_SPIN_CAP) { atomicAdd(&bar[XB_TMO], 1u); break; } }
    }
    nloc = mine > 0u ? mine : 1u; nx = cnt > 0u ? cnt : 1u;
}

__device__ __forceinline__ void xcd_barrier(const XcdBarrier& b) {
    asm volatile("s_waitcnt vmcnt(0)" ::: "memory");
    __syncthreads();
    if (wg_tid() == 0) {
        unsigned* bar = b.bar;
        __builtin_amdgcn_s_waitcnt(0);
        unsigned nloc = b.st[0], nx = b.st[1];
        if (nloc == 0u) { xcd_barrier_complete(bar, b.x, nloc, nx); b.st[0] = nloc; b.st[1] = nx; }
        const unsigned old = xb_add(&bar[XB_XSUB(b.x)], 1u);
        const unsigned gen = old / nloc;
        if (old + 1u == (gen + 1u) * nloc) {
            __builtin_amdgcn_fence(__ATOMIC_RELEASE, "agent");
            asm volatile("s_waitcnt vmcnt(0)" ::: "memory");
            const unsigned og = xb_add(&bar[XB_TOP], 1u);
            const unsigned tg = og / nx;
            if (og + 1u == (tg + 1u) * nx) xb_add(&bar[XB_TOPGEN], 1u);
            else XB_SPIN(xb_ld(&bar[XB_TOPGEN]) == tg, bar);
            __builtin_amdgcn_fence(__ATOMIC_ACQUIRE, "agent");
            xb_add(&bar[XB_XGEN(b.x)], 1u);
            asm volatile("s_waitcnt vmcnt(0)" ::: "memory");
        } else {
            XB_SPIN(xb_ld(&bar[XB_XGEN(b.x)]) == gen, bar);
            __builtin_amdgcn_fence(__ATOMIC_ACQUIRE, "agent");
            asm volatile("s_waitcnt vmcnt(0)" ::: "memory");
        }
    }
    __syncthreads();
}

struct Frame {
    LAS unsigned char* lds;
    volatile LAS unsigned* MISC;
    gu32* ctl;
    int tid, lane, wave, G;
    const float* x; float* out;
    const float *g_mix, *w_in, *qk_gain_a, *rel_bias, *qk_gain_b, *g_idx_k, *conv_w, *conv_b, *lru_wa, *lru_ba, *lru_wx, *lru_bx, *lru_lambda, *b_gate, *w_branch, *w_out, *g_ffn, *w_ffn_in, *w_ffn_out;
    float *rcos, *rsin, *SS;
    bf16 *W, *H, *YC, *YCAT, *QA, *QB, *KA, *VA, *KB, *VB, *IQ, *IK, *CX, *CY, *GT, *ACT, *MG; float* IW; u64* MASK;
    bf16 *W2a, *W2b;
};
struct WSet { bf16 *in, *ba, *out, *f1, *f2; };
__device__ __forceinline__ WSet wset(const Frame& F, int l) {
    WSet w;
    if (l & 1) { w.in = F.W + WO_IN / 2; w.ba = F.W + WO_BA / 2; w.out = F.W + WO_OUT / 2; w.f1 = F.W + WO_F1 / 2; w.f2 = F.W + WO_F2 / 2; }
    else { w.in = F.W2a; w.ba = F.W2a + (12 * MiB) / 2; w.out = F.W2a + (14 * MiB) / 2; w.f1 = F.W2b; w.f2 = F.W2b + (11 * MiB) / 2; }
    return w;
}

__device__ __forceinline__ void cvt_item(const float* W, int ldw, int k0, int n_src0, int nvalid, bf16* WT, int dpitch, int drow0, LAS float* scr, int lane, const float* gk = nullptr, bool s16 = false) {
    { const int col4 = (lane & 7) * 4; f32x4 v[8];
#pragma unroll
      for (int i = 0; i < 8; ++i) { const int kk = 8 * i + (lane >> 3); v[i] = (col4 < nvalid) ? *(const GAS f32x4*)(W + (size_t)(k0 + kk) * ldw + n_src0 + (s16 ? 16 * (col4 >> 3) + (col4 & 7) : col4)) : (f32x4){0.f, 0.f, 0.f, 0.f}; }
#pragma unroll
      for (int i = 0; i < 8; ++i) { const int kk = 8 * i + (lane >> 3); LAS float* d = scr + kk * 33 + col4; const float gg = gk ? gk[k0 + kk] : 1.f; d[0] = v[i].x * gg; d[1] = v[i].y * gg; d[2] = v[i].z * gg; d[3] = v[i].w * gg; } }
    LDS_WAIT(); asm volatile("" ::: "memory");
    const int c = lane & 7;
#pragma unroll
    for (int j = 0; j < 4; ++j) { const int n = (lane >> 3) + 8 * j; const LAS float* s = scr + (8 * c) * 33 + n;
        v4u o; o.x = pk2(s[0 * 33], s[1 * 33]); o.y = pk2(s[2 * 33], s[3 * 33]); o.z = pk2(s[4 * 33], s[5 * 33]); o.w = pk2(s[6 * 33], s[7 * 33]);
        *(GAS v4u*)(WT + (size_t)(drow0 + n) * dpitch + k0 + 8 * c) = o; }
    LDS_WAIT(); asm volatile("" ::: "memory");
}
__device__ __forceinline__ void phase_xb0(Frame& F, const float* xin, float* ss) {
    const int gw = blockIdx.x * NWAVES + F.wave, NGW = F.G * NWAVES;
    for (int m = gw; m < M; m += NGW) { const GAS f32x4* xr = (const GAS f32x4*)(xin + (size_t)m * D) + F.lane; f32x4 v[4]; float s = 0.f;
#pragma unroll
        for (int j = 0; j < 4; ++j) { v[j] = xr[64 * j]; s += (v[j].x * v[j].x + v[j].y * v[j].y) + (v[j].z * v[j].z + v[j].w * v[j].w); }
        s = wave_sum(s); if (F.lane < 16) ss[(size_t)m * 16 + F.lane] = (F.lane == 0) ? s : 0.f;
        GAS u64* o8 = (GAS u64*)(F.H + (size_t)m * D) + F.lane;
#pragma unroll
        for (int j = 0; j < 4; ++j) o8[64 * j] = (u64)pk2(v[j].x, v[j].y) | ((u64)pk2(v[j].z, v[j].w) << 32); }
}
__device__ __forceinline__ void phase_weights(Frame& F, int l, unsigned* queue = nullptr) {
    LAS float* scr = (LAS float*)(F.lds + RING_OFF + F.wave * 16384);
    const int gw = blockIdx.x * NWAVES + F.wave, NGW = F.G * NWAVES;
    const float* w_in = F.w_in + (size_t)l * D * DIN; const float* w_br = F.w_branch + (size_t)l * D * D; const float* w_out = F.w_out + (size_t)l * D * D;
    const float* w_f1 = F.w_ffn_in + (size_t)l * D * NF1; const float* w_f2 = F.w_ffn_out + (size_t)l * FF * D;
    const WSet WS = wset(F, l);
    constexpr int I_IN = 16 * 192, I_BA = 4 * 32, I_BB = 4 * 32, I_BC = 8 * 32, I_OUT = 16 * 32, I_F1 = 16 * 176, I_F2 = 44 * 32;
    constexpr int NITEMS = I_IN + I_BA + I_BB + I_BC + I_OUT + I_F1 + I_F2;
    for (int it0 = gw;; it0 += NGW) {
        int it = it0;
        if (queue) { unsigned v = 0u; if (F.lane == 0) v = __hip_atomic_fetch_add(queue, 1u, __ATOMIC_RELAXED, __HIP_MEMORY_SCOPE_AGENT); it = __builtin_amdgcn_readfirstlane((int)v); }
        if (it >= NITEMS) break;
        int r = it;
        if (r < I_IN) { const int kb = r / 192, ng = r % 192, pn = ng >> 3, grp = ng & 7, bj = grp >> 2, hh = grp & 3; int src = 0, nv = 32;
            if (pn < 7) src = pn * 256 + 64 * hh + 32 * bj;
            else if (pn == 7) { if (hh == 0) src = 1792 + 32 * bj; else if (grp == 1) { src = 1856; nv = 4; } else nv = 0; }
            else if (pn < 12) src = 1860 + (pn - 8) * 256 + grp * 32;
            else src = 2884 + (pn - 12) * 256 + 64 * hh + 8 * bj;
            cvt_item(w_in, DIN, kb * 64, src, nv, WS.in, D, ng * 32, scr, F.lane, F.g_mix + l * D, pn >= 12); continue; } r -= I_IN;
        if (r < I_BA + I_BB + I_BC) { const int kb = r / 32, ng = r % 32; cvt_item(w_br, D, kb * 64, ng * 32, 32, WS.ba, D, ng * 32, scr, F.lane); continue; } r -= I_BA + I_BB + I_BC;
        if (r < I_OUT) { const int kb = r / 32, ng = r % 32; cvt_item(w_out, D, kb * 64, ng * 32, 32, WS.out, D, ng * 32, scr, F.lane); continue; } r -= I_OUT;
        if (r < I_F1) { const int kb = r / 176, ng = r % 176, pn = ng >> 3, grp = ng & 7, bj = grp >> 2; const int src = FF * bj + 128 * pn + (grp & 3) * 32;
            cvt_item(w_f1, NF1, kb * 64, src, 32, WS.f1, D, ng * 32, scr, F.lane, F.g_ffn + l * D); continue; } r -= I_F1;
        { const int kb = r / 32, ng = r % 32; cvt_item(w_f2, D, kb * 64, ng * 32, 32, WS.f2, FF, ng * 32, scr, F.lane); }
    }
    if (l == 0) {
        for (int i = blockIdx.x * 512 + F.tid; i < SEQ * 32; i += F.G * 512) { const int pos = i >> 5, k = i & 31;
            const float inv = exp2f(-(float)k * 0.41524101186092029f); const float ang = (float)pos * inv;
            F.rcos[i] = cosf(ang); F.rsin[i] = sinf(ang); }
    }
}

__device__ __forceinline__ void naive_attn_a(Frame& F, int l) {
    LAS float* bias_s = (LAS float*)F.lds;
    LAS float* qs = (LAS float*)F.lds + 320 + F.wave * 640;
    LAS float* ps = qs + 64;
    const int lane = F.lane;
    for (int u = blockIdx.x; u < BATCH * 4 * 64; u += F.G) {
        const int c = u & 63, h = (u >> 6) & 3, b = u >> 8;
        __syncthreads();
        for (int i = F.tid; i < 257; i += 512) bias_s[i] = F.rel_bias[(l * 4 + h) * 257 + i] * LOG2E;
        __syncthreads();
        const int kc0 = (c - 8 > 0) ? c - 8 : 0; const int nk = (c - kc0 + 1) * 64;
        for (int qi = 0; qi < 8; ++qi) {
            const int t = c * 64 + F.wave * 8 + qi; const size_t row = (size_t)b * SEQ + t;
            qs[lane] = bf2f(F.QA[row * 256 + h * 64 + lane]);
            LDS_WAIT();
            float s[9]; float mx = -INFINITY;
#pragma unroll
            for (int jj = 0; jj < 9; ++jj) { const int j = jj * 64 + lane; s[jj] = -INFINITY;
                if (j < nk) { const size_t krow = (size_t)b * SEQ + kc0 * 64 + j; const v4u* kp = (const v4u*)(F.KA + krow * 256 + h * 64); float dot = 0.f;
#pragma unroll
                    for (int i8 = 0; i8 < 8; ++i8) { const v4u kw = kp[i8]; const LAS float* q = qs + i8 * 8;
                        dot += q[0] * bflo(kw.x) + q[1] * bfhi(kw.x) + q[2] * bflo(kw.y) + q[3] * bfhi(kw.y) + q[4] * bflo(kw.z) + q[5] * bfhi(kw.z) + q[6] * bflo(kw.w) + q[7] * bfhi(kw.w); }
                    int rel = t - (kc0 * 64 + j); rel = rel < -128 ? -128 : (rel > 128 ? 128 : rel);
                    s[jj] = dot + bias_s[rel + 128]; }
                mx = fmaxf(mx, s[jj]); }
            mx = wave_max(mx); float sum = 0.f;
#pragma unroll
            for (int jj = 0; jj < 9; ++jj) { const int j = jj * 64 + lane; if (j < nk) { const float p = exp2f(s[jj] - mx); sum += p; ps[j] = p; } }
            sum = wave_sum(sum);
            LDS_WAIT();
            float o = 0.f; const bf16* vp = F.VA + ((size_t)b * SEQ + kc0 * 64) * 256 + h * 64 + lane;
            for (int j = 0; j < nk; ++j) o += ps[j] * bf2f(vp[(size_t)j * 256]);
            F.QA[row * 256 + h * 64 + lane] = (bf16)f2bf(o / sum);
            LDS_WAIT();
        }
    }
}
__device__ __forceinline__ unsigned fkey(float f) { const unsigned u = __builtin_bit_cast(unsigned, f); return (u & 0x80000000u) ? ~u : (u | 0x80000000u); }
__device__ __forceinline__ void naive_idx(Frame& F) {
    LAS float* sc = (LAS float*)F.lds + F.wave * 4096;
    LAS float* qs = (LAS float*)(F.lds + XTRA_OFF) + F.wave * 256;
    const int lane = F.lane;
    for (int u = blockIdx.x; u < BATCH * 512; u += F.G) {
        const int b = u >> 9, t = (u & 511) * 8 + F.wave; const size_t row = (size_t)b * SEQ + t; const int nw = (t >> 6) + 1;
        { const unsigned* qp = (const unsigned*)(F.IQ + row * 256) + lane * 2; const unsigned w0 = qp[0], w1 = qp[1];
          qs[4 * lane] = bflo(w0); qs[4 * lane + 1] = bfhi(w0); qs[4 * lane + 2] = bflo(w1); qs[4 * lane + 3] = bfhi(w1); }
        const f32x4 wv = *(const f32x4*)(F.IW + row * 4);
        LDS_WAIT();
        for (int jj = 0; jj < nw; ++jj) { const int j = jj * 64 + lane; const v4u* kp = (const v4u*)(F.IK + ((size_t)b * SEQ + j) * 64);
            float d0 = 0.f, d1 = 0.f, d2 = 0.f, d3 = 0.f;
#pragma unroll
            for (int i8 = 0; i8 < 8; ++i8) { const v4u kw = kp[i8]; float kf[8] = {bflo(kw.x), bfhi(kw.x), bflo(kw.y), bfhi(kw.y), bflo(kw.z), bfhi(kw.z), bflo(kw.w), bfhi(kw.w)};
#pragma unroll
                for (int e = 0; e < 8; ++e) { const int d = i8 * 8 + e; d0 += qs[d] * kf[e]; d1 += qs[64 + d] * kf[e]; d2 += qs[128 + d] * kf[e]; d3 += qs[192 + d] * kf[e]; } }
            float s = 0.f; s += wv[0] * fmaxf(d0, 0.f); s += wv[1] * fmaxf(d1, 0.f); s += wv[2] * fmaxf(d2, 0.f); s += wv[3] * fmaxf(d3, 0.f); s += 0.0f;
            sc[j] = s; }
        LDS_WAIT();
        u64* mrow = F.MASK + row * 64;
        if (nw <= 4) { if (lane < nw) { unsigned o1 = ~0u, o2 = ~0u; asm volatile("" : "+v"(o1), "+v"(o2)); ((unsigned*)mrow)[2 * lane] = o1; ((unsigned*)mrow)[2 * lane + 1] = o2; } }
        else {
            unsigned prefix = 0u;
            for (int bit = 31; bit >= 0; --bit) { const unsigned cand = prefix | (1u << bit); int cnt = 0;
                for (int jj = 0; jj < nw; ++jj) cnt += __popcll(__ballot(fkey(sc[jj * 64 + lane]) >= cand));
                if (cnt >= 256) prefix = cand; }
            int n_gt = 0;
            for (int jj = 0; jj < nw; ++jj) n_gt += __popcll(__ballot(fkey(sc[jj * 64 + lane]) > prefix));
            const int allowed = 256 - n_gt; int running = 0; const u64 lt = (1ull << lane) - 1ull;
            for (int jj = 0; jj < nw; ++jj) { const unsigned key = fkey(sc[jj * 64 + lane]); const bool gt = key > prefix, eq = key == prefix; const u64 eqb = __ballot(eq);
                const int rank = running + __popcll(eqb & lt); const bool sel = gt || (eq && rank < allowed); running += __popcll(eqb);
                const u64 w = __ballot(sel); if (lane == 0) mrow[jj] = w; }
        }
        LDS_WAIT();
    }
}
__device__ __forceinline__ void naive_sparse(Frame& F) {
    LAS int* list = (LAS int*)F.lds + F.wave * 256;
    LAS float* ps = (LAS float*)F.lds + 2048 + F.wave * 256;
    LAS float* qs = (LAS float*)F.lds + 4096 + F.wave * 64;
    const int lane = F.lane; const u64 lt = (1ull << lane) - 1ull;
    for (int u = blockIdx.x; u < BATCH * 512; u += F.G) {
        const int b = u >> 9, t = (u & 511) * 8 + F.wave; const size_t row = (size_t)b * SEQ + t; const int nw = (t >> 6) + 1;
        int running = 0;
        for (int jj = 0; jj < nw; ++jj) { const u64 w = F.MASK[row * 64 + jj]; if ((w >> lane) & 1ull) list[running + __popcll(w & lt)] = jj * 64 + lane; running += __popcll(w); }
        const int nsel = running < 256 ? running : 256;
        LDS_WAIT();
        for (int h = 0; h < 4; ++h) {
            qs[lane] = bf2f(F.QB[row * 256 + h * 64 + lane]);
            LDS_WAIT();
            float s[4]; float mx = -INFINITY;
#pragma unroll
            for (int e = 0; e < 4; ++e) { const int idx = e * 64 + lane; s[e] = -INFINITY;
                if (idx < nsel) { const int j = list[idx]; const v4u* kp = (const v4u*)(F.KB + ((size_t)b * SEQ + j) * 256 + h * 64); float dot = 0.f;
#pragma unroll
                    for (int i8 = 0; i8 < 8; ++i8) { const v4u kw = kp[i8]; const LAS float* q = qs + i8 * 8;
                        dot += q[0] * bflo(kw.x) + q[1] * bfhi(kw.x) + q[2] * bflo(kw.y) + q[3] * bfhi(kw.y) + q[4] * bflo(kw.z) + q[5] * bfhi(kw.z) + q[6] * bflo(kw.w) + q[7] * bfhi(kw.w); }
                    s[e] = dot; }
                mx = fmaxf(mx, s[e]); }
            mx = wave_max(mx); float sum = 0.f;
#pragma unroll
            for (int e = 0; e < 4; ++e) { const int idx = e * 64 + lane; if (idx < nsel) { const float p = exp2f(s[e] - mx); sum += p; ps[idx] = p; } }
            sum = wave_sum(sum);
            LDS_WAIT();
            float o = 0.f;
            for (int i = 0; i < nsel; ++i) o += ps[i] * bf2f(F.VB[((size_t)b * SEQ + list[i]) * 256 + h * 64 + lane]);
            F.QB[row * 256 + h * 64 + lane] = (bf16)f2bf(o / sum);
            LDS_WAIT();
        }
    }
}
__device__ __forceinline__ float gelu_tanh(float x) { return 0.5f * x * (1.f + tanhf(0.7978845608028654f * (x + 0.044715f * x * x * x))); }
__device__ __forceinline__ void naive_lru(Frame& F, int l) {
    LAS float* wa_s = (LAS float*)F.lds; LAS float* wx_s = wa_s + 4096; LAS float* us = wx_s + 4096; LAS float* as = us + 64 * 65; LAS float* gs = as + 4096;
    const int tid = F.tid, lane = F.lane;
    for (int u = blockIdx.x; u < 64; u += F.G) {
        const int b = u >> 3, g = u & 7;
        __syncthreads();
        for (int i = tid; i < 4096; i += 512) { wa_s[i] = F.lru_wa[(size_t)(l * 8 + g) * 4096 + i]; wx_s[i] = F.lru_wx[(size_t)(l * 8 + g) * 4096 + i]; }
        float h = 0.f;
        for (int tile = 0; tile < 64; ++tile) {
            __syncthreads();
            { const int tok = tid >> 3, t = tile * 64 + tok;
#pragma unroll
              for (int e = 0; e < 8; ++e) { const int ch = (tid & 7) * 8 + e, cg = g * 64 + ch; float acc = F.conv_b[l * 512 + cg];
#pragma unroll
                  for (int j = 0; j < 4; ++j) { const int tt = t - 3 + j; if (tt >= 0) acc += F.conv_w[(l * 4 + j) * 512 + cg] * bf2f(F.CX[((size_t)b * SEQ + tt) * 512 + cg]); }
                  us[tok * 65 + ch] = acc; } }
            __syncthreads();
            { const int tok = tid & 63, og = tid >> 6;
              for (int o = 0; o < 8; ++o) { const int cc = 8 * og + o, cg = g * 64 + cc; float ra = 0.f, rx = 0.f;
                  for (int k = 0; k < 64; ++k) { const float uv = us[tok * 65 + k]; ra += uv * wa_s[k * 64 + cc]; rx += uv * wx_s[k * 64 + cc]; }
                  const float r = 1.f / (1.f + expf(-(ra + F.lru_ba[l * 512 + cg]))), ig = 1.f / (1.f + expf(-(rx + F.lru_bx[l * 512 + cg])));
                  const float sp = log1pf(expf(-F.lru_lambda[l * 512 + cg])); const float log_a = -8.0f * r * sp;
                  as[tok * 64 + cc] = expf(log_a); gs[tok * 64 + cc] = sqrtf(-expm1f(2.f * log_a)) * (ig * us[tok * 65 + cc]); } }
            __syncthreads();
            if (F.wave == 0) {
                for (int tok = 0; tok < 64; ++tok) { h = as[tok * 64 + lane] * h + gs[tok * 64 + lane]; const size_t row = (size_t)b * SEQ + tile * 64 + tok;
                    const float cy = bf2f(F.CY[row * 512 + g * 64 + lane]); F.YC[row * 512 + g * 64 + lane] = (bf16)f2bf(h * gelu_tanh(cy)); }
            }
        }
    }
}


typedef float f32x16 __attribute__((ext_vector_type(16)));
typedef short s16x4 __attribute__((ext_vector_type(4)));
typedef float f32x2v __attribute__((ext_vector_type(2)));
typedef __bf16 bf16x2v __attribute__((ext_vector_type(2)));
__device__ __forceinline__ unsigned cvtpk(float lo, float hi) { const f32x2v v = {lo, hi}; const bf16x2v b = __builtin_convertvector(v, bf16x2v); return __builtin_bit_cast(unsigned, b); }
__device__ __forceinline__ int crow(int r, int hi) { return (r & 3) + 8 * (r >> 2) + 4 * hi; }
__device__ __forceinline__ s16x4 vtr(const LAS unsigned char* p) { return __builtin_bit_cast(s16x4, __builtin_amdgcn_ds_read_tr16_b64_v4i16((LAS s16x4*)p)); }

template <int MODE> __device__ __forceinline__ void flash_wave(int b, int h, int qblk, const bf16* Q, const bf16* K, const bf16* V, bf16* Y, LAS unsigned char* vl, const LAS float* bias_s, const u64* MASK, int lane) {
    asm volatile("" : "+v"(lane));
    const int r32 = lane & 31, hi = lane >> 5; const size_t row0 = (size_t)b * SEQ + (size_t)qblk * 32; const int c = qblk >> 1;
    bf16x8 qr[4];
#pragma unroll
    for (int d0 = 0; d0 < 4; ++d0) qr[d0] = *(const bf16x8*)(Q + (row0 + r32) * 256 + h * 64 + d0 * 16 + hi * 8);
    const int kb_lo = (MODE == 0) ? ((c > 8 ? c - 8 : 0) * 2) : 0, kb_hi = (c + 1) * 2;
    f32x16 o0, o1;
#pragma unroll
    for (int r = 0; r < 16; ++r) { o0[r] = 0.f; o1[r] = 0.f; }
    float m = -1e30f, lsum = 0.f; const int tq = qblk * 32 + r32;
    const LAS unsigned char* vrd = vl + ((lane >> 4) & 1) * 32 + (lane & 3) * 8 + (4 * hi + ((lane & 15) >> 2)) * 64;
    unsigned mword = 0, mnext = 0;
    const unsigned* M32 = (const unsigned*)MASK + (size_t)(b * 64 + c) * (128 * 64) + (qblk & 1) * 32 + r32;
    const bf16* Kt = K + ((size_t)b * 128 * 4 + h) * 2048 + lane * 8;
    bf16x8 kfn[4]; v4u vvn[4];
    { const size_t krow0 = (size_t)b * SEQ + (size_t)kb_lo * 32;
#pragma unroll
      for (int d0 = 0; d0 < 4; ++d0) kfn[d0] = *(const bf16x8*)(Kt + (size_t)kb_lo * 8192 + d0 * 512);
#pragma unroll
      for (int i = 0; i < 4; ++i) { const int c16 = i * 64 + lane, key = c16 >> 3, dch = c16 & 7; vvn[i] = *(const v4u*)(V + (krow0 + key) * 256 + h * 64 + dch * 8); }
      if (MODE == 1) mnext = M32[kb_lo * 64]; }
    for (int kb = kb_lo; kb < kb_hi; ++kb) {
        bf16x8 kf[4]; v4u vv[4];
#pragma unroll
        for (int d0 = 0; d0 < 4; ++d0) kf[d0] = kfn[d0];
#pragma unroll
        for (int i = 0; i < 4; ++i) vv[i] = vvn[i];
        if (MODE == 1) mword = mnext;
        if (kb + 1 < kb_hi) { const size_t krow1 = (size_t)b * SEQ + (size_t)(kb + 1) * 32;
#pragma unroll
            for (int d0 = 0; d0 < 4; ++d0) kfn[d0] = *(const bf16x8*)(Kt + (size_t)(kb + 1) * 8192 + d0 * 512);
#pragma unroll
            for (int i = 0; i < 4; ++i) { const int c16 = i * 64 + lane, key = c16 >> 3, dch = c16 & 7; vvn[i] = *(const v4u*)(V + (krow1 + key) * 256 + h * 64 + dch * 8); }
            if (MODE == 1) mnext = M32[(kb + 1) * 64]; }
#pragma unroll
        for (int i = 0; i < 4; ++i) { const int c16 = i * 64 + lane, key = c16 >> 3, dch = c16 & 7; *(LAS v4u*)(vl + (dch >> 2) * 2048 + (key >> 4) * 1024 + (key & 15) * 64 + (dch & 3) * 16) = vv[i]; }
        f32x16 p;
#pragma unroll
        for (int r = 0; r < 16; ++r) p[r] = 0.f;
#pragma unroll
        for (int d0 = 0; d0 < 4; ++d0) p = __builtin_amdgcn_mfma_f32_32x32x16_bf16(kf[d0], qr[d0], p, 0, 0, 0);
        if (MODE == 0) {
#pragma unroll
            for (int r = 0; r < 16; ++r) { int rel = tq - (kb * 32 + crow(r, hi)); rel = rel < -128 ? -128 : (rel > 128 ? 128 : rel); p[r] += bias_s[rel + 128]; }
        } else {
            const unsigned bits = mword >> (4 * hi);
#pragma unroll
            for (int r = 0; r < 16; ++r) p[r] = ((bits >> ((r & 3) + 8 * (r >> 2))) & 1u) ? p[r] : -INFINITY;
        }
        float bm = p[0];
#pragma unroll
        for (int r = 1; r < 16; ++r) bm = fmaxf(bm, p[r]);
        bm = fmaxf(bm, shflx(bm, 32));
        const float mn = fmaxf(m, bm), alpha = exp2f(m - mn); m = mn;
        float rs = 0.f;
#pragma unroll
        for (int r = 0; r < 16; ++r) { p[r] = exp2f(p[r] - mn); rs += p[r]; }
        lsum = lsum * alpha + rs;
#pragma unroll
        for (int r = 0; r < 16; ++r) { o0[r] *= alpha; o1[r] *= alpha; }
        bf16x8 pa[2];
#pragma unroll
        for (int s = 0; s < 2; ++s) { v4u w; w.x = cvtpk(p[8 * s], p[8 * s + 1]); w.y = cvtpk(p[8 * s + 2], p[8 * s + 3]); w.z = cvtpk(p[8 * s + 4], p[8 * s + 5]); w.w = cvtpk(p[8 * s + 6], p[8 * s + 7]); pa[s] = __builtin_bit_cast(bf16x8, w); }
#pragma unroll
        for (int s = 0; s < 2; ++s) {
            const s16x4 a_lo = vtr(vrd + s * 1024), a_hi = vtr(vrd + s * 1024 + 512), b_lo = vtr(vrd + 2048 + s * 1024), b_hi = vtr(vrd + 2048 + s * 1024 + 512);
            const bf16x8 va = {a_lo[0], a_lo[1], a_lo[2], a_lo[3], a_hi[0], a_hi[1], a_hi[2], a_hi[3]}, vb = {b_lo[0], b_lo[1], b_lo[2], b_lo[3], b_hi[0], b_hi[1], b_hi[2], b_hi[3]};
            o0 = __builtin_amdgcn_mfma_f32_32x32x16_bf16(va, pa[s], o0, 0, 0, 0); o1 = __builtin_amdgcn_mfma_f32_32x32x16_bf16(vb, pa[s], o1, 0, 0, 0);
        }
    }
    lsum += shflx(lsum, 32); const float inv = 1.f / lsum;
    bf16* yrow = Y + (row0 + r32) * 1024 + h * 64 + 4 * hi;
#pragma unroll
    for (int g4 = 0; g4 < 4; ++g4) {
        uint2 w0, w1; w0.x = cvtpk(o0[4 * g4] * inv, o0[4 * g4 + 1] * inv); w0.y = cvtpk(o0[4 * g4 + 2] * inv, o0[4 * g4 + 3] * inv); w1.x = cvtpk(o1[4 * g4] * inv, o1[4 * g4 + 1] * inv); w1.y = cvtpk(o1[4 * g4 + 2] * inv, o1[4 * g4 + 3] * inv);
        *(uint2*)(yrow + 8 * g4) = w0; *(uint2*)(yrow + 32 + 8 * g4) = w1; }
}

template <int MODE, bool FIXM, bool SPLIT = false> __device__ __forceinline__ void flash_wave2(int b, int h, int c, const bf16* Q, const bf16* K, const bf16* V, bf16* Y, LAS unsigned char* vl, const LAS float* bias_s, const u64* MASK, int lane, float mfix,
        int kb0 = -1, int kb1 = -1, int part = 0, LAS float* cmb = nullptr) {
    asm volatile("" : "+v"(lane));
    const int r32 = lane & 31, hi = lane >> 5; const size_t row0 = (size_t)b * SEQ + (size_t)c * 64;
    bf16x8 qr[2][4];
#pragma unroll
    for (int z = 0; z < 2; ++z)
#pragma unroll
        for (int d0 = 0; d0 < 4; ++d0) qr[z][d0] = *(const bf16x8*)(Q + (row0 + 32 * z + r32) * 256 + h * 64 + d0 * 16 + hi * 8);
    const int kb_lo = SPLIT ? kb0 : ((MODE == 0) ? ((c > 8 ? c - 8 : 0) * 2) : 0), kb_hi = SPLIT ? kb1 : (c + 1) * 2;
    f32x16 o[2][2];
#pragma unroll
    for (int z = 0; z < 2; ++z)
#pragma unroll
        for (int r = 0; r < 16; ++r) { o[z][0][r] = 0.f; o[z][1][r] = 0.f; }
    float m[2] = {-1e30f, -1e30f}, lsum[2] = {0.f, 0.f};
    const LAS unsigned char* vrd = vl + ((lane >> 4) & 1) * 32 + (lane & 3) * 8 + (4 * hi + ((lane & 15) >> 2)) * 64;
    unsigned mword[2] = {0, 0}, mnext[2] = {0, 0};
    constexpr int KSTEP = SPLIT ? 2 : 1;
    const unsigned* M32 = (const unsigned*)MASK + (size_t)(b * 64 + c) * (128 * 64) + r32;
    const bf16* Kt = K + ((size_t)b * 128 * 4 + h) * 2048 + lane * 8;
    const char* Kc = (const char*)K + ((size_t)b * 512 + h) * 4096; const unsigned kvo = (unsigned)lane * 16u;
    const char* Vc = (const char*)V + (size_t)h * 128; const unsigned vvo = (unsigned)(lane >> 3) * 512u + (unsigned)(lane & 7) * 16u;
    if (MODE == 1) { mword[0] = M32[kb_lo * 64]; mword[1] = M32[kb_lo * 64 + 32]; }
    const int kb_last = kb_lo + ((kb_hi - 1 - kb_lo) / KSTEP) * KSTEP;
    bf16x8 kfn[4];
#pragma unroll
    for (int d0 = 0; d0 < 4; ++d0) kfn[d0] = *(const bf16x8*)(Kc + (size_t)kb_lo * 16384 + kvo + d0 * 1024);
    for (int kb = kb_lo; kb < kb_hi; kb += KSTEP) {
        bf16x8 kf[4]; v4u vv[4];
#pragma unroll
        for (int d0 = 0; d0 < 4; ++d0) kf[d0] = kfn[d0];
        const bool mfetch = (MODE == 1) && kb + KSTEP < kb_hi;
        if (mfetch) { mnext[0] = M32[(kb + KSTEP) * 64]; mnext[1] = M32[(kb + KSTEP) * 64 + 32]; }
        { const int k1 = kb + KSTEP <= kb_last ? kb + KSTEP : kb_last;
          const size_t krowc = (size_t)b * SEQ + (size_t)kb * 32;
#pragma unroll
          for (int i = 0; i < 4; ++i) vv[i] = *(const v4u*)(Vc + krowc * 512 + (size_t)i * 4096 + vvo);
#pragma unroll
          for (int d0 = 0; d0 < 4; ++d0) kfn[d0] = *(const bf16x8*)(Kc + (size_t)k1 * 16384 + kvo + d0 * 1024); }
        bf16x8 pa[2][2];
#pragma unroll
        for (int z = 0; z < 2; ++z) {
            f32x16 p;
#pragma unroll
            for (int r = 0; r < 16; ++r) p[r] = FIXM ? -mfix : 0.f;
#pragma unroll
            for (int d0 = 0; d0 < 4; ++d0) p = __builtin_amdgcn_mfma_f32_32x32x16_bf16(kf[d0], qr[z][d0], p, 0, 0, 0);
            if (MODE == 0) { const int tq = c * 64 + 32 * z + r32;
#pragma unroll
                for (int r = 0; r < 16; ++r) { int rel = tq - (kb * 32 + crow(r, hi)); rel = rel < -128 ? -128 : (rel > 128 ? 128 : rel); p[r] += bias_s[rel + 128]; }
            }
            const unsigned bits = (MODE == 1) ? (mword[z] >> (4 * hi)) : 0u;
            float rs = 0.f;
            if (FIXM) {
#pragma unroll
                for (int r = 0; r < 16; ++r) { const float e = __builtin_amdgcn_exp2f(p[r]); if (MODE == 1) { unsigned mk; asm("v_bfe_i32 %0, %1, %2, 1" : "=v"(mk) : "v"(bits), "n"((r & 3) + 8 * (r >> 2))); p[r] = __builtin_bit_cast(float, __builtin_bit_cast(unsigned, e) & mk); } else p[r] = e; rs += p[r]; }
            } else {
                if (MODE == 1) {
#pragma unroll
                    for (int r = 0; r < 16; ++r) p[r] = ((bits >> ((r & 3) + 8 * (r >> 2))) & 1u) ? p[r] : -INFINITY;
                }
                float bm = p[0];
#pragma unroll
                for (int r = 1; r < 16; ++r) bm = fmaxf(bm, p[r]);
                bm = fmaxf(bm, shflx(bm, 32));
                const float mn = fmaxf(m[z], bm);
                if (__any(mn != m[z])) {
                    const float alpha = __builtin_amdgcn_exp2f(m[z] - mn); lsum[z] *= alpha;
#pragma unroll
                    for (int r = 0; r < 16; ++r) { o[z][0][r] *= alpha; o[z][1][r] *= alpha; }
                    m[z] = mn; }
#pragma unroll
                for (int r = 0; r < 16; ++r) { p[r] = __builtin_amdgcn_exp2f(p[r] - mn); rs += p[r]; }
            }
            lsum[z] += rs;
#pragma unroll
            for (int s = 0; s < 2; ++s) { v4u w; w.x = cvtpk(p[8 * s], p[8 * s + 1]); w.y = cvtpk(p[8 * s + 2], p[8 * s + 3]); w.z = cvtpk(p[8 * s + 4], p[8 * s + 5]); w.w = cvtpk(p[8 * s + 6], p[8 * s + 7]); pa[z][s] = __builtin_bit_cast(bf16x8, w); }
        }
        asm volatile("" : "+v"(pa[0][0]), "+v"(pa[0][1]), "+v"(pa[1][0]), "+v"(pa[1][1]) :: "memory");
#pragma unroll
        for (int i = 0; i < 4; ++i) { const int c16 = i * 64 + lane, key = c16 >> 3, dch = c16 & 7; *(LAS v4u*)(vl + (dch >> 2) * 2048 + (key >> 4) * 1024 + (key & 15) * 64 + (dch & 3) * 16) = vv[i]; }
#pragma unroll
        for (int s = 0; s < 2; ++s) {
            const s16x4 a_lo = vtr(vrd + s * 1024), a_hi = vtr(vrd + s * 1024 + 512), b_lo = vtr(vrd + 2048 + s * 1024), b_hi = vtr(vrd + 2048 + s * 1024 + 512);
            const bf16x8 va = {a_lo[0], a_lo[1], a_lo[2], a_lo[3], a_hi[0], a_hi[1], a_hi[2], a_hi[3]}, vb = {b_lo[0], b_lo[1], b_lo[2], b_lo[3], b_hi[0], b_hi[1], b_hi[2], b_hi[3]};
#pragma unroll
            for (int z = 0; z < 2; ++z) { o[z][0] = __builtin_amdgcn_mfma_f32_32x32x16_bf16(va, pa[z][s], o[z][0], 0, 0, 0); o[z][1] = __builtin_amdgcn_mfma_f32_32x32x16_bf16(vb, pa[z][s], o[z][1], 0, 0, 0); }
        }
        if (mfetch) { mword[0] = mnext[0]; mword[1] = mnext[1]; }
    }
    if constexpr (SPLIT) {
        if (part == 1) {
#pragma unroll
            for (int z = 0; z < 2; ++z) {
#pragma unroll
                for (int r = 0; r < 16; ++r) { cmb[((z * 2 + 0) * 16 + r) * 64 + lane] = o[z][0][r]; cmb[((z * 2 + 1) * 16 + r) * 64 + lane] = o[z][1][r]; }
                cmb[4096 + z * 64 + lane] = lsum[z]; } }
        __syncthreads();
        if (part == 2) {
#pragma unroll
            for (int z = 0; z < 2; ++z) {
#pragma unroll
                for (int r = 0; r < 16; ++r) { o[z][0][r] += cmb[((z * 2 + 0) * 16 + r) * 64 + lane]; o[z][1][r] += cmb[((z * 2 + 1) * 16 + r) * 64 + lane]; }
                lsum[z] += cmb[4096 + z * 64 + lane]; } }
        __syncthreads();
        if (part == 1) return;
    }
#pragma unroll
    for (int z = 0; z < 2; ++z) {
        const float lt = lsum[z] + shflx(lsum[z], 32); const float inv = 1.f / lt;
        bf16* yrow = Y + (row0 + 32 * z + r32) * 1024 + h * 64 + 4 * hi;
#pragma unroll
        for (int g4 = 0; g4 < 4; ++g4) {
            uint2 w0, w1; w0.x = cvtpk(o[z][0][4 * g4] * inv, o[z][0][4 * g4 + 1] * inv); w0.y = cvtpk(o[z][0][4 * g4 + 2] * inv, o[z][0][4 * g4 + 3] * inv); w1.x = cvtpk(o[z][1][4 * g4] * inv, o[z][1][4 * g4 + 1] * inv); w1.y = cvtpk(o[z][1][4 * g4 + 2] * inv, o[z][1][4 * g4 + 3] * inv);
            *(uint2*)(yrow + 8 * g4) = w0; *(uint2*)(yrow + 32 + 8 * g4) = w1; }
    }
}
__device__ __forceinline__ void phase_attn_a(Frame& F, int l) {
    LAS float* bias_s = (LAS float*)(F.lds + 32768);
    LAS unsigned char* vl = F.lds + F.wave * 4096;
    __syncthreads();
    for (int i = F.tid; i < 4 * 257; i += 512) bias_s[(i / 257) * 260 + (i % 257)] = F.rel_bias[(size_t)l * 4 * 257 + i] * LOG2E;
    __syncthreads();
    for (int u = blockIdx.x * 8 + F.wave; u < BATCH * 4 * 64; u += F.G * 8) { const int wgi = u >> 3; const int b = wgi & 7, h = (wgi >> 3) & 3, c = (wgi >> 5) * 8 + (u & 7);
        flash_wave2<0, false>(b, h, c, F.QA, F.KA, F.VA, F.YCAT, vl, bias_s + h * 260, nullptr, F.lane, 0.f); }
}
__device__ __forceinline__ void phase_attn_b(Frame& F, int l) {
    LAS unsigned char* vl = F.lds + F.wave * 4096;
    __syncthreads();
    float gq = fabsf(F.qk_gain_b[l * 128 + F.lane]), gk = fabsf(F.qk_gain_b[l * 128 + 64 + F.lane]); gq = wave_max(gq); gk = wave_max(gk);
    const float mfix = 64.f * gq * gk * pg8::QSCALE; const bool fixm = mfix < 40.f;
    for (int wg = blockIdx.x; wg < 256; wg += F.G) { const int b = wg & 7, jc = wg >> 3, w = F.wave; const int h = w & 3;
        if (fixm) {
            LAS float* cmb = (LAS float*)(F.lds + 32768) + h * 4224;
#pragma unroll 1
            for (int ci = 0; ci < 2; ++ci) { const int c = ci ? jc : 63 - jc, half = w >> 2;
                flash_wave2<1, true, true>(b, h, c, F.QB, F.KB, F.VB, F.YCAT + 256, vl, nullptr, F.MASK, F.lane, mfix, half, 2 * (c + 1), half ? 1 : 2, cmb); }
        } else { const int c = (w & 4) ? 63 - jc : jc;
#pragma unroll 1
            for (int z = 0; z < 2; ++z) flash_wave<1>(b, h, 2 * c + z, F.QB, F.KB, F.VB, F.YCAT + 256, vl, nullptr, F.MASK, F.lane); } }
}

__device__ __forceinline__ float dpp_quad_sum(float v) {
    int x = __builtin_bit_cast(int, v); float a = v + __builtin_bit_cast(float, __builtin_amdgcn_update_dpp(0, x, 0xB1, 0xF, 0xF, false));
    x = __builtin_bit_cast(int, a); return a + __builtin_bit_cast(float, __builtin_amdgcn_update_dpp(0, x, 0x4E, 0xF, 0xF, false));
}
__device__ __forceinline__ int wave_sum_dpp(int x) {
    x += __builtin_amdgcn_update_dpp(0, x, 0x111, 0xF, 0xF, true); x += __builtin_amdgcn_update_dpp(0, x, 0x112, 0xF, 0xF, true);
    x += __builtin_amdgcn_update_dpp(0, x, 0x114, 0xF, 0xF, true); x += __builtin_amdgcn_update_dpp(0, x, 0x118, 0xF, 0xF, true);
    x += __builtin_amdgcn_update_dpp(0, x, 0x142, 0xA, 0xF, false); x += __builtin_amdgcn_update_dpp(0, x, 0x143, 0xC, 0xF, false);
    return __builtin_amdgcn_readlane(x, 63);
}
__device__ __forceinline__ int wave_scan_dpp(int x) {
    x += __builtin_amdgcn_update_dpp(0, x, 0x111, 0xF, 0xF, true); x += __builtin_amdgcn_update_dpp(0, x, 0x112, 0xF, 0xF, true);
    x += __builtin_amdgcn_update_dpp(0, x, 0x114, 0xF, 0xF, true); x += __builtin_amdgcn_update_dpp(0, x, 0x118, 0xF, 0xF, true);
    x += __builtin_amdgcn_update_dpp(0, x, 0x142, 0xA, 0xF, false); x += __builtin_amdgcn_update_dpp(0, x, 0x143, 0xC, 0xF, false);
    return x;
}
#define TK_CNT1(acc, key, cand) asm("v_cmp_ge_u32 vcc, %1, %2\n\tv_addc_co_u32 %0, vcc, 0, %0, vcc" : "+v"(acc) : "v"(key), "v"(cand) : "vcc")
template <int N> __device__ __forceinline__ int lane_count_ge(const unsigned (&k)[N], unsigned cand) {
    int c0 = 0, c1 = 0, c2 = 0, c3 = 0;
#pragma unroll
    for (int i = 0; i < N; ++i) { if ((i & 3) == 0) TK_CNT1(c0, k[i], cand); else if ((i & 3) == 1) TK_CNT1(c1, k[i], cand); else if ((i & 3) == 2) TK_CNT1(c2, k[i], cand); else TK_CNT1(c3, k[i], cand); }
    return (c0 + c1) + (c2 + c3);
}
__device__ __forceinline__ unsigned wave_max_dpp(unsigned x) {
    x = max(x, (unsigned)__builtin_amdgcn_update_dpp(0, (int)x, 0x111, 0xF, 0xF, true)); x = max(x, (unsigned)__builtin_amdgcn_update_dpp(0, (int)x, 0x112, 0xF, 0xF, true));
    x = max(x, (unsigned)__builtin_amdgcn_update_dpp(0, (int)x, 0x114, 0xF, 0xF, true)); x = max(x, (unsigned)__builtin_amdgcn_update_dpp(0, (int)x, 0x118, 0xF, 0xF, true));
    x = max(x, (unsigned)__builtin_amdgcn_update_dpp((int)x, (int)x, 0x142, 0xA, 0xF, false)); x = max(x, (unsigned)__builtin_amdgcn_update_dpp((int)x, (int)x, 0x143, 0xC, 0xF, false));
    return (unsigned)__builtin_amdgcn_readlane((int)x, 63);
}
template <int N> __device__ __forceinline__ void bisect_keys(const unsigned (&k)[N], int target, unsigned& prefix, bool& exact, unsigned prefix0 = 0u, int bit0 = 31) {
    prefix = prefix0; exact = false;
    for (int bit = bit0; bit >= 0; --bit) { const unsigned cand = prefix | (1u << bit);
        const int cnt = wave_sum_dpp(lane_count_ge<N>(k, cand));
        if (cnt >= target) { prefix = cand; if (cnt == target) { exact = true; break; } } }
}
template <int NR> __device__ __forceinline__ void topk_core(const unsigned (&k)[NR], int nw, unsigned* mrow, int lane, LAS unsigned* cbuf) {
    unsigned prefix = 0u; bool exact = false, have = false;
    if constexpr (NR >= 32) {
        constexpr int NS = NR / 8; unsigned ks[NS];
#pragma unroll
        for (int j = 0; j < NS; ++j) ks[j] = k[4 + 8 * j];
        const int ns = (nw + 3) >> 3, rs = (352 * ns + nw - 1) / nw;
        unsigned L; bool exs; bisect_keys<NS>(ks, rs, L, exs);
        const int cl = lane_count_ge<NR>(k, L), incl = wave_scan_dpp(cl), C = __builtin_amdgcn_readlane(incl, 63);
        if (C >= 256 && C <= 512) {
            int off = incl - cl;
#pragma unroll
            for (int i = 0; i < NR; ++i) { const bool in = k[i] >= L; cbuf[in ? off : 512 + lane] = k[i]; off += in ? 1 : 0; }
            unsigned kc[8];
#pragma unroll
            for (int j = 0; j < 8; ++j) kc[j] = cbuf[j * 64 + lane];
            asm volatile("" ::: "memory");
#pragma unroll
            for (int j = 0; j < 8; ++j) kc[j] = (j * 64 + lane < C) ? kc[j] : 0u;
            unsigned kmx = kc[0];
#pragma unroll
            for (int j = 1; j < 8; ++j) kmx = max(kmx, kc[j]);
            kmx = wave_max_dpp(kmx);
            const unsigned dx = L ^ kmx; const int hb = dx ? 31 - __builtin_clz(dx) : -1;
            bisect_keys<8>(kc, 256, prefix, exact, hb >= 31 ? 0u : ((L >> (hb + 1)) << (hb + 1)), hb);
            if (exact && prefix < L) prefix = L;
            have = true;
        }
    }
    if (!have) bisect_keys<NR>(k, 256, prefix, exact);
    int wlo = 0, whi = 0;
    if (exact) {
#pragma unroll
        for (int i = 0; i < NR; ++i) { const u64 w = __ballot(k[i] >= prefix); asm("s_nop 1\n\tv_writelane_b32 %0, %2, %4\n\tv_writelane_b32 %1, %3, %4" : "+v"(wlo), "+v"(whi) : "s"((unsigned)w), "s"((unsigned)(w >> 32)), "n"(i)); }
    } else {
        int n_gt = 0;
#pragma unroll
        for (int i = 0; i < NR; ++i) n_gt += __popcll(__ballot(k[i] > prefix));
        const int allowed = 256 - n_gt; int running = 0; const u64 lt = (1ull << lane) - 1ull;
#pragma unroll
        for (int i = 0; i < NR; ++i) { const bool gt = k[i] > prefix, eq = k[i] == prefix; const u64 eqb = __ballot(eq); const int rank = running + __popcll(eqb & lt); running += __popcll(eqb);
            const u64 w = __ballot(gt || (eq && rank < allowed)); asm("s_nop 1\n\tv_writelane_b32 %0, %2, %4\n\tv_writelane_b32 %1, %3, %4" : "+v"(wlo), "+v"(whi) : "s"((unsigned)w), "s"((unsigned)(w >> 32)), "n"(i)); }
    }
    if (lane < nw) { mrow[(2 * lane) * 64] = (unsigned)wlo; mrow[(2 * lane + 1) * 64] = (unsigned)whi; }
}
constexpr int SCP = 2052;
__device__ __forceinline__ void idx_scores16(const bf16* IK, LAS unsigned* sc, int b, int t_lo, int t_hi, int wave, int lane, const bf16x8 (&qf)[2][4], const f32x4 (&wq)[2][4]) {
    asm volatile("" : "+v"(lane));
    const int r32 = lane & 31, hi = lane >> 5;
    const bf16* kbase = IK + (size_t)b * (SEQ * 64) + lane * 8;
    bf16x8 kn[2][4];
#pragma unroll
    for (int g = 0; g < 2; ++g) { const int tt = t_lo + wave + 8 * g, tc = tt < t_hi ? tt : t_hi - 1;
#pragma unroll
        for (int d0 = 0; d0 < 4; ++d0) kn[g][d0] = *(const bf16x8*)(kbase + tc * 2048 + d0 * 512); }
    for (int t = t_lo + wave; t < t_hi; t += 16) {
        bf16x8 kf[2][4];
#pragma unroll
        for (int g = 0; g < 2; ++g)
#pragma unroll
            for (int d0 = 0; d0 < 4; ++d0) kf[g][d0] = kn[g][d0];
        if (t + 16 < t_hi) {
#pragma unroll
            for (int g = 0; g < 2; ++g) { const int tt = t + 16 + 8 * g, tc = tt < t_hi ? tt : t_hi - 1;
#pragma unroll
                for (int d0 = 0; d0 < 4; ++d0) kn[g][d0] = *(const bf16x8*)(kbase + tc * 2048 + d0 * 512); } }
#pragma unroll
        for (int g = 0; g < 2; ++g) { const int tt = t + 8 * g;
            if (tt < t_hi) {
#pragma unroll
                for (int qg = 0; qg < 2; ++qg) {
                    f32x16 d;
#pragma unroll
                    for (int r = 0; r < 16; ++r) d[r] = 0.f;
#pragma unroll
                    for (int d0 = 0; d0 < 4; ++d0) d = __builtin_amdgcn_mfma_f32_32x32x16_bf16(qf[qg][d0], kf[g][d0], d, 0, 0, 0);
#pragma unroll
                    for (int k4 = 0; k4 < 4; ++k4) {
                        typedef float f32x2 __attribute__((ext_vector_type(2)));
                        const f32x2 m01 = {__builtin_amdgcn_fmed3f(d[4 * k4], 0.f, 3.0e38f), __builtin_amdgcn_fmed3f(d[4 * k4 + 1], 0.f, 3.0e38f)}, m23 = {__builtin_amdgcn_fmed3f(d[4 * k4 + 2], 0.f, 3.0e38f), __builtin_amdgcn_fmed3f(d[4 * k4 + 3], 0.f, 3.0e38f)};
                        const f32x2 w01 = {wq[qg][k4][0], wq[qg][k4][1]}, w23 = {wq[qg][k4][2], wq[qg][k4][3]};
                        const f32x2 q2 = m01 * w01 + m23 * w23; const float sv = (q2[0] + q2[1]) + 0.0f;
                        const unsigned su = __builtin_bit_cast(unsigned, sv);
                        sc[(8 * qg + 2 * k4 + hi) * SCP + (tt - t_lo) * 32 + r32] = su ^ ((unsigned)((int)su >> 31) | 0x80000000u); }
                }
            }
        }
    }
}
template <int NR> __device__ __forceinline__ void idx_select_row(const unsigned (&k)[NR], int nw, LAS unsigned* mrow, LAS unsigned* cbuf, unsigned* mg_row, int lane) {
    (void)mrow; topk_core<NR>(k, nw, mg_row, lane, cbuf);
}
__device__ __forceinline__ void phase_idx(Frame& F) {
    LAS unsigned* sc = (LAS unsigned*)F.lds;
    constexpr int MST = 136; LAS unsigned* mst = (LAS unsigned*)(F.lds + 16 * SCP * 4) + F.wave * MST;
    const int lane = F.lane, r32 = lane & 31, hi = lane >> 5, qq = r32 >> 2, hd = r32 & 3;
    __syncthreads();
    for (int u = blockIdx.x; u < BATCH * 256; u += F.G) {
        const int wgv = u & 255, i8 = u >> 8; const int b = wgv & 7, jc = wgv >> 3; const int chunk = (i8 & 4) ? 63 - jc : jc; const int q0 = chunk * 64 + (i8 & 3) * 16;
        const size_t row0 = (size_t)b * SEQ + q0; const int c = q0 >> 6, nw = c + 1, nt = 2 * nw;
        unsigned* mg = (unsigned*)F.MASK + (size_t)(b * 64 + c) * (128 * 64) + (q0 & 63);
        if (nw <= 4) { int tidl = F.tid; asm volatile("" : "+v"(tidl)); const int kbq = tidl >> 4, r16 = tidl & 15; if (kbq < nt) mg[kbq * 64 + r16] = ~0u; continue; }
        bf16x8 qf[2][4]; f32x4 wq[2][4];
#pragma unroll
        for (int qg = 0; qg < 2; ++qg) {
#pragma unroll
            for (int d0 = 0; d0 < 4; ++d0) qf[qg][d0] = *(const bf16x8*)(F.IQ + (row0 + 8 * qg + qq) * 256 + hd * 64 + d0 * 16 + hi * 8);
#pragma unroll
            for (int k4 = 0; k4 < 4; ++k4) wq[qg][k4] = *(const f32x4*)(F.IW + (row0 + 8 * qg + 2 * k4 + hi) * 4); }
        LAS unsigned* srA = sc + F.wave * SCP; LAS unsigned* srB = sc + (F.wave + 8) * SCP;
        int ll = lane; asm volatile("" : "+v"(ll));
        unsigned* mgA = mg + F.wave; unsigned* mgB = mg + F.wave + 8;
        if (nw <= 32) {
            idx_scores16(F.IK, sc, b, 0, nt, F.wave, lane, qf, wq);
            __syncthreads();
            if (nw <= 16) {
                { unsigned k[16];
#pragma unroll
                  for (int i = 0; i < 16; ++i) k[i] = srA[i * 64 + ll];
                  asm volatile("" ::: "memory");
#pragma unroll
                  for (int i = 0; i < 16; ++i) k[i] = (i < nw) ? k[i] : 0u;
                  idx_select_row<16>(k, nw, mst, srA, mgA, ll); }
                { unsigned k[16];
#pragma unroll
                  for (int i = 0; i < 16; ++i) k[i] = srB[i * 64 + ll];
                  asm volatile("" ::: "memory");
#pragma unroll
                  for (int i = 0; i < 16; ++i) k[i] = (i < nw) ? k[i] : 0u;
                  idx_select_row<16>(k, nw, mst, srB, mgB, ll); }
            } else {
                { unsigned k[32];
#pragma unroll
                  for (int i = 0; i < 32; ++i) k[i] = srA[i * 64 + ll];
                  asm volatile("" ::: "memory");
#pragma unroll
                  for (int i = 0; i < 32; ++i) k[i] = (i < nw) ? k[i] : 0u;
                  idx_select_row<32>(k, nw, mst, srA, mgA, ll); }
                { unsigned k[32];
#pragma unroll
                  for (int i = 0; i < 32; ++i) k[i] = srB[i * 64 + ll];
                  asm volatile("" ::: "memory");
#pragma unroll
                  for (int i = 0; i < 32; ++i) k[i] = (i < nw) ? k[i] : 0u;
                  idx_select_row<32>(k, nw, mst, srB, mgB, ll); }
            }
            __syncthreads();
        } else {
            idx_scores16(F.IK, sc, b, 0, 64, F.wave, lane, qf, wq);
            __syncthreads();
            unsigned ka[32], kb_[32];
#pragma unroll
            for (int i = 0; i < 32; ++i) { ka[i] = srA[i * 64 + ll]; kb_[i] = srB[i * 64 + ll]; }
            __syncthreads();
            idx_scores16(F.IK, sc, b, 64, nt, F.wave, lane, qf, wq);
            __syncthreads();
            const int nw2 = nw - 32;
            if (nw <= 48) {
                { unsigned k[48];
#pragma unroll
                  for (int i = 0; i < 32; ++i) k[i] = ka[i];
#pragma unroll
                  for (int i = 0; i < 16; ++i) k[32 + i] = srA[i * 64 + ll];
                  asm volatile("" ::: "memory");
#pragma unroll
                  for (int i = 0; i < 16; ++i) k[32 + i] = (i < nw2) ? k[32 + i] : 0u;
                  idx_select_row<48>(k, nw, mst, srA, mgA, ll); }
                { unsigned k[48];
#pragma unroll
                  for (int i = 0; i < 32; ++i) k[i] = kb_[i];
#pragma unroll
                  for (int i = 0; i < 16; ++i) k[32 + i] = srB[i * 64 + ll];
                  asm volatile("" ::: "memory");
#pragma unroll
                  for (int i = 0; i < 16; ++i) k[32 + i] = (i < nw2) ? k[32 + i] : 0u;
                  idx_select_row<48>(k, nw, mst, srB, mgB, ll); }
            } else {
                { unsigned k[64];
#pragma unroll
                  for (int i = 0; i < 32; ++i) k[i] = ka[i];
#pragma unroll
                  for (int i = 0; i < 32; ++i) k[32 + i] = srA[i * 64 + ll];
                  asm volatile("" ::: "memory");
#pragma unroll
                  for (int i = 0; i < 32; ++i) k[32 + i] = (i < nw2) ? k[32 + i] : 0u;
                  idx_select_row<64>(k, nw, mst, srA, mgA, ll); }
                { unsigned k[64];
#pragma unroll
                  for (int i = 0; i < 32; ++i) k[i] = kb_[i];
#pragma unroll
                  for (int i = 0; i < 32; ++i) k[32 + i] = srB[i * 64 + ll];
                  asm volatile("" ::: "memory");
#pragma unroll
                  for (int i = 0; i < 32; ++i) k[32 + i] = (i < nw2) ? k[32 + i] : 0u;
                  idx_select_row<64>(k, nw, mst, srB, mgB, ll); }
            }
            __syncthreads();
        }
    }
}

typedef float f32x4v __attribute__((ext_vector_type(4)));
template <int SH> __device__ __forceinline__ float dpp_shr(float v, float ident) {
    return __builtin_bit_cast(float, __builtin_amdgcn_update_dpp(__builtin_bit_cast(int, ident), __builtin_bit_cast(int, v), 0x110 + SH, 0xF, 0xF, false));
}
__device__ __forceinline__ float row_last(float v, int lane) { return shfl_from(v, (lane & 48) | 15); }
struct LruIn { bf16x8 x3[2]; uint2 u3; uint2 cyw; };
__device__ __forceinline__ void lru_load(LruIn& I, const bf16* CX, const bf16* CY, size_t brow, int t0, int g, int q4, int lane) {
    const int tk = lane & 15, lg = lane >> 4; const int t = t0 + tk;
#pragma unroll
    for (int hf = 0; hf < 2; ++hf) I.x3[hf] = *(const bf16x8*)(CX + (brow + t) * 512 + g * 64 + 32 * hf + 8 * lg);
    I.u3 = *(const uint2*)(CX + (brow + t) * 512 + g * 64 + 16 * q4 + 4 * lg);
    I.cyw = *(const uint2*)(CY + (brow + t) * 512 + g * 64 + 16 * q4 + 4 * lg);
}
template <int N> __device__ __forceinline__ unsigned tap_shift(unsigned cur, unsigned prev) {
    const int a = __builtin_amdgcn_update_dpp(0, (int)prev, 0x120 + N, 0xF, 0xF, false);
    return (unsigned)__builtin_amdgcn_update_dpp(a, (int)cur, 0x110 + N, 0xF, 0xF, false);
}
template <int N> __device__ __forceinline__ bf16x8 tap_shift8(const bf16x8& cur, const bf16x8& prev) {
    const v4u c = __builtin_bit_cast(v4u, cur), p = __builtin_bit_cast(v4u, prev); v4u r;
    r.x = tap_shift<N>(c.x, p.x); r.y = tap_shift<N>(c.y, p.y); r.z = tap_shift<N>(c.z, p.z); r.w = tap_shift<N>(c.w, p.w); return __builtin_bit_cast(bf16x8, r);
}
__device__ __forceinline__ void lru_subtile(const LruIn& I, const LruIn& P, bf16* Y0, bf16* Y1, size_t brow, int t0, int g, int q4, int lane,
        const bf16x8 (&Awa)[8], const bf16x8 (&Awx)[8], const float (&cw)[4][4], const float (&cb)[4], const float (&ca)[4], const float (&cx_)[4], const float (&sp)[4],
        float (&Arun)[4], float (&hc)[4]) {
    const int tk = lane & 15, lg = lane >> 4; const int t = t0 + tk;
    f32x4v accA = {ca[0], ca[1], ca[2], ca[3]}, accX = {cx_[0], cx_[1], cx_[2], cx_[3]};
    bf16x8 bx[8]; uint2 uw[4];
#pragma unroll
    for (int hf = 0; hf < 2; ++hf) { bx[0 + hf] = tap_shift8<3>(I.x3[hf], P.x3[hf]); bx[2 + hf] = tap_shift8<2>(I.x3[hf], P.x3[hf]); bx[4 + hf] = tap_shift8<1>(I.x3[hf], P.x3[hf]); bx[6 + hf] = I.x3[hf]; }
    uw[0].x = tap_shift<3>(I.u3.x, P.u3.x); uw[0].y = tap_shift<3>(I.u3.y, P.u3.y); uw[1].x = tap_shift<2>(I.u3.x, P.u3.x); uw[1].y = tap_shift<2>(I.u3.y, P.u3.y);
    uw[2].x = tap_shift<1>(I.u3.x, P.u3.x); uw[2].y = tap_shift<1>(I.u3.y, P.u3.y); uw[3] = I.u3;
#pragma unroll
    for (int ks = 0; ks < 8; ++ks) { accA = __builtin_amdgcn_mfma_f32_16x16x32_bf16(Awa[ks], bx[ks], accA, 0, 0, 0); accX = __builtin_amdgcn_mfma_f32_16x16x32_bf16(Awx[ks], bx[ks], accX, 0, 0, 0); }
    float u[4] = {cb[0], cb[1], cb[2], cb[3]};
#pragma unroll
    for (int q = 0; q < 4; ++q) { const uint2 w = uw[q];
        u[0] += cw[q][0] * bflo(w.x); u[1] += cw[q][1] * bfhi(w.x); u[2] += cw[q][2] * bflo(w.y); u[3] += cw[q][3] * bfhi(w.y); }
    const uint2 cyw = I.cyw;
    const float cy[4] = {bflo(cyw.x), bfhi(cyw.x), bflo(cyw.y), bfhi(cyw.y)};
    float A[4], B[4];
#pragma unroll
    for (int r = 0; r < 4; ++r) { const float rg = __builtin_amdgcn_rcpf(1.f + __builtin_amdgcn_exp2f(accA[r])), ig = __builtin_amdgcn_rcpf(1.f + __builtin_amdgcn_exp2f(accX[r]));
        const float tl = rg * sp[r]; const float y2 = tl * 1.3862943611198906f; A[r] = __builtin_amdgcn_exp2f(tl);
        const float om = (y2 > -0.3f) ? -y2 * (1.f + y2 * (0.5f + y2 * (0.16666667f + y2 * 0.041666668f))) : 1.f - A[r] * A[r];
        B[r] = __builtin_amdgcn_sqrtf(om) * (ig * u[r]); }
#define LRU_SCAN_STEP(PRE, N) asm(PRE "v_fmac_f32_dpp %4, %4, %0 row_shr:" #N " row_mask:0xf bank_mask:0xf\n\tv_fmac_f32_dpp %5, %5, %1 row_shr:" #N " row_mask:0xf bank_mask:0xf\n\t" \
        "v_fmac_f32_dpp %6, %6, %2 row_shr:" #N " row_mask:0xf bank_mask:0xf\n\tv_fmac_f32_dpp %7, %7, %3 row_shr:" #N " row_mask:0xf bank_mask:0xf\n\t" \
        "v_mul_f32_dpp %0, %0, %0 row_shr:" #N " row_mask:0xf bank_mask:0xf\n\tv_mul_f32_dpp %1, %1, %1 row_shr:" #N " row_mask:0xf bank_mask:0xf\n\t" \
        "v_mul_f32_dpp %2, %2, %2 row_shr:" #N " row_mask:0xf bank_mask:0xf\n\tv_mul_f32_dpp %3, %3, %3 row_shr:" #N " row_mask:0xf bank_mask:0xf" \
        : "+v"(A[0]), "+v"(A[1]), "+v"(A[2]), "+v"(A[3]), "+v"(B[0]), "+v"(B[1]), "+v"(B[2]), "+v"(B[3]))
    LRU_SCAN_STEP("s_nop 1\n\t", 1); LRU_SCAN_STEP("", 2); LRU_SCAN_STEP("", 4); LRU_SCAN_STEP("", 8);
#undef LRU_SCAN_STEP
    float y0[4], y1[4];
#pragma unroll
    for (int r = 0; r < 4; ++r) { const float h = B[r] + A[r] * hc[r], ap = A[r] * Arun[r]; const float gl = cy[r] * __builtin_amdgcn_rcpf(1.f + __builtin_amdgcn_exp2f(cy[r] * (-2.3022082f + -0.10294324f * (cy[r] * cy[r]))));     y0[r] = h * gl; y1[r] = ap * gl; hc[r] = row_last(h, lane); Arun[r] = row_last(ap, lane); }
    const size_t off = (brow + t) * 512 + g * 64 + 16 * q4 + 4 * lg, off0 = (brow + t) * 1024 + g * 64 + 16 * q4 + 4 * lg;
    uint2 o; o.x = cvtpk(y0[0], y0[1]); o.y = cvtpk(y0[2], y0[3]); *(uint2*)(Y0 + off0) = o;
    o.x = cvtpk(y1[0], y1[1]); o.y = cvtpk(y1[2], y1[3]); *(uint2*)(Y1 + off) = o;
}
constexpr float NL2E = -1.4426950408889634f;
__device__ __forceinline__ void phase_lru(Frame& F, int l) {
    LAS float* agg = (LAS float*)(F.lds + 36864);
    const int lane = F.lane, tk = lane & 15, lg = lane >> 4;
    bf16* Y1 = F.YC; bf16* Y0 = F.YCAT + 512;
    for (int u = blockIdx.x; u < 256; u += F.G) {
        const int b = u & 7, g = u >> 5, q4 = (u >> 3) & 3; const size_t brow = (size_t)b * SEQ;
        const float* wa = F.lru_wa + (size_t)(l * 8 + g) * 4096; const float* wx = F.lru_wx + (size_t)(l * 8 + g) * 4096; const float* cwp = F.conv_w + (size_t)l * 4 * 512 + g * 64; const float* cbp = F.conv_b + l * 512 + g * 64;
        bf16x8 Awa[8], Awx[8];
#pragma unroll
        for (int ks = 0; ks < 8; ++ks) { const int q = ks >> 1; v4u pa, px; unsigned wsa[4], wsx[4];
#pragma unroll
            for (int j2 = 0; j2 < 4; ++j2) { const int i0 = 32 * (ks & 1) + 8 * lg + 2 * j2, oc = 16 * q4 + tk;
                const float c0 = cwp[q * 512 + i0], c1 = cwp[q * 512 + i0 + 1];
                wsa[j2] = cvtpk(NL2E * c0 * wa[i0 * 64 + oc], NL2E * c1 * wa[(i0 + 1) * 64 + oc]); wsx[j2] = cvtpk(NL2E * c0 * wx[i0 * 64 + oc], NL2E * c1 * wx[(i0 + 1) * 64 + oc]); }
            pa.x = wsa[0]; pa.y = wsa[1]; pa.z = wsa[2]; pa.w = wsa[3]; px.x = wsx[0]; px.y = wsx[1]; px.z = wsx[2]; px.w = wsx[3];
            Awa[ks] = __builtin_bit_cast(bf16x8, pa); Awx[ks] = __builtin_bit_cast(bf16x8, px); }
        float cw[4][4], cb[4], ca[4], cx_[4], sp[4];
#pragma unroll
        for (int r = 0; r < 4; ++r) { const int oc = 16 * q4 + 4 * lg + r, cg = g * 64 + oc;
#pragma unroll
            for (int q = 0; q < 4; ++q) cw[q][r] = cwp[q * 512 + oc];
            cb[r] = cbp[oc]; float sa = 0.f, sx = 0.f;
#pragma unroll
            for (int i4 = 0; i4 < 4; ++i4) { const int i = tk + 16 * i4; const float bi = cbp[i]; sa += bi * wa[i * 64 + oc]; sx += bi * wx[i * 64 + oc]; }
#pragma unroll
            for (int o = 1; o < 16; o <<= 1) { sa += shflx(sa, o); sx += shflx(sx, o); }
            ca[r] = NL2E * (sa + F.lru_ba[l * 512 + cg]); cx_[r] = NL2E * (sx + F.lru_bx[l * 512 + cg]); sp[r] = (8.f * NL2E) * log1pf(expf(-F.lru_lambda[l * 512 + cg])); }
        float Arun[4] = {1.f, 1.f, 1.f, 1.f}, hc[4] = {0.f, 0.f, 0.f, 0.f};
        const int tseg = F.wave * 512;
        LruIn cur, prv; lru_load(cur, F.CX, F.CY, brow, tseg, g, q4, lane);
        lru_load(prv, F.CX, F.CY, brow, tseg >= 16 ? tseg - 16 : 0, g, q4, lane);
        if (tseg == 0) { prv.x3[0] = (bf16x8){0, 0, 0, 0, 0, 0, 0, 0}; prv.x3[1] = (bf16x8){0, 0, 0, 0, 0, 0, 0, 0}; prv.u3 = (uint2){0u, 0u}; }
#pragma unroll 2
        for (int s = 0; s < 32; ++s) { LruIn nxt;
            lru_load(nxt, F.CX, F.CY, brow, tseg + 16 * (s + 1 < 32 ? s + 1 : s), g, q4, lane);
            asm volatile("" ::: "memory");
            lru_subtile(cur, prv, Y0, Y1, brow, tseg + 16 * s, g, q4, lane, Awa, Awx, cw, cb, ca, cx_, sp, Arun, hc);
            prv = cur; cur = nxt; }
        __syncthreads();
        if (tk == 0) {
#pragma unroll
            for (int r = 0; r < 4; ++r) { agg[F.wave * 32 + 4 * lg + r] = Arun[r]; agg[F.wave * 32 + 16 + 4 * lg + r] = hc[r]; } }
        __syncthreads();
        float hin[4] = {0.f, 0.f, 0.f, 0.f};
        for (int w = 0; w < F.wave; ++w) {
#pragma unroll
            for (int r = 0; r < 4; ++r) hin[r] = agg[w * 32 + 4 * lg + r] * hin[r] + agg[w * 32 + 16 + 4 * lg + r]; }
        if (F.wave > 0) {
            asm volatile("s_waitcnt vmcnt(0)" ::: "memory");
#pragma unroll 1
            for (int s8 = 0; s8 < 32; s8 += 8) { uint2 a0[8], a1[8];
#pragma unroll
                for (int j = 0; j < 8; ++j) { const size_t row = brow + tseg + 16 * (s8 + j) + tk; a0[j] = *(const uint2*)(Y0 + row * 1024 + g * 64 + 16 * q4 + 4 * lg); a1[j] = *(const uint2*)(Y1 + row * 512 + g * 64 + 16 * q4 + 4 * lg); }
#pragma unroll
                for (int j = 0; j < 8; ++j) { const size_t row = brow + tseg + 16 * (s8 + j) + tk; uint2 o;
                    o.x = cvtpk(bflo(a0[j].x) + bflo(a1[j].x) * hin[0], bfhi(a0[j].x) + bfhi(a1[j].x) * hin[1]); o.y = cvtpk(bflo(a0[j].y) + bflo(a1[j].y) * hin[2], bfhi(a0[j].y) + bfhi(a1[j].y) * hin[3]);
                    *(uint2*)(Y0 + row * 1024 + g * 64 + 16 * q4 + 4 * lg) = o; } }
        }
    }
}

struct Args { const float* in[20]; float* out; unsigned char* ws; int l_lo, l_hi, ph_lo, ph_hi; };
__device__ __forceinline__ void make_frame(Frame& F, const Args& args, unsigned char* lds_) {
    int tid = wg_tid(); asm volatile("" : "+v"(tid));
    const __attribute__((address_space(4))) unsigned char* ka = (const __attribute__((address_space(4))) unsigned char*)__builtin_amdgcn_kernarg_segment_ptr(); asm volatile("" : "+s"(ka));
#define KARG(k) ((const float*)(GAS const float*)(*(const unsigned long long __attribute__((address_space(4)))*)(ka + 8 * (k))))
    GAS unsigned char* wsg = (GAS unsigned char*)(*(const unsigned long long __attribute__((address_space(4)))*)(ka + 168)); unsigned char* ws = (unsigned char*)wsg;
    F.lds = (LAS unsigned char*)lds_; F.MISC = (volatile LAS unsigned*)(F.lds + MISC_OFF);
    F.tid = tid; F.lane = tid & 63; F.wave = __builtin_amdgcn_readfirstlane(tid >> 6); F.G = gridDim.x;
    F.ctl = (gu32*)(ws + WS_CTL);
    F.x = KARG(0); F.g_mix = KARG(1); F.w_in = KARG(2); F.qk_gain_a = KARG(3); F.rel_bias = KARG(4); F.qk_gain_b = KARG(5); F.g_idx_k = KARG(6);
    F.conv_w = KARG(7); F.conv_b = KARG(8); F.lru_wa = KARG(9); F.lru_ba = KARG(10); F.lru_wx = KARG(11); F.lru_bx = KARG(12); F.lru_lambda = KARG(13);
    F.b_gate = KARG(14); F.w_branch = KARG(15); F.w_out = KARG(16); F.g_ffn = KARG(17); F.w_ffn_in = KARG(18); F.w_ffn_out = KARG(19); F.out = (float*)KARG(20);
#undef KARG
    F.rcos = (float*)(ws + WS_ROPE); F.rsin = F.rcos + SEQ * 32; F.SS = (float*)(ws + WS_SS);
    F.W = (bf16*)(ws + WS_W); F.W2a = (bf16*)(ws + 462 * MiB); F.W2b = (bf16*)((unsigned char*)F.out + 32 * MiB); F.H = (bf16*)(ws + WS_H); F.YC = (bf16*)F.out; F.YCAT = (bf16*)F.out + (size_t)32 * 1024 * 1024;
    F.QA = (bf16*)(ws + WS_QA); F.QB = (bf16*)(ws + WS_QB); F.KA = (bf16*)(ws + WS_KA); F.VA = (bf16*)(ws + WS_VA); F.KB = (bf16*)(ws + WS_KB); F.VB = (bf16*)(ws + WS_VB);
    F.IQ = (bf16*)(ws + WS_IQ); F.IK = (bf16*)(ws + WS_IK); F.IW = (float*)(ws + WS_IW); F.CX = (bf16*)(ws + WS_CX); F.CY = (bf16*)(ws + WS_CY);
    F.GT = (bf16*)(ws + WS_GT); F.ACT = (bf16*)(ws + WS_ACT); F.MG = (bf16*)(ws + WS_MG); F.MASK = (u64*)(ws + WS_MASK);
}
template <int PHM> __global__ void __launch_bounds__(NWAVES * 64, 2) fwd(Args args) {
    { LAS unsigned char* l3 = (LAS unsigned char*)lds; for (int u = threadIdx.x; u < (LDS_BYTES - LDSCTL_OFF) / 4; u += NWAVES * 64) ((LAS unsigned*)(l3 + LDSCTL_OFF))[u] = 0u; }
    __syncthreads();
    static_assert(WGT_LDS_OFF == MISC_OFF + 256 && WGT_LDS_OFF + 256 <= LDS_BYTES, "wave-index table inside the LDS control area");
    if ((threadIdx.x & 63) == 0) ((LAS unsigned*)((LAS unsigned char*)lds + WGT_LDS_OFF))[wgt_slot()] = threadIdx.x >> 6;
    __syncthreads();
    XcdBarrier bar; bar.bar = (unsigned*)(args.ws + WS_CTL) + CW_BAR; bar.x = 0; bar.st = nullptr;
    if (!MK_PER_PHASE) bar = xcd_barrier_post((unsigned*)(args.ws + WS_CTL) + CW_BAR, (volatile LAS unsigned*)((LAS unsigned char*)lds + MISC_OFF) + 8);
#define GRID_BAR() do { if (!MK_PER_PHASE) xcd_barrier(bar); } while (0)
    const int plo = args.ph_lo, phi = args.ph_hi; (void)plo; (void)phi;
#ifndef PHMASK
#define PHMASK 0x1ff
#endif
#if MK_PER_PHASE
#define IN(k) (((PHMASK >> (k)) & 1) && ((PHM >> (k)) & 1) && plo <= (k) && (k) < phi)
#else
#define IN(k) (((PHMASK >> (k)) & 1) && ((PHM >> (k)) & 1))
#endif
    bool first = true;
    for (int l = MK_PER_PHASE ? args.l_lo : 0; l < (MK_PER_PHASE ? args.l_hi : DEPTH); ++l) {
        if (IN(0) && (MK_PER_PHASE || l == 0)) { if (!first) GRID_BAR(); first = false; Frame F; make_frame(F, args, lds); phase_weights(F, l); if (l == 0) phase_xb0(F, F.x, F.SS); }
        if (IN(1)) { if (!first) GRID_BAR(); first = false; Frame F; make_frame(F, args, lds);
            pg8::Gemm g{F.H, wset(F, l).in, M, NIN, D}; pg8::StaticOrder S; S.init(M, NIN, F.G, (int)blockIdx.x);
            pg8::EpiIn E{F.QA, F.KA, F.VA, F.QB, F.KB, F.VB, F.IQ, F.IK, F.IW, F.CX, F.CY, F.GT, F.qk_gain_a + l * 128, F.qk_gain_b + l * 128, F.g_idx_k + l * 64, F.b_gate + l * 3072, F.rcos, F.rsin, F.SS + (size_t)(2 * l) * M * 16, (LAS float*)(F.lds + XTRA_OFF)};
            pg8::gemm_phase<pg8::EpiIn, pg8::StaticOrder, PG8_ALIGN, PG8_SP2>(F.lds + RING_OFF, g, S, E); }
        if (IN(2)) { if (!first) GRID_BAR(); first = false; { Frame F0; make_frame(F0, args, lds); phase_lru(F0, l); } __syncthreads(); Frame F; make_frame(F, args, lds); phase_attn_a(F, l); __syncthreads(); phase_idx(F);
            if (F.G == 256) { asm volatile("s_waitcnt vmcnt(0)" ::: "memory"); __syncthreads(); } else GRID_BAR();
            { Frame F2; make_frame(F2, args, lds); phase_attn_b(F2, l); }
            if (!MK_PER_PHASE && l + 1 < DEPTH) { __syncthreads();
                Frame F3; make_frame(F3, args, lds); phase_weights(F3, l + 1, (unsigned*)(args.ws + WS_CTL) + 64 + l); } }
        if (IN(4)) { if (!first) GRID_BAR(); first = false; Frame F; make_frame(F, args, lds);
#ifndef DBG_HALF
#define DBG_HALF 0
#endif
#ifndef DBG_SKIP_BR
#define DBG_SKIP_BR 0
#endif
            pg8::Gemm g{F.YCAT, wset(F, l).ba, M, D, D}; pg8::StaticOrder S; S.init(M, D, F.G, (int)blockIdx.x); pg8::EpiGateCat E{F.MG, F.GT};
            pg8::gemm_phase<pg8::EpiGateCat, pg8::StaticOrder, PG8_ALIGN, PG8_SP2, true>(F.lds + RING_OFF, g, S, E); }
        if (IN(5)) { if (!first) GRID_BAR(); first = false; Frame F; make_frame(F, args, lds);
            pg8::Gemm g{F.MG, wset(F, l).out, M, D, D}; pg8::StaticOrder S; S.init(M, D, F.G, (int)blockIdx.x); pg8::EpiResidB E{F.H, F.SS + (size_t)(2 * l + 1) * M * 16, nullptr};
            pg8::gemm_phase<pg8::EpiResidB, pg8::StaticOrder, PG8_ALIGN, PG8_SP2>(F.lds + RING_OFF, g, S, E); }
        if (IN(7)) { if (!first) GRID_BAR(); first = false; Frame F; make_frame(F, args, lds);
            pg8::Gemm g{F.H, wset(F, l).f1, M, NF1, D}; pg8::StaticOrder S; S.init(M, NF1, F.G, (int)blockIdx.x); pg8::EpiSwiGLU E{F.ACT, F.SS + (size_t)(2 * l + 1) * M * 16, (LAS float*)(F.lds + XTRA_OFF)};
            pg8::gemm_phase<pg8::EpiSwiGLU, pg8::StaticOrder, PG8_ALIGN, PG8_SP2>(F.lds + RING_OFF, g, S, E); }
        if (IN(8)) { if (!first) GRID_BAR(); first = false; Frame F; make_frame(F, args, lds);
            pg8::Gemm g{F.ACT, wset(F, l).f2, M, D, FF}; pg8::StaticOrder S; S.init(M, D, F.G, (int)blockIdx.x); pg8::EpiResidB E{F.H, F.SS + (size_t)(2 * l + 2 < 2 * DEPTH ? 2 * l + 2 : 0) * M * 16, (l + 1 < DEPTH) ? (float*)nullptr : F.out};
            pg8::gemm_phase<pg8::EpiResidB, pg8::StaticOrder, PG8_ALIGN, PG8_SP2>(F.lds + RING_OFF, g, S, E); }
    }
#undef IN
}

extern "C" void kernel_launch(void* const* d_in, const int* in_sizes, int n_in, void* d_out, int out_size, void* d_ws, size_t ws_size, hipStream_t stream) {
    static int grid = 0;
    if (grid == 0) {
        if (n_in != 20 || in_sizes[0] != M * D || out_size != M * D || ws_size < WS_END) { fprintf(stderr, "kernel_launch: unexpected problem shape / workspace (n_in %d, ws %zu); nothing launched\n", n_in, ws_size); grid = -1; return; }
        int dev = 0, cus = 0, per_cu = 0;
        if (hipGetDevice(&dev) != hipSuccess || hipDeviceGetAttribute(&cus, hipDeviceAttributeMultiprocessorCount, dev) != hipSuccess) { grid = -1; return; }
#if MK_PER_PHASE
        const void* fns[NPH] = {(const void*)fwd<1>, (const void*)fwd<2>, (const void*)fwd<4>, (const void*)fwd<8>, (const void*)fwd<16>, (const void*)fwd<32>, (const void*)fwd<64>, (const void*)fwd<128>, (const void*)fwd<256>};
        for (int i = 0; i < NPH; ++i) if (hipFuncSetAttribute(fns[i], hipFuncAttributeMaxDynamicSharedMemorySize, LDS_BYTES) != hipSuccess) { fprintf(stderr, "kernel_launch: hipFuncSetAttribute failed\n"); grid = -1; return; }
#else
        if (hipFuncSetAttribute((const void*)fwd<0x1ff>, hipFuncAttributeMaxDynamicSharedMemorySize, LDS_BYTES) != hipSuccess) { fprintf(stderr, "kernel_launch: hipFuncSetAttribute failed\n"); grid = -1; return; }
        if (hipOccupancyMaxActiveBlocksPerMultiprocessor(&per_cu, (const void*)fwd<0x1ff>, NWAVES * 64, LDS_BYTES) != hipSuccess || per_cu < 1) fprintf(stderr, "kernel_launch: occupancy query reports %d workgroups per CU\n", per_cu);
#endif
        (void)hipGetLastError(); (void)per_cu;
        grid = cus;
    }
    if (grid < 0) return;
    if (hipMemsetAsync((char*)d_ws + WS_CTL, 0, CTL_ZERO_BYTES, stream) != hipSuccess) return;
    Args a{};
    for (int i = 0; i < 20; ++i) a.in[i] = (const float*)d_in[i];
    a.out = (float*)d_out; a.ws = (unsigned char*)d_ws;
#if MK_PER_PHASE
    for (int l = 0; l < DEPTH; ++l) for (int p = 0; p < NPH; ++p) { a.l_lo = l; a.l_hi = l + 1; a.ph_lo = p; a.ph_hi = p + 1;
        switch (p) {
            case 0: hipLaunchKernelGGL(fwd<1>, dim3(grid), dim3(NWAVES * 64), LDS_BYTES, stream, a); break;
            case 1: hipLaunchKernelGGL(fwd<2>, dim3(grid), dim3(NWAVES * 64), LDS_BYTES, stream, a); break;
            case 2: hipLaunchKernelGGL(fwd<4>, dim3(grid), dim3(NWAVES * 64), LDS_BYTES, stream, a); break;
            case 3: hipLaunchKernelGGL(fwd<8>, dim3(grid), dim3(NWAVES * 64), LDS_BYTES, stream, a); break;
            case 4: hipLaunchKernelGGL(fwd<16>, dim3(grid), dim3(NWAVES * 64), LDS_BYTES, stream, a); break;
            case 5: hipLaunchKernelGGL(fwd<32>, dim3(grid), dim3(NWAVES * 64), LDS_BYTES, stream, a); break;
            case 6: hipLaunchKernelGGL(fwd<64>, dim3(grid), dim3(NWAVES * 64), LDS_BYTES, stream, a); break;
            case 7: hipLaunchKernelGGL(fwd<128>, dim3(grid), dim3(NWAVES * 64), LDS_BYTES, stream, a); break;
            default: hipLaunchKernelGGL(fwd<256>, dim3(grid), dim3(NWAVES * 64), LDS_BYTES, stream, a); break;
        } }
#else
    a.l_lo = 0; a.l_hi = DEPTH; a.ph_lo = 0; a.ph_hi = NPH;
    hipLaunchKernelGGL(fwd<0x1ff>, dim3(grid), dim3(NWAVES * 64), LDS_BYTES, stream, a);
#endif
}
```

```cpp
#include <hip/hip_runtime.h>
#include <cstdio>
#include <cstdint>

#define WGT_LDS_OFF 139840
extern __shared__ __attribute__((aligned(16))) unsigned char lds[];
__device__ __forceinline__ unsigned wgt_slot() { return (unsigned)__builtin_amdgcn_s_getreg((5 << 11) | 4) & 63u; }
__device__ __forceinline__ int wg_lane() { int l; asm volatile("v_mbcnt_lo_u32_b32 %0, -1, 0\n\tv_mbcnt_hi_u32_b32 %0, -1, %0" : "=v"(l)); return l; }
__device__ __forceinline__ int wg_wave() { const volatile __attribute__((address_space(3))) unsigned* tab = (const volatile __attribute__((address_space(3))) unsigned*)((__attribute__((address_space(3))) unsigned char*)lds + WGT_LDS_OFF);
    return __builtin_amdgcn_readfirstlane((int)tab[wgt_slot()]); }
__device__ __forceinline__ int wg_tid() { return wg_wave() * 64 + wg_lane(); }
__device__ __forceinline__ float shflx(float v, int m) { return __builtin_bit_cast(float, __builtin_amdgcn_ds_bpermute((wg_lane() ^ m) << 2, __builtin_bit_cast(int, v))); }
__device__ __forceinline__ float shfl_from(float v, int src) { return __builtin_bit_cast(float, __builtin_amdgcn_ds_bpermute(src << 2, __builtin_bit_cast(int, v))); }
namespace pg8 {
#define PG8_LAS __attribute__((address_space(3)))
typedef unsigned short bf16_t;
typedef short bf16x8 __attribute__((ext_vector_type(8)));
typedef float f32x4 __attribute__((ext_vector_type(4)));
typedef unsigned u32x4 __attribute__((ext_vector_type(4)));
constexpr int BM = 256, BK = 64, HALF = 128, HTB = HALF * BK * 2  , STAGE_BYTES = 8 * HTB, NXCD = 8, WGM = 8;

__host__ __device__ __forceinline__ int lds_byte(int r, int c) { const int st = (r >> 4) * 2 + (c >> 5), rr = r & 15, cc = c & 31, ob = rr * 64 + cc * 2; return st * 1024 + (ob ^ (((ob >> 9) & 1) << 5)); }
__host__ __device__ __forceinline__ void stage_rc(int b, int& R, int& C) { const int st = b / 1024, sb = b % 1024, swz = sb ^ (((sb >> 9) & 1) << 5); R = (st >> 1) * 16 + swz / 64; C = (st & 1) * 32 + (swz % 64) / 2; }
__host__ __device__ __forceinline__ int perm32(int rho) { const int n = rho >> 4, i = rho & 15; return 8 * (i >> 2) + 4 * n + (i & 3); }

struct Unit { int pm, pn; };
struct Gemm { const bf16_t* A; const bf16_t* Bt; int M, N, K; };

struct StaticOrder {
    int nM, nN, nwg, G, c;
    __host__ __device__ void init(int M, int N, int G_, int c_) { nM = M / BM; nN = N / BM; nwg = nM * nN; G = G_; c = c_; }
    __host__ __device__ bool next(int i, Unit& u) const {
        const long L = (long)i * G + c; if (L >= nwg) return false;
        int wgid = (int)L; { const int q = nwg / NXCD, r = nwg % NXCD, xcd = wgid % NXCD, off = wgid / NXCD; wgid = (xcd < r ? xcd * (q + 1) : r * (q + 1) + (xcd - r) * q) + off; }
        const int nig = WGM * nN, gid = wgid / nig, fm = gid * WGM, gsz = (nM - fm) < WGM ? (nM - fm) : WGM;
        u.pm = fm + ((wgid % nig) % gsz); u.pn = (wgid % nig) / gsz; return true;
    }
    __device__ __forceinline__ void a_ready(const Unit&) const {}
    __device__ __forceinline__ void done(const Unit&) const {}
};


typedef float f32x2_t __attribute__((ext_vector_type(2))); typedef __bf16 bf16x2_t __attribute__((ext_vector_type(2)));
__device__ __forceinline__ unsigned cvt_pk_bf16(float lo, float hi) { const f32x2_t v = {lo, hi}; const bf16x2_t b = __builtin_convertvector(v, bf16x2_t); return __builtin_bit_cast(unsigned, b); }
__device__ __forceinline__ u32x4 pack8(const f32x4 a, const f32x4 b) { u32x4 w; w.x = cvt_pk_bf16(a[0], a[1]); w.y = cvt_pk_bf16(a[2], a[3]); w.z = cvt_pk_bf16(b[0], b[1]); w.w = cvt_pk_bf16(b[2], b[3]); return w; }
__device__ __forceinline__ float bflo(unsigned w) { return __builtin_bit_cast(float, w << 16); }
__device__ __forceinline__ float bfhi(unsigned w) { return __builtin_bit_cast(float, w & 0xffff0000u); }
__device__ __forceinline__ float fast_sigmoid(float x) { return __builtin_amdgcn_rcpf(1.f + __expf(-x)); }

__device__ __forceinline__ float row_rs(const float* ssp, int row) { const f32x4* q = (const f32x4*)(ssp + (size_t)row * 16); const f32x4 a = q[0], b = q[1], c = q[2], d = q[3];
    const f32x4 s = (a + b) + (c + d); return __builtin_amdgcn_rsqf(((s[0] + s[1]) + (s[2] + s[3])) * (1.f / 1024.f) + 1e-6f); }
__device__ __forceinline__ const PG8_LAS float* unit_row_scales(const float* ssp, PG8_LAS float* rsl, const Unit& u, int wr, int wc, int fr, int fq, int& cached_pm) {
    const int lane = fr + 16 * fq;
    PG8_LAS float* mine = rsl + (wr * 4 + wc) * 128;
    if (u.pm != cached_pm) {
        mine[lane] = row_rs(ssp, u.pm * BM + wr * 64 + lane); mine[64 + lane] = row_rs(ssp, u.pm * BM + HALF + wr * 64 + lane);
        asm volatile("s_waitcnt lgkmcnt(0)" ::: "memory");
        cached_pm = u.pm; }
    return mine;
}
constexpr float QSCALE = 0.125f * 1.4426950408889634f;

struct EpiIn {
    static constexpr bool PERM = true, AFTER_DRAIN = false;
    bf16_t *QA, *KA, *VA, *QB, *KB, *VB, *IQ, *IK; float* IW; bf16_t *CX, *CY, *GT;
    const float *gain_a, *gain_b, *gain_ik, *bgate, *rcos, *rsin;
    const float* ss;
    PG8_LAS float* rsl;
    mutable int rs_pm = -1;
    __device__ __forceinline__ void operator()(const f32x4 (&acc)[2][2][4][2], const Unit& u, int wr, int wc, int fr, int fq) const {
        const int pn = u.pn; int row0 = u.pm * BM + wr * 64 + fr; asm volatile("" : "+v"(row0));
        const PG8_LAS float* rsw = unit_row_scales(ss, rsl, u, wr, wc, fr, fq, rs_pm) + fr;
        if (pn >= 12) {
            const int gi = (pn - 12) >> 2, ct = ((pn - 12) & 3) * BM; unsigned char* base = (unsigned char*)GT + (size_t)gi * 32768 * 1024;
            const int col0 = ct + wc * 64 + 16 * fq; const float* bp = bgate + gi * 1024 + col0;
            f32x4 bv[2][2];
#pragma unroll
            for (int bj = 0; bj < 2; ++bj)
#pragma unroll
                for (int n = 0; n < 2; ++n) bv[bj][n] = *(const f32x4*)(bp + 8 * bj + 4 * n) * -1.4426950408889634f;
#pragma unroll
            for (int ai = 0; ai < 2; ++ai)
#pragma unroll
                for (int m = 0; m < 4; ++m) { unsigned char* rowp = base + (size_t)(row0 + ai * HALF + m * 16) * 1024 + col0; const float rs = rsw[ai * 64 + m * 16] * -1.4426950408889634f; u32x4 wq;
                    typedef float f32x2 __attribute__((ext_vector_type(2)));
                    const f32x2 rs2 = {rs, rs}, one2 = {1.f, 1.f}, k255 = {255.f, 255.f};
#pragma unroll
                    for (int bj = 0; bj < 2; ++bj) { unsigned w[2] = {0u, 0u};
#pragma unroll
                        for (int n = 0; n < 2; ++n)
#pragma unroll
                            for (int h2 = 0; h2 < 2; ++h2) { const f32x4 a4 = acc[ai][bj][m][n], b4 = bv[bj][n];
                                const f32x2 a2 = {a4[2 * h2], a4[2 * h2 + 1]}, b2 = {b4[2 * h2], b4[2 * h2 + 1]};
                                const f32x2 t = a2 * rs2 + b2; f32x2 ex = {__builtin_amdgcn_exp2f(t[0]), __builtin_amdgcn_exp2f(t[1])};
                                const f32x2 dn = ex + one2; f32x2 rc2 = {__builtin_amdgcn_rcpf(dn[0]), __builtin_amdgcn_rcpf(dn[1])};
                                f32x2 q = rc2 * k255; q[0] = __builtin_rintf(q[0]); q[1] = __builtin_rintf(q[1]); q = __builtin_elementwise_max(q, one2);
                                w[n] = __builtin_amdgcn_cvt_pk_u8_f32(q[0], 2 * h2, w[n]); w[n] = __builtin_amdgcn_cvt_pk_u8_f32(q[1], 2 * h2 + 1, w[n]); }
                        if (bj == 0) { wq.x = w[0]; wq.y = w[1]; } else { wq.z = w[0]; wq.w = w[1]; } }
                    *(u32x4*)rowp = wq; asm volatile("" ::: "memory"); }
            return;
        }
        if (pn >= 8) {
            bf16_t* base = (pn < 10) ? CX : CY; const int col0 = ((pn - 8) & 1) * BM + wc * 32 + 8 * fq;
#pragma unroll
            for (int ai = 0; ai < 2; ++ai)
#pragma unroll
                for (int m = 0; m < 4; ++m) { bf16_t* rowp = base + (size_t)(row0 + ai * HALF + m * 16) * 512 + col0; const float rs = rsw[ai * 64 + m * 16];
#pragma unroll
                    for (int bj = 0; bj < 2; ++bj) *(u32x4*)(rowp + bj * HALF) = pack8(acc[ai][bj][m][0] * rs, acc[ai][bj][m][1] * rs);
                    asm volatile("" ::: "memory"); }
            return;
        }
        bf16_t* dst; const float* gain = nullptr; bool do_norm = false, do_rope = false; float scale = 1.f; int pitch = 256;
        switch (pn) {
            case 0: dst = QA; gain = gain_a; do_norm = true; scale = QSCALE; break;
            case 1: dst = KA; gain = gain_a + 64; do_norm = true; break;
            case 2: dst = VA; break;
            case 3: dst = QB; gain = gain_b; do_norm = true; do_rope = true; scale = QSCALE; break;
            case 4: dst = KB; gain = gain_b + 64; do_norm = true; do_rope = true; break;
            case 5: dst = VB; break;
            case 6: dst = IQ; do_rope = true; break;
            default: dst = IK; gain = gain_ik; do_norm = true; do_rope = true; pitch = 64; break;
        }
        if (pn == 7) {
            if (wc == 1) {
                if (fq == 0) {
#pragma unroll
                    for (int ai = 0; ai < 2; ++ai)
#pragma unroll
                        for (int m = 0; m < 4; ++m) { const int row = row0 + ai * HALF + m * 16; *(f32x4*)(IW + (size_t)row * 4) = acc[ai][0][m][0] * (0.0625f * rsw[ai * 64 + m * 16]); }
                }
                return;
            }
            if (wc != 0) return;
        }
        f32x4 g[2][2];
#pragma unroll
        for (int bj = 0; bj < 2; ++bj)
#pragma unroll
            for (int n = 0; n < 2; ++n) g[bj][n] = do_norm ? *(const f32x4*)(gain + bj * 32 + 8 * fq + 4 * n) * scale : (f32x4){scale, scale, scale, scale};
        const int colb = (pn == 7 ? 0 : wc * 64) + 8 * fq;
        f32x4 rc[4];
        if (do_rope) { const int t = row0 & 4095; const float* cp = rcos + t * 32 + 8 * fq; const float* sp = rsin + t * 32 + 8 * fq; rc[0] = *(const f32x4*)cp; rc[1] = *(const f32x4*)(cp + 4); rc[2] = *(const f32x4*)sp; rc[3] = *(const f32x4*)(sp + 4); }
#pragma unroll
        for (int ai = 0; ai < 2; ++ai)
#pragma unroll
            for (int m = 0; m < 4; ++m) {
                const int row = row0 + ai * HALF + m * 16;
                const float rsx = rsw[ai * 64 + m * 16];
                f32x4 lo0 = acc[ai][0][m][0] * rsx, lo1 = acc[ai][0][m][1] * rsx, hi0 = acc[ai][1][m][0] * rsx, hi1 = acc[ai][1][m][1] * rsx;
                if (do_norm) {
                    f32x4 s4 = lo0 * lo0 + lo1 * lo1 + hi0 * hi0 + hi1 * hi1; float ss = (s4[0] + s4[1]) + (s4[2] + s4[3]);
                    ss += shflx(ss, 16); ss += shflx(ss, 32);
                    const float rs = __builtin_amdgcn_rsqf(ss * (1.f / 64.f) + 1e-6f);
                    lo0 = lo0 * rs; lo1 = lo1 * rs; hi0 = hi0 * rs; hi1 = hi1 * rs;
                }
                lo0 = lo0 * g[0][0]; lo1 = lo1 * g[0][1]; hi0 = hi0 * g[1][0]; hi1 = hi1 * g[1][1];
                if (do_rope) {
                    const f32x4 c0 = rc[0], c1 = rc[1], s0 = rc[2], s1 = rc[3];
                    const f32x4 a0 = lo0 * c0 - hi0 * s0, a1 = lo1 * c1 - hi1 * s1, b0 = hi0 * c0 + lo0 * s0, b1 = hi1 * c1 + lo1 * s1;
                    lo0 = a0; lo1 = a1; hi0 = b0; hi1 = b1;
                    const int nx = ai * 4 + m + 1;
                    if (nx < 8) { asm volatile("" : "+v"(lo0), "+v"(lo1), "+v"(hi0), "+v"(hi1));
                        const int t = (row0 + (nx >> 2) * HALF + (nx & 3) * 16) & 4095; const float* cp = rcos + t * 32 + 8 * fq; const float* sp = rsin + t * 32 + 8 * fq;
                        rc[0] = *(const f32x4*)cp; rc[1] = *(const f32x4*)(cp + 4); rc[2] = *(const f32x4*)sp; rc[3] = *(const f32x4*)(sp + 4); }
                }
                if (pn == 7) {
                    bf16_t* tp = dst + (size_t)(row >> 5) * 2048 + (fq >> 1) * 512 + ((fq & 1) * 32 + (row & 31)) * 8;
                    *(u32x4*)(tp) = pack8(lo0, lo1); *(u32x4*)(tp + 1024) = pack8(hi0, hi1);
                } else if (pn == 1 || pn == 4) {
                    bf16_t* tp = dst + ((size_t)(row >> 5) * 4 + wc) * 2048 + (fq >> 1) * 512 + ((fq & 1) * 32 + (row & 31)) * 8;
                    *(u32x4*)(tp) = pack8(lo0, lo1); *(u32x4*)(tp + 1024) = pack8(hi0, hi1);
                } else {
                    bf16_t* rowp = dst + (size_t)row * pitch + colb;
                    *(u32x4*)(rowp) = pack8(lo0, lo1); *(u32x4*)(rowp + 32) = pack8(hi0, hi1); }
                asm volatile("" ::: "memory");
            }
    }
};

struct EpiGate {
    static constexpr bool PERM = true, AFTER_DRAIN = false;
    bf16_t* MG; const bf16_t* G; bool first;
    __device__ __forceinline__ void operator()(const f32x4 (&acc)[2][2][4][2], const Unit& u, int wr, int wc, int fr, int fq) const {
        int row0 = u.pm * BM + wr * 64 + fr; const int col0 = u.pn * BM + wc * 32 + 8 * fq; asm volatile("" : "+v"(row0));
#pragma unroll
        for (int ai = 0; ai < 2; ++ai)
#pragma unroll
            for (int m = 0; m < 4; ++m) { const size_t off = (size_t)(row0 + ai * HALF + m * 16) * 1024 + col0;
#pragma unroll
                for (int bj = 0; bj < 2; ++bj) { const u32x4 gw = *(const u32x4*)(G + off + bj * HALF);
                    f32x4 v0 = acc[ai][bj][m][0], v1 = acc[ai][bj][m][1];
                    v0[0] *= bflo(gw.x); v0[1] *= bfhi(gw.x); v0[2] *= bflo(gw.y); v0[3] *= bfhi(gw.y); v1[0] *= bflo(gw.z); v1[1] *= bfhi(gw.z); v1[2] *= bflo(gw.w); v1[3] *= bfhi(gw.w);
                    if (!first) { const u32x4 ow = *(const u32x4*)(MG + off + bj * HALF);
                        v0[0] += bflo(ow.x); v0[1] += bfhi(ow.x); v0[2] += bflo(ow.y); v0[3] += bfhi(ow.y); v1[0] += bflo(ow.z); v1[1] += bfhi(ow.z); v1[2] += bflo(ow.w); v1[3] += bfhi(ow.w); }
                    *(u32x4*)(MG + off + bj * HALF) = pack8(v0, v1); asm volatile("" ::: "memory"); } }
    }
};

struct EpiResid {
    static constexpr bool PERM = true, AFTER_DRAIN = false;
    const float* xin; float* out; bf16_t* XB; float* ss;
    __device__ __forceinline__ void operator()(const f32x4 (&acc)[2][2][4][2], const Unit& u, int wr, int wc, int fr, int fq) const {
        int row0 = u.pm * BM + wr * 64 + fr; const int col0 = u.pn * BM + wc * 32 + 8 * fq; asm volatile("" : "+v"(row0));
#pragma unroll
        for (int ai = 0; ai < 2; ++ai)
#pragma unroll
            for (int m = 0; m < 4; ++m) { const int row = row0 + ai * HALF + m * 16; const size_t off = (size_t)row * 1024 + col0; float sq = 0.f;
#pragma unroll
                for (int bj = 0; bj < 2; ++bj) { const f32x4 r0 = *(const f32x4*)(xin + off + bj * HALF) + acc[ai][bj][m][0], r1 = *(const f32x4*)(xin + off + bj * HALF + 4) + acc[ai][bj][m][1];
                    *(f32x4*)(out + off + bj * HALF) = r0; *(f32x4*)(out + off + bj * HALF + 4) = r1;
                    if (XB) { *(u32x4*)(XB + off + bj * HALF) = pack8(r0, r1); const f32x4 q = r0 * r0 + r1 * r1; sq += (q[0] + q[1]) + (q[2] + q[3]); } }
                if (XB) { sq += shflx(sq, 16); sq += shflx(sq, 32); if (fq == 0) ss[(size_t)row * 16 + u.pn * 4 + wc] = sq; }
                asm volatile("" ::: "memory"); }
    }
};

struct EpiGateCat {
    static constexpr bool PERM = true, AFTER_DRAIN = false;
    bf16_t* MG; const bf16_t* G;
    __device__ __forceinline__ void mid(f32x4 (&acc)[2][2][4][2], const Unit& u, int kdone, int wr, int wc, int fr, int fq) const {
        if (kdone != 4 && kdone != 8) return;
        const unsigned char* Gp = (const unsigned char*)G + (size_t)(kdone == 4 ? 0 : 1) * 32768 * 1024; const unsigned char* Gn = Gp + (size_t)32768 * 1024;
        int row0 = u.pm * BM + wr * 64 + fr; const int col0 = u.pn * BM + wc * 32 + 8 * fq; asm volatile("" : "+v"(row0));
        {
            uint2 ga[2][4][2], gb[2][4][2];
#pragma unroll
            for (int ai = 0; ai < 2; ++ai)
#pragma unroll
                for (int mm = 0; mm < 4; ++mm)
#pragma unroll
                    for (int bj = 0; bj < 2; ++bj) { const size_t off = (size_t)(row0 + ai * HALF + mm * 16) * 1024 + col0 + bj * HALF; ga[ai][mm][bj] = *(const uint2*)(Gp + off); gb[ai][mm][bj] = *(const uint2*)(Gn + off); }
            asm volatile("" ::: "memory");
#pragma unroll
            for (int ai = 0; ai < 2; ++ai)
#pragma unroll
                for (int mm = 0; mm < 4; ++mm)
#pragma unroll
                    for (int bj = 0; bj < 2; ++bj) { const int m = mm; const uint2 a = ga[ai][mm][bj], b = gb[ai][mm][bj]; f32x4 r0, r1;
#pragma unroll
                        for (int e = 0; e < 4; ++e) { r0[e] = (float)((a.x >> (8 * e)) & 255u) * __builtin_amdgcn_rcpf((float)((b.x >> (8 * e)) & 255u)); r1[e] = (float)((a.y >> (8 * e)) & 255u) * __builtin_amdgcn_rcpf((float)((b.y >> (8 * e)) & 255u)); }
                        acc[ai][bj][m][0] = acc[ai][bj][m][0] * r0; acc[ai][bj][m][1] = acc[ai][bj][m][1] * r1; }
            asm volatile("" ::: "memory");
        }
    }
    __device__ __forceinline__ void operator()(const f32x4 (&acc)[2][2][4][2], const Unit& u, int wr, int wc, int fr, int fq) const {
        const unsigned char* G2 = (const unsigned char*)G + (size_t)2 * 32768 * 1024;
        int row0 = u.pm * BM + wr * 64 + fr; const int col0 = u.pn * BM + wc * 32 + 8 * fq; asm volatile("" : "+v"(row0));
#pragma unroll
        for (int ai = 0; ai < 2; ++ai) {
            uint2 gw[4][2];
#pragma unroll
            for (int m = 0; m < 4; ++m)
#pragma unroll
                for (int bj = 0; bj < 2; ++bj) gw[m][bj] = *(const uint2*)(G2 + (size_t)(row0 + ai * HALF + m * 16) * 1024 + col0 + bj * HALF);
            asm volatile("" ::: "memory");
#pragma unroll
            for (int m = 0; m < 4; ++m) { const size_t off = (size_t)(row0 + ai * HALF + m * 16) * 1024 + col0;
#pragma unroll
                for (int bj = 0; bj < 2; ++bj) { const uint2 g = gw[m][bj];
                    f32x4 v0 = acc[ai][bj][m][0], v1 = acc[ai][bj][m][1];
#pragma unroll
                    for (int e = 0; e < 4; ++e) { v0[e] *= (float)((g.x >> (8 * e)) & 255u) * (1.f / 255.f); v1[e] *= (float)((g.y >> (8 * e)) & 255u) * (1.f / 255.f); }
                    *(u32x4*)(MG + off + bj * HALF) = pack8(v0, v1); } }
            asm volatile("" ::: "memory"); }
    }
};

struct EpiResidB {
    static constexpr bool PERM = true, AFTER_DRAIN = false;
    bf16_t* XB; float* ss; float* out32;
    __device__ __forceinline__ void operator()(const f32x4 (&acc)[2][2][4][2], const Unit& u, int wr, int wc, int fr, int fq) const {
        int row0 = u.pm * BM + wr * 64 + fr; const int col0 = u.pn * BM + wc * 32 + 8 * fq; asm volatile("" : "+v"(row0));
#pragma unroll
        for (int ai = 0; ai < 2; ++ai) {
            u32x4 xw[4][2];
#pragma unroll
            for (int m = 0; m < 4; ++m)
#pragma unroll
                for (int bj = 0; bj < 2; ++bj) xw[m][bj] = *(const u32x4*)(XB + (size_t)(row0 + ai * HALF + m * 16) * 1024 + col0 + bj * HALF);
            asm volatile("" ::: "memory");
#pragma unroll
            for (int m = 0; m < 4; ++m) { const int row = row0 + ai * HALF + m * 16; const size_t off = (size_t)row * 1024 + col0; float sq = 0.f;
#pragma unroll
                for (int bj = 0; bj < 2; ++bj) { const u32x4 w = xw[m][bj];
                    f32x4 r0 = acc[ai][bj][m][0], r1 = acc[ai][bj][m][1];
                    r0[0] += bflo(w.x); r0[1] += bfhi(w.x); r0[2] += bflo(w.y); r0[3] += bfhi(w.y); r1[0] += bflo(w.z); r1[1] += bfhi(w.z); r1[2] += bflo(w.w); r1[3] += bfhi(w.w);
                    if (out32) { *(f32x4*)(out32 + off + bj * HALF) = r0; *(f32x4*)(out32 + off + bj * HALF + 4) = r1; }
                    else { *(u32x4*)(XB + off + bj * HALF) = pack8(r0, r1); const f32x4 q = r0 * r0 + r1 * r1; sq += (q[0] + q[1]) + (q[2] + q[3]); } }
                if (!out32) { sq += shflx(sq, 16); sq += shflx(sq, 32); if (fq == 0) ss[(size_t)row * 16 + u.pn * 4 + wc] = sq; } }
            asm volatile("" ::: "memory"); }
    }
};

struct EpiSwiGLU {
    static constexpr bool PERM = true, AFTER_DRAIN = false;
    bf16_t* ACT; const float* ss; PG8_LAS float* rsl;
    mutable int rs_pm = -1;
    __device__ __forceinline__ void operator()(const f32x4 (&acc)[2][2][4][2], const Unit& u, int wr, int wc, int fr, int fq) const {
        int row0 = u.pm * BM + wr * 64 + fr; const int col0 = u.pn * HALF + wc * 32 + 8 * fq; asm volatile("" : "+v"(row0));
        const PG8_LAS float* rsw = unit_row_scales(ss, rsl, u, wr, wc, fr, fq, rs_pm) + fr;
#pragma unroll
        for (int ai = 0; ai < 2; ++ai)
#pragma unroll
            for (int m = 0; m < 4; ++m) { f32x4 o[2]; const float rs = rsw[ai * 64 + m * 16];
                typedef float f32x2 __attribute__((ext_vector_type(2)));
                const f32x2 rs2 = {rs, rs}, nrs2 = {rs * -1.4426950408889634f, rs * -1.4426950408889634f}, one2 = {1.f, 1.f};
#pragma unroll
                for (int n = 0; n < 2; ++n)
#pragma unroll
                    for (int h2 = 0; h2 < 2; ++h2) { const f32x4 g4 = acc[ai][0][m][n], u4 = acc[ai][1][m][n];
                        const f32x2 ga = {g4[2 * h2], g4[2 * h2 + 1]}, ua = {u4[2 * h2], u4[2 * h2 + 1]};
                        const f32x2 t = ga * nrs2; const f32x2 ex = {__builtin_amdgcn_exp2f(t[0]), __builtin_amdgcn_exp2f(t[1])};
                        const f32x2 dn = ex + one2; const f32x2 rc2 = {__builtin_amdgcn_rcpf(dn[0]), __builtin_amdgcn_rcpf(dn[1])};
                        const f32x2 r = ((ga * rs2) * (ua * rs2)) * rc2; o[n][2 * h2] = r[0]; o[n][2 * h2 + 1] = r[1]; }
                *(u32x4*)(ACT + (size_t)(row0 + ai * HALF + m * 16) * 2816 + col0) = pack8(o[0], o[1]); asm volatile("" ::: "memory"); }
    }
};

template <class Epi, class Sched, bool ALIGN_EPI = false, bool SP2 = false, bool MIDHOOK = false>
__device__ __forceinline__ void gemm_phase(PG8_LAS unsigned char* lds, const Gemm g, const Sched& S, const Epi& E) {
    int tid_ = wg_tid(); asm volatile("" : "+v"(tid_));
    const int tid = tid_, wid = __builtin_amdgcn_readfirstlane(tid >> 6), lane = tid & 63, wr = wid >> 2, wc = wid & 3, fr = lane & 15, fq = lane >> 4;
    const int K = g.K, nt = K / BK;
    unsigned voffA[2], voffB[2];
#pragma unroll
    for (int i = 0; i < 2; ++i) { int R, C; stage_rc(tid * 16 + i * 8192, R, C); const int Rb = Epi::PERM ? ((R & ~31) + perm32(R & 31)) : R;
        voffA[i] = (unsigned)(R * K + C) * 2u; voffB[i] = (unsigned)(Rb * K + C) * 2u; }
    const size_t kstep = (size_t)(BK * 2);
    const size_t hstep = (size_t)HALF * K * 2;
    const size_t tstep = 2 * hstep;
    const unsigned ldsw = (unsigned)wid * 1024u;
    const int aoff = lds_byte(wr * 64 + fr, fq * 8), boff = lds_byte(wc * 32 + fr, fq * 8);
#define PG8_SA(b, h) (((b) * 2 + (h)) * HTB)
#define PG8_SB(b, h) ((4 + (b) * 2 + (h)) * HTB)
#define PG8_STAGE(bufoff, gbase, voff) do { _Pragma("unroll") for (int _i = 0; _i < 2; ++_i) \
        __builtin_amdgcn_global_load_lds((const unsigned*)((const char*)(gbase) + (voff)[_i]), (PG8_LAS unsigned*)(lds + (bufoff) + ldsw + _i * 8192), 16, 0, 0); } while (0)
#define PG8_LDA(dst, b, h) do { _Pragma("unroll") for (int m = 0; m < 4; ++m) _Pragma("unroll") for (int k = 0; k < 2; ++k) dst[m][k] = *(const PG8_LAS bf16x8*)(lds + PG8_SA(b, h) + aoff + m * 2048 + k * 1024); } while (0)
#define PG8_LDB(dst, b, h) do { _Pragma("unroll") for (int n = 0; n < 2; ++n) _Pragma("unroll") for (int k = 0; k < 2; ++k) dst[n][k] = *(const PG8_LAS bf16x8*)(lds + PG8_SB(b, h) + boff + n * 2048 + k * 1024); } while (0)
#define PG8_MMA(ai, bj, At, Bt) do { __builtin_amdgcn_s_setprio(1); _Pragma("unroll") for (int m = 0; m < 4; ++m) _Pragma("unroll") for (int n = 0; n < 2; ++n) _Pragma("unroll") for (int k = 0; k < 2; ++k) \
        acc[ai][bj][m][n] = __builtin_amdgcn_mfma_f32_16x16x32_bf16(Bt[n][k], At[m][k], acc[ai][bj][m][n], 0, 0, 0); __builtin_amdgcn_s_setprio(0); } while (0)
#define PG8_WAIT_V(n) asm volatile("s_waitcnt vmcnt(" #n ")" ::: "memory")
#define PG8_WAIT_L(n) asm volatile("s_waitcnt lgkmcnt(" #n ")" ::: "memory")
#define PG8_BAR __builtin_amdgcn_s_barrier()
#define PG8_SCHED __builtin_amdgcn_sched_barrier(0)
    Unit cur, nxt; int ui = 0;
    if (!S.next(0, cur)) return;
    f32x4 acc[2][2][4][2];
#pragma unroll
    for (int a = 0; a < 2; ++a)
#pragma unroll
        for (int b = 0; b < 2; ++b)
#pragma unroll
            for (int m = 0; m < 4; ++m)
#pragma unroll
                for (int n = 0; n < 2; ++n) acc[a][b][m][n] = (f32x4){0.f, 0.f, 0.f, 0.f};
    bf16x8 At[4][2], B0[2][2], B1[2][2];
    const char* cA = (const char*)g.A + (size_t)cur.pm * tstep; const char* cB = (const char*)g.Bt + (size_t)cur.pn * tstep;
    S.a_ready(cur);
    if constexpr (SP2) {
        PG8_STAGE(PG8_SB(0, 0), cB, voffB); PG8_STAGE(PG8_SB(0, 1), cB + hstep, voffB); PG8_STAGE(PG8_SA(0, 0), cA, voffA); PG8_STAGE(PG8_SA(0, 1), cA + hstep, voffA);
        if (wr == 1) PG8_BAR;
        PG8_WAIT_V(2); PG8_BAR;
        PG8_STAGE(PG8_SB(1, 0), cB + kstep, voffB); PG8_STAGE(PG8_SA(1, 0), cA + kstep, voffA); PG8_STAGE(PG8_SB(1, 1), cB + hstep + kstep, voffB);
        PG8_WAIT_V(6); PG8_BAR;
    } else {
        PG8_STAGE(PG8_SB(0, 0), cB, voffB); PG8_STAGE(PG8_SA(0, 0), cA, voffA); PG8_STAGE(PG8_SB(0, 1), cB + hstep, voffB); PG8_STAGE(PG8_SA(0, 1), cA + hstep, voffA);
        if (wr == 1) PG8_BAR;
        PG8_WAIT_V(4); PG8_BAR;
        PG8_STAGE(PG8_SB(1, 0), cB + kstep, voffB); PG8_STAGE(PG8_SA(1, 0), cA + kstep, voffA); PG8_STAGE(PG8_SB(1, 1), cB + hstep + kstep, voffB);
        PG8_WAIT_V(6); PG8_BAR;
    }
    for (;;) {
        const bool has_next = S.next(ui + 1, nxt);
        const char* nA = has_next ? (const char*)g.A + (size_t)nxt.pm * tstep : cA; const char* nB = has_next ? (const char*)g.Bt + (size_t)nxt.pn * tstep : cB;
        for (int t = 0; t < nt; t += 2) {
            const bool last = (t == nt - 2);
            const char* a1 = cA + (size_t)(t + 1) * kstep;
            const char* a2 = last ? nA : cA + (size_t)(t + 2) * kstep; const char* b2 = last ? nB : cB + (size_t)(t + 2) * kstep;
            const char* a3 = a2 + kstep; const char* b3 = b2 + kstep;
            if (last && has_next) S.a_ready(nxt);
            if constexpr (SP2) {
            PG8_LDB(B0, 0, 0); PG8_LDB(B1, 0, 1); PG8_SCHED; PG8_LDA(At, 0, 0); PG8_STAGE(PG8_SA(1, 1), a1 + hstep, voffA);
            PG8_WAIT_V(8); PG8_WAIT_L(0); PG8_BAR; PG8_MMA(0, 0, At, B0); PG8_MMA(0, 1, At, B1); PG8_BAR; PG8_SCHED;
            PG8_LDA(At, 0, 1); PG8_STAGE(PG8_SB(0, 0), b2, voffB); PG8_STAGE(PG8_SB(0, 1), b2 + hstep, voffB); PG8_STAGE(PG8_SA(0, 0), a2, voffA);
            PG8_WAIT_V(8); PG8_WAIT_L(0); PG8_BAR; PG8_MMA(1, 0, At, B0); PG8_MMA(1, 1, At, B1); PG8_BAR; PG8_SCHED;
            PG8_LDB(B0, 1, 0); PG8_LDB(B1, 1, 1); PG8_SCHED; PG8_LDA(At, 1, 0); PG8_STAGE(PG8_SA(0, 1), a2 + hstep, voffA);
            PG8_WAIT_V(8); PG8_WAIT_L(0); PG8_BAR; PG8_MMA(0, 0, At, B0); PG8_MMA(0, 1, At, B1); PG8_BAR; PG8_SCHED;
            PG8_LDA(At, 1, 1); PG8_STAGE(PG8_SB(1, 0), b3, voffB); PG8_STAGE(PG8_SB(1, 1), b3 + hstep, voffB); PG8_STAGE(PG8_SA(1, 0), a3, voffA);
            PG8_WAIT_V(8); PG8_WAIT_L(0); PG8_BAR; PG8_MMA(1, 0, At, B0); PG8_MMA(1, 1, At, B1); PG8_BAR; PG8_SCHED;
            } else {
            PG8_LDB(B0, 0, 0); PG8_SCHED; PG8_LDA(At, 0, 0); PG8_STAGE(PG8_SA(1, 1), a1 + hstep, voffA);
            PG8_WAIT_L(8); PG8_BAR; PG8_WAIT_L(0); PG8_MMA(0, 0, At, B0); PG8_BAR; PG8_SCHED;
            PG8_LDB(B1, 0, 1); PG8_STAGE(PG8_SB(0, 0), b2, voffB);
            PG8_BAR; PG8_WAIT_L(0); PG8_MMA(0, 1, At, B1); PG8_BAR;
            PG8_LDA(At, 0, 1); PG8_STAGE(PG8_SA(0, 0), a2, voffA);
            PG8_BAR; PG8_WAIT_L(0); PG8_MMA(1, 0, At, B0); PG8_BAR; PG8_SCHED;
            PG8_STAGE(PG8_SB(0, 1), b2 + hstep, voffB);
            PG8_WAIT_V(6); PG8_BAR; PG8_MMA(1, 1, At, B1); PG8_BAR;
            PG8_LDB(B0, 1, 0); PG8_SCHED; PG8_LDA(At, 1, 0); PG8_STAGE(PG8_SA(0, 1), a2 + hstep, voffA);
            PG8_WAIT_L(8); PG8_BAR; PG8_WAIT_L(0); PG8_MMA(0, 0, At, B0); PG8_BAR; PG8_SCHED;
            PG8_LDB(B1, 1, 1); PG8_STAGE(PG8_SB(1, 0), b3, voffB);
            PG8_BAR; PG8_WAIT_L(0); PG8_MMA(0, 1, At, B1); PG8_BAR;
            PG8_LDA(At, 1, 1); PG8_STAGE(PG8_SA(1, 0), a3, voffA);
            PG8_BAR; PG8_WAIT_L(0); PG8_MMA(1, 0, At, B0); PG8_BAR; PG8_SCHED;
            PG8_STAGE(PG8_SB(1, 1), b3 + hstep, voffB);
            PG8_WAIT_V(6); PG8_BAR; PG8_MMA(1, 1, At, B1); PG8_BAR;
            }
            if constexpr (MIDHOOK) E.mid(acc, cur, t + 2, wr, wc, fr, fq);
        }
        if constexpr (ALIGN_EPI) { if (wr == 0) PG8_BAR; }
        if constexpr (!Epi::AFTER_DRAIN) { E(acc, cur, wr, wc, fr, fq); S.done(cur); }
        if (!has_next) break;
#pragma unroll
        for (int a = 0; a < 2; ++a)
#pragma unroll
            for (int b = 0; b < 2; ++b)
#pragma unroll
                for (int m = 0; m < 4; ++m)
#pragma unroll
                    for (int n = 0; n < 2; ++n) acc[a][b][m][n] = (f32x4){0.f, 0.f, 0.f, 0.f};
        cur = nxt; cA = nA; cB = nB; ++ui;
        if constexpr (ALIGN_EPI) { if (wr == 1) PG8_BAR; }
    }
    PG8_WAIT_V(0);
    if constexpr (!ALIGN_EPI) { if (wr == 0) PG8_BAR; }
    PG8_BAR;
    if constexpr (Epi::AFTER_DRAIN) { E.fused(acc, cur, wr, wc, fr, fq, lds, wid, lane); S.done(cur); }
#undef PG8_SA
#undef PG8_SB
#undef PG8_STAGE
#undef PG8_LDA
#undef PG8_LDB
#undef PG8_MMA
#undef PG8_WAIT_V
#undef PG8_WAIT_L
#undef PG8_BAR
#undef PG8_SCHED
}
}

constexpr int NWAVES = 8;
#ifndef MK_PER_PHASE
#define MK_PER_PHASE 0
#endif
#ifndef PG8_SP2
#define PG8_SP2 true
#endif
#ifndef PG8_ALIGN
#define PG8_ALIGN true
#endif

constexpr int BATCH = 8, SEQ = 4096, D = 1024, DEPTH = 4, M = BATCH * SEQ;
constexpr int NIN = 6144, DIN = 5956, FF = 2816, NF1 = 2 * FF;
constexpr int NPH = 9;
constexpr float EPS = 1e-6f, LOG2E = 1.4426950408889634f;

constexpr size_t MiB = 1u << 20;
constexpr size_t WS_CTL = 0, CTL_ZERO_BYTES = 1 * MiB;
constexpr size_t WS_ROPE = 1 * MiB;
constexpr size_t WS_SS = 494 * MiB;
constexpr size_t WS_W = 4 * MiB;
constexpr size_t WO_IN = 0, WO_BA = 12 * MiB, WO_BB = WO_BA + MiB / 2, WO_BC = WO_BB + MiB / 2, WO_OUT = WO_BC + MiB, WO_F1 = WO_OUT + 2 * MiB, WO_F2 = WO_F1 + 11 * MiB;
constexpr size_t WS_H = 40 * MiB;
constexpr size_t WS_YC = WS_H;
constexpr size_t WS_QA = 104 * MiB, WS_QB = 120 * MiB, WS_KA = 136 * MiB, WS_VA = 152 * MiB, WS_KB = 168 * MiB, WS_VB = 184 * MiB, WS_IQ = 200 * MiB;
constexpr size_t WS_MG = WS_KA;
constexpr size_t WS_IK = 216 * MiB, WS_IW = 220 * MiB;
constexpr size_t WS_CX = 222 * MiB, WS_CY = 254 * MiB;
constexpr size_t WS_GT = 286 * MiB;
constexpr size_t WS_ACT = WS_GT;
constexpr size_t WS_MASK = 478 * MiB;
constexpr size_t WS_END = 510 * MiB;
constexpr int CW_TMO = 0, CW_CODE = 1, CW_BAR = 4096;

constexpr int RING_OFF = 0, RING_BYTES = 131072;
constexpr int XTRA_OFF = RING_BYTES, XTRA_BYTES = 8192;
constexpr int LDSCTL_OFF = XTRA_OFF + XTRA_BYTES, MISC_OFF = LDSCTL_OFF + 320;
constexpr int LDS_BYTES = 147456;
static_assert(MISC_OFF + 128 <= LDS_BYTES, "LDS map");

#define GAS __attribute__((address_space(1)))
#define LAS __attribute__((address_space(3)))
typedef unsigned short bf16;
typedef unsigned v4u __attribute__((ext_vector_type(4)));
typedef float f32x4 __attribute__((ext_vector_type(4)));
typedef short bf16x8 __attribute__((ext_vector_type(8)));
typedef GAS unsigned gu32;
typedef unsigned long long u64;
#define RLX_AGENT __ATOMIC_RELAXED, __HIP_MEMORY_SCOPE_AGENT
#define LDS_WAIT() asm volatile("s_waitcnt lgkmcnt(0)" ::: "memory")
#define VM_WAIT() asm volatile("s_waitcnt vmcnt(0)" ::: "memory")
__device__ __forceinline__ unsigned f2bf(float f) { unsigned u = __builtin_bit_cast(unsigned, f); return (u + 0x7fffu + ((u >> 16) & 1u)) >> 16; }
__device__ __forceinline__ unsigned pk2(float lo, float hi) { return f2bf(lo) | (f2bf(hi) << 16); }
__device__ __forceinline__ float bf2f(bf16 v) { return __builtin_bit_cast(float, (unsigned)v << 16); }
__device__ __forceinline__ float bflo(unsigned w) { return __builtin_bit_cast(float, w << 16); }
__device__ __forceinline__ float bfhi(unsigned w) { return __builtin_bit_cast(float, w & 0xffff0000u); }
__device__ __forceinline__ float wave_sum(float v) {
#pragma unroll
    for (int o = 1; o < 64; o <<= 1) v += shflx(v, o);
    return v;
}
__device__ __forceinline__ float wave_max(float v) {
#pragma unroll
    for (int o = 1; o < 64; o <<= 1) v = fmaxf(v, shflx(v, o));
    return v;
}
#define XB_TMO      128
#define XB_XCNT(j)  (256  + 64 * (j))
#define XB_XSUB(j)  (1280 + 64 * (j))
#define XB_XGEN(j)  (2304 + 64 * (j))
#define XB_TOP      3328
#define XB_TOPGEN   3392
#define XCD_BAR_WORDS 3456
#define XB_SPIN_CAP (1u << 27)

__device__ __forceinline__ unsigned xb_ld(unsigned* p)              { return __hip_atomic_load(p, __ATOMIC_RELAXED, __HIP_MEMORY_SCOPE_AGENT); }
__device__ __forceinline__ unsigned xb_add(unsigned* p, unsigned v) { return __hip_atomic_fetch_add(p, v, __ATOMIC_RELAXED, __HIP_MEMORY_SCOPE_AGENT); }
__device__ __forceinline__ unsigned xb_xcc_id() { return (unsigned)__builtin_amdgcn_s_getreg((3 << 11) | 20) & 0xFu; }
#define XB_SPIN(cond, bar) do { unsigned _sp = 0; while (cond) { __builtin_amdgcn_s_sleep(1); \
    if ((++_sp & 255u) == 0u) { if (xb_ld(&(bar)[XB_TMO])) break; if (_sp > XB_SPIN_CAP) { atomicAdd(&(bar)[XB_TMO], 1u); break; } } } } while (0)

struct XcdBarrier {
    unsigned* bar; unsigned x;
    volatile LAS unsigned* st;
};

__device__ __forceinline__ XcdBarrier xcd_barrier_post(unsigned* bar, volatile LAS unsigned* st) {
    XcdBarrier b; b.bar = bar; b.x = xb_xcc_id(); b.st = st;
    if (wg_tid() == 0) (void)xb_add(&bar[XB_XCNT(b.x)], 1u);
    return b;
}
__device__ __forceinline__ void xcd_barrier_complete(unsigned* bar, unsigned x, unsigned& nloc, unsigned& nx) {
    const unsigned G = gridDim.x * gridDim.y * gridDim.z;
    unsigned sum, cnt, mine, sp = 0u;
    for (;;) {
        sum = 0u; cnt = 0u; mine = 0u;
#pragma unroll
        for (unsigned j = 0; j < 16; ++j) { const unsigned c = xb_ld(&bar[XB_XCNT(j)]); sum += c; cnt += (c > 0u) ? 1u : 0u; mine = (j == x) ? c : mine; }
        if (sum == G) break;
        __builtin_amdgcn_s_sleep(1);
        if ((++sp & 255u) == 0u) { if (xb_ld(&bar[XB_TMO])) break; if (sp > XB_SPIN_CAP) { atomicAdd(&bar[XB_TMO], 1u); break; } }
    }
    nloc = mine > 0u ? mine : 1u; nx = cnt > 0u ? cnt : 1u;
}

__device__ __forceinline__ void xcd_barrier(const XcdBarrier& b) {
    asm volatile("s_waitcnt vmcnt(0)" ::: "memory");
    __syncthreads();
    if (wg_tid() == 0) {
        unsigned* bar = b.bar;
        __builtin_amdgcn_s_waitcnt(0);
        unsigned nloc = b.st[0], nx = b.st[1];
        if (nloc == 0u) { xcd_barrier_complete(bar, b.x, nloc, nx); b.st[0] = nloc; b.st[1] = nx; }
        const unsigned old = xb_add(&bar[XB_XSUB(b.x)], 1u);
        const unsigned gen = old / nloc;
        if (old + 1u == (gen + 1u) * nloc) {
            __builtin_amdgcn_fence(__ATOMIC_RELEASE, "agent");
            asm volatile("s_waitcnt vmcnt(0)" ::: "memory");
            const unsigned og = xb_add(&bar[XB_TOP], 1u);
            const unsigned tg = og / nx;
            if (og + 1u == (tg + 1u) * nx) xb_add(&bar[XB_TOPGEN], 1u);
            else XB_SPIN(xb_ld(&bar[XB_TOPGEN]) == tg, bar);
            __builtin_amdgcn_fence(__ATOMIC_ACQUIRE, "agent");
            xb_add(&bar[XB_XGEN(b.x)], 1u);
            asm volatile("s_waitcnt vmcnt(0)" ::: "memory");
        } else {
            XB_SPIN(xb_ld(&bar[XB_XGEN(b.x)]) == gen, bar);
            __builtin_amdgcn_fence(__ATOMIC_ACQUIRE, "agent");
            asm volatile("s_waitcnt vmcnt(0)" ::: "memory");
        }
    }
    __syncthreads();
}

struct Frame {
    LAS unsigned char* lds;
    volatile LAS unsigned* MISC;
    gu32* ctl;
    int tid, lane, wave, G;
    const float* x; float* out;
    const float *g_mix, *w_in, *qk_gain_a, *rel_bias, *qk_gain_b, *g_idx_k, *conv_w, *conv_b, *lru_wa, *lru_ba, *lru_wx, *lru_bx, *lru_lambda, *b_gate, *w_branch, *w_out, *g_ffn, *w_ffn_in, *w_ffn_out;
    float *rcos, *rsin, *SS;
    bf16 *W, *H, *YC, *YCAT, *QA, *QB, *KA, *VA, *KB, *VB, *IQ, *IK, *CX, *CY, *GT, *ACT, *MG; float* IW; u64* MASK;
    bf16 *W2a, *W2b;
};
struct WSet { bf16 *in, *ba, *out, *f1, *f2; };
__device__ __forceinline__ WSet wset(const Frame& F, int l) {
    WSet w;
    if (l & 1) { w.in = F.W + WO_IN / 2; w.ba = F.W + WO_BA / 2; w.out = F.W + WO_OUT / 2; w.f1 = F.W + WO_F1 / 2; w.f2 = F.W + WO_F2 / 2; }
    else { w.in = F.W2a; w.ba = F.W2a + (12 * MiB) / 2; w.out = F.W2a + (14 * MiB) / 2; w.f1 = F.W2b; w.f2 = F.W2b + (11 * MiB) / 2; }
    return w;
}

__device__ __forceinline__ void cvt_item(const float* W, int ldw, int k0, int n_src0, int nvalid, bf16* WT, int dpitch, int drow0, LAS float* scr, int lane, const float* gk = nullptr, bool s16 = false) {
    { const int col4 = (lane & 7) * 4; f32x4 v[8];
#pragma unroll
      for (int i = 0; i < 8; ++i) { const int kk = 8 * i + (lane >> 3); v[i] = (col4 < nvalid) ? *(const GAS f32x4*)(W + (size_t)(k0 + kk) * ldw + n_src0 + (s16 ? 16 * (col4 >> 3) + (col4 & 7) : col4)) : (f32x4){0.f, 0.f, 0.f, 0.f}; }
#pragma unroll
      for (int i = 0; i < 8; ++i) { const int kk = 8 * i + (lane >> 3); LAS float* d = scr + kk * 33 + col4; const float gg = gk ? gk[k0 + kk] : 1.f; d[0] = v[i].x * gg; d[1] = v[i].y * gg; d[2] = v[i].z * gg; d[3] = v[i].w * gg; } }
    LDS_WAIT(); asm volatile("" ::: "memory");
    const int c = lane & 7;
#pragma unroll
    for (int j = 0; j < 4; ++j) { const int n = (lane >> 3) + 8 * j; const LAS float* s = scr + (8 * c) * 33 + n;
        v4u o; o.x = pk2(s[0 * 33], s[1 * 33]); o.y = pk2(s[2 * 33], s[3 * 33]); o.z = pk2(s[4 * 33], s[5 * 33]); o.w = pk2(s[6 * 33], s[7 * 33]);
        *(GAS v4u*)(WT + (size_t)(drow0 + n) * dpitch + k0 + 8 * c) = o; }
    LDS_WAIT(); asm volatile("" ::: "memory");
}
__device__ __forceinline__ void phase_xb0(Frame& F, const float* xin, float* ss) {
    const int gw = blockIdx.x * NWAVES + F.wave, NGW = F.G * NWAVES;
    for (int m = gw; m < M; m += NGW) { const GAS f32x4* xr = (const GAS f32x4*)(xin + (size_t)m * D) + F.lane; f32x4 v[4]; float s = 0.f;
#pragma unroll
        for (int j = 0; j < 4; ++j) { v[j] = xr[64 * j]; s += (v[j].x * v[j].x + v[j].y * v[j].y) + (v[j].z * v[j].z + v[j].w * v[j].w); }
        s = wave_sum(s); if (F.lane < 16) ss[(size_t)m * 16 + F.lane] = (F.lane == 0) ? s : 0.f;
        GAS u64* o8 = (GAS u64*)(F.H + (size_t)m * D) + F.lane;
#pragma unroll
        for (int j = 0; j < 4; ++j) o8[64 * j] = (u64)pk2(v[j].x, v[j].y) | ((u64)pk2(v[j].z, v[j].w) << 32); }
}
__device__ __forceinline__ void phase_weights(Frame& F, int l, unsigned* queue = nullptr) {
    LAS float* scr = (LAS float*)(F.lds + RING_OFF + F.wave * 16384);
    const int gw = blockIdx.x * NWAVES + F.wave, NGW = F.G * NWAVES;
    const float* w_in = F.w_in + (size_t)l * D * DIN; const float* w_br = F.w_branch + (size_t)l * D * D; const float* w_out = F.w_out + (size_t)l * D * D;
    const float* w_f1 = F.w_ffn_in + (size_t)l * D * NF1; const float* w_f2 = F.w_ffn_out + (size_t)l * FF * D;
    const WSet WS = wset(F, l);
    constexpr int I_IN = 16 * 192, I_BA = 4 * 32, I_BB = 4 * 32, I_BC = 8 * 32, I_OUT = 16 * 32, I_F1 = 16 * 176, I_F2 = 44 * 32;
    constexpr int NITEMS = I_IN + I_BA + I_BB + I_BC + I_OUT + I_F1 + I_F2;
    for (int it0 = gw;; it0 += NGW) {
        int it = it0;
        if (queue) { unsigned v = 0u; if (F.lane == 0) v = __hip_atomic_fetch_add(queue, 1u, __ATOMIC_RELAXED, __HIP_MEMORY_SCOPE_AGENT); it = __builtin_amdgcn_readfirstlane((int)v); }
        if (it >= NITEMS) break;
        int r = it;
        if (r < I_IN) { const int kb = r / 192, ng = r % 192, pn = ng >> 3, grp = ng & 7, bj = grp >> 2, hh = grp & 3; int src = 0, nv = 32;
            if (pn < 7) src = pn * 256 + 64 * hh + 32 * bj;
            else if (pn == 7) { if (hh == 0) src = 1792 + 32 * bj; else if (grp == 1) { src = 1856; nv = 4; } else nv = 0; }
            else if (pn < 12) src = 1860 + (pn - 8) * 256 + grp * 32;
            else src = 2884 + (pn - 12) * 256 + 64 * hh + 8 * bj;
            cvt_item(w_in, DIN, kb * 64, src, nv, WS.in, D, ng * 32, scr, F.lane, F.g_mix + l * D, pn >= 12); continue; } r -= I_IN;
        if (r < I_BA + I_BB + I_BC) { const int kb = r / 32, ng = r % 32; cvt_item(w_br, D, kb * 64, ng * 32, 32, WS.ba, D, ng * 32, scr, F.lane); continue; } r -= I_BA + I_BB + I_BC;
        if (r < I_OUT) { const int kb = r / 32, ng = r % 32; cvt_item(w_out, D, kb * 64, ng * 32, 32, WS.out, D, ng * 32, scr, F.lane); continue; } r -= I_OUT;
        if (r < I_F1) { const int kb = r / 176, ng = r % 176, pn = ng >> 3, grp = ng & 7, bj = grp >> 2; const int src = FF * bj + 128 * pn + (grp & 3) * 32;
            cvt_item(w_f1, NF1, kb * 64, src, 32, WS.f1, D, ng * 32, scr, F.lane, F.g_ffn + l * D); continue; } r -= I_F1;
        { const int kb = r / 32, ng = r % 32; cvt_item(w_f2, D, kb * 64, ng * 32, 32, WS.f2, FF, ng * 32, scr, F.lane); }
    }
    if (l == 0) {
        for (int i = blockIdx.x * 512 + F.tid; i < SEQ * 32; i += F.G * 512) { const int pos = i >> 5, k = i & 31;
            const float inv = exp2f(-(float)k * 0.41524101186092029f); const float ang = (float)pos * inv;
            F.rcos[i] = cosf(ang); F.rsin[i] = sinf(ang); }
    }
}

__device__ __forceinline__ void naive_attn_a(Frame& F, int l) {
    LAS float* bias_s = (LAS float*)F.lds;
    LAS float* qs = (LAS float*)F.lds + 320 + F.wave * 640;
    LAS float* ps = qs + 64;
    const int lane = F.lane;
    for (int u = blockIdx.x; u < BATCH * 4 * 64; u += F.G) {
        const int c = u & 63, h = (u >> 6) & 3, b = u >> 8;
        __syncthreads();
        for (int i = F.tid; i < 257; i += 512) bias_s[i] = F.rel_bias[(l * 4 + h) * 257 + i] * LOG2E;
        __syncthreads();
        const int kc0 = (c - 8 > 0) ? c - 8 : 0; const int nk = (c - kc0 + 1) * 64;
        for (int qi = 0; qi < 8; ++qi) {
            const int t = c * 64 + F.wave * 8 + qi; const size_t row = (size_t)b * SEQ + t;
            qs[lane] = bf2f(F.QA[row * 256 + h * 64 + lane]);
            LDS_WAIT();
            float s[9]; float mx = -INFINITY;
#pragma unroll
            for (int jj = 0; jj < 9; ++jj) { const int j = jj * 64 + lane; s[jj] = -INFINITY;
                if (j < nk) { const size_t krow = (size_t)b * SEQ + kc0 * 64 + j; const v4u* kp = (const v4u*)(F.KA + krow * 256 + h * 64); float dot = 0.f;
#pragma unroll
                    for (int i8 = 0; i8 < 8; ++i8) { const v4u kw = kp[i8]; const LAS float* q = qs + i8 * 8;
                        dot += q[0] * bflo(kw.x) + q[1] * bfhi(kw.x) + q[2] * bflo(kw.y) + q[3] * bfhi(kw.y) + q[4] * bflo(kw.z) + q[5] * bfhi(kw.z) + q[6] * bflo(kw.w) + q[7] * bfhi(kw.w); }
                    int rel = t - (kc0 * 64 + j); rel = rel < -128 ? -128 : (rel > 128 ? 128 : rel);
                    s[jj] = dot + bias_s[rel + 128]; }
                mx = fmaxf(mx, s[jj]); }
            mx = wave_max(mx); float sum = 0.f;
#pragma unroll
            for (int jj = 0; jj < 9; ++jj) { const int j = jj * 64 + lane; if (j < nk) { const float p = exp2f(s[jj] - mx); sum += p; ps[j] = p; } }
            sum = wave_sum(sum);
            LDS_WAIT();
            float o = 0.f; const bf16* vp = F.VA + ((size_t)b * SEQ + kc0 * 64) * 256 + h * 64 + lane;
            for (int j = 0; j < nk; ++j) o += ps[j] * bf2f(vp[(size_t)j * 256]);
            F.QA[row * 256 + h * 64 + lane] = (bf16)f2bf(o / sum);
            LDS_WAIT();
        }
    }
}
__device__ __forceinline__ unsigned fkey(float f) { const unsigned u = __builtin_bit_cast(unsigned, f); return (u & 0x80000000u) ? ~u : (u | 0x80000000u); }
__device__ __forceinline__ void naive_idx(Frame& F) {
    LAS float* sc = (LAS float*)F.lds + F.wave * 4096;
    LAS float* qs = (LAS float*)(F.lds + XTRA_OFF) + F.wave * 256;
    const int lane = F.lane;
    for (int u = blockIdx.x; u < BATCH * 512; u += F.G) {
        const int b = u >> 9, t = (u & 511) * 8 + F.wave; const size_t row = (size_t)b * SEQ + t; const int nw = (t >> 6) + 1;
        { const unsigned* qp = (const unsigned*)(F.IQ + row * 256) + lane * 2; const unsigned w0 = qp[0], w1 = qp[1];
          qs[4 * lane] = bflo(w0); qs[4 * lane + 1] = bfhi(w0); qs[4 * lane + 2] = bflo(w1); qs[4 * lane + 3] = bfhi(w1); }
        const f32x4 wv = *(const f32x4*)(F.IW + row * 4);
        LDS_WAIT();
        for (int jj = 0; jj < nw; ++jj) { const int j = jj * 64 + lane; const v4u* kp = (const v4u*)(F.IK + ((size_t)b * SEQ + j) * 64);
            float d0 = 0.f, d1 = 0.f, d2 = 0.f, d3 = 0.f;
#pragma unroll
            for (int i8 = 0; i8 < 8; ++i8) { const v4u kw = kp[i8]; float kf[8] = {bflo(kw.x), bfhi(kw.x), bflo(kw.y), bfhi(kw.y), bflo(kw.z), bfhi(kw.z), bflo(kw.w), bfhi(kw.w)};
#pragma unroll
                for (int e = 0; e < 8; ++e) { const int d = i8 * 8 + e; d0 += qs[d] * kf[e]; d1 += qs[64 + d] * kf[e]; d2 += qs[128 + d] * kf[e]; d3 += qs[192 + d] * kf[e]; } }
            float s = 0.f; s += wv[0] * fmaxf(d0, 0.f); s += wv[1] * fmaxf(d1, 0.f); s += wv[2] * fmaxf(d2, 0.f); s += wv[3] * fmaxf(d3, 0.f); s += 0.0f;
            sc[j] = s; }
        LDS_WAIT();
        u64* mrow = F.MASK + row * 64;
        if (nw <= 4) { if (lane < nw) { unsigned o1 = ~0u, o2 = ~0u; asm volatile("" : "+v"(o1), "+v"(o2)); ((unsigned*)mrow)[2 * lane] = o1; ((unsigned*)mrow)[2 * lane + 1] = o2; } }
        else {
            unsigned prefix = 0u;
            for (int bit = 31; bit >= 0; --bit) { const unsigned cand = prefix | (1u << bit); int cnt = 0;
                for (int jj = 0; jj < nw; ++jj) cnt += __popcll(__ballot(fkey(sc[jj * 64 + lane]) >= cand));
                if (cnt >= 256) prefix = cand; }
            int n_gt = 0;
            for (int jj = 0; jj < nw; ++jj) n_gt += __popcll(__ballot(fkey(sc[jj * 64 + lane]) > prefix));
            const int allowed = 256 - n_gt; int running = 0; const u64 lt = (1ull << lane) - 1ull;
            for (int jj = 0; jj < nw; ++jj) { const unsigned key = fkey(sc[jj * 64 + lane]); const bool gt = key > prefix, eq = key == prefix; const u64 eqb = __ballot(eq);
                const int rank = running + __popcll(eqb & lt); const bool sel = gt || (eq && rank < allowed); running += __popcll(eqb);
                const u64 w = __ballot(sel); if (lane == 0) mrow[jj] = w; }
        }
        LDS_WAIT();
    }
}
__device__ __forceinline__ void naive_sparse(Frame& F) {
    LAS int* list = (LAS int*)F.lds + F.wave * 256;
    LAS float* ps = (LAS float*)F.lds + 2048 + F.wave * 256;
    LAS float* qs = (LAS float*)F.lds + 4096 + F.wave * 64;
    const int lane = F.lane; const u64 lt = (1ull << lane) - 1ull;
    for (int u = blockIdx.x; u < BATCH * 512; u += F.G) {
        const int b = u >> 9, t = (u & 511) * 8 + F.wave; const size_t row = (size_t)b * SEQ + t; const int nw = (t >> 6) + 1;
        int running = 0;
        for (int jj = 0; jj < nw; ++jj) { const u64 w = F.MASK[row * 64 + jj]; if ((w >> lane) & 1ull) list[running + __popcll(w & lt)] = jj * 64 + lane; running += __popcll(w); }
        const int nsel = running < 256 ? running : 256;
        LDS_WAIT();
        for (int h = 0; h < 4; ++h) {
            qs[lane] = bf2f(F.QB[row * 256 + h * 64 + lane]);
            LDS_WAIT();
            float s[4]; float mx = -INFINITY;
#pragma unroll
            for (int e = 0; e < 4; ++e) { const int idx = e * 64 + lane; s[e] = -INFINITY;
                if (idx < nsel) { const int j = list[idx]; const v4u* kp = (const v4u*)(F.KB + ((size_t)b * SEQ + j) * 256 + h * 64); float dot = 0.f;
#pragma unroll
                    for (int i8 = 0; i8 < 8; ++i8) { const v4u kw = kp[i8]; const LAS float* q = qs + i8 * 8;
                        dot += q[0] * bflo(kw.x) + q[1] * bfhi(kw.x) + q[2] * bflo(kw.y) + q[3] * bfhi(kw.y) + q[4] * bflo(kw.z) + q[5] * bfhi(kw.z) + q[6] * bflo(kw.w) + q[7] * bfhi(kw.w); }
                    s[e] = dot; }
                mx = fmaxf(mx, s[e]); }
            mx = wave_max(mx); float sum = 0.f;
#pragma unroll
            for (int e = 0; e < 4; ++e) { const int idx = e * 64 + lane; if (idx < nsel) { const float p = exp2f(s[e] - mx); sum += p; ps[idx] = p; } }
            sum = wave_sum(sum);
            LDS_WAIT();
            float o = 0.f;
            for (int i = 0; i < nsel; ++i) o += ps[i] * bf2f(F.VB[((size_t)b * SEQ + list[i]) * 256 + h * 64 + lane]);
            F.QB[row * 256 + h * 64 + lane] = (bf16)f2bf(o / sum);
            LDS_WAIT();
        }
    }
}
__device__ __forceinline__ float gelu_tanh(float x) { return 0.5f * x * (1.f + tanhf(0.7978845608028654f * (x + 0.044715f * x * x * x))); }
__device__ __forceinline__ void naive_lru(Frame& F, int l) {
    LAS float* wa_s = (LAS float*)F.lds; LAS float* wx_s = wa_s + 4096; LAS float* us = wx_s + 4096; LAS float* as = us + 64 * 65; LAS float* gs = as + 4096;
    const int tid = F.tid, lane = F.lane;
    for (int u = blockIdx.x; u < 64; u += F.G) {
        const int b = u >> 3, g = u & 7;
        __syncthreads();
        for (int i = tid; i < 4096; i += 512) { wa_s[i] = F.lru_wa[(size_t)(l * 8 + g) * 4096 + i]; wx_s[i] = F.lru_wx[(size_t)(l * 8 + g) * 4096 + i]; }
        float h = 0.f;
        for (int tile = 0; tile < 64; ++tile) {
            __syncthreads();
            { const int tok = tid >> 3, t = tile * 64 + tok;
#pragma unroll
              for (int e = 0; e < 8; ++e) { const int ch = (tid & 7) * 8 + e, cg = g * 64 + ch; float acc = F.conv_b[l * 512 + cg];
#pragma unroll
                  for (int j = 0; j < 4; ++j) { const int tt = t - 3 + j; if (tt >= 0) acc += F.conv_w[(l * 4 + j) * 512 + cg] * bf2f(F.CX[((size_t)b * SEQ + tt) * 512 + cg]); }
                  us[tok * 65 + ch] = acc; } }
            __syncthreads();
            { const int tok = tid & 63, og = tid >> 6;
              for (int o = 0; o < 8; ++o) { const int cc = 8 * og + o, cg = g * 64 + cc; float ra = 0.f, rx = 0.f;
                  for (int k = 0; k < 64; ++k) { const float uv = us[tok * 65 + k]; ra += uv * wa_s[k * 64 + cc]; rx += uv * wx_s[k * 64 + cc]; }
                  const float r = 1.f / (1.f + expf(-(ra + F.lru_ba[l * 512 + cg]))), ig = 1.f / (1.f + expf(-(rx + F.lru_bx[l * 512 + cg])));
                  const float sp = log1pf(expf(-F.lru_lambda[l * 512 + cg])); const float log_a = -8.0f * r * sp;
                  as[tok * 64 + cc] = expf(log_a); gs[tok * 64 + cc] = sqrtf(-expm1f(2.f * log_a)) * (ig * us[tok * 65 + cc]); } }
            __syncthreads();
            if (F.wave == 0) {
                for (int tok = 0; tok < 64; ++tok) { h = as[tok * 64 + lane] * h + gs[tok * 64 + lane]; const size_t row = (size_t)b * SEQ + tile * 64 + tok;
                    const float cy = bf2f(F.CY[row * 512 + g * 64 + lane]); F.YC[row * 512 + g * 64 + lane] = (bf16)f2bf(h * gelu_tanh(cy)); }
            }
        }
    }
}


typedef float f32x16 __attribute__((ext_vector_type(16)));
typedef short s16x4 __attribute__((ext_vector_type(4)));
typedef float f32x2v __attribute__((ext_vector_type(2)));
typedef __bf16 bf16x2v __attribute__((ext_vector_type(2)));
__device__ __forceinline__ unsigned cvtpk(float lo, float hi) { const f32x2v v = {lo, hi}; const bf16x2v b = __builtin_convertvector(v, bf16x2v); return __builtin_bit_cast(unsigned, b); }
__device__ __forceinline__ int crow(int r, int hi) { return (r & 3) + 8 * (r >> 2) + 4 * hi; }
__device__ __forceinline__ s16x4 vtr(const LAS unsigned char* p) { return __builtin_bit_cast(s16x4, __builtin_amdgcn_ds_read_tr16_b64_v4i16((LAS s16x4*)p)); }

template <int MODE> __device__ __forceinline__ void flash_wave(int b, int h, int qblk, const bf16* Q, const bf16* K, const bf16* V, bf16* Y, LAS unsigned char* vl, const LAS float* bias_s, const u64* MASK, int lane) {
    asm volatile("" : "+v"(lane));
    const int r32 = lane & 31, hi = lane >> 5; const size_t row0 = (size_t)b * SEQ + (size_t)qblk * 32; const int c = qblk >> 1;
    bf16x8 qr[4];
#pragma unroll
    for (int d0 = 0; d0 < 4; ++d0) qr[d0] = *(const bf16x8*)(Q + (row0 + r32) * 256 + h * 64 + d0 * 16 + hi * 8);
    const int kb_lo = (MODE == 0) ? ((c > 8 ? c - 8 : 0) * 2) : 0, kb_hi = (c + 1) * 2;
    f32x16 o0, o1;
#pragma unroll
    for (int r = 0; r < 16; ++r) { o0[r] = 0.f; o1[r] = 0.f; }
    float m = -1e30f, lsum = 0.f; const int tq = qblk * 32 + r32;
    const LAS unsigned char* vrd = vl + ((lane >> 4) & 1) * 32 + (lane & 3) * 8 + (4 * hi + ((lane & 15) >> 2)) * 64;
    unsigned mword = 0, mnext = 0;
    const unsigned* M32 = (const unsigned*)MASK + (size_t)(b * 64 + c) * (128 * 64) + (qblk & 1) * 32 + r32;
    const bf16* Kt = K + ((size_t)b * 128 * 4 + h) * 2048 + lane * 8;
    bf16x8 kfn[4]; v4u vvn[4];
    { const size_t krow0 = (size_t)b * SEQ + (size_t)kb_lo * 32;
#pragma unroll
      for (int d0 = 0; d0 < 4; ++d0) kfn[d0] = *(const bf16x8*)(Kt + (size_t)kb_lo * 8192 + d0 * 512);
#pragma unroll
      for (int i = 0; i < 4; ++i) { const int c16 = i * 64 + lane, key = c16 >> 3, dch = c16 & 7; vvn[i] = *(const v4u*)(V + (krow0 + key) * 256 + h * 64 + dch * 8); }
      if (MODE == 1) mnext = M32[kb_lo * 64]; }
    for (int kb = kb_lo; kb < kb_hi; ++kb) {
        bf16x8 kf[4]; v4u vv[4];
#pragma unroll
        for (int d0 = 0; d0 < 4; ++d0) kf[d0] = kfn[d0];
#pragma unroll
        for (int i = 0; i < 4; ++i) vv[i] = vvn[i];
        if (MODE == 1) mword = mnext;
        if (kb + 1 < kb_hi) { const size_t krow1 = (size_t)b * SEQ + (size_t)(kb + 1) * 32;
#pragma unroll
            for (int d0 = 0; d0 < 4; ++d0) kfn[d0] = *(const bf16x8*)(Kt + (size_t)(kb + 1) * 8192 + d0 * 512);
#pragma unroll
            for (int i = 0; i < 4; ++i) { const int c16 = i * 64 + lane, key = c16 >> 3, dch = c16 & 7; vvn[i] = *(const v4u*)(V + (krow1 + key) * 256 + h * 64 + dch * 8); }
            if (MODE == 1) mnext = M32[(kb + 1) * 64]; }
#pragma unroll
        for (int i = 0; i < 4; ++i) { const int c16 = i * 64 + lane, key = c16 >> 3, dch = c16 & 7; *(LAS v4u*)(vl + (dch >> 2) * 2048 + (key >> 4) * 1024 + (key & 15) * 64 + (dch & 3) * 16) = vv[i]; }
        f32x16 p;
#pragma unroll
        for (int r = 0; r < 16; ++r) p[r] = 0.f;
#pragma unroll
        for (int d0 = 0; d0 < 4; ++d0) p = __builtin_amdgcn_mfma_f32_32x32x16_bf16(kf[d0], qr[d0], p, 0, 0, 0);
        if (MODE == 0) {
#pragma unroll
            for (int r = 0; r < 16; ++r) { int rel = tq - (kb * 32 + crow(r, hi)); rel = rel < -128 ? -128 : (rel > 128 ? 128 : rel); p[r] += bias_s[rel + 128]; }
        } else {
            const unsigned bits = mword >> (4 * hi);
#pragma unroll
            for (int r = 0; r < 16; ++r) p[r] = ((bits >> ((r & 3) + 8 * (r >> 2))) & 1u) ? p[r] : -INFINITY;
        }
        float bm = p[0];
#pragma unroll
        for (int r = 1; r < 16; ++r) bm = fmaxf(bm, p[r]);
        bm = fmaxf(bm, shflx(bm, 32));
        const float mn = fmaxf(m, bm), alpha = exp2f(m - mn); m = mn;
        float rs = 0.f;
#pragma unroll
        for (int r = 0; r < 16; ++r) { p[r] = exp2f(p[r] - mn); rs += p[r]; }
        lsum = lsum * alpha + rs;
#pragma unroll
        for (int r = 0; r < 16; ++r) { o0[r] *= alpha; o1[r] *= alpha; }
        bf16x8 pa[2];
#pragma unroll
        for (int s = 0; s < 2; ++s) { v4u w; w.x = cvtpk(p[8 * s], p[8 * s + 1]); w.y = cvtpk(p[8 * s + 2], p[8 * s + 3]); w.z = cvtpk(p[8 * s + 4], p[8 * s + 5]); w.w = cvtpk(p[8 * s + 6], p[8 * s + 7]); pa[s] = __builtin_bit_cast(bf16x8, w); }
#pragma unroll
        for (int s = 0; s < 2; ++s) {
            const s16x4 a_lo = vtr(vrd + s * 1024), a_hi = vtr(vrd + s * 1024 + 512), b_lo = vtr(vrd + 2048 + s * 1024), b_hi = vtr(vrd + 2048 + s * 1024 + 512);
            const bf16x8 va = {a_lo[0], a_lo[1], a_lo[2], a_lo[3], a_hi[0], a_hi[1], a_hi[2], a_hi[3]}, vb = {b_lo[0], b_lo[1], b_lo[2], b_lo[3], b_hi[0], b_hi[1], b_hi[2], b_hi[3]};
            o0 = __builtin_amdgcn_mfma_f32_32x32x16_bf16(va, pa[s], o0, 0, 0, 0); o1 = __builtin_amdgcn_mfma_f32_32x32x16_bf16(vb, pa[s], o1, 0, 0, 0);
        }
    }
    lsum += shflx(lsum, 32); const float inv = 1.f / lsum;
    bf16* yrow = Y + (row0 + r32) * 1024 + h * 64 + 4 * hi;
#pragma unroll
    for (int g4 = 0; g4 < 4; ++g4) {
        uint2 w0, w1; w0.x = cvtpk(o0[4 * g4] * inv, o0[4 * g4 + 1] * inv); w0.y = cvtpk(o0[4 * g4 + 2] * inv, o0[4 * g4 + 3] * inv); w1.x = cvtpk(o1[4 * g4] * inv, o1[4 * g4 + 1] * inv); w1.y = cvtpk(o1[4 * g4 + 2] * inv, o1[4 * g4 + 3] * inv);
        *(uint2*)(yrow + 8 * g4) = w0; *(uint2*)(yrow + 32 + 8 * g4) = w1; }
}

template <int MODE, bool FIXM, bool SPLIT = false> __device__ __forceinline__ void flash_wave2(int b, int h, int c, const bf16* Q, const bf16* K, const bf16* V, bf16* Y, LAS unsigned char* vl, const LAS float* bias_s, const u64* MASK, int lane, float mfix,
        int kb0 = -1, int kb1 = -1, int part = 0, LAS float* cmb = nullptr) {
    asm volatile("" : "+v"(lane));
    const int r32 = lane & 31, hi = lane >> 5; const size_t row0 = (size_t)b * SEQ + (size_t)c * 64;
    bf16x8 qr[2][4];
#pragma unroll
    for (int z = 0; z < 2; ++z)
#pragma unroll
        for (int d0 = 0; d0 < 4; ++d0) qr[z][d0] = *(const bf16x8*)(Q + (row0 + 32 * z + r32) * 256 + h * 64 + d0 * 16 + hi * 8);
    const int kb_lo = SPLIT ? kb0 : ((MODE == 0) ? ((c > 8 ? c - 8 : 0) * 2) : 0), kb_hi = SPLIT ? kb1 : (c + 1) * 2;
    f32x16 o[2][2];
#pragma unroll
    for (int z = 0; z < 2; ++z)
#pragma unroll
        for (int r = 0; r < 16; ++r) { o[z][0][r] = 0.f; o[z][1][r] = 0.f; }
    float m[2] = {-1e30f, -1e30f}, lsum[2] = {0.f, 0.f};
    const LAS unsigned char* vrd = vl + ((lane >> 4) & 1) * 32 + (lane & 3) * 8 + (4 * hi + ((lane & 15) >> 2)) * 64;
    unsigned mword[2] = {0, 0}, mnext[2] = {0, 0};
    constexpr int KSTEP = SPLIT ? 2 : 1;
    const unsigned* M32 = (const unsigned*)MASK + (size_t)(b * 64 + c) * (128 * 64) + r32;
    const bf16* Kt = K + ((size_t)b * 128 * 4 + h) * 2048 + lane * 8;
    const char* Kc = (const char*)K + ((size_t)b * 512 + h) * 4096; const unsigned kvo = (unsigned)lane * 16u;
    const char* Vc = (const char*)V + (size_t)h * 128; const unsigned vvo = (unsigned)(lane >> 3) * 512u + (unsigned)(lane & 7) * 16u;
    if (MODE == 1) { mword[0] = M32[kb_lo * 64]; mword[1] = M32[kb_lo * 64 + 32]; }
    const int kb_last = kb_lo + ((kb_hi - 1 - kb_lo) / KSTEP) * KSTEP;
    bf16x8 kfn[4];
#pragma unroll
    for (int d0 = 0; d0 < 4; ++d0) kfn[d0] = *(const bf16x8*)(Kc + (size_t)kb_lo * 16384 + kvo + d0 * 1024);
    for (int kb = kb_lo; kb < kb_hi; kb += KSTEP) {
        bf16x8 kf[4]; v4u vv[4];
#pragma unroll
        for (int d0 = 0; d0 < 4; ++d0) kf[d0] = kfn[d0];
        const bool mfetch = (MODE == 1) && kb + KSTEP < kb_hi;
        if (mfetch) { mnext[0] = M32[(kb + KSTEP) * 64]; mnext[1] = M32[(kb + KSTEP) * 64 + 32]; }
        { const int k1 = kb + KSTEP <= kb_last ? kb + KSTEP : kb_last;
          const size_t krowc = (size_t)b * SEQ + (size_t)kb * 32;
#pragma unroll
          for (int i = 0; i < 4; ++i) vv[i] = *(const v4u*)(Vc + krowc * 512 + (size_t)i * 4096 + vvo);
#pragma unroll
          for (int d0 = 0; d0 < 4; ++d0) kfn[d0] = *(const bf16x8*)(Kc + (size_t)k1 * 16384 + kvo + d0 * 1024); }
        const bool farblk = (MODE == 0) && (c * 64 - (kb * 32 + 31) >= 128);
        const float bfar = (MODE == 0) ? bias_s[256] : 0.f;
        bf16x8 pa[2][2];
#pragma unroll
        for (int z = 0; z < 2; ++z) {
            f32x16 p;
#pragma unroll
            for (int r = 0; r < 16; ++r) p[r] = FIXM ? -mfix : ((MODE == 0 && farblk) ? bfar : 0.f);
#pragma unroll
            for (int d0 = 0; d0 < 4; ++d0) p = __builtin_amdgcn_mfma_f32_32x32x16_bf16(kf[d0], qr[z][d0], p, 0, 0, 0);
            if (MODE == 0 && !farblk) { const int tq = c * 64 + 32 * z + r32;
#pragma unroll
                for (int r = 0; r < 16; ++r) { int rel = tq - (kb * 32 + crow(r, hi)); rel = rel < -128 ? -128 : (rel > 128 ? 128 : rel); p[r] += bias_s[rel + 128]; }
            }
            const unsigned bits = (MODE == 1) ? (mword[z] >> (4 * hi)) : 0u;
            float rs = 0.f;
            if (FIXM) {
#pragma unroll
                for (int r = 0; r < 16; ++r) { const float e = __builtin_amdgcn_exp2f(p[r]); if (MODE == 1) { unsigned mk; asm("v_bfe_i32 %0, %1, %2, 1" : "=v"(mk) : "v"(bits), "n"((r & 3) + 8 * (r >> 2))); p[r] = __builtin_bit_cast(float, __builtin_bit_cast(unsigned, e) & mk); } else p[r] = e; rs += p[r]; }
            } else {
                if (MODE == 1) {
#pragma unroll
                    for (int r = 0; r < 16; ++r) p[r] = ((bits >> ((r & 3) + 8 * (r >> 2))) & 1u) ? p[r] : -INFINITY;
                }
                float bm = p[0];
#pragma unroll
                for (int r = 1; r < 16; ++r) bm = fmaxf(bm, p[r]);
                bm = fmaxf(bm, shflx(bm, 32));
                const float mn = fmaxf(m[z], bm);
                if (__any(mn != m[z])) {
                    const float alpha = __builtin_amdgcn_exp2f(m[z] - mn); lsum[z] *= alpha;
#pragma unroll
                    for (int r = 0; r < 16; ++r) { o[z][0][r] *= alpha; o[z][1][r] *= alpha; }
                    m[z] = mn; }
#pragma unroll
                for (int r = 0; r < 16; ++r) { p[r] = __builtin_amdgcn_exp2f(p[r] - mn); rs += p[r]; }
            }
            lsum[z] += rs;
#pragma unroll
            for (int s = 0; s < 2; ++s) { v4u w; w.x = cvtpk(p[8 * s], p[8 * s + 1]); w.y = cvtpk(p[8 * s + 2], p[8 * s + 3]); w.z = cvtpk(p[8 * s + 4], p[8 * s + 5]); w.w = cvtpk(p[8 * s + 6], p[8 * s + 7]); pa[z][s] = __builtin_bit_cast(bf16x8, w); }
        }
        asm volatile("" : "+v"(pa[0][0]), "+v"(pa[0][1]), "+v"(pa[1][0]), "+v"(pa[1][1]) :: "memory");
#pragma unroll
        for (int i = 0; i < 4; ++i) { const int c16 = i * 64 + lane, key = c16 >> 3, dch = c16 & 7; *(LAS v4u*)(vl + (dch >> 2) * 2048 + (key >> 4) * 1024 + (key & 15) * 64 + (dch & 3) * 16) = vv[i]; }
#pragma unroll
        for (int s = 0; s < 2; ++s) {
            const s16x4 a_lo = vtr(vrd + s * 1024), a_hi = vtr(vrd + s * 1024 + 512), b_lo = vtr(vrd + 2048 + s * 1024), b_hi = vtr(vrd + 2048 + s * 1024 + 512);
            const bf16x8 va = {a_lo[0], a_lo[1], a_lo[2], a_lo[3], a_hi[0], a_hi[1], a_hi[2], a_hi[3]}, vb = {b_lo[0], b_lo[1], b_lo[2], b_lo[3], b_hi[0], b_hi[1], b_hi[2], b_hi[3]};
#pragma unroll
            for (int z = 0; z < 2; ++z) { o[z][0] = __builtin_amdgcn_mfma_f32_32x32x16_bf16(va, pa[z][s], o[z][0], 0, 0, 0); o[z][1] = __builtin_amdgcn_mfma_f32_32x32x16_bf16(vb, pa[z][s], o[z][1], 0, 0, 0); }
        }
        if (mfetch) { mword[0] = mnext[0]; mword[1] = mnext[1]; }
    }
    if constexpr (SPLIT) {
        if (part == 1) {
#pragma unroll
            for (int z = 0; z < 2; ++z) {
#pragma unroll
                for (int r = 0; r < 16; ++r) { cmb[((z * 2 + 0) * 16 + r) * 64 + lane] = o[z][0][r]; cmb[((z * 2 + 1) * 16 + r) * 64 + lane] = o[z][1][r]; }
                cmb[4096 + z * 64 + lane] = lsum[z]; } }
        __syncthreads();
        if (part == 2) {
#pragma unroll
            for (int z = 0; z < 2; ++z) {
#pragma unroll
                for (int r = 0; r < 16; ++r) { o[z][0][r] += cmb[((z * 2 + 0) * 16 + r) * 64 + lane]; o[z][1][r] += cmb[((z * 2 + 1) * 16 + r) * 64 + lane]; }
                lsum[z] += cmb[4096 + z * 64 + lane]; } }
        __syncthreads();
        if (part == 1) return;
    }
#pragma unroll
    for (int z = 0; z < 2; ++z) {
        const float lt = lsum[z] + shflx(lsum[z], 32); const float inv = 1.f / lt;
        bf16* yrow = Y + (row0 + 32 * z + r32) * 1024 + h * 64 + 4 * hi;
#pragma unroll
        for (int g4 = 0; g4 < 4; ++g4) {
            uint2 w0, w1; w0.x = cvtpk(o[z][0][4 * g4] * inv, o[z][0][4 * g4 + 1] * inv); w0.y = cvtpk(o[z][0][4 * g4 + 2] * inv, o[z][0][4 * g4 + 3] * inv); w1.x = cvtpk(o[z][1][4 * g4] * inv, o[z][1][4 * g4 + 1] * inv); w1.y = cvtpk(o[z][1][4 * g4 + 2] * inv, o[z][1][4 * g4 + 3] * inv);
            *(uint2*)(yrow + 8 * g4) = w0; *(uint2*)(yrow + 32 + 8 * g4) = w1; }
    }
}
__device__ __forceinline__ void phase_attn_a(Frame& F, int l) {
    LAS float* bias_s = (LAS float*)(F.lds + 32768);
    LAS unsigned char* vl = F.lds + F.wave * 4096;
    __syncthreads();
    for (int i = F.tid; i < 4 * 257; i += 512) bias_s[(i / 257) * 260 + (i % 257)] = F.rel_bias[(size_t)l * 4 * 257 + i] * LOG2E;
    __syncthreads();
    for (int u = blockIdx.x * 8 + F.wave; u < BATCH * 4 * 64; u += F.G * 8) { const int wgi = u >> 3; const int b = wgi & 7, h = (wgi >> 3) & 3, c = (wgi >> 5) * 8 + (u & 7);
        flash_wave2<0, false>(b, h, c, F.QA, F.KA, F.VA, F.YCAT, vl, bias_s + h * 260, nullptr, F.lane, 0.f); }
}
__device__ __forceinline__ void phase_attn_b(Frame& F, int l) {
    LAS unsigned char* vl = F.lds + F.wave * 4096;
    __syncthreads();
    float gq = fabsf(F.qk_gain_b[l * 128 + F.lane]), gk = fabsf(F.qk_gain_b[l * 128 + 64 + F.lane]); gq = wave_max(gq); gk = wave_max(gk);
    const float mfix = 64.f * gq * gk * pg8::QSCALE; const bool fixm = mfix < 40.f;
    for (int wg = blockIdx.x; wg < 256; wg += F.G) { const int b = wg & 7, jc = wg >> 3, w = F.wave; const int h = w & 3;
        if (fixm) {
            LAS float* cmb = (LAS float*)(F.lds + 32768) + h * 4224;
#pragma unroll 1
            for (int ci = 0; ci < 2; ++ci) { const int c = ci ? jc : 63 - jc, half = w >> 2;
                flash_wave2<1, true, true>(b, h, c, F.QB, F.KB, F.VB, F.YCAT + 256, vl, nullptr, F.MASK, F.lane, mfix, half, 2 * (c + 1), half ? 1 : 2, cmb); }
        } else { const int c = (w & 4) ? 63 - jc : jc;
#pragma unroll 1
            for (int z = 0; z < 2; ++z) flash_wave<1>(b, h, 2 * c + z, F.QB, F.KB, F.VB, F.YCAT + 256, vl, nullptr, F.MASK, F.lane); } }
}

__device__ __forceinline__ float dpp_quad_sum(float v) {
    int x = __builtin_bit_cast(int, v); float a = v + __builtin_bit_cast(float, __builtin_amdgcn_update_dpp(0, x, 0xB1, 0xF, 0xF, false));
    x = __builtin_bit_cast(int, a); return a + __builtin_bit_cast(float, __builtin_amdgcn_update_dpp(0, x, 0x4E, 0xF, 0xF, false));
}
__device__ __forceinline__ int wave_sum_dpp(int x) {
    x += __builtin_amdgcn_update_dpp(0, x, 0x111, 0xF, 0xF, true); x += __builtin_amdgcn_update_dpp(0, x, 0x112, 0xF, 0xF, true);
    x += __builtin_amdgcn_update_dpp(0, x, 0x114, 0xF, 0xF, true); x += __builtin_amdgcn_update_dpp(0, x, 0x118, 0xF, 0xF, true);
    x += __builtin_amdgcn_update_dpp(0, x, 0x142, 0xA, 0xF, false); x += __builtin_amdgcn_update_dpp(0, x, 0x143, 0xC, 0xF, false);
    return __builtin_amdgcn_readlane(x, 63);
}
__device__ __forceinline__ int wave_scan_dpp(int x) {
    x += __builtin_amdgcn_update_dpp(0, x, 0x111, 0xF, 0xF, true); x += __builtin_amdgcn_update_dpp(0, x, 0x112, 0xF, 0xF, true);
    x += __builtin_amdgcn_update_dpp(0, x, 0x114, 0xF, 0xF, true); x += __builtin_amdgcn_update_dpp(0, x, 0x118, 0xF, 0xF, true);
    x += __builtin_amdgcn_update_dpp(0, x, 0x142, 0xA, 0xF, false); x += __builtin_amdgcn_update_dpp(0, x, 0x143, 0xC, 0xF, false);
    return x;
}
#define TK_CNT1(acc, key, cand) asm("v_cmp_ge_u32 vcc, %1, %2\n\tv_addc_co_u32 %0, vcc, 0, %0, vcc" : "+v"(acc) : "v"(key), "v"(cand) : "vcc")
template <int N> __device__ __forceinline__ int lane_count_ge(const unsigned (&k)[N], unsigned cand) {
    int c0 = 0, c1 = 0, c2 = 0, c3 = 0;
#pragma unroll
    for (int i = 0; i < N; ++i) { if ((i & 3) == 0) TK_CNT1(c0, k[i], cand); else if ((i & 3) == 1) TK_CNT1(c1, k[i], cand); else if ((i & 3) == 2) TK_CNT1(c2, k[i], cand); else TK_CNT1(c3, k[i], cand); }
    return (c0 + c1) + (c2 + c3);
}
__device__ __forceinline__ unsigned wave_max_dpp(unsigned x) {
    x = max(x, (unsigned)__builtin_amdgcn_update_dpp(0, (int)x, 0x111, 0xF, 0xF, true)); x = max(x, (unsigned)__builtin_amdgcn_update_dpp(0, (int)x, 0x112, 0xF, 0xF, true));
    x = max(x, (unsigned)__builtin_amdgcn_update_dpp(0, (int)x, 0x114, 0xF, 0xF, true)); x = max(x, (unsigned)__builtin_amdgcn_update_dpp(0, (int)x, 0x118, 0xF, 0xF, true));
    x = max(x, (unsigned)__builtin_amdgcn_update_dpp((int)x, (int)x, 0x142, 0xA, 0xF, false)); x = max(x, (unsigned)__builtin_amdgcn_update_dpp((int)x, (int)x, 0x143, 0xC, 0xF, false));
    return (unsigned)__builtin_amdgcn_readlane((int)x, 63);
}
template <int N> __device__ __forceinline__ void bisect_keys(const unsigned (&k)[N], int target, unsigned& prefix, bool& exact, unsigned prefix0 = 0u, int bit0 = 31) {
    prefix = prefix0; exact = false;
    for (int bit = bit0; bit >= 0; --bit) { const unsigned cand = prefix | (1u << bit);
        const int cnt = wave_sum_dpp(lane_count_ge<N>(k, cand));
        if (cnt >= target) { prefix = cand; if (cnt == target) { exact = true; break; } } }
}
template <int NR> __device__ __forceinline__ void topk_core(const unsigned (&k)[NR], int nw, unsigned* mrow, int lane, LAS unsigned* cbuf) {
    unsigned prefix = 0u; bool exact = false, have = false;
    if constexpr (NR >= 32) {
        constexpr int NS = NR / 8; unsigned ks[NS];
#pragma unroll
        for (int j = 0; j < NS; ++j) ks[j] = k[4 + 8 * j];
        const int ns = (nw + 3) >> 3, rs = (352 * ns + nw - 1) / nw;
        unsigned L; bool exs; bisect_keys<NS>(ks, rs, L, exs);
        const int cl = lane_count_ge<NR>(k, L), incl = wave_scan_dpp(cl), C = __builtin_amdgcn_readlane(incl, 63);
        if (C >= 256 && C <= 512) {
            int off = incl - cl;
#pragma unroll
            for (int i = 0; i < NR; ++i) { const bool in = k[i] >= L; cbuf[in ? off : 512 + lane] = k[i]; off += in ? 1 : 0; }
            unsigned kc[8];
#pragma unroll
            for (int j = 0; j < 8; ++j) kc[j] = cbuf[j * 64 + lane];
            asm volatile("" ::: "memory");
#pragma unroll
            for (int j = 0; j < 8; ++j) kc[j] = (j * 64 + lane < C) ? kc[j] : 0u;
            unsigned kmx = kc[0];
#pragma unroll
            for (int j = 1; j < 8; ++j) kmx = max(kmx, kc[j]);
            kmx = wave_max_dpp(kmx);
            const unsigned dx = L ^ kmx; const int hb = dx ? 31 - __builtin_clz(dx) : -1;
            bisect_keys<8>(kc, 256, prefix, exact, hb >= 31 ? 0u : ((L >> (hb + 1)) << (hb + 1)), hb);
            if (exact && prefix < L) prefix = L;
            have = true;
        }
    }
    if (!have) bisect_keys<NR>(k, 256, prefix, exact);
    int wlo = 0, whi = 0;
    if (exact) {
#pragma unroll
        for (int i = 0; i < NR; ++i) { const u64 w = __ballot(k[i] >= prefix); asm("s_nop 1\n\tv_writelane_b32 %0, %2, %4\n\tv_writelane_b32 %1, %3, %4" : "+v"(wlo), "+v"(whi) : "s"((unsigned)w), "s"((unsigned)(w >> 32)), "n"(i)); }
    } else {
        int n_gt = 0;
#pragma unroll
        for (int i = 0; i < NR; ++i) n_gt += __popcll(__ballot(k[i] > prefix));
        const int allowed = 256 - n_gt; int running = 0; const u64 lt = (1ull << lane) - 1ull;
#pragma unroll
        for (int i = 0; i < NR; ++i) { const bool gt = k[i] > prefix, eq = k[i] == prefix; const u64 eqb = __ballot(eq); const int rank = running + __popcll(eqb & lt); running += __popcll(eqb);
            const u64 w = __ballot(gt || (eq && rank < allowed)); asm("s_nop 1\n\tv_writelane_b32 %0, %2, %4\n\tv_writelane_b32 %1, %3, %4" : "+v"(wlo), "+v"(whi) : "s"((unsigned)w), "s"((unsigned)(w >> 32)), "n"(i)); }
    }
    if (lane < nw) { mrow[(2 * lane) * 64] = (unsigned)wlo; mrow[(2 * lane + 1) * 64] = (unsigned)whi; }
}
constexpr int SCP = 2052;
__device__ __forceinline__ void idx_scores16(const bf16* IK, LAS unsigned* sc, int b, int t_lo, int t_hi, int wave, int lane, const bf16x8 (&qf)[2][4], const f32x4 (&wq)[2][4]) {
    asm volatile("" : "+v"(lane));
    const int r32 = lane & 31, hi = lane >> 5;
    const bf16* kbase = IK + (size_t)b * (SEQ * 64) + lane * 8;
    bf16x8 kn[2][4];
#pragma unroll
    for (int g = 0; g < 2; ++g) { const int tt = t_lo + wave + 8 * g, tc = tt < t_hi ? tt : t_hi - 1;
#pragma unroll
        for (int d0 = 0; d0 < 4; ++d0) kn[g][d0] = *(const bf16x8*)(kbase + tc * 2048 + d0 * 512); }
    for (int t = t_lo + wave; t < t_hi; t += 16) {
        bf16x8 kf[2][4];
#pragma unroll
        for (int g = 0; g < 2; ++g)
#pragma unroll
            for (int d0 = 0; d0 < 4; ++d0) kf[g][d0] = kn[g][d0];
        if (t + 16 < t_hi) {
#pragma unroll
            for (int g = 0; g < 2; ++g) { const int tt = t + 16 + 8 * g, tc = tt < t_hi ? tt : t_hi - 1;
#pragma unroll
                for (int d0 = 0; d0 < 4; ++d0) kn[g][d0] = *(const bf16x8*)(kbase + tc * 2048 + d0 * 512); } }
#pragma unroll
        for (int g = 0; g < 2; ++g) { const int tt = t + 8 * g;
            if (tt < t_hi) {
#pragma unroll
                for (int qg = 0; qg < 2; ++qg) {
                    f32x16 d;
#pragma unroll
                    for (int r = 0; r < 16; ++r) d[r] = 0.f;
#pragma unroll
                    for (int d0 = 0; d0 < 4; ++d0) d = __builtin_amdgcn_mfma_f32_32x32x16_bf16(qf[qg][d0], kf[g][d0], d, 0, 0, 0);
#pragma unroll
                    for (int k4 = 0; k4 < 4; ++k4) {
                        typedef float f32x2 __attribute__((ext_vector_type(2)));
                        const f32x2 m01 = {__builtin_amdgcn_fmed3f(d[4 * k4], 0.f, 3.0e38f), __builtin_amdgcn_fmed3f(d[4 * k4 + 1], 0.f, 3.0e38f)}, m23 = {__builtin_amdgcn_fmed3f(d[4 * k4 + 2], 0.f, 3.0e38f), __builtin_amdgcn_fmed3f(d[4 * k4 + 3], 0.f, 3.0e38f)};
                        const f32x2 w01 = {wq[qg][k4][0], wq[qg][k4][1]}, w23 = {wq[qg][k4][2], wq[qg][k4][3]};
                        const f32x2 q2 = m01 * w01 + m23 * w23; const float sv = (q2[0] + q2[1]) + 0.0f;
                        const unsigned su = __builtin_bit_cast(unsigned, sv);
                        sc[(8 * qg + 2 * k4 + hi) * SCP + (tt - t_lo) * 32 + r32] = su ^ ((unsigned)((int)su >> 31) | 0x80000000u); }
                }
            }
        }
    }
}
template <int NR> __device__ __forceinline__ void idx_select_row(const unsigned (&k)[NR], int nw, LAS unsigned* mrow, LAS unsigned* cbuf, unsigned* mg_row, int lane) {
    (void)mrow; topk_core<NR>(k, nw, mg_row, lane, cbuf);
}
__device__ __forceinline__ void phase_idx(Frame& F) {
    LAS unsigned* sc = (LAS unsigned*)F.lds;
    constexpr int MST = 136; LAS unsigned* mst = (LAS unsigned*)(F.lds + 16 * SCP * 4) + F.wave * MST;
    const int lane = F.lane, r32 = lane & 31, hi = lane >> 5, qq = r32 >> 2, hd = r32 & 3;
    __syncthreads();
    for (int u = blockIdx.x; u < BATCH * 256; u += F.G) {
        const int wgv = u & 255, i8 = u >> 8; const int b = wgv & 7, jc = wgv >> 3; const int chunk = (i8 & 4) ? 63 - jc : jc; const int q0 = chunk * 64 + (i8 & 3) * 16;
        const size_t row0 = (size_t)b * SEQ + q0; const int c = q0 >> 6, nw = c + 1, nt = 2 * nw;
        unsigned* mg = (unsigned*)F.MASK + (size_t)(b * 64 + c) * (128 * 64) + (q0 & 63);
        if (nw <= 4) { int tidl = F.tid; asm volatile("" : "+v"(tidl)); const int kbq = tidl >> 4, r16 = tidl & 15; if (kbq < nt) mg[kbq * 64 + r16] = ~0u; continue; }
        bf16x8 qf[2][4]; f32x4 wq[2][4];
#pragma unroll
        for (int qg = 0; qg < 2; ++qg) {
#pragma unroll
            for (int d0 = 0; d0 < 4; ++d0) qf[qg][d0] = *(const bf16x8*)(F.IQ + (row0 + 8 * qg + qq) * 256 + hd * 64 + d0 * 16 + hi * 8);
#pragma unroll
            for (int k4 = 0; k4 < 4; ++k4) wq[qg][k4] = *(const f32x4*)(F.IW + (row0 + 8 * qg + 2 * k4 + hi) * 4); }
        LAS unsigned* srA = sc + F.wave * SCP; LAS unsigned* srB = sc + (F.wave + 8) * SCP;
        int ll = lane; asm volatile("" : "+v"(ll));
        unsigned* mgA = mg + F.wave; unsigned* mgB = mg + F.wave + 8;
        if (nw <= 32) {
            idx_scores16(F.IK, sc, b, 0, nt, F.wave, lane, qf, wq);
            __syncthreads();
            if (nw <= 16) {
                { unsigned k[16];
#pragma unroll
                  for (int i = 0; i < 16; ++i) k[i] = srA[i * 64 + ll];
                  asm volatile("" ::: "memory");
#pragma unroll
                  for (int i = 0; i < 16; ++i) k[i] = (i < nw) ? k[i] : 0u;
                  idx_select_row<16>(k, nw, mst, srA, mgA, ll); }
                { unsigned k[16];
#pragma unroll
                  for (int i = 0; i < 16; ++i) k[i] = srB[i * 64 + ll];
                  asm volatile("" ::: "memory");
#pragma unroll
                  for (int i = 0; i < 16; ++i) k[i] = (i < nw) ? k[i] : 0u;
                  idx_select_row<16>(k, nw, mst, srB, mgB, ll); }
            } else {
                { unsigned k[32];
#pragma unroll
                  for (int i = 0; i < 32; ++i) k[i] = srA[i * 64 + ll];
                  asm volatile("" ::: "memory");
#pragma unroll
                  for (int i = 0; i < 32; ++i) k[i] = (i < nw) ? k[i] : 0u;
                  idx_select_row<32>(k, nw, mst, srA, mgA, ll); }
                { unsigned k[32];
#pragma unroll
                  for (int i = 0; i < 32; ++i) k[i] = srB[i * 64 + ll];
                  asm volatile("" ::: "memory");
#pragma unroll
                  for (int i = 0; i < 32; ++i) k[i] = (i < nw) ? k[i] : 0u;
                  idx_select_row<32>(k, nw, mst, srB, mgB, ll); }
            }
            __syncthreads();
        } else {
            idx_scores16(F.IK, sc, b, 0, 64, F.wave, lane, qf, wq);
            __syncthreads();
            unsigned ka[32], kb_[32];
#pragma unroll
            for (int i = 0; i < 32; ++i) { ka[i] = srA[i * 64 + ll]; kb_[i] = srB[i * 64 + ll]; }
            __syncthreads();
            idx_scores16(F.IK, sc, b, 64, nt, F.wave, lane, qf, wq);
            __syncthreads();
            const int nw2 = nw - 32;
            if (nw <= 48) {
                { unsigned k[48];
#pragma unroll
                  for (int i = 0; i < 32; ++i) k[i] = ka[i];
#pragma unroll
                  for (int i = 0; i < 16; ++i) k[32 + i] = srA[i * 64 + ll];
                  asm volatile("" ::: "memory");
#pragma unroll
                  for (int i = 0; i < 16; ++i) k[32 + i] = (i < nw2) ? k[32 + i] : 0u;
                  idx_select_row<48>(k, nw, mst, srA, mgA, ll); }
                { unsigned k[48];
#pragma unroll
                  for (int i = 0; i < 32; ++i) k[i] = kb_[i];
#pragma unroll
                  for (int i = 0; i < 16; ++i) k[32 + i] = srB[i * 64 + ll];
                  asm volatile("" ::: "memory");
#pragma unroll
                  for (int i = 0; i < 16; ++i) k[32 + i] = (i < nw2) ? k[32 + i] : 0u;
                  idx_select_row<48>(k, nw, mst, srB, mgB, ll); }
            } else {
                { unsigned k[64];
#pragma unroll
                  for (int i = 0; i < 32; ++i) k[i] = ka[i];
#pragma unroll
                  for (int i = 0; i < 32; ++i) k[32 + i] = srA[i * 64 + ll];
                  asm volatile("" ::: "memory");
#pragma unroll
                  for (int i = 0; i < 32; ++i) k[32 + i] = (i < nw2) ? k[32 + i] : 0u;
                  idx_select_row<64>(k, nw, mst, srA, mgA, ll); }
                { unsigned k[64];
#pragma unroll
                  for (int i = 0; i < 32; ++i) k[i] = kb_[i];
#pragma unroll
                  for (int i = 0; i < 32; ++i) k[32 + i] = srB[i * 64 + ll];
                  asm volatile("" ::: "memory");
#pragma unroll
                  for (int i = 0; i < 32; ++i) k[32 + i] = (i < nw2) ? k[32 + i] : 0u;
                  idx_select_row<64>(k, nw, mst, srB, mgB, ll); }
            }
            __syncthreads();
        }
    }
}

typedef float f32x4v __attribute__((ext_vector_type(4)));
template <int SH> __device__ __forceinline__ float dpp_shr(float v, float ident) {
    return __builtin_bit_cast(float, __builtin_amdgcn_update_dpp(__builtin_bit_cast(int, ident), __builtin_bit_cast(int, v), 0x110 + SH, 0xF, 0xF, false));
}
__device__ __forceinline__ float row_last(float v, int lane) { return shfl_from(v, (lane & 48) | 15); }
struct LruIn { bf16x8 x3[2]; uint2 u3; uint2 cyw; };
__device__ __forceinline__ void lru_load(LruIn& I, const bf16* CX, const bf16* CY, size_t brow, int t0, int g, int q4, int lane) {
    const int tk = lane & 15, lg = lane >> 4; const int t = t0 + tk;
#pragma unroll
    for (int hf = 0; hf < 2; ++hf) I.x3[hf] = *(const bf16x8*)(CX + (brow + t) * 512 + g * 64 + 32 * hf + 8 * lg);
    I.u3 = *(const uint2*)(CX + (brow + t) * 512 + g * 64 + 16 * q4 + 4 * lg);
    I.cyw = *(const uint2*)(CY + (brow + t) * 512 + g * 64 + 16 * q4 + 4 * lg);
}
template <int N> __device__ __forceinline__ unsigned tap_shift(unsigned cur, unsigned prev) {
    const int a = __builtin_amdgcn_update_dpp(0, (int)prev, 0x120 + N, 0xF, 0xF, false);
    return (unsigned)__builtin_amdgcn_update_dpp(a, (int)cur, 0x110 + N, 0xF, 0xF, false);
}
template <int N> __device__ __forceinline__ bf16x8 tap_shift8(const bf16x8& cur, const bf16x8& prev) {
    const v4u c = __builtin_bit_cast(v4u, cur), p = __builtin_bit_cast(v4u, prev); v4u r;
    r.x = tap_shift<N>(c.x, p.x); r.y = tap_shift<N>(c.y, p.y); r.z = tap_shift<N>(c.z, p.z); r.w = tap_shift<N>(c.w, p.w); return __builtin_bit_cast(bf16x8, r);
}
__device__ __forceinline__ void lru_subtile(const LruIn& I, const LruIn& P, bf16* Y0, bf16* Y1, size_t brow, int t0, int g, int q4, int lane,
        const bf16x8 (&Awa)[8], const bf16x8 (&Awx)[8], const float (&cw)[4][4], const float (&cb)[4], const float (&ca)[4], const float (&cx_)[4], const float (&sp)[4],
        float (&Arun)[4], float (&hc)[4]) {
    const int tk = lane & 15, lg = lane >> 4; const int t = t0 + tk;
    f32x4v accA = {ca[0], ca[1], ca[2], ca[3]}, accX = {cx_[0], cx_[1], cx_[2], cx_[3]};
    bf16x8 bx[8]; uint2 uw[4];
#pragma unroll
    for (int hf = 0; hf < 2; ++hf) { bx[0 + hf] = tap_shift8<3>(I.x3[hf], P.x3[hf]); bx[2 + hf] = tap_shift8<2>(I.x3[hf], P.x3[hf]); bx[4 + hf] = tap_shift8<1>(I.x3[hf], P.x3[hf]); bx[6 + hf] = I.x3[hf]; }
    uw[0].x = tap_shift<3>(I.u3.x, P.u3.x); uw[0].y = tap_shift<3>(I.u3.y, P.u3.y); uw[1].x = tap_shift<2>(I.u3.x, P.u3.x); uw[1].y = tap_shift<2>(I.u3.y, P.u3.y);
    uw[2].x = tap_shift<1>(I.u3.x, P.u3.x); uw[2].y = tap_shift<1>(I.u3.y, P.u3.y); uw[3] = I.u3;
#pragma unroll
    for (int ks = 0; ks < 8; ++ks) { accA = __builtin_amdgcn_mfma_f32_16x16x32_bf16(Awa[ks], bx[ks], accA, 0, 0, 0); accX = __builtin_amdgcn_mfma_f32_16x16x32_bf16(Awx[ks], bx[ks], accX, 0, 0, 0); }
    float u[4] = {cb[0], cb[1], cb[2], cb[3]};
#pragma unroll
    for (int q = 0; q < 4; ++q) { const uint2 w = uw[q];
        u[0] += cw[q][0] * bflo(w.x); u[1] += cw[q][1] * bfhi(w.x); u[2] += cw[q][2] * bflo(w.y); u[3] += cw[q][3] * bfhi(w.y); }
    const uint2 cyw = I.cyw;
    const float cy[4] = {bflo(cyw.x), bfhi(cyw.x), bflo(cyw.y), bfhi(cyw.y)};
    float A[4], B[4];
#pragma unroll
    for (int r = 0; r < 4; ++r) { const float rg = __builtin_amdgcn_rcpf(1.f + __builtin_amdgcn_exp2f(accA[r])), ig = __builtin_amdgcn_rcpf(1.f + __builtin_amdgcn_exp2f(accX[r]));
        const float tl = rg * sp[r]; const float y2 = tl * 1.3862943611198906f; A[r] = __builtin_amdgcn_exp2f(tl);
        const float om = (y2 > -0.3f) ? -y2 * (1.f + y2 * (0.5f + y2 * (0.16666667f + y2 * 0.041666668f))) : 1.f - A[r] * A[r];
        B[r] = __builtin_amdgcn_sqrtf(om) * (ig * u[r]); }
#define LRU_SCAN_STEP(PRE, N) asm(PRE "v_fmac_f32_dpp %4, %4, %0 row_shr:" #N " row_mask:0xf bank_mask:0xf\n\tv_fmac_f32_dpp %5, %5, %1 row_shr:" #N " row_mask:0xf bank_mask:0xf\n\t" \
        "v_fmac_f32_dpp %6, %6, %2 row_shr:" #N " row_mask:0xf bank_mask:0xf\n\tv_fmac_f32_dpp %7, %7, %3 row_shr:" #N " row_mask:0xf bank_mask:0xf\n\t" \
        "v_mul_f32_dpp %0, %0, %0 row_shr:" #N " row_mask:0xf bank_mask:0xf\n\tv_mul_f32_dpp %1, %1, %1 row_shr:" #N " row_mask:0xf bank_mask:0xf\n\t" \
        "v_mul_f32_dpp %2, %2, %2 row_shr:" #N " row_mask:0xf bank_mask:0xf\n\tv_mul_f32_dpp %3, %3, %3 row_shr:" #N " row_mask:0xf bank_mask:0xf" \
        : "+v"(A[0]), "+v"(A[1]), "+v"(A[2]), "+v"(A[3]), "+v"(B[0]), "+v"(B[1]), "+v"(B[2]), "+v"(B[3]))
    LRU_SCAN_STEP("s_nop 1\n\t", 1); LRU_SCAN_STEP("", 2); LRU_SCAN_STEP("", 4); LRU_SCAN_STEP("", 8);
#undef LRU_SCAN_STEP
    float y0[4], y1[4];
#pragma unroll
    for (int r = 0; r < 4; ++r) { const float h = B[r] + A[r] * hc[r], ap = A[r] * Arun[r]; const float gl = cy[r] * __builtin_amdgcn_rcpf(1.f + __builtin_amdgcn_exp2f(cy[r] * (-2.3022082f + -0.10294324f * (cy[r] * cy[r]))));     y0[r] = h * gl; y1[r] = ap * gl; hc[r] = row_last(h, lane); Arun[r] = row_last(ap, lane); }
    const size_t off = (brow + t) * 512 + g * 64 + 16 * q4 + 4 * lg, off0 = (brow + t) * 1024 + g * 64 + 16 * q4 + 4 * lg;
    uint2 o; o.x = cvtpk(y0[0], y0[1]); o.y = cvtpk(y0[2], y0[3]); *(uint2*)(Y0 + off0) = o;
    o.x = cvtpk(y1[0], y1[1]); o.y = cvtpk(y1[2], y1[3]); *(uint2*)(Y1 + off) = o;
}
constexpr float NL2E = -1.4426950408889634f;
__device__ __forceinline__ void phase_lru(Frame& F, int l) {
    LAS float* agg = (LAS float*)(F.lds + 36864);
    const int lane = F.lane, tk = lane & 15, lg = lane >> 4;
    bf16* Y1 = F.YC; bf16* Y0 = F.YCAT + 512;
    for (int u = blockIdx.x; u < 256; u += F.G) {
        const int b = u & 7, g = u >> 5, q4 = (u >> 3) & 3; const size_t brow = (size_t)b * SEQ;
        const float* wa = F.lru_wa + (size_t)(l * 8 + g) * 4096; const float* wx = F.lru_wx + (size_t)(l * 8 + g) * 4096; const float* cwp = F.conv_w + (size_t)l * 4 * 512 + g * 64; const float* cbp = F.conv_b + l * 512 + g * 64;
        bf16x8 Awa[8], Awx[8];
#pragma unroll
        for (int ks = 0; ks < 8; ++ks) { const int q = ks >> 1; v4u pa, px; unsigned wsa[4], wsx[4];
#pragma unroll
            for (int j2 = 0; j2 < 4; ++j2) { const int i0 = 32 * (ks & 1) + 8 * lg + 2 * j2, oc = 16 * q4 + tk;
                const float c0 = cwp[q * 512 + i0], c1 = cwp[q * 512 + i0 + 1];
                wsa[j2] = cvtpk(NL2E * c0 * wa[i0 * 64 + oc], NL2E * c1 * wa[(i0 + 1) * 64 + oc]); wsx[j2] = cvtpk(NL2E * c0 * wx[i0 * 64 + oc], NL2E * c1 * wx[(i0 + 1) * 64 + oc]); }
            pa.x = wsa[0]; pa.y = wsa[1]; pa.z = wsa[2]; pa.w = wsa[3]; px.x = wsx[0]; px.y = wsx[1]; px.z = wsx[2]; px.w = wsx[3];
            Awa[ks] = __builtin_bit_cast(bf16x8, pa); Awx[ks] = __builtin_bit_cast(bf16x8, px); }
        float cw[4][4], cb[4], ca[4], cx_[4], sp[4];
#pragma unroll
        for (int r = 0; r < 4; ++r) { const int oc = 16 * q4 + 4 * lg + r, cg = g * 64 + oc;
#pragma unroll
            for (int q = 0; q < 4; ++q) cw[q][r] = cwp[q * 512 + oc];
            cb[r] = cbp[oc]; float sa = 0.f, sx = 0.f;
#pragma unroll
            for (int i4 = 0; i4 < 4; ++i4) { const int i = tk + 16 * i4; const float bi = cbp[i]; sa += bi * wa[i * 64 + oc]; sx += bi * wx[i * 64 + oc]; }
#pragma unroll
            for (int o = 1; o < 16; o <<= 1) { sa += shflx(sa, o); sx += shflx(sx, o); }
            ca[r] = NL2E * (sa + F.lru_ba[l * 512 + cg]); cx_[r] = NL2E * (sx + F.lru_bx[l * 512 + cg]); sp[r] = (8.f * NL2E) * log1pf(expf(-F.lru_lambda[l * 512 + cg])); }
        float Arun[4] = {1.f, 1.f, 1.f, 1.f}, hc[4] = {0.f, 0.f, 0.f, 0.f};
        const int tseg = F.wave * 512;
        LruIn cur, prv; lru_load(cur, F.CX, F.CY, brow, tseg, g, q4, lane);
        lru_load(prv, F.CX, F.CY, brow, tseg >= 16 ? tseg - 16 : 0, g, q4, lane);
        if (tseg == 0) { prv.x3[0] = (bf16x8){0, 0, 0, 0, 0, 0, 0, 0}; prv.x3[1] = (bf16x8){0, 0, 0, 0, 0, 0, 0, 0}; prv.u3 = (uint2){0u, 0u}; }
#pragma unroll 2
        for (int s = 0; s < 32; ++s) { LruIn nxt;
            lru_load(nxt, F.CX, F.CY, brow, tseg + 16 * (s + 1 < 32 ? s + 1 : s), g, q4, lane);
            asm volatile("" ::: "memory");
            lru_subtile(cur, prv, Y0, Y1, brow, tseg + 16 * s, g, q4, lane, Awa, Awx, cw, cb, ca, cx_, sp, Arun, hc);
            prv = cur; cur = nxt; }
        __syncthreads();
        if (tk == 0) {
#pragma unroll
            for (int r = 0; r < 4; ++r) { agg[F.wave * 32 + 4 * lg + r] = Arun[r]; agg[F.wave * 32 + 16 + 4 * lg + r] = hc[r]; } }
        __syncthreads();
        float hin[4] = {0.f, 0.f, 0.f, 0.f};
        for (int w = 0; w < F.wave; ++w) {
#pragma unroll
            for (int r = 0; r < 4; ++r) hin[r] = agg[w * 32 + 4 * lg + r] * hin[r] + agg[w * 32 + 16 + 4 * lg + r]; }
        if (F.wave > 0) {
            asm volatile("s_waitcnt vmcnt(0)" ::: "memory");
#pragma unroll 1
            for (int s8 = 0; s8 < 32; s8 += 8) { uint2 a0[8], a1[8];
#pragma unroll
                for (int j = 0; j < 8; ++j) { const size_t row = brow + tseg + 16 * (s8 + j) + tk; a0[j] = *(const uint2*)(Y0 + row * 1024 + g * 64 + 16 * q4 + 4 * lg); a1[j] = *(const uint2*)(Y1 + row * 512 + g * 64 + 16 * q4 + 4 * lg); }
#pragma unroll
                for (int j = 0; j < 8; ++j) { const size_t row = brow + tseg + 16 * (s8 + j) + tk; uint2 o;
                    o.x = cvtpk(bflo(a0[j].x) + bflo(a1[j].x) * hin[0], bfhi(a0[j].x) + bfhi(a1[j].x) * hin[1]); o.y = cvtpk(bflo(a0[j].y) + bflo(a1[j].y) * hin[2], bfhi(a0[j].y) + bfhi(a1[j].y) * hin[3]);
                    *(uint2*)(Y0 + row * 1024 + g * 64 + 16 * q4 + 4 * lg) = o; } }
        }
    }
}

struct Args { const float* in[20]; float* out; unsigned char* ws; int l_lo, l_hi, ph_lo, ph_hi; };
__device__ __forceinline__ void make_frame(Frame& F, const Args& args, unsigned char* lds_) {
    int tid = wg_tid(); asm volatile("" : "+v"(tid));
    const __attribute__((address_space(4))) unsigned char* ka = (const __attribute__((address_space(4))) unsigned char*)__builtin_amdgcn_kernarg_segment_ptr(); asm volatile("" : "+s"(ka));
#define KARG(k) ((const float*)(GAS const float*)(*(const unsigned long long __attribute__((address_space(4)))*)(ka + 8 * (k))))
    GAS unsigned char* wsg = (GAS unsigned char*)(*(const unsigned long long __attribute__((address_space(4)))*)(ka + 168)); unsigned char* ws = (unsigned char*)wsg;
    F.lds = (LAS unsigned char*)lds_; F.MISC = (volatile LAS unsigned*)(F.lds + MISC_OFF);
    F.tid = tid; F.lane = tid & 63; F.wave = __builtin_amdgcn_readfirstlane(tid >> 6); F.G = gridDim.x;
    F.ctl = (gu32*)(ws + WS_CTL);
    F.x = KARG(0); F.g_mix = KARG(1); F.w_in = KARG(2); F.qk_gain_a = KARG(3); F.rel_bias = KARG(4); F.qk_gain_b = KARG(5); F.g_idx_k = KARG(6);
    F.conv_w = KARG(7); F.conv_b = KARG(8); F.lru_wa = KARG(9); F.lru_ba = KARG(10); F.lru_wx = KARG(11); F.lru_bx = KARG(12); F.lru_lambda = KARG(13);
    F.b_gate = KARG(14); F.w_branch = KARG(15); F.w_out = KARG(16); F.g_ffn = KARG(17); F.w_ffn_in = KARG(18); F.w_ffn_out = KARG(19); F.out = (float*)KARG(20);
#undef KARG
    F.rcos = (float*)(ws + WS_ROPE); F.rsin = F.rcos + SEQ * 32; F.SS = (float*)(ws + WS_SS);
    F.W = (bf16*)(ws + WS_W); F.W2a = (bf16*)(ws + 462 * MiB); F.W2b = (bf16*)((unsigned char*)F.out + 32 * MiB); F.H = (bf16*)(ws + WS_H); F.YC = (bf16*)F.out; F.YCAT = (bf16*)F.out + (size_t)32 * 1024 * 1024;
    F.QA = (bf16*)(ws + WS_QA); F.QB = (bf16*)(ws + WS_QB); F.KA = (bf16*)(ws + WS_KA); F.VA = (bf16*)(ws + WS_VA); F.KB = (bf16*)(ws + WS_KB); F.VB = (bf16*)(ws + WS_VB);
    F.IQ = (bf16*)(ws + WS_IQ); F.IK = (bf16*)(ws + WS_IK); F.IW = (float*)(ws + WS_IW); F.CX = (bf16*)(ws + WS_CX); F.CY = (bf16*)(ws + WS_CY);
    F.GT = (bf16*)(ws + WS_GT); F.ACT = (bf16*)(ws + WS_ACT); F.MG = (bf16*)(ws + WS_MG); F.MASK = (u64*)(ws + WS_MASK);
}
template <int PHM> __global__ void __launch_bounds__(NWAVES * 64, 2) fwd(Args args) {
    { LAS unsigned char* l3 = (LAS unsigned char*)lds; for (int u = threadIdx.x; u < (LDS_BYTES - LDSCTL_OFF) / 4; u += NWAVES * 64) ((LAS unsigned*)(l3 + LDSCTL_OFF))[u] = 0u; }
    __syncthreads();
    static_assert(WGT_LDS_OFF == MISC_OFF + 256 && WGT_LDS_OFF + 256 <= LDS_BYTES, "wave-index table inside the LDS control area");
    if ((threadIdx.x & 63) == 0) ((LAS unsigned*)((LAS unsigned char*)lds + WGT_LDS_OFF))[wgt_slot()] = threadIdx.x >> 6;
    __syncthreads();
    XcdBarrier bar; bar.bar = (unsigned*)(args.ws + WS_CTL) + CW_BAR; bar.x = 0; bar.st = nullptr;
    if (!MK_PER_PHASE) bar = xcd_barrier_post((unsigned*)(args.ws + WS_CTL) + CW_BAR, (volatile LAS unsigned*)((LAS unsigned char*)lds + MISC_OFF) + 8);
#define GRID_BAR() do { if (!MK_PER_PHASE) xcd_barrier(bar); } while (0)
    const int plo = args.ph_lo, phi = args.ph_hi; (void)plo; (void)phi;
#ifndef PHMASK
#define PHMASK 0x1ff
#endif
#if MK_PER_PHASE
#define IN(k) (((PHMASK >> (k)) & 1) && ((PHM >> (k)) & 1) && plo <= (k) && (k) < phi)
#else
#define IN(k) (((PHMASK >> (k)) & 1) && ((PHM >> (k)) & 1))
#endif
    bool first = true;
    for (int l = MK_PER_PHASE ? args.l_lo : 0; l < (MK_PER_PHASE ? args.l_hi : DEPTH); ++l) {
        if (IN(0) && (MK_PER_PHASE || l == 0)) { if (!first) GRID_BAR(); first = false; Frame F; make_frame(F, args, lds); phase_weights(F, l); if (l == 0) phase_xb0(F, F.x, F.SS); }
        if (IN(1)) { if (!first) GRID_BAR(); first = false; Frame F; make_frame(F, args, lds);
            pg8::Gemm g{F.H, wset(F, l).in, M, NIN, D}; pg8::StaticOrder S; S.init(M, NIN, F.G, (int)blockIdx.x);
            pg8::EpiIn E{F.QA, F.KA, F.VA, F.QB, F.KB, F.VB, F.IQ, F.IK, F.IW, F.CX, F.CY, F.GT, F.qk_gain_a + l * 128, F.qk_gain_b + l * 128, F.g_idx_k + l * 64, F.b_gate + l * 3072, F.rcos, F.rsin, F.SS + (size_t)(2 * l) * M * 16, (LAS float*)(F.lds + XTRA_OFF)};
            pg8::gemm_phase<pg8::EpiIn, pg8::StaticOrder, PG8_ALIGN, PG8_SP2>(F.lds + RING_OFF, g, S, E); }
        if (IN(2)) { if (!first) GRID_BAR(); first = false; { Frame F0; make_frame(F0, args, lds); phase_lru(F0, l); } __syncthreads(); Frame F; make_frame(F, args, lds); phase_attn_a(F, l); __syncthreads(); phase_idx(F);
            if (F.G == 256) { asm volatile("s_waitcnt vmcnt(0)" ::: "memory"); __syncthreads(); } else GRID_BAR();
            { Frame F2; make_frame(F2, args, lds); phase_attn_b(F2, l); }
            if (!MK_PER_PHASE && l + 1 < DEPTH) { __syncthreads();
                Frame F3; make_frame(F3, args, lds); phase_weights(F3, l + 1, (unsigned*)(args.ws + WS_CTL) + 64 + l); } }
        if (IN(4)) { if (!first) GRID_BAR(); first = false; Frame F; make_frame(F, args, lds);
#ifndef DBG_HALF
#define DBG_HALF 0
#endif
#ifndef DBG_SKIP_BR
#define DBG_SKIP_BR 0
#endif
            pg8::Gemm g{F.YCAT, wset(F, l).ba, M, D, D}; pg8::StaticOrder S; S.init(M, D, F.G, (int)blockIdx.x); pg8::EpiGateCat E{F.MG, F.GT};
            pg8::gemm_phase<pg8::EpiGateCat, pg8::StaticOrder, PG8_ALIGN, PG8_SP2, true>(F.lds + RING_OFF, g, S, E); }
        if (IN(5)) { if (!first) GRID_BAR(); first = false; Frame F; make_frame(F, args, lds);
            pg8::Gemm g{F.MG, wset(F, l).out, M, D, D}; pg8::StaticOrder S; S.init(M, D, F.G, (int)blockIdx.x); pg8::EpiResidB E{F.H, F.SS + (size_t)(2 * l + 1) * M * 16, nullptr};
            pg8::gemm_phase<pg8::EpiResidB, pg8::StaticOrder, PG8_ALIGN, PG8_SP2>(F.lds + RING_OFF, g, S, E); }
        if (IN(7)) { if (!first) GRID_BAR(); first = false; Frame F; make_frame(F, args, lds);
            pg8::Gemm g{F.H, wset(F, l).f1, M, NF1, D}; pg8::StaticOrder S; S.init(M, NF1, F.G, (int)blockIdx.x); pg8::EpiSwiGLU E{F.ACT, F.SS + (size_t)(2 * l + 1) * M * 16, (LAS float*)(F.lds + XTRA_OFF)};
            pg8::gemm_phase<pg8::EpiSwiGLU, pg8::StaticOrder, PG8_ALIGN, PG8_SP2>(F.lds + RING_OFF, g, S, E); }
        if (IN(8)) { if (!first) GRID_BAR(); first = false; Frame F; make_frame(F, args, lds);
            pg8::Gemm g{F.ACT, wset(F, l).f2, M, D, FF}; pg8::StaticOrder S; S.init(M, D, F.G, (int)blockIdx.x); pg8::EpiResidB E{F.H, F.SS + (size_t)(2 * l + 2 < 2 * DEPTH ? 2 * l + 2 : 0) * M * 16, (l + 1 < DEPTH) ? (float*)nullptr : F.out};
            pg8::gemm_phase<pg8::EpiResidB, pg8::StaticOrder, PG8_ALIGN, PG8_SP2>(F.lds + RING_OFF, g, S, E); }
    }
#undef IN
}

extern "C" void kernel_launch(void* const* d_in, const int* in_sizes, int n_in, void* d_out, int out_size, void* d_ws, size_t ws_size, hipStream_t stream) {
    static int grid = 0;
    if (grid == 0) {
        if (n_in != 20 || in_sizes[0] != M * D || out_size != M * D || ws_size < WS_END) { fprintf(stderr, "kernel_launch: unexpected problem shape / workspace (n_in %d, ws %zu); nothing launched\n", n_in, ws_size); grid = -1; return; }
        int dev = 0, cus = 0, per_cu = 0;
        if (hipGetDevice(&dev) != hipSuccess || hipDeviceGetAttribute(&cus, hipDeviceAttributeMultiprocessorCount, dev) != hipSuccess) { grid = -1; return; }
#if MK_PER_PHASE
        const void* fns[NPH] = {(const void*)fwd<1>, (const void*)fwd<2>, (const void*)fwd<4>, (const void*)fwd<8>, (const void*)fwd<16>, (const void*)fwd<32>, (const void*)fwd<64>, (const void*)fwd<128>, (const void*)fwd<256>};
        for (int i = 0; i < NPH; ++i) if (hipFuncSetAttribute(fns[i], hipFuncAttributeMaxDynamicSharedMemorySize, LDS_BYTES) != hipSuccess) { fprintf(stderr, "kernel_launch: hipFuncSetAttribute failed\n"); grid = -1; return; }
#else
        if (hipFuncSetAttribute((const void*)fwd<0x1ff>, hipFuncAttributeMaxDynamicSharedMemorySize, LDS_BYTES) != hipSuccess) { fprintf(stderr, "kernel_launch: hipFuncSetAttribute failed\n"); grid = -1; return; }
        if (hipOccupancyMaxActiveBlocksPerMultiprocessor(&per_cu, (const void*)fwd<0x1ff>, NWAVES * 64, LDS_BYTES) != hipSuccess || per_cu < 1) fprintf(stderr, "kernel_launch: occupancy query reports %d workgroups per CU\n", per_cu);
#endif
        (void)hipGetLastError(); (void)per_cu;
        grid = cus;
    }
    if (grid < 0) return;
    if (hipMemsetAsync((char*)d_ws + WS_CTL, 0, CTL_ZERO_BYTES, stream) != hipSuccess) return;
    Args a{};
    for (int i = 0; i < 20; ++i) a.in[i] = (const float*)d_in[i];
    a.out = (float*)d_out; a.ws = (unsigned char*)d_ws;
#if MK_PER_PHASE
    for (int l = 0; l < DEPTH; ++l) for (int p = 0; p < NPH; ++p) { a.l_lo = l; a.l_hi = l + 1; a.ph_lo = p; a.ph_hi = p + 1;
        switch (p) {
            case 0: hipLaunchKernelGGL(fwd<1>, dim3(grid), dim3(NWAVES * 64), LDS_BYTES, stream, a); break;
            case 1: hipLaunchKernelGGL(fwd<2>, dim3(grid), dim3(NWAVES * 64), LDS_BYTES, stream, a); break;
            case 2: hipLaunchKernelGGL(fwd<4>, dim3(grid), dim3(NWAVES * 64), LDS_BYTES, stream, a); break;
            case 3: hipLaunchKernelGGL(fwd<8>, dim3(grid), dim3(NWAVES * 64), LDS_BYTES, stream, a); break;
            case 4: hipLaunchKernelGGL(fwd<16>, dim3(grid), dim3(NWAVES * 64), LDS_BYTES, stream, a); break;
            case 5: hipLaunchKernelGGL(fwd<32>, dim3(grid), dim3(NWAVES * 64), LDS_BYTES, stream, a); break;
            case 6: hipLaunchKernelGGL(fwd<64>, dim3(grid), dim3(NWAVES * 64), LDS_BYTES, stream, a); break;
            case 7: hipLaunchKernelGGL(fwd<128>, dim3(grid), dim3(NWAVES * 64), LDS_BYTES, stream, a); break;
            default: hipLaunchKernelGGL(fwd<256>, dim3(grid), dim3(NWAVES * 64), LDS_BYTES, stream, a); break;
        } }
#else
    a.l_lo = 0; a.l_hi = DEPTH; a.ph_lo = 0; a.ph_hi = NPH;
    hipLaunchKernelGGL(fwd<0x1ff>, dim3(grid), dim3(NWAVES * 64), LDS_BYTES, stream, a);
#endif
}
```

```cpp
#include <hip/hip_runtime.h>
#include <cstdio>
#include <cstdint>

#define WGT_LDS_OFF 139840
extern __shared__ __attribute__((aligned(16))) unsigned char lds[];
__device__ __forceinline__ unsigned wgt_slot() { return (unsigned)__builtin_amdgcn_s_getreg((5 << 11) | 4) & 63u; }
__device__ __forceinline__ int wg_lane() { int l; asm volatile("v_mbcnt_lo_u32_b32 %0, -1, 0\n\tv_mbcnt_hi_u32_b32 %0, -1, %0" : "=v"(l)); return l; }
__device__ __forceinline__ int wg_wave() { const volatile __attribute__((address_space(3))) unsigned* tab = (const volatile __attribute__((address_space(3))) unsigned*)((__attribute__((address_space(3))) unsigned char*)lds + WGT_LDS_OFF);
    return __builtin_amdgcn_readfirstlane((int)tab[wgt_slot()]); }
__device__ __forceinline__ int wg_tid() { return wg_wave() * 64 + wg_lane(); }
__device__ __forceinline__ float shflx(float v, int m) { return __builtin_bit_cast(float, __builtin_amdgcn_ds_bpermute((wg_lane() ^ m) << 2, __builtin_bit_cast(int, v))); }
__device__ __forceinline__ float shfl_from(float v, int src) { return __builtin_bit_cast(float, __builtin_amdgcn_ds_bpermute(src << 2, __builtin_bit_cast(int, v))); }
namespace pg8 {
#define PG8_LAS __attribute__((address_space(3)))
typedef unsigned short bf16_t;
typedef short bf16x8 __attribute__((ext_vector_type(8)));
typedef float f32x4 __attribute__((ext_vector_type(4)));
typedef unsigned u32x4 __attribute__((ext_vector_type(4)));
constexpr int BM = 256, BK = 64, HALF = 128, HTB = HALF * BK * 2  , STAGE_BYTES = 8 * HTB, NXCD = 8, WGM = 8;

__host__ __device__ __forceinline__ int lds_byte(int r, int c) { const int st = (r >> 4) * 2 + (c >> 5), rr = r & 15, cc = c & 31, ob = rr * 64 + cc * 2; return st * 1024 + (ob ^ (((ob >> 9) & 1) << 5)); }
__host__ __device__ __forceinline__ void stage_rc(int b, int& R, int& C) { const int st = b / 1024, sb = b % 1024, swz = sb ^ (((sb >> 9) & 1) << 5); R = (st >> 1) * 16 + swz / 64; C = (st & 1) * 32 + (swz % 64) / 2; }
__host__ __device__ __forceinline__ int perm32(int rho) { const int n = rho >> 4, i = rho & 15; return 8 * (i >> 2) + 4 * n + (i & 3); }

struct Unit { int pm, pn; };
struct Gemm { const bf16_t* A; const bf16_t* Bt; int M, N, K; };

struct StaticOrder {
    int nM, nN, nwg, G, c;
    __host__ __device__ void init(int M, int N, int G_, int c_) { nM = M / BM; nN = N / BM; nwg = nM * nN; G = G_; c = c_; }
    __host__ __device__ bool next(int i, Unit& u) const {
        const long L = (long)i * G + c; if (L >= nwg) return false;
        int wgid = (int)L; { const int q = nwg / NXCD, r = nwg % NXCD, xcd = wgid % NXCD, off = wgid / NXCD; wgid = (xcd < r ? xcd * (q + 1) : r * (q + 1) + (xcd - r) * q) + off; }
        const int nig = WGM * nN, gid = wgid / nig, fm = gid * WGM, gsz = (nM - fm) < WGM ? (nM - fm) : WGM;
        u.pm = fm + ((wgid % nig) % gsz); u.pn = (wgid % nig) / gsz; return true;
    }
    __device__ __forceinline__ void a_ready(const Unit&) const {}
    __device__ __forceinline__ void done(const Unit&) const {}
};


typedef float f32x2_t __attribute__((ext_vector_type(2))); typedef __bf16 bf16x2_t __attribute__((ext_vector_type(2)));
__device__ __forceinline__ unsigned cvt_pk_bf16(float lo, float hi) { const f32x2_t v = {lo, hi}; const bf16x2_t b = __builtin_convertvector(v, bf16x2_t); return __builtin_bit_cast(unsigned, b); }
__device__ __forceinline__ u32x4 pack8(const f32x4 a, const f32x4 b) { u32x4 w; w.x = cvt_pk_bf16(a[0], a[1]); w.y = cvt_pk_bf16(a[2], a[3]); w.z = cvt_pk_bf16(b[0], b[1]); w.w = cvt_pk_bf16(b[2], b[3]); return w; }
__device__ __forceinline__ float bflo(unsigned w) { return __builtin_bit_cast(float, w << 16); }
__device__ __forceinline__ float bfhi(unsigned w) { return __builtin_bit_cast(float, w & 0xffff0000u); }
__device__ __forceinline__ float fast_sigmoid(float x) { return __builtin_amdgcn_rcpf(1.f + __expf(-x)); }

__device__ __forceinline__ float row_rs(const float* ssp, int row) { const f32x4* q = (const f32x4*)(ssp + (size_t)row * 16); const f32x4 a = q[0], b = q[1], c = q[2], d = q[3];
    const f32x4 s = (a + b) + (c + d); return __builtin_amdgcn_rsqf(((s[0] + s[1]) + (s[2] + s[3])) * (1.f / 1024.f) + 1e-6f); }
__device__ __forceinline__ const PG8_LAS float* unit_row_scales(const float* ssp, PG8_LAS float* rsl, const Unit& u, int wr, int wc, int fr, int fq, int& cached_pm) {
    const int lane = fr + 16 * fq;
    PG8_LAS float* mine = rsl + (wr * 4 + wc) * 128;
    if (u.pm != cached_pm) {
        mine[lane] = row_rs(ssp, u.pm * BM + wr * 64 + lane); mine[64 + lane] = row_rs(ssp, u.pm * BM + HALF + wr * 64 + lane);
        asm volatile("s_waitcnt lgkmcnt(0)" ::: "memory");
        cached_pm = u.pm; }
    return mine;
}
constexpr float QSCALE = 0.125f * 1.4426950408889634f;

struct EpiIn {
    static constexpr bool PERM = true, AFTER_DRAIN = false;
    bf16_t *QA, *KA, *VA, *QB, *KB, *VB, *IQ, *IK; float* IW; bf16_t *CX, *CY, *GT;
    const float *gain_a, *gain_b, *gain_ik, *bgate, *rcos, *rsin;
    const float* ss;
    PG8_LAS float* rsl;
    mutable int rs_pm = -1;
    __device__ __forceinline__ void operator()(const f32x4 (&acc)[2][2][4][2], const Unit& u, int wr, int wc, int fr, int fq) const {
        const int pn = u.pn; int row0 = u.pm * BM + wr * 64 + fr; asm volatile("" : "+v"(row0));
        const PG8_LAS float* rsw = unit_row_scales(ss, rsl, u, wr, wc, fr, fq, rs_pm) + fr;
        if (pn >= 12) {
            const int gi = (pn - 12) >> 2, ct = ((pn - 12) & 3) * BM; unsigned char* base = (unsigned char*)GT + (size_t)gi * 32768 * 1024;
            const int col0 = ct + wc * 64 + 16 * fq; const float* bp = bgate + gi * 1024 + col0;
            f32x4 bv[2][2];
#pragma unroll
            for (int bj = 0; bj < 2; ++bj)
#pragma unroll
                for (int n = 0; n < 2; ++n) bv[bj][n] = *(const f32x4*)(bp + 8 * bj + 4 * n) * -1.4426950408889634f;
#pragma unroll
            for (int ai = 0; ai < 2; ++ai)
#pragma unroll
                for (int m = 0; m < 4; ++m) { unsigned char* rowp = base + (size_t)(row0 + ai * HALF + m * 16) * 1024 + col0; const float rs = rsw[ai * 64 + m * 16] * -1.4426950408889634f; u32x4 wq;
                    typedef float f32x2 __attribute__((ext_vector_type(2)));
                    const f32x2 rs2 = {rs, rs}, one2 = {1.f, 1.f}, k255 = {255.f, 255.f};
#pragma unroll
                    for (int bj = 0; bj < 2; ++bj) { unsigned w[2] = {0u, 0u};
#pragma unroll
                        for (int n = 0; n < 2; ++n)
#pragma unroll
                            for (int h2 = 0; h2 < 2; ++h2) { const f32x4 a4 = acc[ai][bj][m][n], b4 = bv[bj][n];
                                const f32x2 a2 = {a4[2 * h2], a4[2 * h2 + 1]}, b2 = {b4[2 * h2], b4[2 * h2 + 1]};
                                const f32x2 t = a2 * rs2 + b2; f32x2 ex = {__builtin_amdgcn_exp2f(t[0]), __builtin_amdgcn_exp2f(t[1])};
                                const f32x2 dn = ex + one2; f32x2 rc2 = {__builtin_amdgcn_rcpf(dn[0]), __builtin_amdgcn_rcpf(dn[1])};
                                f32x2 q = rc2 * k255; q[0] = __builtin_rintf(q[0]); q[1] = __builtin_rintf(q[1]); q = __builtin_elementwise_max(q, one2);
                                w[n] = __builtin_amdgcn_cvt_pk_u8_f32(q[0], 2 * h2, w[n]); w[n] = __builtin_amdgcn_cvt_pk_u8_f32(q[1], 2 * h2 + 1, w[n]); }
                        if (bj == 0) { wq.x = w[0]; wq.y = w[1]; } else { wq.z = w[0]; wq.w = w[1]; } }
                    *(u32x4*)rowp = wq; asm volatile("" ::: "memory"); }
            return;
        }
        if (pn >= 8) {
            bf16_t* base = (pn < 10) ? CX : CY; const int col0 = ((pn - 8) & 1) * BM + wc * 32 + 8 * fq;
#pragma unroll
            for (int ai = 0; ai < 2; ++ai)
#pragma unroll
                for (int m = 0; m < 4; ++m) { bf16_t* rowp = base + (size_t)(row0 + ai * HALF + m * 16) * 512 + col0; const float rs = rsw[ai * 64 + m * 16];
#pragma unroll
                    for (int bj = 0; bj < 2; ++bj) *(u32x4*)(rowp + bj * HALF) = pack8(acc[ai][bj][m][0] * rs, acc[ai][bj][m][1] * rs);
                    asm volatile("" ::: "memory"); }
            return;
        }
        bf16_t* dst; const float* gain = nullptr; bool do_norm = false, do_rope = false; float scale = 1.f; int pitch = 256;
        switch (pn) {
            case 0: dst = QA; gain = gain_a; do_norm = true; scale = QSCALE; break;
            case 1: dst = KA; gain = gain_a + 64; do_norm = true; break;
            case 2: dst = VA; break;
            case 3: dst = QB; gain = gain_b; do_norm = true; do_rope = true; scale = QSCALE; break;
            case 4: dst = KB; gain = gain_b + 64; do_norm = true; do_rope = true; break;
            case 5: dst = VB; break;
            case 6: dst = IQ; do_rope = true; break;
            default: dst = IK; gain = gain_ik; do_norm = true; do_rope = true; pitch = 64; break;
        }
        if (pn == 7) {
            if (wc == 1) {
                if (fq == 0) {
#pragma unroll
                    for (int ai = 0; ai < 2; ++ai)
#pragma unroll
                        for (int m = 0; m < 4; ++m) { const int row = row0 + ai * HALF + m * 16; *(f32x4*)(IW + (size_t)row * 4) = acc[ai][0][m][0] * (0.0625f * rsw[ai * 64 + m * 16]); }
                }
                return;
            }
            if (wc != 0) return;
        }
        f32x4 g[2][2];
#pragma unroll
        for (int bj = 0; bj < 2; ++bj)
#pragma unroll
            for (int n = 0; n < 2; ++n) g[bj][n] = do_norm ? *(const f32x4*)(gain + bj * 32 + 8 * fq + 4 * n) * scale : (f32x4){scale, scale, scale, scale};
        const int colb = (pn == 7 ? 0 : wc * 64) + 8 * fq;
        f32x4 rc[4];
        if (do_rope) { const int t = row0 & 4095; const float* cp = rcos + t * 32 + 8 * fq; const float* sp = rsin + t * 32 + 8 * fq; rc[0] = *(const f32x4*)cp; rc[1] = *(const f32x4*)(cp + 4); rc[2] = *(const f32x4*)sp; rc[3] = *(const f32x4*)(sp + 4); }
#pragma unroll
        for (int ai = 0; ai < 2; ++ai)
#pragma unroll
            for (int m = 0; m < 4; ++m) {
                const int row = row0 + ai * HALF + m * 16;
                const float rsx = rsw[ai * 64 + m * 16];
                f32x4 lo0 = acc[ai][0][m][0] * rsx, lo1 = acc[ai][0][m][1] * rsx, hi0 = acc[ai][1][m][0] * rsx, hi1 = acc[ai][1][m][1] * rsx;
                if (do_norm) {
                    f32x4 s4 = lo0 * lo0 + lo1 * lo1 + hi0 * hi0 + hi1 * hi1; float ss = (s4[0] + s4[1]) + (s4[2] + s4[3]);
                    ss += shflx(ss, 16); ss += shflx(ss, 32);
                    const float rs = __builtin_amdgcn_rsqf(ss * (1.f / 64.f) + 1e-6f);
                    lo0 = lo0 * rs; lo1 = lo1 * rs; hi0 = hi0 * rs; hi1 = hi1 * rs;
                }
                lo0 = lo0 * g[0][0]; lo1 = lo1 * g[0][1]; hi0 = hi0 * g[1][0]; hi1 = hi1 * g[1][1];
                if (do_rope) {
                    const f32x4 c0 = rc[0], c1 = rc[1], s0 = rc[2], s1 = rc[3];
                    const f32x4 a0 = lo0 * c0 - hi0 * s0, a1 = lo1 * c1 - hi1 * s1, b0 = hi0 * c0 + lo0 * s0, b1 = hi1 * c1 + lo1 * s1;
                    lo0 = a0; lo1 = a1; hi0 = b0; hi1 = b1;
                    const int nx = ai * 4 + m + 1;
                    if (nx < 8) { asm volatile("" : "+v"(lo0), "+v"(lo1), "+v"(hi0), "+v"(hi1));
                        const int t = (row0 + (nx >> 2) * HALF + (nx & 3) * 16) & 4095; const float* cp = rcos + t * 32 + 8 * fq; const float* sp = rsin + t * 32 + 8 * fq;
                        rc[0] = *(const f32x4*)cp; rc[1] = *(const f32x4*)(cp + 4); rc[2] = *(const f32x4*)sp; rc[3] = *(const f32x4*)(sp + 4); }
                }
                if (pn == 7) {
                    bf16_t* tp = dst + (size_t)(row >> 5) * 2048 + (fq >> 1) * 512 + ((fq & 1) * 32 + (row & 31)) * 8;
                    *(u32x4*)(tp) = pack8(lo0, lo1); *(u32x4*)(tp + 1024) = pack8(hi0, hi1);
                } else if (pn == 1 || pn == 4) {
                    bf16_t* tp = dst + ((size_t)(row >> 5) * 4 + wc) * 2048 + (fq >> 1) * 512 + ((fq & 1) * 32 + (row & 31)) * 8;
                    *(u32x4*)(tp) = pack8(lo0, lo1); *(u32x4*)(tp + 1024) = pack8(hi0, hi1);
                } else {
                    bf16_t* rowp = dst + (size_t)row * pitch + colb;
                    *(u32x4*)(rowp) = pack8(lo0, lo1); *(u32x4*)(rowp + 32) = pack8(hi0, hi1); }
                asm volatile("" ::: "memory");
            }
    }
};

struct EpiGate {
    static constexpr bool PERM = true, AFTER_DRAIN = false;
    bf16_t* MG; const bf16_t* G; bool first;
    __device__ __forceinline__ void operator()(const f32x4 (&acc)[2][2][4][2], const Unit& u, int wr, int wc, int fr, int fq) const {
        int row0 = u.pm * BM + wr * 64 + fr; const int col0 = u.pn * BM + wc * 32 + 8 * fq; asm volatile("" : "+v"(row0));
#pragma unroll
        for (int ai = 0; ai < 2; ++ai)
#pragma unroll
            for (int m = 0; m < 4; ++m) { const size_t off = (size_t)(row0 + ai * HALF + m * 16) * 1024 + col0;
#pragma unroll
                for (int bj = 0; bj < 2; ++bj) { const u32x4 gw = *(const u32x4*)(G + off + bj * HALF);
                    f32x4 v0 = acc[ai][bj][m][0], v1 = acc[ai][bj][m][1];
                    v0[0] *= bflo(gw.x); v0[1] *= bfhi(gw.x); v0[2] *= bflo(gw.y); v0[3] *= bfhi(gw.y); v1[0] *= bflo(gw.z); v1[1] *= bfhi(gw.z); v1[2] *= bflo(gw.w); v1[3] *= bfhi(gw.w);
                    if (!first) { const u32x4 ow = *(const u32x4*)(MG + off + bj * HALF);
                        v0[0] += bflo(ow.x); v0[1] += bfhi(ow.x); v0[2] += bflo(ow.y); v0[3] += bfhi(ow.y); v1[0] += bflo(ow.z); v1[1] += bfhi(ow.z); v1[2] += bflo(ow.w); v1[3] += bfhi(ow.w); }
                    *(u32x4*)(MG + off + bj * HALF) = pack8(v0, v1); asm volatile("" ::: "memory"); } }
    }
};

struct EpiResid {
    static constexpr bool PERM = true, AFTER_DRAIN = false;
    const float* xin; float* out; bf16_t* XB; float* ss;
    __device__ __forceinline__ void operator()(const f32x4 (&acc)[2][2][4][2], const Unit& u, int wr, int wc, int fr, int fq) const {
        int row0 = u.pm * BM + wr * 64 + fr; const int col0 = u.pn * BM + wc * 32 + 8 * fq; asm volatile("" : "+v"(row0));
#pragma unroll
        for (int ai = 0; ai < 2; ++ai)
#pragma unroll
            for (int m = 0; m < 4; ++m) { const int row = row0 + ai * HALF + m * 16; const size_t off = (size_t)row * 1024 + col0; float sq = 0.f;
#pragma unroll
                for (int bj = 0; bj < 2; ++bj) { const f32x4 r0 = *(const f32x4*)(xin + off + bj * HALF) + acc[ai][bj][m][0], r1 = *(const f32x4*)(xin + off + bj * HALF + 4) + acc[ai][bj][m][1];
                    *(f32x4*)(out + off + bj * HALF) = r0; *(f32x4*)(out + off + bj * HALF + 4) = r1;
                    if (XB) { *(u32x4*)(XB + off + bj * HALF) = pack8(r0, r1); const f32x4 q = r0 * r0 + r1 * r1; sq += (q[0] + q[1]) + (q[2] + q[3]); } }
                if (XB) { sq += shflx(sq, 16); sq += shflx(sq, 32); if (fq == 0) ss[(size_t)row * 16 + u.pn * 4 + wc] = sq; }
                asm volatile("" ::: "memory"); }
    }
};

struct EpiGateCat {
    static constexpr bool PERM = true, AFTER_DRAIN = false;
    bf16_t* MG; const bf16_t* G;
    __device__ __forceinline__ void mid(f32x4 (&acc)[2][2][4][2], const Unit& u, int kdone, int wr, int wc, int fr, int fq) const {
        if (kdone != 4 && kdone != 8) return;
        const unsigned char* Gp = (const unsigned char*)G + (size_t)(kdone == 4 ? 0 : 1) * 32768 * 1024; const unsigned char* Gn = Gp + (size_t)32768 * 1024;
        int row0 = u.pm * BM + wr * 64 + fr; const int col0 = u.pn * BM + wc * 32 + 8 * fq; asm volatile("" : "+v"(row0));
        {
            uint2 ga[2][4][2], gb[2][4][2];
#pragma unroll
            for (int ai = 0; ai < 2; ++ai)
#pragma unroll
                for (int mm = 0; mm < 4; ++mm)
#pragma unroll
                    for (int bj = 0; bj < 2; ++bj) { const size_t off = (size_t)(row0 + ai * HALF + mm * 16) * 1024 + col0 + bj * HALF; ga[ai][mm][bj] = *(const uint2*)(Gp + off); gb[ai][mm][bj] = *(const uint2*)(Gn + off); }
            asm volatile("" ::: "memory");
#pragma unroll
            for (int ai = 0; ai < 2; ++ai)
#pragma unroll
                for (int mm = 0; mm < 4; ++mm)
#pragma unroll
                    for (int bj = 0; bj < 2; ++bj) { const int m = mm; const uint2 a = ga[ai][mm][bj], b = gb[ai][mm][bj]; f32x4 r0, r1;
#pragma unroll
                        for (int e = 0; e < 4; ++e) { r0[e] = (float)((a.x >> (8 * e)) & 255u) * __builtin_amdgcn_rcpf((float)((b.x >> (8 * e)) & 255u)); r1[e] = (float)((a.y >> (8 * e)) & 255u) * __builtin_amdgcn_rcpf((float)((b.y >> (8 * e)) & 255u)); }
                        acc[ai][bj][m][0] = acc[ai][bj][m][0] * r0; acc[ai][bj][m][1] = acc[ai][bj][m][1] * r1; }
            asm volatile("" ::: "memory");
        }
    }
    __device__ __forceinline__ void operator()(const f32x4 (&acc)[2][2][4][2], const Unit& u, int wr, int wc, int fr, int fq) const {
        const unsigned char* G2 = (const unsigned char*)G + (size_t)2 * 32768 * 1024;
        int row0 = u.pm * BM + wr * 64 + fr; const int col0 = u.pn * BM + wc * 32 + 8 * fq; asm volatile("" : "+v"(row0));
#pragma unroll
        for (int ai = 0; ai < 2; ++ai) {
            uint2 gw[4][2];
#pragma unroll
            for (int m = 0; m < 4; ++m)
#pragma unroll
                for (int bj = 0; bj < 2; ++bj) gw[m][bj] = *(const uint2*)(G2 + (size_t)(row0 + ai * HALF + m * 16) * 1024 + col0 + bj * HALF);
            asm volatile("" ::: "memory");
#pragma unroll
            for (int m = 0; m < 4; ++m) { const size_t off = (size_t)(row0 + ai * HALF + m * 16) * 1024 + col0;
#pragma unroll
                for (int bj = 0; bj < 2; ++bj) { const uint2 g = gw[m][bj];
                    f32x4 v0 = acc[ai][bj][m][0], v1 = acc[ai][bj][m][1];
#pragma unroll
                    for (int e = 0; e < 4; ++e) { v0[e] *= (float)((g.x >> (8 * e)) & 255u) * (1.f / 255.f); v1[e] *= (float)((g.y >> (8 * e)) & 255u) * (1.f / 255.f); }
                    *(u32x4*)(MG + off + bj * HALF) = pack8(v0, v1); } }
            asm volatile("" ::: "memory"); }
    }
};

struct EpiResidB {
    static constexpr bool PERM = true, AFTER_DRAIN = false;
    bf16_t* XB; float* ss; float* out32;
    __device__ __forceinline__ void operator()(const f32x4 (&acc)[2][2][4][2], const Unit& u, int wr, int wc, int fr, int fq) const {
        int row0 = u.pm * BM + wr * 64 + fr; const int col0 = u.pn * BM + wc * 32 + 8 * fq; asm volatile("" : "+v"(row0));
#pragma unroll
        for (int ai = 0; ai < 2; ++ai) {
            u32x4 xw[4][2];
#pragma unroll
            for (int m = 0; m < 4; ++m)
#pragma unroll
                for (int bj = 0; bj < 2; ++bj) xw[m][bj] = *(const u32x4*)(XB + (size_t)(row0 + ai * HALF + m * 16) * 1024 + col0 + bj * HALF);
            asm volatile("" ::: "memory");
#pragma unroll
            for (int m = 0; m < 4; ++m) { const int row = row0 + ai * HALF + m * 16; const size_t off = (size_t)row * 1024 + col0; float sq = 0.f;
#pragma unroll
                for (int bj = 0; bj < 2; ++bj) { const u32x4 w = xw[m][bj];
                    f32x4 r0 = acc[ai][bj][m][0], r1 = acc[ai][bj][m][1];
                    r0[0] += bflo(w.x); r0[1] += bfhi(w.x); r0[2] += bflo(w.y); r0[3] += bfhi(w.y); r1[0] += bflo(w.z); r1[1] += bfhi(w.z); r1[2] += bflo(w.w); r1[3] += bfhi(w.w);
                    if (out32) { *(f32x4*)(out32 + off + bj * HALF) = r0; *(f32x4*)(out32 + off + bj * HALF + 4) = r1; }
                    else { *(u32x4*)(XB + off + bj * HALF) = pack8(r0, r1); const f32x4 q = r0 * r0 + r1 * r1; sq += (q[0] + q[1]) + (q[2] + q[3]); } }
                if (!out32) { sq += shflx(sq, 16); sq += shflx(sq, 32); if (fq == 0) ss[(size_t)row * 16 + u.pn * 4 + wc] = sq; } }
            asm volatile("" ::: "memory"); }
    }
};

struct EpiSwiGLU {
    static constexpr bool PERM = true, AFTER_DRAIN = false;
    bf16_t* ACT; const float* ss; PG8_LAS float* rsl;
    mutable int rs_pm = -1;
    __device__ __forceinline__ void operator()(const f32x4 (&acc)[2][2][4][2], const Unit& u, int wr, int wc, int fr, int fq) const {
        int row0 = u.pm * BM + wr * 64 + fr; const int col0 = u.pn * HALF + wc * 32 + 8 * fq; asm volatile("" : "+v"(row0));
        const PG8_LAS float* rsw = unit_row_scales(ss, rsl, u, wr, wc, fr, fq, rs_pm) + fr;
#pragma unroll
        for (int ai = 0; ai < 2; ++ai)
#pragma unroll
            for (int m = 0; m < 4; ++m) { f32x4 o[2]; const float rs = rsw[ai * 64 + m * 16];
                typedef float f32x2 __attribute__((ext_vector_type(2)));
                const f32x2 rs2 = {rs, rs}, nrs2 = {rs * -1.4426950408889634f, rs * -1.4426950408889634f}, one2 = {1.f, 1.f};
#pragma unroll
                for (int n = 0; n < 2; ++n)
#pragma unroll
                    for (int h2 = 0; h2 < 2; ++h2) { const f32x4 g4 = acc[ai][0][m][n], u4 = acc[ai][1][m][n];
                        const f32x2 ga = {g4[2 * h2], g4[2 * h2 + 1]}, ua = {u4[2 * h2], u4[2 * h2 + 1]};
                        const f32x2 t = ga * nrs2; const f32x2 ex = {__builtin_amdgcn_exp2f(t[0]), __builtin_amdgcn_exp2f(t[1])};
                        const f32x2 dn = ex + one2; const f32x2 rc2 = {__builtin_amdgcn_rcpf(dn[0]), __builtin_amdgcn_rcpf(dn[1])};
                        const f32x2 r = ((ga * rs2) * (ua * rs2)) * rc2; o[n][2 * h2] = r[0]; o[n][2 * h2 + 1] = r[1]; }
                *(u32x4*)(ACT + (size_t)(row0 + ai * HALF + m * 16) * 2816 + col0) = pack8(o[0], o[1]); asm volatile("" ::: "memory"); }
    }
};

template <class Epi, class Sched, bool ALIGN_EPI = false, bool SP2 = false, bool MIDHOOK = false>
__device__ __forceinline__ void gemm_phase(PG8_LAS unsigned char* lds, const Gemm g, const Sched& S, const Epi& E) {
    int tid_ = wg_tid(); asm volatile("" : "+v"(tid_));
    const int tid = tid_, wid = __builtin_amdgcn_readfirstlane(tid >> 6), lane = tid & 63, wr = wid >> 2, wc = wid & 3, fr = lane & 15, fq = lane >> 4;
    const int K = g.K, nt = K / BK;
    unsigned voffA[2], voffB[2];
#pragma unroll
    for (int i = 0; i < 2; ++i) { int R, C; stage_rc(tid * 16 + i * 8192, R, C); const int Rb = Epi::PERM ? ((R & ~31) + perm32(R & 31)) : R;
        voffA[i] = (unsigned)(R * K + C) * 2u; voffB[i] = (unsigned)(Rb * K + C) * 2u; }
    const size_t kstep = (size_t)(BK * 2);
    const size_t hstep = (size_t)HALF * K * 2;
    const size_t tstep = 2 * hstep;
    const unsigned ldsw = (unsigned)wid * 1024u;
    const int aoff = lds_byte(wr * 64 + fr, fq * 8), boff = lds_byte(wc * 32 + fr, fq * 8);
#define PG8_SA(b, h) (((b) * 2 + (h)) * HTB)
#define PG8_SB(b, h) ((4 + (b) * 2 + (h)) * HTB)
#define PG8_STAGE(bufoff, gbase, voff) do { _Pragma("unroll") for (int _i = 0; _i < 2; ++_i) \
        __builtin_amdgcn_global_load_lds((const unsigned*)((const char*)(gbase) + (voff)[_i]), (PG8_LAS unsigned*)(lds + (bufoff) + ldsw + _i * 8192), 16, 0, 0); } while (0)
#define PG8_LDA(dst, b, h) do { _Pragma("unroll") for (int m = 0; m < 4; ++m) _Pragma("unroll") for (int k = 0; k < 2; ++k) dst[m][k] = *(const PG8_LAS bf16x8*)(lds + PG8_SA(b, h) + aoff + m * 2048 + k * 1024); } while (0)
#define PG8_LDB(dst, b, h) do { _Pragma("unroll") for (int n = 0; n < 2; ++n) _Pragma("unroll") for (int k = 0; k < 2; ++k) dst[n][k] = *(const PG8_LAS bf16x8*)(lds + PG8_SB(b, h) + boff + n * 2048 + k * 1024); } while (0)
#define PG8_MMA(ai, bj, At, Bt) do { __builtin_amdgcn_s_setprio(1); _Pragma("unroll") for (int m = 0; m < 4; ++m) _Pragma("unroll") for (int n = 0; n < 2; ++n) _Pragma("unroll") for (int k = 0; k < 2; ++k) \
        acc[ai][bj][m][n] = __builtin_amdgcn_mfma_f32_16x16x32_bf16(Bt[n][k], At[m][k], acc[ai][bj][m][n], 0, 0, 0); __builtin_amdgcn_s_setprio(0); } while (0)
#define PG8_WAIT_V(n) asm volatile("s_waitcnt vmcnt(" #n ")" ::: "memory")
#define PG8_WAIT_L(n) asm volatile("s_waitcnt lgkmcnt(" #n ")" ::: "memory")
#define PG8_BAR __builtin_amdgcn_s_barrier()
#define PG8_SCHED __builtin_amdgcn_sched_barrier(0)
    Unit cur, nxt; int ui = 0;
    if (!S.next(0, cur)) return;
    f32x4 acc[2][2][4][2];
#pragma unroll
    for (int a = 0; a < 2; ++a)
#pragma unroll
        for (int b = 0; b < 2; ++b)
#pragma unroll
            for (int m = 0; m < 4; ++m)
#pragma unroll
                for (int n = 0; n < 2; ++n) acc[a][b][m][n] = (f32x4){0.f, 0.f, 0.f, 0.f};
    bf16x8 At[4][2], B0[2][2], B1[2][2];
    const char* cA = (const char*)g.A + (size_t)cur.pm * tstep; const char* cB = (const char*)g.Bt + (size_t)cur.pn * tstep;
    S.a_ready(cur);
    if constexpr (SP2) {
        PG8_STAGE(PG8_SB(0, 0), cB, voffB); PG8_STAGE(PG8_SB(0, 1), cB + hstep, voffB); PG8_STAGE(PG8_SA(0, 0), cA, voffA); PG8_STAGE(PG8_SA(0, 1), cA + hstep, voffA);
        if (wr == 1) PG8_BAR;
        PG8_WAIT_V(2); PG8_BAR;
        PG8_STAGE(PG8_SB(1, 0), cB + kstep, voffB); PG8_STAGE(PG8_SA(1, 0), cA + kstep, voffA); PG8_STAGE(PG8_SB(1, 1), cB + hstep + kstep, voffB);
        PG8_WAIT_V(6); PG8_BAR;
    } else {
        PG8_STAGE(PG8_SB(0, 0), cB, voffB); PG8_STAGE(PG8_SA(0, 0), cA, voffA); PG8_STAGE(PG8_SB(0, 1), cB + hstep, voffB); PG8_STAGE(PG8_SA(0, 1), cA + hstep, voffA);
        if (wr == 1) PG8_BAR;
        PG8_WAIT_V(4); PG8_BAR;
        PG8_STAGE(PG8_SB(1, 0), cB + kstep, voffB); PG8_STAGE(PG8_SA(1, 0), cA + kstep, voffA); PG8_STAGE(PG8_SB(1, 1), cB + hstep + kstep, voffB);
        PG8_WAIT_V(6); PG8_BAR;
    }
    for (;;) {
        const bool has_next = S.next(ui + 1, nxt);
        const char* nA = has_next ? (const char*)g.A + (size_t)nxt.pm * tstep : cA; const char* nB = has_next ? (const char*)g.Bt + (size_t)nxt.pn * tstep : cB;
        for (int t = 0; t < nt; t += 2) {
            const bool last = (t == nt - 2);
            const char* a1 = cA + (size_t)(t + 1) * kstep;
            const char* a2 = last ? nA : cA + (size_t)(t + 2) * kstep; const char* b2 = last ? nB : cB + (size_t)(t + 2) * kstep;
            const char* a3 = a2 + kstep; const char* b3 = b2 + kstep;
            if (last && has_next) S.a_ready(nxt);
            if constexpr (SP2) {
            PG8_LDB(B0, 0, 0); PG8_LDB(B1, 0, 1); PG8_SCHED; PG8_LDA(At, 0, 0); PG8_STAGE(PG8_SA(1, 1), a1 + hstep, voffA);
            PG8_WAIT_V(8); PG8_WAIT_L(0); PG8_BAR; PG8_MMA(0, 0, At, B0); PG8_MMA(0, 1, At, B1); PG8_BAR; PG8_SCHED;
            PG8_LDA(At, 0, 1); PG8_STAGE(PG8_SB(0, 0), b2, voffB); PG8_STAGE(PG8_SB(0, 1), b2 + hstep, voffB); PG8_STAGE(PG8_SA(0, 0), a2, voffA);
            PG8_WAIT_V(8); PG8_WAIT_L(0); PG8_BAR; PG8_MMA(1, 0, At, B0); PG8_MMA(1, 1, At, B1); PG8_BAR; PG8_SCHED;
            PG8_LDB(B0, 1, 0); PG8_LDB(B1, 1, 1); PG8_SCHED; PG8_LDA(At, 1, 0); PG8_STAGE(PG8_SA(0, 1), a2 + hstep, voffA);
            PG8_WAIT_V(8); PG8_WAIT_L(0); PG8_BAR; PG8_MMA(0, 0, At, B0); PG8_MMA(0, 1, At, B1); PG8_BAR; PG8_SCHED;
            PG8_LDA(At, 1, 1); PG8_STAGE(PG8_SB(1, 0), b3, voffB); PG8_STAGE(PG8_SB(1, 1), b3 + hstep, voffB); PG8_STAGE(PG8_SA(1, 0), a3, voffA);
            PG8_WAIT_V(8); PG8_WAIT_L(0); PG8_BAR; PG8_MMA(1, 0, At, B0); PG8_MMA(1, 1, At, B1); PG8_BAR; PG8_SCHED;
            } else {
            PG8_LDB(B0, 0, 0); PG8_SCHED; PG8_LDA(At, 0, 0); PG8_STAGE(PG8_SA(1, 1), a1 + hstep, voffA);
            PG8_WAIT_L(8); PG8_BAR; PG8_WAIT_L(0); PG8_MMA(0, 0, At, B0); PG8_BAR; PG8_SCHED;
            PG8_LDB(B1, 0, 1); PG8_STAGE(PG8_SB(0, 0), b2, voffB);
            PG8_BAR; PG8_WAIT_L(0); PG8_MMA(0, 1, At, B1); PG8_BAR;
            PG8_LDA(At, 0, 1); PG8_STAGE(PG8_SA(0, 0), a2, voffA);
            PG8_BAR; PG8_WAIT_L(0); PG8_MMA(1, 0, At, B0); PG8_BAR; PG8_SCHED;
            PG8_STAGE(PG8_SB(0, 1), b2 + hstep, voffB);
            PG8_WAIT_V(6); PG8_BAR; PG8_MMA(1, 1, At, B1); PG8_BAR;
            PG8_LDB(B0, 1, 0); PG8_SCHED; PG8_LDA(At, 1, 0); PG8_STAGE(PG8_SA(0, 1), a2 + hstep, voffA);
            PG8_WAIT_L(8); PG8_BAR; PG8_WAIT_L(0); PG8_MMA(0, 0, At, B0); PG8_BAR; PG8_SCHED;
            PG8_LDB(B1, 1, 1); PG8_STAGE(PG8_SB(1, 0), b3, voffB);
            PG8_BAR; PG8_WAIT_L(0); PG8_MMA(0, 1, At, B1); PG8_BAR;
            PG8_LDA(At, 1, 1); PG8_STAGE(PG8_SA(1, 0), a3, voffA);
            PG8_BAR; PG8_WAIT_L(0); PG8_MMA(1, 0, At, B0); PG8_BAR; PG8_SCHED;
            PG8_STAGE(PG8_SB(1, 1), b3 + hstep, voffB);
            PG8_WAIT_V(6); PG8_BAR; PG8_MMA(1, 1, At, B1); PG8_BAR;
            }
            if constexpr (MIDHOOK) E.mid(acc, cur, t + 2, wr, wc, fr, fq);
        }
        if constexpr (ALIGN_EPI) { if (wr == 0) PG8_BAR; }
        if constexpr (!Epi::AFTER_DRAIN) { E(acc, cur, wr, wc, fr, fq); S.done(cur); }
        if (!has_next) break;
#pragma unroll
        for (int a = 0; a < 2; ++a)
#pragma unroll
            for (int b = 0; b < 2; ++b)
#pragma unroll
                for (int m = 0; m < 4; ++m)
#pragma unroll
                    for (int n = 0; n < 2; ++n) acc[a][b][m][n] = (f32x4){0.f, 0.f, 0.f, 0.f};
        cur = nxt; cA = nA; cB = nB; ++ui;
        if constexpr (ALIGN_EPI) { if (wr == 1) PG8_BAR; }
    }
    PG8_WAIT_V(0);
    if constexpr (!ALIGN_EPI) { if (wr == 0) PG8_BAR; }
    PG8_BAR;
    if constexpr (Epi::AFTER_DRAIN) { E.fused(acc, cur, wr, wc, fr, fq, lds, wid, lane); S.done(cur); }
#undef PG8_SA
#undef PG8_SB
#undef PG8_STAGE
#undef PG8_LDA
#undef PG8_LDB
#undef PG8_MMA
#undef PG8_WAIT_V
#undef PG8_WAIT_L
#undef PG8_BAR
#undef PG8_SCHED
}
}

constexpr int NWAVES = 8;
#ifndef MK_PER_PHASE
#define MK_PER_PHASE 0
#endif
#ifndef PG8_SP2
#define PG8_SP2 true
#endif
#ifndef PG8_ALIGN
#define PG8_ALIGN true
#endif

constexpr int BATCH = 8, SEQ = 4096, D = 1024, DEPTH = 4, M = BATCH * SEQ;
constexpr int NIN = 6144, DIN = 5956, FF = 2816, NF1 = 2 * FF;
constexpr int NPH = 9;
constexpr float EPS = 1e-6f, LOG2E = 1.4426950408889634f;

constexpr size_t MiB = 1u << 20;
constexpr size_t WS_CTL = 0, CTL_ZERO_BYTES = 1 * MiB;
constexpr size_t WS_ROPE = 1 * MiB;
constexpr size_t WS_SS = 494 * MiB;
constexpr size_t WS_W = 4 * MiB;
constexpr size_t WO_IN = 0, WO_BA = 12 * MiB, WO_BB = WO_BA + MiB / 2, WO_BC = WO_BB + MiB / 2, WO_OUT = WO_BC + MiB, WO_F1 = WO_OUT + 2 * MiB, WO_F2 = WO_F1 + 11 * MiB;
constexpr size_t WS_H = 40 * MiB;
constexpr size_t WS_YC = WS_H;
constexpr size_t WS_QA = 104 * MiB, WS_QB = 120 * MiB, WS_KA = 136 * MiB, WS_VA = 152 * MiB, WS_KB = 168 * MiB, WS_VB = 184 * MiB, WS_IQ = 200 * MiB;
constexpr size_t WS_MG = WS_KA;
constexpr size_t WS_IK = 216 * MiB, WS_IW = 220 * MiB;
constexpr size_t WS_CX = 222 * MiB, WS_CY = 254 * MiB;
constexpr size_t WS_GT = 286 * MiB;
constexpr size_t WS_ACT = WS_GT;
constexpr size_t WS_MASK = 478 * MiB;
constexpr size_t WS_END = 510 * MiB;
constexpr int CW_TMO = 0, CW_CODE = 1, CW_BAR = 4096;

constexpr int RING_OFF = 0, RING_BYTES = 131072;
constexpr int XTRA_OFF = RING_BYTES, XTRA_BYTES = 8192;
constexpr int LDSCTL_OFF = XTRA_OFF + XTRA_BYTES, MISC_OFF = LDSCTL_OFF + 320;
constexpr int LDS_BYTES = 147456;
static_assert(MISC_OFF + 128 <= LDS_BYTES, "LDS map");

#define GAS __attribute__((address_space(1)))
#define LAS __attribute__((address_space(3)))
typedef unsigned short bf16;
typedef unsigned v4u __attribute__((ext_vector_type(4)));
typedef float f32x4 __attribute__((ext_vector_type(4)));
typedef short bf16x8 __attribute__((ext_vector_type(8)));
typedef GAS unsigned gu32;
typedef unsigned long long u64;
#define RLX_AGENT __ATOMIC_RELAXED, __HIP_MEMORY_SCOPE_AGENT
#define LDS_WAIT() asm volatile("s_waitcnt lgkmcnt(0)" ::: "memory")
#define VM_WAIT() asm volatile("s_waitcnt vmcnt(0)" ::: "memory")
__device__ __forceinline__ unsigned f2bf(float f) { unsigned u = __builtin_bit_cast(unsigned, f); return (u + 0x7fffu + ((u >> 16) & 1u)) >> 16; }
__device__ __forceinline__ unsigned pk2(float lo, float hi) { return f2bf(lo) | (f2bf(hi) << 16); }
__device__ __forceinline__ float bf2f(bf16 v) { return __builtin_bit_cast(float, (unsigned)v << 16); }
__device__ __forceinline__ float bflo(unsigned w) { return __builtin_bit_cast(float, w << 16); }
__device__ __forceinline__ float bfhi(unsigned w) { return __builtin_bit_cast(float, w & 0xffff0000u); }
__device__ __forceinline__ float wave_sum(float v) {
#pragma unroll
    for (int o = 1; o < 64; o <<= 1) v += shflx(v, o);
    return v;
}
__device__ __forceinline__ float wave_max(float v) {
#pragma unroll
    for (int o = 1; o < 64; o <<= 1) v = fmaxf(v, shflx(v, o));
    return v;
}
#define XB_TMO      128
#define XB_XCNT(j)  (256  + 64 * (j))
#define XB_XSUB(j)  (1280 + 64 * (j))
#define XB_XGEN(j)  (2304 + 64 * (j))
#define XB_TOP      3328
#define XB_TOPGEN   3392
#define XCD_BAR_WORDS 3456
#define XB_SPIN_CAP (1u << 27)

__device__ __forceinline__ unsigned xb_ld(unsigned* p)              { return __hip_atomic_load(p, __ATOMIC_RELAXED, __HIP_MEMORY_SCOPE_AGENT); }
__device__ __forceinline__ unsigned xb_add(unsigned* p, unsigned v) { return __hip_atomic_fetch_add(p, v, __ATOMIC_RELAXED, __HIP_MEMORY_SCOPE_AGENT); }
__device__ __forceinline__ unsigned xb_xcc_id() { return (unsigned)__builtin_amdgcn_s_getreg((3 << 11) | 20) & 0xFu; }
#define XB_SPIN(cond, bar) do { unsigned _sp = 0; while (cond) { __builtin_amdgcn_s_sleep(1); \
    if ((++_sp & 255u) == 0u) { if (xb_ld(&(bar)[XB_TMO])) break; if (_sp > XB_SPIN_CAP) { atomicAdd(&(bar)[XB_TMO], 1u); break; } } } } while (0)

struct XcdBarrier {
    unsigned* bar; unsigned x;
    volatile LAS unsigned* st;
};

__device__ __forceinline__ XcdBarrier xcd_barrier_post(unsigned* bar, volatile LAS unsigned* st) {
    XcdBarrier b; b.bar = bar; b.x = xb_xcc_id(); b.st = st;
    if (wg_tid() == 0) (void)xb_add(&bar[XB_XCNT(b.x)], 1u);
    return b;
}
__device__ __forceinline__ void xcd_barrier_complete(unsigned* bar, unsigned x, unsigned& nloc, unsigned& nx) {
    const unsigned G = gridDim.x * gridDim.y * gridDim.z;
    unsigned sum, cnt, mine, sp = 0u;
    for (;;) {
        sum = 0u; cnt = 0u; mine = 0u;
#pragma unroll
        for (unsigned j = 0; j < 16; ++j) { const unsigned c = xb_ld(&bar[XB_XCNT(j)]); sum += c; cnt += (c > 0u) ? 1u : 0u; mine = (j == x) ? c : mine; }
        if (sum == G) break;
        __builtin_amdgcn_s_sleep(1);
        if ((++sp & 255u) == 0u) { if (xb_ld(&bar[XB_TMO])) break; if (sp > XB_SPIN_CAP) { atomicAdd(&bar[XB_TMO], 1u); break; } }
    }
    nloc = mine > 0u ? mine : 1u; nx = cnt > 0u ? cnt : 1u;
}

__device__ __forceinline__ void xcd_barrier(const XcdBarrier& b) {
    asm volatile("s_waitcnt vmcnt(0)" ::: "memory");
    __syncthreads();
    if (wg_tid() == 0) {
        unsigned* bar = b.bar;
        __builtin_amdgcn_s_waitcnt(0);
        unsigned nloc = b.st[0], nx = b.st[1];
        if (nloc == 0u) { xcd_barrier_complete(bar, b.x, nloc, nx); b.st[0] = nloc; b.st[1] = nx; }
        const unsigned old = xb_add(&bar[XB_XSUB(b.x)], 1u);
        const unsigned gen = old / nloc;
        if (old + 1u == (gen + 1u) * nloc) {
            __builtin_amdgcn_fence(__ATOMIC_RELEASE, "agent");
            asm volatile("s_waitcnt vmcnt(0)" ::: "memory");
            const unsigned og = xb_add(&bar[XB_TOP], 1u);
            const unsigned tg = og / nx;
            if (og + 1u == (tg + 1u) * nx) xb_add(&bar[XB_TOPGEN], 1u);
            else XB_SPIN(xb_ld(&bar[XB_TOPGEN]) == tg, bar);
            __builtin_amdgcn_fence(__ATOMIC_ACQUIRE, "agent");
            xb_add(&bar[XB_XGEN(b.x)], 1u);
            asm volatile("s_waitcnt vmcnt(0)" ::: "memory");
        } else {
            XB_SPIN(xb_ld(&bar[XB_XGEN(b.x)]) == gen, bar);
            __builtin_amdgcn_fence(__ATOMIC_ACQUIRE, "agent");
            asm volatile("s_waitcnt vmcnt(0)" ::: "memory");
        }
    }
    __syncthreads();
}

struct Frame {
    LAS unsigned char* lds;
    volatile LAS unsigned* MISC;
    gu32* ctl;
    int tid, lane, wave, G;
    const float* x; float* out;
    const float *g_mix, *w_in, *qk_gain_a, *rel_bias, *qk_gain_b, *g_idx_k, *conv_w, *conv_b, *lru_wa, *lru_ba, *lru_wx, *lru_bx, *lru_lambda, *b_gate, *w_branch, *w_out, *g_ffn, *w_ffn_in, *w_ffn_out;
    float *rcos, *rsin, *SS;
    bf16 *W, *H, *YC, *YCAT, *QA, *QB, *KA, *VA, *KB, *VB, *IQ, *IK, *CX, *CY, *GT, *ACT, *MG; float* IW; u64* MASK;
    bf16 *W2a, *W2b;
};
struct WSet { bf16 *in, *ba, *out, *f1, *f2; };
__device__ __forceinline__ WSet wset(const Frame& F, int l) {
    WSet w;
    if (l & 1) { w.in = F.W + WO_IN / 2; w.ba = F.W + WO_BA / 2; w.out = F.W + WO_OUT / 2; w.f1 = F.W + WO_F1 / 2; w.f2 = F.W + WO_F2 / 2; }
    else { w.in = F.W2a; w.ba = F.W2a + (12 * MiB) / 2; w.out = F.W2a + (14 * MiB) / 2; w.f1 = F.W2b; w.f2 = F.W2b + (11 * MiB) / 2; }
    return w;
}

__device__ __forceinline__ void cvt_item(const float* W, int ldw, int k0, int n_src0, int nvalid, bf16* WT, int dpitch, int drow0, LAS float* scr, int lane, const float* gk = nullptr, bool s16 = false) {
    { const int col4 = (lane & 7) * 4; f32x4 v[8];
#pragma unroll
      for (int i = 0; i < 8; ++i) { const int kk = 8 * i + (lane >> 3); v[i] = (col4 < nvalid) ? *(const GAS f32x4*)(W + (size_t)(k0 + kk) * ldw + n_src0 + (s16 ? 16 * (col4 >> 3) + (col4 & 7) : col4)) : (f32x4){0.f, 0.f, 0.f, 0.f}; }
#pragma unroll
      for (int i = 0; i < 8; ++i) { const int kk = 8 * i + (lane >> 3); LAS float* d = scr + kk * 33 + col4; const float gg = gk ? gk[k0 + kk] : 1.f; d[0] = v[i].x * gg; d[1] = v[i].y * gg; d[2] = v[i].z * gg; d[3] = v[i].w * gg; } }
    LDS_WAIT(); asm volatile("" ::: "memory");
    const int c = lane & 7;
#pragma unroll
    for (int j = 0; j < 4; ++j) { const int n = (lane >> 3) + 8 * j; const LAS float* s = scr + (8 * c) * 33 + n;
        v4u o; o.x = pk2(s[0 * 33], s[1 * 33]); o.y = pk2(s[2 * 33], s[3 * 33]); o.z = pk2(s[4 * 33], s[5 * 33]); o.w = pk2(s[6 * 33], s[7 * 33]);
        *(GAS v4u*)(WT + (size_t)(drow0 + n) * dpitch + k0 + 8 * c) = o; }
    LDS_WAIT(); asm volatile("" ::: "memory");
}
__device__ __forceinline__ void phase_xb0(Frame& F, const float* xin, float* ss) {
    const int gw = blockIdx.x * NWAVES + F.wave, NGW = F.G * NWAVES;
    for (int m = gw; m < M; m += NGW) { const GAS f32x4* xr = (const GAS f32x4*)(xin + (size_t)m * D) + F.lane; f32x4 v[4]; float s = 0.f;
#pragma unroll
        for (int j = 0; j < 4; ++j) { v[j] = xr[64 * j]; s += (v[j].x * v[j].x + v[j].y * v[j].y) + (v[j].z * v[j].z + v[j].w * v[j].w); }
        s = wave_sum(s); if (F.lane < 16) ss[(size_t)m * 16 + F.lane] = (F.lane == 0) ? s : 0.f;
        GAS u64* o8 = (GAS u64*)(F.H + (size_t)m * D) + F.lane;
#pragma unroll
        for (int j = 0; j < 4; ++j) o8[64 * j] = (u64)pk2(v[j].x, v[j].y) | ((u64)pk2(v[j].z, v[j].w) << 32); }
}
__device__ __forceinline__ void phase_weights(Frame& F, int l, unsigned* queue = nullptr) {
    LAS float* scr = (LAS float*)(F.lds + RING_OFF + F.wave * 16384);
    const int gw = blockIdx.x * NWAVES + F.wave, NGW = F.G * NWAVES;
    const float* w_in = F.w_in + (size_t)l * D * DIN; const float* w_br = F.w_branch + (size_t)l * D * D; const float* w_out = F.w_out + (size_t)l * D * D;
    const float* w_f1 = F.w_ffn_in + (size_t)l * D * NF1; const float* w_f2 = F.w_ffn_out + (size_t)l * FF * D;
    const WSet WS = wset(F, l);
    constexpr int I_IN = 16 * 192, I_BA = 4 * 32, I_BB = 4 * 32, I_BC = 8 * 32, I_OUT = 16 * 32, I_F1 = 16 * 176, I_F2 = 44 * 32;
    constexpr int NITEMS = I_IN + I_BA + I_BB + I_BC + I_OUT + I_F1 + I_F2;
    for (int it0 = gw;; it0 += NGW) {
        int it = it0;
        if (queue) { unsigned v = 0u; if (F.lane == 0) v = __hip_atomic_fetch_add(queue, 1u, __ATOMIC_RELAXED, __HIP_MEMORY_SCOPE_AGENT); it = __builtin_amdgcn_readfirstlane((int)v); }
        if (it >= NITEMS) break;
        int r = it;
        if (r < I_IN) { const int kb = r / 192, ng = r % 192, pn = ng >> 3, grp = ng & 7, bj = grp >> 2, hh = grp & 3; int src = 0, nv = 32;
            if (pn < 7) src = pn * 256 + 64 * hh + 32 * bj;
            else if (pn == 7) { if (hh == 0) src = 1792 + 32 * bj; else if (grp == 1) { src = 1856; nv = 4; } else nv = 0; }
            else if (pn < 12) src = 1860 + (pn - 8) * 256 + grp * 32;
            else src = 2884 + (pn - 12) * 256 + 64 * hh + 8 * bj;
            cvt_item(w_in, DIN, kb * 64, src, nv, WS.in, D, ng * 32, scr, F.lane, F.g_mix + l * D, pn >= 12); continue; } r -= I_IN;
        if (r < I_BA + I_BB + I_BC) { const int kb = r / 32, ng = r % 32; cvt_item(w_br, D, kb * 64, ng * 32, 32, WS.ba, D, ng * 32, scr, F.lane); continue; } r -= I_BA + I_BB + I_BC;
        if (r < I_OUT) { const int kb = r / 32, ng = r % 32; cvt_item(w_out, D, kb * 64, ng * 32, 32, WS.out, D, ng * 32, scr, F.lane); continue; } r -= I_OUT;
        if (r < I_F1) { const int kb = r / 176, ng = r % 176, pn = ng >> 3, grp = ng & 7, bj = grp >> 2; const int src = FF * bj + 128 * pn + (grp & 3) * 32;
            cvt_item(w_f1, NF1, kb * 64, src, 32, WS.f1, D, ng * 32, scr, F.lane, F.g_ffn + l * D); continue; } r -= I_F1;
        { const int kb = r / 32, ng = r % 32; cvt_item(w_f2, D, kb * 64, ng * 32, 32, WS.f2, FF, ng * 32, scr, F.lane); }
    }
    if (l == 0) {
        for (int i = blockIdx.x * 512 + F.tid; i < SEQ * 32; i += F.G * 512) { const int pos = i >> 5, k = i & 31;
            const float inv = exp2f(-(float)k * 0.41524101186092029f); const float ang = (float)pos * inv;
            F.rcos[i] = cosf(ang); F.rsin[i] = sinf(ang); }
    }
}

__device__ __forceinline__ void naive_attn_a(Frame& F, int l) {
    LAS float* bias_s = (LAS float*)F.lds;
    LAS float* qs = (LAS float*)F.lds + 320 + F.wave * 640;
    LAS float* ps = qs + 64;
    const int lane = F.lane;
    for (int u = blockIdx.x; u < BATCH * 4 * 64; u += F.G) {
        const int c = u & 63, h = (u >> 6) & 3, b = u >> 8;
        __syncthreads();
        for (int i = F.tid; i < 257; i += 512) bias_s[i] = F.rel_bias[(l * 4 + h) * 257 + i] * LOG2E;
        __syncthreads();
        const int kc0 = (c - 8 > 0) ? c - 8 : 0; const int nk = (c - kc0 + 1) * 64;
        for (int qi = 0; qi < 8; ++qi) {
            const int t = c * 64 + F.wave * 8 + qi; const size_t row = (size_t)b * SEQ + t;
            qs[lane] = bf2f(F.QA[row * 256 + h * 64 + lane]);
            LDS_WAIT();
            float s[9]; float mx = -INFINITY;
#pragma unroll
            for (int jj = 0; jj < 9; ++jj) { const int j = jj * 64 + lane; s[jj] = -INFINITY;
                if (j < nk) { const size_t krow = (size_t)b * SEQ + kc0 * 64 + j; const v4u* kp = (const v4u*)(F.KA + krow * 256 + h * 64); float dot = 0.f;
#pragma unroll
                    for (int i8 = 0; i8 < 8; ++i8) { const v4u kw = kp[i8]; const LAS float* q = qs + i8 * 8;
                        dot += q[0] * bflo(kw.x) + q[1] * bfhi(kw.x) + q[2] * bflo(kw.y) + q[3] * bfhi(kw.y) + q[4] * bflo(kw.z) + q[5] * bfhi(kw.z) + q[6] * bflo(kw.w) + q[7] * bfhi(kw.w); }
                    int rel = t - (kc0 * 64 + j); rel = rel < -128 ? -128 : (rel > 128 ? 128 : rel);
                    s[jj] = dot + bias_s[rel + 128]; }
                mx = fmaxf(mx, s[jj]); }
            mx = wave_max(mx); float sum = 0.f;
#pragma unroll
            for (int jj = 0; jj < 9; ++jj) { const int j = jj * 64 + lane; if (j < nk) { const float p = exp2f(s[jj] - mx); sum += p; ps[j] = p; } }
            sum = wave_sum(sum);
            LDS_WAIT();
            float o = 0.f; const bf16* vp = F.VA + ((size_t)b * SEQ + kc0 * 64) * 256 + h * 64 + lane;
            for (int j = 0; j < nk; ++j) o += ps[j] * bf2f(vp[(size_t)j * 256]);
            F.QA[row * 256 + h * 64 + lane] = (bf16)f2bf(o / sum);
            LDS_WAIT();
        }
    }
}
__device__ __forceinline__ unsigned fkey(float f) { const unsigned u = __builtin_bit_cast(unsigned, f); return (u & 0x80000000u) ? ~u : (u | 0x80000000u); }
__device__ __forceinline__ void naive_idx(Frame& F) {
    LAS float* sc = (LAS float*)F.lds + F.wave * 4096;
    LAS float* qs = (LAS float*)(F.lds + XTRA_OFF) + F.wave * 256;
    const int lane = F.lane;
    for (int u = blockIdx.x; u < BATCH * 512; u += F.G) {
        const int b = u >> 9, t = (u & 511) * 8 + F.wave; const size_t row = (size_t)b * SEQ + t; const int nw = (t >> 6) + 1;
        { const unsigned* qp = (const unsigned*)(F.IQ + row * 256) + lane * 2; const unsigned w0 = qp[0], w1 = qp[1];
          qs[4 * lane] = bflo(w0); qs[4 * lane + 1] = bfhi(w0); qs[4 * lane + 2] = bflo(w1); qs[4 * lane + 3] = bfhi(w1); }
        const f32x4 wv = *(const f32x4*)(F.IW + row * 4);
        LDS_WAIT();
        for (int jj = 0; jj < nw; ++jj) { const int j = jj * 64 + lane; const v4u* kp = (const v4u*)(F.IK + ((size_t)b * SEQ + j) * 64);
            float d0 = 0.f, d1 = 0.f, d2 = 0.f, d3 = 0.f;
#pragma unroll
            for (int i8 = 0; i8 < 8; ++i8) { const v4u kw = kp[i8]; float kf[8] = {bflo(kw.x), bfhi(kw.x), bflo(kw.y), bfhi(kw.y), bflo(kw.z), bfhi(kw.z), bflo(kw.w), bfhi(kw.w)};
#pragma unroll
                for (int e = 0; e < 8; ++e) { const int d = i8 * 8 + e; d0 += qs[d] * kf[e]; d1 += qs[64 + d] * kf[e]; d2 += qs[128 + d] * kf[e]; d3 += qs[192 + d] * kf[e]; } }
            float s = 0.f; s += wv[0] * fmaxf(d0, 0.f); s += wv[1] * fmaxf(d1, 0.f); s += wv[2] * fmaxf(d2, 0.f); s += wv[3] * fmaxf(d3, 0.f); s += 0.0f;
            sc[j] = s; }
        LDS_WAIT();
        u64* mrow = F.MASK + row * 64;
        if (nw <= 4) { if (lane < nw) { unsigned o1 = ~0u, o2 = ~0u; asm volatile("" : "+v"(o1), "+v"(o2)); ((unsigned*)mrow)[2 * lane] = o1; ((unsigned*)mrow)[2 * lane + 1] = o2; } }
        else {
            unsigned prefix = 0u;
            for (int bit = 31; bit >= 0; --bit) { const unsigned cand = prefix | (1u << bit); int cnt = 0;
                for (int jj = 0; jj < nw; ++jj) cnt += __popcll(__ballot(fkey(sc[jj * 64 + lane]) >= cand));
                if (cnt >= 256) prefix = cand; }
            int n_gt = 0;
            for (int jj = 0; jj < nw; ++jj) n_gt += __popcll(__ballot(fkey(sc[jj * 64 + lane]) > prefix));
            const int allowed = 256 - n_gt; int running = 0; const u64 lt = (1ull << lane) - 1ull;
            for (int jj = 0; jj < nw; ++jj) { const unsigned key = fkey(sc[jj * 64 + lane]); const bool gt = key > prefix, eq = key == prefix; const u64 eqb = __ballot(eq);
                const int rank = running + __popcll(eqb & lt); const bool sel = gt || (eq && rank < allowed); running += __popcll(eqb);
                const u64 w = __ballot(sel); if (lane == 0) mrow[jj] = w; }
        }
        LDS_WAIT();
    }
}
__device__ __forceinline__ void naive_sparse(Frame& F) {
    LAS int* list = (LAS int*)F.lds + F.wave * 256;
    LAS float* ps = (LAS float*)F.lds + 2048 + F.wave * 256;
    LAS float* qs = (LAS float*)F.lds + 4096 + F.wave * 64;
    const int lane = F.lane; const u64 lt = (1ull << lane) - 1ull;
    for (int u = blockIdx.x; u < BATCH * 512; u += F.G) {
        const int b = u >> 9, t = (u & 511) * 8 + F.wave; const size_t row = (size_t)b * SEQ + t; const int nw = (t >> 6) + 1;
        int running = 0;
        for (int jj = 0; jj < nw; ++jj) { const u64 w = F.MASK[row * 64 + jj]; if ((w >> lane) & 1ull) list[running + __popcll(w & lt)] = jj * 64 + lane; running += __popcll(w); }
        const int nsel = running < 256 ? running : 256;
        LDS_WAIT();
        for (int h = 0; h < 4; ++h) {
            qs[lane] = bf2f(F.QB[row * 256 + h * 64 + lane]);
            LDS_WAIT();
            float s[4]; float mx = -INFINITY;
#pragma unroll
            for (int e = 0; e < 4; ++e) { const int idx = e * 64 + lane; s[e] = -INFINITY;
                if (idx < nsel) { const int j = list[idx]; const v4u* kp = (const v4u*)(F.KB + ((size_t)b * SEQ + j) * 256 + h * 64); float dot = 0.f;
#pragma unroll
                    for (int i8 = 0; i8 < 8; ++i8) { const v4u kw = kp[i8]; const LAS float* q = qs + i8 * 8;
                        dot += q[0] * bflo(kw.x) + q[1] * bfhi(kw.x) + q[2] * bflo(kw.y) + q[3] * bfhi(kw.y) + q[4] * bflo(kw.z) + q[5] * bfhi(kw.z) + q[6] * bflo(kw.w) + q[7] * bfhi(kw.w); }
                    s[e] = dot; }
                mx = fmaxf(mx, s[e]); }
            mx = wave_max(mx); float sum = 0.f;
#pragma unroll
            for (int e = 0; e < 4; ++e) { const int idx = e * 64 + lane; if (idx < nsel) { const float p = exp2f(s[e] - mx); sum += p; ps[idx] = p; } }
            sum = wave_sum(sum);
            LDS_WAIT();
            float o = 0.f;
            for (int i = 0; i < nsel; ++i) o += ps[i] * bf2f(F.VB[((size_t)b * SEQ + list[i]) * 256 + h * 64 + lane]);
            F.QB[row * 256 + h * 64 + lane] = (bf16)f2bf(o / sum);
            LDS_WAIT();
        }
    }
}
__device__ __forceinline__ float gelu_tanh(float x) { return 0.5f * x * (1.f + tanhf(0.7978845608028654f * (x + 0.044715f * x * x * x))); }
__device__ __forceinline__ void naive_lru(Frame& F, int l) {
    LAS float* wa_s = (LAS float*)F.lds; LAS float* wx_s = wa_s + 4096; LAS float* us = wx_s + 4096; LAS float* as = us + 64 * 65; LAS float* gs = as + 4096;
    const int tid = F.tid, lane = F.lane;
    for (int u = blockIdx.x; u < 64; u += F.G) {
        const int b = u >> 3, g = u & 7;
        __syncthreads();
        for (int i = tid; i < 4096; i += 512) { wa_s[i] = F.lru_wa[(size_t)(l * 8 + g) * 4096 + i]; wx_s[i] = F.lru_wx[(size_t)(l * 8 + g) * 4096 + i]; }
        float h = 0.f;
        for (int tile = 0; tile < 64; ++tile) {
            __syncthreads();
            { const int tok = tid >> 3, t = tile * 64 + tok;
#pragma unroll
              for (int e = 0; e < 8; ++e) { const int ch = (tid & 7) * 8 + e, cg = g * 64 + ch; float acc = F.conv_b[l * 512 + cg];
#pragma unroll
                  for (int j = 0; j < 4; ++j) { const int tt = t - 3 + j; if (tt >= 0) acc += F.conv_w[(l * 4 + j) * 512 + cg] * bf2f(F.CX[((size_t)b * SEQ + tt) * 512 + cg]); }
                  us[tok * 65 + ch] = acc; } }
            __syncthreads();
            { const int tok = tid & 63, og = tid >> 6;
              for (int o = 0; o < 8; ++o) { const int cc = 8 * og + o, cg = g * 64 + cc; float ra = 0.f, rx = 0.f;
                  for (int k = 0; k < 64; ++k) { const float uv = us[tok * 65 + k]; ra += uv * wa_s[k * 64 + cc]; rx += uv * wx_s[k * 64 + cc]; }
                  const float r = 1.f / (1.f + expf(-(ra + F.lru_ba[l * 512 + cg]))), ig = 1.f / (1.f + expf(-(rx + F.lru_bx[l * 512 + cg])));
                  const float sp = log1pf(expf(-F.lru_lambda[l * 512 + cg])); const float log_a = -8.0f * r * sp;
                  as[tok * 64 + cc] = expf(log_a); gs[tok * 64 + cc] = sqrtf(-expm1f(2.f * log_a)) * (ig * us[tok * 65 + cc]); } }
            __syncthreads();
            if (F.wave == 0) {
                for (int tok = 0; tok < 64; ++tok) { h = as[tok * 64 + lane] * h + gs[tok * 64 + lane]; const size_t row = (size_t)b * SEQ + tile * 64 + tok;
                    const float cy = bf2f(F.CY[row * 512 + g * 64 + lane]); F.YC[row * 512 + g * 64 + lane] = (bf16)f2bf(h * gelu_tanh(cy)); }
            }
        }
    }
}


typedef float f32x16 __attribute__((ext_vector_type(16)));
typedef short s16x4 __attribute__((ext_vector_type(4)));
typedef float f32x2v __attribute__((ext_vector_type(2)));
typedef __bf16 bf16x2v __attribute__((ext_vector_type(2)));
__device__ __forceinline__ unsigned cvtpk(float lo, float hi) { const f32x2v v = {lo, hi}; const bf16x2v b = __builtin_convertvector(v, bf16x2v); return __builtin_bit_cast(unsigned, b); }
__device__ __forceinline__ int crow(int r, int hi) { return (r & 3) + 8 * (r >> 2) + 4 * hi; }
__device__ __forceinline__ s16x4 vtr(const LAS unsigned char* p) { return __builtin_bit_cast(s16x4, __builtin_amdgcn_ds_read_tr16_b64_v4i16((LAS s16x4*)p)); }

template <int MODE> __device__ __forceinline__ void flash_wave(int b, int h, int qblk, const bf16* Q, const bf16* K, const bf16* V, bf16* Y, LAS unsigned char* vl, const LAS float* bias_s, const u64* MASK, int lane) {
    asm volatile("" : "+v"(lane));
    const int r32 = lane & 31, hi = lane >> 5; const size_t row0 = (size_t)b * SEQ + (size_t)qblk * 32; const int c = qblk >> 1;
    bf16x8 qr[4];
#pragma unroll
    for (int d0 = 0; d0 < 4; ++d0) qr[d0] = *(const bf16x8*)(Q + (row0 + r32) * 256 + h * 64 + d0 * 16 + hi * 8);
    const int kb_lo = (MODE == 0) ? ((c > 8 ? c - 8 : 0) * 2) : 0, kb_hi = (c + 1) * 2;
    f32x16 o0, o1;
#pragma unroll
    for (int r = 0; r < 16; ++r) { o0[r] = 0.f; o1[r] = 0.f; }
    float m = -1e30f, lsum = 0.f; const int tq = qblk * 32 + r32;
    const LAS unsigned char* vrd = vl + ((lane >> 4) & 1) * 32 + (lane & 3) * 8 + (4 * hi + ((lane & 15) >> 2)) * 64;
    unsigned mword = 0, mnext = 0;
    const unsigned* M32 = (const unsigned*)MASK + (size_t)(b * 64 + c) * (128 * 64) + (qblk & 1) * 32 + r32;
    const bf16* Kt = K + ((size_t)b * 128 * 4 + h) * 2048 + lane * 8;
    bf16x8 kfn[4]; v4u vvn[4];
    { const size_t krow0 = (size_t)b * SEQ + (size_t)kb_lo * 32;
#pragma unroll
      for (int d0 = 0; d0 < 4; ++d0) kfn[d0] = *(const bf16x8*)(Kt + (size_t)kb_lo * 8192 + d0 * 512);
#pragma unroll
      for (int i = 0; i < 4; ++i) { const int c16 = i * 64 + lane, key = c16 >> 3, dch = c16 & 7; vvn[i] = *(const v4u*)(V + (krow0 + key) * 256 + h * 64 + dch * 8); }
      if (MODE == 1) mnext = M32[kb_lo * 64]; }
    for (int kb = kb_lo; kb < kb_hi; ++kb) {
        bf16x8 kf[4]; v4u vv[4];
#pragma unroll
        for (int d0 = 0; d0 < 4; ++d0) kf[d0] = kfn[d0];
#pragma unroll
        for (int i = 0; i < 4; ++i) vv[i] = vvn[i];
        if (MODE == 1) mword = mnext;
        if (kb + 1 < kb_hi) { const size_t krow1 = (size_t)b * SEQ + (size_t)(kb + 1) * 32;
#pragma unroll
            for (int d0 = 0; d0 < 4; ++d0) kfn[d0] = *(const bf16x8*)(Kt + (size_t)(kb + 1) * 8192 + d0 * 512);
#pragma unroll
            for (int i = 0; i < 4; ++i) { const int c16 = i * 64 + lane, key = c16 >> 3, dch = c16 & 7; vvn[i] = *(const v4u*)(V + (krow1 + key) * 256 + h * 64 + dch * 8); }
            if (MODE == 1) mnext = M32[(kb + 1) * 64]; }
#pragma unroll
        for (int i = 0; i < 4; ++i) { const int c16 = i * 64 + lane, key = c16 >> 3, dch = c16 & 7; *(LAS v4u*)(vl + (dch >> 2) * 2048 + (key >> 4) * 1024 + (key & 15) * 64 + (dch & 3) * 16) = vv[i]; }
        f32x16 p;
#pragma unroll
        for (int r = 0; r < 16; ++r) p[r] = 0.f;
#pragma unroll
        for (int d0 = 0; d0 < 4; ++d0) p = __builtin_amdgcn_mfma_f32_32x32x16_bf16(kf[d0], qr[d0], p, 0, 0, 0);
        if (MODE == 0) {
#pragma unroll
            for (int r = 0; r < 16; ++r) { int rel = tq - (kb * 32 + crow(r, hi)); rel = rel < -128 ? -128 : (rel > 128 ? 128 : rel); p[r] += bias_s[rel + 128]; }
        } else {
            const unsigned bits = mword >> (4 * hi);
#pragma unroll
            for (int r = 0; r < 16; ++r) p[r] = ((bits >> ((r & 3) + 8 * (r >> 2))) & 1u) ? p[r] : -INFINITY;
        }
        float bm = p[0];
#pragma unroll
        for (int r = 1; r < 16; ++r) bm = fmaxf(bm, p[r]);
        bm = fmaxf(bm, shflx(bm, 32));
        const float mn = fmaxf(m, bm), alpha = exp2f(m - mn); m = mn;
        float rs = 0.f;
#pragma unroll
        for (int r = 0; r < 16; ++r) { p[r] = exp2f(p[r] - mn); rs += p[r]; }
        lsum = lsum * alpha + rs;
#pragma unroll
        for (int r = 0; r < 16; ++r) { o0[r] *= alpha; o1[r] *= alpha; }
        bf16x8 pa[2];
#pragma unroll
        for (int s = 0; s < 2; ++s) { v4u w; w.x = cvtpk(p[8 * s], p[8 * s + 1]); w.y = cvtpk(p[8 * s + 2], p[8 * s + 3]); w.z = cvtpk(p[8 * s + 4], p[8 * s + 5]); w.w = cvtpk(p[8 * s + 6], p[8 * s + 7]); pa[s] = __builtin_bit_cast(bf16x8, w); }
#pragma unroll
        for (int s = 0; s < 2; ++s) {
            const s16x4 a_lo = vtr(vrd + s * 1024), a_hi = vtr(vrd + s * 1024 + 512), b_lo = vtr(vrd + 2048 + s * 1024), b_hi = vtr(vrd + 2048 + s * 1024 + 512);
            const bf16x8 va = {a_lo[0], a_lo[1], a_lo[2], a_lo[3], a_hi[0], a_hi[1], a_hi[2], a_hi[3]}, vb = {b_lo[0], b_lo[1], b_lo[2], b_lo[3], b_hi[0], b_hi[1], b_hi[2], b_hi[3]};
            o0 = __builtin_amdgcn_mfma_f32_32x32x16_bf16(va, pa[s], o0, 0, 0, 0); o1 = __builtin_amdgcn_mfma_f32_32x32x16_bf16(vb, pa[s], o1, 0, 0, 0);
        }
    }
    lsum += shflx(lsum, 32); const float inv = 1.f / lsum;
    bf16* yrow = Y + (row0 + r32) * 1024 + h * 64 + 4 * hi;
#pragma unroll
    for (int g4 = 0; g4 < 4; ++g4) {
        uint2 w0, w1; w0.x = cvtpk(o0[4 * g4] * inv, o0[4 * g4 + 1] * inv); w0.y = cvtpk(o0[4 * g4 + 2] * inv, o0[4 * g4 + 3] * inv); w1.x = cvtpk(o1[4 * g4] * inv, o1[4 * g4 + 1] * inv); w1.y = cvtpk(o1[4 * g4 + 2] * inv, o1[4 * g4 + 3] * inv);
        *(uint2*)(yrow + 8 * g4) = w0; *(uint2*)(yrow + 32 + 8 * g4) = w1; }
}

template <int MODE, bool FIXM, bool SPLIT = false> __device__ __forceinline__ void flash_wave2(int b, int h, int c, const bf16* Q, const bf16* K, const bf16* V, bf16* Y, LAS unsigned char* vl, const LAS float* bias_s, const u64* MASK, int lane, float mfix,
        int kb0 = -1, int kb1 = -1, int part = 0, LAS float* cmb = nullptr) {
    asm volatile("" : "+v"(lane));
    const int r32 = lane & 31, hi = lane >> 5; const size_t row0 = (size_t)b * SEQ + (size_t)c * 64;
    bf16x8 qr[2][4];
#pragma unroll
    for (int z = 0; z < 2; ++z)
#pragma unroll
        for (int d0 = 0; d0 < 4; ++d0) qr[z][d0] = *(const bf16x8*)(Q + (row0 + 32 * z + r32) * 256 + h * 64 + d0 * 16 + hi * 8);
    const int kb_lo = SPLIT ? kb0 : ((MODE == 0) ? ((c > 8 ? c - 8 : 0) * 2) : 0), kb_hi = SPLIT ? kb1 : (c + 1) * 2;
    f32x16 o[2][2];
#pragma unroll
    for (int z = 0; z < 2; ++z)
#pragma unroll
        for (int r = 0; r < 16; ++r) { o[z][0][r] = 0.f; o[z][1][r] = 0.f; }
    float m[2] = {-1e30f, -1e30f}, lsum[2] = {0.f, 0.f};
    const LAS unsigned char* vrd = vl + ((lane >> 4) & 1) * 32 + (lane & 3) * 8 + (4 * hi + ((lane & 15) >> 2)) * 64;
    unsigned mword[2] = {0, 0}, mnext[2] = {0, 0};
    constexpr int KSTEP = SPLIT ? 2 : 1;
    const unsigned* M32 = (const unsigned*)MASK + (size_t)(b * 64 + c) * (128 * 64) + r32;
    const bf16* Kt = K + ((size_t)b * 128 * 4 + h) * 2048 + lane * 8;
    const char* Kc = (const char*)K + ((size_t)b * 512 + h) * 4096; const unsigned kvo = (unsigned)lane * 16u;
    const char* Vc = (const char*)V + (size_t)h * 128; const unsigned vvo = (unsigned)(lane >> 3) * 512u + (unsigned)(lane & 7) * 16u;
    if (MODE == 1) { mword[0] = M32[kb_lo * 64]; mword[1] = M32[kb_lo * 64 + 32]; }
    const int kb_last = kb_lo + ((kb_hi - 1 - kb_lo) / KSTEP) * KSTEP;
    bf16x8 kfn[4];
#pragma unroll
    for (int d0 = 0; d0 < 4; ++d0) kfn[d0] = *(const bf16x8*)(Kc + (size_t)kb_lo * 16384 + kvo + d0 * 1024);
    for (int kb = kb_lo; kb < kb_hi; kb += KSTEP) {
        bf16x8 kf[4]; v4u vv[4];
#pragma unroll
        for (int d0 = 0; d0 < 4; ++d0) kf[d0] = kfn[d0];
        const bool mfetch = (MODE == 1) && kb + KSTEP < kb_hi;
        if (mfetch) { mnext[0] = M32[(kb + KSTEP) * 64]; mnext[1] = M32[(kb + KSTEP) * 64 + 32]; }
        { const int k1 = kb + KSTEP <= kb_last ? kb + KSTEP : kb_last;
          const size_t krowc = (size_t)b * SEQ + (size_t)kb * 32;
#pragma unroll
          for (int i = 0; i < 4; ++i) vv[i] = *(const v4u*)(Vc + krowc * 512 + (size_t)i * 4096 + vvo);
#pragma unroll
          for (int d0 = 0; d0 < 4; ++d0) kfn[d0] = *(const bf16x8*)(Kc + (size_t)k1 * 16384 + kvo + d0 * 1024); }
        const bool farblk = (MODE == 0) && (c * 64 - (kb * 32 + 31) >= 128);
        const float bfar = (MODE == 0) ? bias_s[256] : 0.f;
        bf16x8 pa[2][2];
#pragma unroll
        for (int z = 0; z < 2; ++z) {
            f32x16 p;
#pragma unroll
            for (int r = 0; r < 16; ++r) p[r] = ((MODE == 0 && farblk) ? bfar : 0.f) - (FIXM ? mfix : 0.f);
#pragma unroll
            for (int d0 = 0; d0 < 4; ++d0) p = __builtin_amdgcn_mfma_f32_32x32x16_bf16(kf[d0], qr[z][d0], p, 0, 0, 0);
            if (MODE == 0 && !farblk) { const int tq = c * 64 + 32 * z + r32;
#pragma unroll
                for (int r = 0; r < 16; ++r) { int rel = tq - (kb * 32 + crow(r, hi)); rel = rel < -128 ? -128 : (rel > 128 ? 128 : rel); p[r] += bias_s[rel + 128]; }
            }
            const unsigned bits = (MODE == 1) ? (mword[z] >> (4 * hi)) : 0u;
            float rs = 0.f;
            if (FIXM) {
#pragma unroll
                for (int r = 0; r < 16; ++r) { const float e = __builtin_amdgcn_exp2f(p[r]); if (MODE == 1) { unsigned mk; asm("v_bfe_i32 %0, %1, %2, 1" : "=v"(mk) : "v"(bits), "n"((r & 3) + 8 * (r >> 2))); p[r] = __builtin_bit_cast(float, __builtin_bit_cast(unsigned, e) & mk); } else p[r] = e; rs += p[r]; }
            } else {
                if (MODE == 1) {
#pragma unroll
                    for (int r = 0; r < 16; ++r) p[r] = ((bits >> ((r & 3) + 8 * (r >> 2))) & 1u) ? p[r] : -INFINITY;
                }
                float bm = p[0];
#pragma unroll
                for (int r = 1; r < 16; ++r) bm = fmaxf(bm, p[r]);
                bm = fmaxf(bm, shflx(bm, 32));
                const float mn = fmaxf(m[z], bm);
                if (__any(mn != m[z])) {
                    const float alpha = __builtin_amdgcn_exp2f(m[z] - mn); lsum[z] *= alpha;
#pragma unroll
                    for (int r = 0; r < 16; ++r) { o[z][0][r] *= alpha; o[z][1][r] *= alpha; }
                    m[z] = mn; }
#pragma unroll
                for (int r = 0; r < 16; ++r) { p[r] = __builtin_amdgcn_exp2f(p[r] - mn); rs += p[r]; }
            }
            lsum[z] += rs;
#pragma unroll
            for (int s = 0; s < 2; ++s) { v4u w; w.x = cvtpk(p[8 * s], p[8 * s + 1]); w.y = cvtpk(p[8 * s + 2], p[8 * s + 3]); w.z = cvtpk(p[8 * s + 4], p[8 * s + 5]); w.w = cvtpk(p[8 * s + 6], p[8 * s + 7]); pa[z][s] = __builtin_bit_cast(bf16x8, w); }
        }
        asm volatile("" : "+v"(pa[0][0]), "+v"(pa[0][1]), "+v"(pa[1][0]), "+v"(pa[1][1]) :: "memory");
#pragma unroll
        for (int i = 0; i < 4; ++i) { const int c16 = i * 64 + lane, key = c16 >> 3, dch = c16 & 7; *(LAS v4u*)(vl + (dch >> 2) * 2048 + (key >> 4) * 1024 + (key & 15) * 64 + (dch & 3) * 16) = vv[i]; }
#pragma unroll
        for (int s = 0; s < 2; ++s) {
            const s16x4 a_lo = vtr(vrd + s * 1024), a_hi = vtr(vrd + s * 1024 + 512), b_lo = vtr(vrd + 2048 + s * 1024), b_hi = vtr(vrd + 2048 + s * 1024 + 512);
            const bf16x8 va = {a_lo[0], a_lo[1], a_lo[2], a_lo[3], a_hi[0], a_hi[1], a_hi[2], a_hi[3]}, vb = {b_lo[0], b_lo[1], b_lo[2], b_lo[3], b_hi[0], b_hi[1], b_hi[2], b_hi[3]};
#pragma unroll
            for (int z = 0; z < 2; ++z) { o[z][0] = __builtin_amdgcn_mfma_f32_32x32x16_bf16(va, pa[z][s], o[z][0], 0, 0, 0); o[z][1] = __builtin_amdgcn_mfma_f32_32x32x16_bf16(vb, pa[z][s], o[z][1], 0, 0, 0); }
        }
        if (mfetch) { mword[0] = mnext[0]; mword[1] = mnext[1]; }
    }
    if constexpr (SPLIT) {
        if (part == 1) {
#pragma unroll
            for (int z = 0; z < 2; ++z) {
#pragma unroll
                for (int r = 0; r < 16; ++r) { cmb[((z * 2 + 0) * 16 + r) * 64 + lane] = o[z][0][r]; cmb[((z * 2 + 1) * 16 + r) * 64 + lane] = o[z][1][r]; }
                cmb[4096 + z * 64 + lane] = lsum[z]; } }
        __syncthreads();
        if (part == 2) {
#pragma unroll
            for (int z = 0; z < 2; ++z) {
#pragma unroll
                for (int r = 0; r < 16; ++r) { o[z][0][r] += cmb[((z * 2 + 0) * 16 + r) * 64 + lane]; o[z][1][r] += cmb[((z * 2 + 1) * 16 + r) * 64 + lane]; }
                lsum[z] += cmb[4096 + z * 64 + lane]; } }
        __syncthreads();
        if (part == 1) return;
    }
#pragma unroll
    for (int z = 0; z < 2; ++z) {
        const float lt = lsum[z] + shflx(lsum[z], 32); const float inv = 1.f / lt;
        bf16* yrow = Y + (row0 + 32 * z + r32) * 1024 + h * 64 + 4 * hi;
#pragma unroll
        for (int g4 = 0; g4 < 4; ++g4) {
            uint2 w0, w1; w0.x = cvtpk(o[z][0][4 * g4] * inv, o[z][0][4 * g4 + 1] * inv); w0.y = cvtpk(o[z][0][4 * g4 + 2] * inv, o[z][0][4 * g4 + 3] * inv); w1.x = cvtpk(o[z][1][4 * g4] * inv, o[z][1][4 * g4 + 1] * inv); w1.y = cvtpk(o[z][1][4 * g4 + 2] * inv, o[z][1][4 * g4 + 3] * inv);
            *(uint2*)(yrow + 8 * g4) = w0; *(uint2*)(yrow + 32 + 8 * g4) = w1; }
    }
}
__device__ __forceinline__ void phase_attn_a(Frame& F, int l) {
    LAS float* bias_s = (LAS float*)(F.lds + 32768);
    LAS unsigned char* vl = F.lds + F.wave * 4096;
    __syncthreads();
    for (int i = F.tid; i < 4 * 257; i += 512) bias_s[(i / 257) * 260 + (i % 257)] = F.rel_bias[(size_t)l * 4 * 257 + i] * LOG2E;
    __syncthreads();
    float gq = fabsf(F.qk_gain_a[l * 128 + F.lane]), gk = fabsf(F.qk_gain_a[l * 128 + 64 + F.lane]); gq = wave_max(gq); gk = wave_max(gk);
    float bm = 0.f; for (int i = F.lane; i < 4 * 260; i += 64) { const int hh = i / 260, j = i % 260; if (j < 257) bm = fmaxf(bm, fabsf(bias_s[hh * 260 + j])); } bm = wave_max(bm);
    const float mfix = 64.f * gq * gk * pg8::QSCALE + bm; const bool fixm = mfix < 40.f;
    for (int u = blockIdx.x * 8 + F.wave; u < BATCH * 4 * 64; u += F.G * 8) { const int wgi = u >> 3; const int b = wgi & 7, h = (wgi >> 3) & 3, c = (wgi >> 5) * 8 + (u & 7);
        if (fixm) flash_wave2<0, true>(b, h, c, F.QA, F.KA, F.VA, F.YCAT, vl, bias_s + h * 260, nullptr, F.lane, mfix);
        else flash_wave2<0, false>(b, h, c, F.QA, F.KA, F.VA, F.YCAT, vl, bias_s + h * 260, nullptr, F.lane, 0.f); }
}
__device__ __forceinline__ void phase_attn_b(Frame& F, int l) {
    LAS unsigned char* vl = F.lds + F.wave * 4096;
    __syncthreads();
    float gq = fabsf(F.qk_gain_b[l * 128 + F.lane]), gk = fabsf(F.qk_gain_b[l * 128 + 64 + F.lane]); gq = wave_max(gq); gk = wave_max(gk);
    const float mfix = 64.f * gq * gk * pg8::QSCALE; const bool fixm = mfix < 40.f;
    for (int wg = blockIdx.x; wg < 256; wg += F.G) { const int b = wg & 7, jc = wg >> 3, w = F.wave; const int h = w & 3;
        if (fixm) {
            LAS float* cmb = (LAS float*)(F.lds + 32768) + h * 4224;
#pragma unroll 1
            for (int ci = 0; ci < 2; ++ci) { const int c = ci ? jc : 63 - jc, half = w >> 2;
                flash_wave2<1, true, true>(b, h, c, F.QB, F.KB, F.VB, F.YCAT + 256, vl, nullptr, F.MASK, F.lane, mfix, half, 2 * (c + 1), half ? 1 : 2, cmb); }
        } else { const int c = (w & 4) ? 63 - jc : jc;
#pragma unroll 1
            for (int z = 0; z < 2; ++z) flash_wave<1>(b, h, 2 * c + z, F.QB, F.KB, F.VB, F.YCAT + 256, vl, nullptr, F.MASK, F.lane); } }
}

__device__ __forceinline__ float dpp_quad_sum(float v) {
    int x = __builtin_bit_cast(int, v); float a = v + __builtin_bit_cast(float, __builtin_amdgcn_update_dpp(0, x, 0xB1, 0xF, 0xF, false));
    x = __builtin_bit_cast(int, a); return a + __builtin_bit_cast(float, __builtin_amdgcn_update_dpp(0, x, 0x4E, 0xF, 0xF, false));
}
__device__ __forceinline__ int wave_sum_dpp(int x) {
    x += __builtin_amdgcn_update_dpp(0, x, 0x111, 0xF, 0xF, true); x += __builtin_amdgcn_update_dpp(0, x, 0x112, 0xF, 0xF, true);
    x += __builtin_amdgcn_update_dpp(0, x, 0x114, 0xF, 0xF, true); x += __builtin_amdgcn_update_dpp(0, x, 0x118, 0xF, 0xF, true);
    x += __builtin_amdgcn_update_dpp(0, x, 0x142, 0xA, 0xF, false); x += __builtin_amdgcn_update_dpp(0, x, 0x143, 0xC, 0xF, false);
    return __builtin_amdgcn_readlane(x, 63);
}
__device__ __forceinline__ int wave_scan_dpp(int x) {
    x += __builtin_amdgcn_update_dpp(0, x, 0x111, 0xF, 0xF, true); x += __builtin_amdgcn_update_dpp(0, x, 0x112, 0xF, 0xF, true);
    x += __builtin_amdgcn_update_dpp(0, x, 0x114, 0xF, 0xF, true); x += __builtin_amdgcn_update_dpp(0, x, 0x118, 0xF, 0xF, true);
    x += __builtin_amdgcn_update_dpp(0, x, 0x142, 0xA, 0xF, false); x += __builtin_amdgcn_update_dpp(0, x, 0x143, 0xC, 0xF, false);
    return x;
}
#define TK_CNT1(acc, key, cand) asm("v_cmp_ge_u32 vcc, %1, %2\n\tv_addc_co_u32 %0, vcc, 0, %0, vcc" : "+v"(acc) : "v"(key), "v"(cand) : "vcc")
template <int N> __device__ __forceinline__ int lane_count_ge(const unsigned (&k)[N], unsigned cand) {
    int c0 = 0, c1 = 0, c2 = 0, c3 = 0;
#pragma unroll
    for (int i = 0; i < N; ++i) { if ((i & 3) == 0) TK_CNT1(c0, k[i], cand); else if ((i & 3) == 1) TK_CNT1(c1, k[i], cand); else if ((i & 3) == 2) TK_CNT1(c2, k[i], cand); else TK_CNT1(c3, k[i], cand); }
    return (c0 + c1) + (c2 + c3);
}
__device__ __forceinline__ unsigned wave_max_dpp(unsigned x) {
    x = max(x, (unsigned)__builtin_amdgcn_update_dpp(0, (int)x, 0x111, 0xF, 0xF, true)); x = max(x, (unsigned)__builtin_amdgcn_update_dpp(0, (int)x, 0x112, 0xF, 0xF, true));
    x = max(x, (unsigned)__builtin_amdgcn_update_dpp(0, (int)x, 0x114, 0xF, 0xF, true)); x = max(x, (unsigned)__builtin_amdgcn_update_dpp(0, (int)x, 0x118, 0xF, 0xF, true));
    x = max(x, (unsigned)__builtin_amdgcn_update_dpp((int)x, (int)x, 0x142, 0xA, 0xF, false)); x = max(x, (unsigned)__builtin_amdgcn_update_dpp((int)x, (int)x, 0x143, 0xC, 0xF, false));
    return (unsigned)__builtin_amdgcn_readlane((int)x, 63);
}
template <int N> __device__ __forceinline__ void bisect_keys(const unsigned (&k)[N], int target, unsigned& prefix, bool& exact, unsigned prefix0 = 0u, int bit0 = 31) {
    prefix = prefix0; exact = false;
    for (int bit = bit0; bit >= 0; --bit) { const unsigned cand = prefix | (1u << bit);
        const int cnt = wave_sum_dpp(lane_count_ge<N>(k, cand));
        if (cnt >= target) { prefix = cand; if (cnt == target) { exact = true; break; } } }
}
template <int NR> __device__ __forceinline__ void topk_core(const unsigned (&k)[NR], int nw, unsigned* mrow, int lane, LAS unsigned* cbuf) {
    unsigned prefix = 0u; bool exact = false, have = false;
    if constexpr (NR >= 32) {
        constexpr int NS = NR / 8; unsigned ks[NS];
#pragma unroll
        for (int j = 0; j < NS; ++j) ks[j] = k[4 + 8 * j];
        const int ns = (nw + 3) >> 3, rs = (352 * ns + nw - 1) / nw;
        unsigned L; bool exs; bisect_keys<NS>(ks, rs, L, exs);
        const int cl = lane_count_ge<NR>(k, L), incl = wave_scan_dpp(cl), C = __builtin_amdgcn_readlane(incl, 63);
        if (C >= 256 && C <= 512) {
            int off = incl - cl;
#pragma unroll
            for (int i = 0; i < NR; ++i) { const bool in = k[i] >= L; cbuf[in ? off : 512 + lane] = k[i]; off += in ? 1 : 0; }
            unsigned kc[8];
#pragma unroll
            for (int j = 0; j < 8; ++j) kc[j] = cbuf[j * 64 + lane];
            asm volatile("" ::: "memory");
#pragma unroll
            for (int j = 0; j < 8; ++j) kc[j] = (j * 64 + lane < C) ? kc[j] : 0u;
            unsigned kmx = kc[0];
#pragma unroll
            for (int j = 1; j < 8; ++j) kmx = max(kmx, kc[j]);
            kmx = wave_max_dpp(kmx);
            const unsigned dx = L ^ kmx; const int hb = dx ? 31 - __builtin_clz(dx) : -1;
            bisect_keys<8>(kc, 256, prefix, exact, hb >= 31 ? 0u : ((L >> (hb + 1)) << (hb + 1)), hb);
            if (exact && prefix < L) prefix = L;
            have = true;
        }
    }
    if (!have) bisect_keys<NR>(k, 256, prefix, exact);
    int wlo = 0, whi = 0;
    if (exact) {
#pragma unroll
        for (int i = 0; i < NR; ++i) { const u64 w = __ballot(k[i] >= prefix); asm("s_nop 1\n\tv_writelane_b32 %0, %2, %4\n\tv_writelane_b32 %1, %3, %4" : "+v"(wlo), "+v"(whi) : "s"((unsigned)w), "s"((unsigned)(w >> 32)), "n"(i)); }
    } else {
        int n_gt = 0;
#pragma unroll
        for (int i = 0; i < NR; ++i) n_gt += __popcll(__ballot(k[i] > prefix));
        const int allowed = 256 - n_gt; int running = 0; const u64 lt = (1ull << lane) - 1ull;
#pragma unroll
        for (int i = 0; i < NR; ++i) { const bool gt = k[i] > prefix, eq = k[i] == prefix; const u64 eqb = __ballot(eq); const int rank = running + __popcll(eqb & lt); running += __popcll(eqb);
            const u64 w = __ballot(gt || (eq && rank < allowed)); asm("s_nop 1\n\tv_writelane_b32 %0, %2, %4\n\tv_writelane_b32 %1, %3, %4" : "+v"(wlo), "+v"(whi) : "s"((unsigned)w), "s"((unsigned)(w >> 32)), "n"(i)); }
    }
    if (lane < nw) { mrow[(2 * lane) * 64] = (unsigned)wlo; mrow[(2 * lane + 1) * 64] = (unsigned)whi; }
}
constexpr int SCP = 2052;
__device__ __forceinline__ void idx_scores16(const bf16* IK, LAS unsigned* sc, int b, int t_lo, int t_hi, int wave, int lane, const bf16x8 (&qf)[2][4], const f32x4 (&wq)[2][4]) {
    asm volatile("" : "+v"(lane));
    const int r32 = lane & 31, hi = lane >> 5;
    const bf16* kbase = IK + (size_t)b * (SEQ * 64) + lane * 8;
    bf16x8 kn[2][4];
#pragma unroll
    for (int g = 0; g < 2; ++g) { const int tt = t_lo + wave + 8 * g, tc = tt < t_hi ? tt : t_hi - 1;
#pragma unroll
        for (int d0 = 0; d0 < 4; ++d0) kn[g][d0] = *(const bf16x8*)(kbase + tc * 2048 + d0 * 512); }
    for (int t = t_lo + wave; t < t_hi; t += 16) {
        bf16x8 kf[2][4];
#pragma unroll
        for (int g = 0; g < 2; ++g)
#pragma unroll
            for (int d0 = 0; d0 < 4; ++d0) kf[g][d0] = kn[g][d0];
        if (t + 16 < t_hi) {
#pragma unroll
            for (int g = 0; g < 2; ++g) { const int tt = t + 16 + 8 * g, tc = tt < t_hi ? tt : t_hi - 1;
#pragma unroll
                for (int d0 = 0; d0 < 4; ++d0) kn[g][d0] = *(const bf16x8*)(kbase + tc * 2048 + d0 * 512); } }
#pragma unroll
        for (int g = 0; g < 2; ++g) { const int tt = t + 8 * g;
            if (tt < t_hi) {
#pragma unroll
                for (int qg = 0; qg < 2; ++qg) {
                    f32x16 d;
#pragma unroll
                    for (int r = 0; r < 16; ++r) d[r] = 0.f;
#pragma unroll
                    for (int d0 = 0; d0 < 4; ++d0) d = __builtin_amdgcn_mfma_f32_32x32x16_bf16(qf[qg][d0], kf[g][d0], d, 0, 0, 0);
#pragma unroll
                    for (int k4 = 0; k4 < 4; ++k4) {
                        typedef float f32x2 __attribute__((ext_vector_type(2)));
                        const f32x2 m01 = {__builtin_amdgcn_fmed3f(d[4 * k4], 0.f, 3.0e38f), __builtin_amdgcn_fmed3f(d[4 * k4 + 1], 0.f, 3.0e38f)}, m23 = {__builtin_amdgcn_fmed3f(d[4 * k4 + 2], 0.f, 3.0e38f), __builtin_amdgcn_fmed3f(d[4 * k4 + 3], 0.f, 3.0e38f)};
                        const f32x2 w01 = {wq[qg][k4][0], wq[qg][k4][1]}, w23 = {wq[qg][k4][2], wq[qg][k4][3]};
                        const f32x2 q2 = m01 * w01 + m23 * w23; const float sv = (q2[0] + q2[1]) + 0.0f;
                        const unsigned su = __builtin_bit_cast(unsigned, sv);
                        sc[(8 * qg + 2 * k4 + hi) * SCP + (tt - t_lo) * 32 + r32] = su ^ ((unsigned)((int)su >> 31) | 0x80000000u); }
                }
            }
        }
    }
}
template <int NR> __device__ __forceinline__ void idx_select_row(const unsigned (&k)[NR], int nw, LAS unsigned* mrow, LAS unsigned* cbuf, unsigned* mg_row, int lane) {
    (void)mrow; topk_core<NR>(k, nw, mg_row, lane, cbuf);
}
__device__ __forceinline__ void phase_idx(Frame& F) {
    LAS unsigned* sc = (LAS unsigned*)F.lds;
    constexpr int MST = 136; LAS unsigned* mst = (LAS unsigned*)(F.lds + 16 * SCP * 4) + F.wave * MST;
    const int lane = F.lane, r32 = lane & 31, hi = lane >> 5, qq = r32 >> 2, hd = r32 & 3;
    __syncthreads();
    for (int u = blockIdx.x; u < BATCH * 256; u += F.G) {
        const int wgv = u & 255, i8 = u >> 8; const int b = wgv & 7, jc = wgv >> 3; const int chunk = (i8 & 4) ? 63 - jc : jc; const int q0 = chunk * 64 + (i8 & 3) * 16;
        const size_t row0 = (size_t)b * SEQ + q0; const int c = q0 >> 6, nw = c + 1, nt = 2 * nw;
        unsigned* mg = (unsigned*)F.MASK + (size_t)(b * 64 + c) * (128 * 64) + (q0 & 63);
        if (nw <= 4) { int tidl = F.tid; asm volatile("" : "+v"(tidl)); const int kbq = tidl >> 4, r16 = tidl & 15; if (kbq < nt) mg[kbq * 64 + r16] = ~0u; continue; }
        bf16x8 qf[2][4]; f32x4 wq[2][4];
#pragma unroll
        for (int qg = 0; qg < 2; ++qg) {
#pragma unroll
            for (int d0 = 0; d0 < 4; ++d0) qf[qg][d0] = *(const bf16x8*)(F.IQ + (row0 + 8 * qg + qq) * 256 + hd * 64 + d0 * 16 + hi * 8);
#pragma unroll
            for (int k4 = 0; k4 < 4; ++k4) wq[qg][k4] = *(const f32x4*)(F.IW + (row0 + 8 * qg + 2 * k4 + hi) * 4); }
        LAS unsigned* srA = sc + F.wave * SCP; LAS unsigned* srB = sc + (F.wave + 8) * SCP;
        int ll = lane; asm volatile("" : "+v"(ll));
        unsigned* mgA = mg + F.wave; unsigned* mgB = mg + F.wave + 8;
        if (nw <= 32) {
            idx_scores16(F.IK, sc, b, 0, nt, F.wave, lane, qf, wq);
            __syncthreads();
            if (nw <= 16) {
                { unsigned k[16];
#pragma unroll
                  for (int i = 0; i < 16; ++i) k[i] = srA[i * 64 + ll];
                  asm volatile("" ::: "memory");
#pragma unroll
                  for (int i = 0; i < 16; ++i) k[i] = (i < nw) ? k[i] : 0u;
                  idx_select_row<16>(k, nw, mst, srA, mgA, ll); }
                { unsigned k[16];
#pragma unroll
                  for (int i = 0; i < 16; ++i) k[i] = srB[i * 64 + ll];
                  asm volatile("" ::: "memory");
#pragma unroll
                  for (int i = 0; i < 16; ++i) k[i] = (i < nw) ? k[i] : 0u;
                  idx_select_row<16>(k, nw, mst, srB, mgB, ll); }
            } else {
                { unsigned k[32];
#pragma unroll
                  for (int i = 0; i < 32; ++i) k[i] = srA[i * 64 + ll];
                  asm volatile("" ::: "memory");
#pragma unroll
                  for (int i = 0; i < 32; ++i) k[i] = (i < nw) ? k[i] : 0u;
                  idx_select_row<32>(k, nw, mst, srA, mgA, ll); }
                { unsigned k[32];
#pragma unroll
                  for (int i = 0; i < 32; ++i) k[i] = srB[i * 64 + ll];
                  asm volatile("" ::: "memory");
#pragma unroll
                  for (int i = 0; i < 32; ++i) k[i] = (i < nw) ? k[i] : 0u;
                  idx_select_row<32>(k, nw, mst, srB, mgB, ll); }
            }
            __syncthreads();
        } else {
            idx_scores16(F.IK, sc, b, 0, 64, F.wave, lane, qf, wq);
            __syncthreads();
            unsigned ka[32], kb_[32];
#pragma unroll
            for (int i = 0; i < 32; ++i) { ka[i] = srA[i * 64 + ll]; kb_[i] = srB[i * 64 + ll]; }
            __syncthreads();
            idx_scores16(F.IK, sc, b, 64, nt, F.wave, lane, qf, wq);
            __syncthreads();
            const int nw2 = nw - 32;
            if (nw <= 48) {
                { unsigned k[48];
#pragma unroll
                  for (int i = 0; i < 32; ++i) k[i] = ka[i];
#pragma unroll
                  for (int i = 0; i < 16; ++i) k[32 + i] = srA[i * 64 + ll];
                  asm volatile("" ::: "memory");
#pragma unroll
                  for (int i = 0; i < 16; ++i) k[32 + i] = (i < nw2) ? k[32 + i] : 0u;
                  idx_select_row<48>(k, nw, mst, srA, mgA, ll); }
                { unsigned k[48];
#pragma unroll
                  for (int i = 0; i < 32; ++i) k[i] = kb_[i];
#pragma unroll
                  for (int i = 0; i < 16; ++i) k[32 + i] = srB[i * 64 + ll];
                  asm volatile("" ::: "memory");
#pragma unroll
                  for (int i = 0; i < 16; ++i) k[32 + i] = (i < nw2) ? k[32 + i] : 0u;
                  idx_select_row<48>(k, nw, mst, srB, mgB, ll); }
            } else {
                { unsigned k[64];
#pragma unroll
                  for (int i = 0; i < 32; ++i) k[i] = ka[i];
#pragma unroll
                  for (int i = 0; i < 32; ++i) k[32 + i] = srA[i * 64 + ll];
                  asm volatile("" ::: "memory");
#pragma unroll
                  for (int i = 0; i < 32; ++i) k[32 + i] = (i < nw2) ? k[32 + i] : 0u;
                  idx_select_row<64>(k, nw, mst, srA, mgA, ll); }
                { unsigned k[64];
#pragma unroll
                  for (int i = 0; i < 32; ++i) k[i] = kb_[i];
#pragma unroll
                  for (int i = 0; i < 32; ++i) k[32 + i] = srB[i * 64 + ll];
                  asm volatile("" ::: "memory");
#pragma unroll
                  for (int i = 0; i < 32; ++i) k[32 + i] = (i < nw2) ? k[32 + i] : 0u;
                  idx_select_row<64>(k, nw, mst, srB, mgB, ll); }
            }
            __syncthreads();
        }
    }
}

typedef float f32x4v __attribute__((ext_vector_type(4)));
template <int SH> __device__ __forceinline__ float dpp_shr(float v, float ident) {
    return __builtin_bit_cast(float, __builtin_amdgcn_update_dpp(__builtin_bit_cast(int, ident), __builtin_bit_cast(int, v), 0x110 + SH, 0xF, 0xF, false));
}
__device__ __forceinline__ float row_last(float v, int lane) { return shfl_from(v, (lane & 48) | 15); }
struct LruIn { bf16x8 x3[2]; uint2 u3; uint2 cyw; };
__device__ __forceinline__ void lru_load(LruIn& I, const bf16* CX, const bf16* CY, size_t brow, int t0, int g, int q4, int lane) {
    const int tk = lane & 15, lg = lane >> 4; const int t = t0 + tk;
#pragma unroll
    for (int hf = 0; hf < 2; ++hf) I.x3[hf] = *(const bf16x8*)(CX + (brow + t) * 512 + g * 64 + 32 * hf + 8 * lg);
    I.u3 = *(const uint2*)(CX + (brow + t) * 512 + g * 64 + 16 * q4 + 4 * lg);
    I.cyw = *(const uint2*)(CY + (brow + t) * 512 + g * 64 + 16 * q4 + 4 * lg);
}
template <int N> __device__ __forceinline__ unsigned tap_shift(unsigned cur, unsigned prev) {
    const int a = __builtin_amdgcn_update_dpp(0, (int)prev, 0x120 + N, 0xF, 0xF, false);
    return (unsigned)__builtin_amdgcn_update_dpp(a, (int)cur, 0x110 + N, 0xF, 0xF, false);
}
template <int N> __device__ __forceinline__ bf16x8 tap_shift8(const bf16x8& cur, const bf16x8& prev) {
    const v4u c = __builtin_bit_cast(v4u, cur), p = __builtin_bit_cast(v4u, prev); v4u r;
    r.x = tap_shift<N>(c.x, p.x); r.y = tap_shift<N>(c.y, p.y); r.z = tap_shift<N>(c.z, p.z); r.w = tap_shift<N>(c.w, p.w); return __builtin_bit_cast(bf16x8, r);
}
__device__ __forceinline__ void lru_subtile(const LruIn& I, const LruIn& P, bf16* Y0, bf16* Y1, size_t brow, int t0, int g, int q4, int lane,
        const bf16x8 (&Awa)[8], const bf16x8 (&Awx)[8], const float (&cw)[4][4], const float (&cb)[4], const float (&ca)[4], const float (&cx_)[4], const float (&sp)[4],
        float (&Arun)[4], float (&hc)[4]) {
    const int tk = lane & 15, lg = lane >> 4; const int t = t0 + tk;
    f32x4v accA = {ca[0], ca[1], ca[2], ca[3]}, accX = {cx_[0], cx_[1], cx_[2], cx_[3]};
    bf16x8 bx[8]; uint2 uw[4];
#pragma unroll
    for (int hf = 0; hf < 2; ++hf) { bx[0 + hf] = tap_shift8<3>(I.x3[hf], P.x3[hf]); bx[2 + hf] = tap_shift8<2>(I.x3[hf], P.x3[hf]); bx[4 + hf] = tap_shift8<1>(I.x3[hf], P.x3[hf]); bx[6 + hf] = I.x3[hf]; }
    uw[0].x = tap_shift<3>(I.u3.x, P.u3.x); uw[0].y = tap_shift<3>(I.u3.y, P.u3.y); uw[1].x = tap_shift<2>(I.u3.x, P.u3.x); uw[1].y = tap_shift<2>(I.u3.y, P.u3.y);
    uw[2].x = tap_shift<1>(I.u3.x, P.u3.x); uw[2].y = tap_shift<1>(I.u3.y, P.u3.y); uw[3] = I.u3;
#pragma unroll
    for (int ks = 0; ks < 8; ++ks) { accA = __builtin_amdgcn_mfma_f32_16x16x32_bf16(Awa[ks], bx[ks], accA, 0, 0, 0); accX = __builtin_amdgcn_mfma_f32_16x16x32_bf16(Awx[ks], bx[ks], accX, 0, 0, 0); }
    float u[4] = {cb[0], cb[1], cb[2], cb[3]};
#pragma unroll
    for (int q = 0; q < 4; ++q) { const uint2 w = uw[q];
        u[0] += cw[q][0] * bflo(w.x); u[1] += cw[q][1] * bfhi(w.x); u[2] += cw[q][2] * bflo(w.y); u[3] += cw[q][3] * bfhi(w.y); }
    const uint2 cyw = I.cyw;
    const float cy[4] = {bflo(cyw.x), bfhi(cyw.x), bflo(cyw.y), bfhi(cyw.y)};
    float A[4], B[4];
#pragma unroll
    for (int r = 0; r < 4; ++r) { const float rg = __builtin_amdgcn_rcpf(1.f + __builtin_amdgcn_exp2f(accA[r])), ig = __builtin_amdgcn_rcpf(1.f + __builtin_amdgcn_exp2f(accX[r]));
        const float tl = rg * sp[r]; const float y2 = tl * 1.3862943611198906f; A[r] = __builtin_amdgcn_exp2f(tl);
        const float om = (y2 > -0.3f) ? -y2 * (1.f + y2 * (0.5f + y2 * (0.16666667f + y2 * 0.041666668f))) : 1.f - A[r] * A[r];
        B[r] = __builtin_amdgcn_sqrtf(om) * (ig * u[r]); }
#define LRU_SCAN_STEP(PRE, N) asm(PRE "v_fmac_f32_dpp %4, %4, %0 row_shr:" #N " row_mask:0xf bank_mask:0xf\n\tv_fmac_f32_dpp %5, %5, %1 row_shr:" #N " row_mask:0xf bank_mask:0xf\n\t" \
        "v_fmac_f32_dpp %6, %6, %2 row_shr:" #N " row_mask:0xf bank_mask:0xf\n\tv_fmac_f32_dpp %7, %7, %3 row_shr:" #N " row_mask:0xf bank_mask:0xf\n\t" \
        "v_mul_f32_dpp %0, %0, %0 row_shr:" #N " row_mask:0xf bank_mask:0xf\n\tv_mul_f32_dpp %1, %1, %1 row_shr:" #N " row_mask:0xf bank_mask:0xf\n\t" \
        "v_mul_f32_dpp %2, %2, %2 row_shr:" #N " row_mask:0xf bank_mask:0xf\n\tv_mul_f32_dpp %3, %3, %3 row_shr:" #N " row_mask:0xf bank_mask:0xf" \
        : "+v"(A[0]), "+v"(A[1]), "+v"(A[2]), "+v"(A[3]), "+v"(B[0]), "+v"(B[1]), "+v"(B[2]), "+v"(B[3]))
    LRU_SCAN_STEP("s_nop 1\n\t", 1); LRU_SCAN_STEP("", 2); LRU_SCAN_STEP("", 4); LRU_SCAN_STEP("", 8);
#undef LRU_SCAN_STEP
    float y0[4], y1[4];
#pragma unroll
    for (int r = 0; r < 4; ++r) { const float h = B[r] + A[r] * hc[r], ap = A[r] * Arun[r]; const float gl = cy[r] * __builtin_amdgcn_rcpf(1.f + __builtin_amdgcn_exp2f(cy[r] * (-2.3022082f + -0.10294324f * (cy[r] * cy[r]))));     y0[r] = h * gl; y1[r] = ap * gl; hc[r] = row_last(h, lane); Arun[r] = row_last(ap, lane); }
    const size_t off = (brow + t) * 512 + g * 64 + 16 * q4 + 4 * lg, off0 = (brow + t) * 1024 + g * 64 + 16 * q4 + 4 * lg;
    uint2 o; o.x = cvtpk(y0[0], y0[1]); o.y = cvtpk(y0[2], y0[3]); *(uint2*)(Y0 + off0) = o;
    o.x = cvtpk(y1[0], y1[1]); o.y = cvtpk(y1[2], y1[3]); *(uint2*)(Y1 + off) = o;
}
constexpr float NL2E = -1.4426950408889634f;
__device__ __forceinline__ void phase_lru(Frame& F, int l) {
    LAS float* agg = (LAS float*)(F.lds + 36864);
    const int lane = F.lane, tk = lane & 15, lg = lane >> 4;
    bf16* Y1 = F.YC; bf16* Y0 = F.YCAT + 512;
    for (int u = blockIdx.x; u < 256; u += F.G) {
        const int b = u & 7, g = u >> 5, q4 = (u >> 3) & 3; const size_t brow = (size_t)b * SEQ;
        const float* wa = F.lru_wa + (size_t)(l * 8 + g) * 4096; const float* wx = F.lru_wx + (size_t)(l * 8 + g) * 4096; const float* cwp = F.conv_w + (size_t)l * 4 * 512 + g * 64; const float* cbp = F.conv_b + l * 512 + g * 64;
        bf16x8 Awa[8], Awx[8];
#pragma unroll
        for (int ks = 0; ks < 8; ++ks) { const int q = ks >> 1; v4u pa, px; unsigned wsa[4], wsx[4];
#pragma unroll
            for (int j2 = 0; j2 < 4; ++j2) { const int i0 = 32 * (ks & 1) + 8 * lg + 2 * j2, oc = 16 * q4 + tk;
                const float c0 = cwp[q * 512 + i0], c1 = cwp[q * 512 + i0 + 1];
                wsa[j2] = cvtpk(NL2E * c0 * wa[i0 * 64 + oc], NL2E * c1 * wa[(i0 + 1) * 64 + oc]); wsx[j2] = cvtpk(NL2E * c0 * wx[i0 * 64 + oc], NL2E * c1 * wx[(i0 + 1) * 64 + oc]); }
            pa.x = wsa[0]; pa.y = wsa[1]; pa.z = wsa[2]; pa.w = wsa[3]; px.x = wsx[0]; px.y = wsx[1]; px.z = wsx[2]; px.w = wsx[3];
            Awa[ks] = __builtin_bit_cast(bf16x8, pa); Awx[ks] = __builtin_bit_cast(bf16x8, px); }
        float cw[4][4], cb[4], ca[4], cx_[4], sp[4];
#pragma unroll
        for (int r = 0; r < 4; ++r) { const int oc = 16 * q4 + 4 * lg + r, cg = g * 64 + oc;
#pragma unroll
            for (int q = 0; q < 4; ++q) cw[q][r] = cwp[q * 512 + oc];
            cb[r] = cbp[oc]; float sa = 0.f, sx = 0.f;
#pragma unroll
            for (int i4 = 0; i4 < 4; ++i4) { const int i = tk + 16 * i4; const float bi = cbp[i]; sa += bi * wa[i * 64 + oc]; sx += bi * wx[i * 64 + oc]; }
#pragma unroll
            for (int o = 1; o < 16; o <<= 1) { sa += shflx(sa, o); sx += shflx(sx, o); }
            ca[r] = NL2E * (sa + F.lru_ba[l * 512 + cg]); cx_[r] = NL2E * (sx + F.lru_bx[l * 512 + cg]); sp[r] = (8.f * NL2E) * log1pf(expf(-F.lru_lambda[l * 512 + cg])); }
        float Arun[4] = {1.f, 1.f, 1.f, 1.f}, hc[4] = {0.f, 0.f, 0.f, 0.f};
        const int tseg = F.wave * 512;
        LruIn cur, prv; lru_load(cur, F.CX, F.CY, brow, tseg, g, q4, lane);
        lru_load(prv, F.CX, F.CY, brow, tseg >= 16 ? tseg - 16 : 0, g, q4, lane);
        if (tseg == 0) { prv.x3[0] = (bf16x8){0, 0, 0, 0, 0, 0, 0, 0}; prv.x3[1] = (bf16x8){0, 0, 0, 0, 0, 0, 0, 0}; prv.u3 = (uint2){0u, 0u}; }
#pragma unroll 2
        for (int s = 0; s < 32; ++s) { LruIn nxt;
            lru_load(nxt, F.CX, F.CY, brow, tseg + 16 * (s + 1 < 32 ? s + 1 : s), g, q4, lane);
            asm volatile("" ::: "memory");
            lru_subtile(cur, prv, Y0, Y1, brow, tseg + 16 * s, g, q4, lane, Awa, Awx, cw, cb, ca, cx_, sp, Arun, hc);
            prv = cur; cur = nxt; }
        __syncthreads();
        if (tk == 0) {
#pragma unroll
            for (int r = 0; r < 4; ++r) { agg[F.wave * 32 + 4 * lg + r] = Arun[r]; agg[F.wave * 32 + 16 + 4 * lg + r] = hc[r]; } }
        __syncthreads();
        float hin[4] = {0.f, 0.f, 0.f, 0.f};
        for (int w = 0; w < F.wave; ++w) {
#pragma unroll
            for (int r = 0; r < 4; ++r) hin[r] = agg[w * 32 + 4 * lg + r] * hin[r] + agg[w * 32 + 16 + 4 * lg + r]; }
        if (F.wave > 0) {
            asm volatile("s_waitcnt vmcnt(0)" ::: "memory");
#pragma unroll 1
            for (int s8 = 0; s8 < 32; s8 += 8) { uint2 a0[8], a1[8];
#pragma unroll
                for (int j = 0; j < 8; ++j) { const size_t row = brow + tseg + 16 * (s8 + j) + tk; a0[j] = *(const uint2*)(Y0 + row * 1024 + g * 64 + 16 * q4 + 4 * lg); a1[j] = *(const uint2*)(Y1 + row * 512 + g * 64 + 16 * q4 + 4 * lg); }
#pragma unroll
                for (int j = 0; j < 8; ++j) { const size_t row = brow + tseg + 16 * (s8 + j) + tk; uint2 o;
                    o.x = cvtpk(bflo(a0[j].x) + bflo(a1[j].x) * hin[0], bfhi(a0[j].x) + bfhi(a1[j].x) * hin[1]); o.y = cvtpk(bflo(a0[j].y) + bflo(a1[j].y) * hin[2], bfhi(a0[j].y) + bfhi(a1[j].y) * hin[3]);
                    *(uint2*)(Y0 + row * 1024 + g * 64 + 16 * q4 + 4 * lg) = o; } }
        }
    }
}

struct Args { const float* in[20]; float* out; unsigned char* ws; int l_lo, l_hi, ph_lo, ph_hi; };
__device__ __forceinline__ void make_frame(Frame& F, const Args& args, unsigned char* lds_) {
    int tid = wg_tid(); asm volatile("" : "+v"(tid));
    const __attribute__((address_space(4))) unsigned char* ka = (const __attribute__((address_space(4))) unsigned char*)__builtin_amdgcn_kernarg_segment_ptr(); asm volatile("" : "+s"(ka));
#define KARG(k) ((const float*)(GAS const float*)(*(const unsigned long long __attribute__((address_space(4)))*)(ka + 8 * (k))))
    GAS unsigned char* wsg = (GAS unsigned char*)(*(const unsigned long long __attribute__((address_space(4)))*)(ka + 168)); unsigned char* ws = (unsigned char*)wsg;
    F.lds = (LAS unsigned char*)lds_; F.MISC = (volatile LAS unsigned*)(F.lds + MISC_OFF);
    F.tid = tid; F.lane = tid & 63; F.wave = __builtin_amdgcn_readfirstlane(tid >> 6); F.G = gridDim.x;
    F.ctl = (gu32*)(ws + WS_CTL);
    F.x = KARG(0); F.g_mix = KARG(1); F.w_in = KARG(2); F.qk_gain_a = KARG(3); F.rel_bias = KARG(4); F.qk_gain_b = KARG(5); F.g_idx_k = KARG(6);
    F.conv_w = KARG(7); F.conv_b = KARG(8); F.lru_wa = KARG(9); F.lru_ba = KARG(10); F.lru_wx = KARG(11); F.lru_bx = KARG(12); F.lru_lambda = KARG(13);
    F.b_gate = KARG(14); F.w_branch = KARG(15); F.w_out = KARG(16); F.g_ffn = KARG(17); F.w_ffn_in = KARG(18); F.w_ffn_out = KARG(19); F.out = (float*)KARG(20);
#undef KARG
    F.rcos = (float*)(ws + WS_ROPE); F.rsin = F.rcos + SEQ * 32; F.SS = (float*)(ws + WS_SS);
    F.W = (bf16*)(ws + WS_W); F.W2a = (bf16*)(ws + 462 * MiB); F.W2b = (bf16*)((unsigned char*)F.out + 32 * MiB); F.H = (bf16*)(ws + WS_H); F.YC = (bf16*)F.out; F.YCAT = (bf16*)F.out + (size_t)32 * 1024 * 1024;
    F.QA = (bf16*)(ws + WS_QA); F.QB = (bf16*)(ws + WS_QB); F.KA = (bf16*)(ws + WS_KA); F.VA = (bf16*)(ws + WS_VA); F.KB = (bf16*)(ws + WS_KB); F.VB = (bf16*)(ws + WS_VB);
    F.IQ = (bf16*)(ws + WS_IQ); F.IK = (bf16*)(ws + WS_IK); F.IW = (float*)(ws + WS_IW); F.CX = (bf16*)(ws + WS_CX); F.CY = (bf16*)(ws + WS_CY);
    F.GT = (bf16*)(ws + WS_GT); F.ACT = (bf16*)(ws + WS_ACT); F.MG = (bf16*)(ws + WS_MG); F.MASK = (u64*)(ws + WS_MASK);
}
template <int PHM> __global__ void __launch_bounds__(NWAVES * 64, 2) fwd(Args args) {
    { LAS unsigned char* l3 = (LAS unsigned char*)lds; for (int u = threadIdx.x; u < (LDS_BYTES - LDSCTL_OFF) / 4; u += NWAVES * 64) ((LAS unsigned*)(l3 + LDSCTL_OFF))[u] = 0u; }
    __syncthreads();
    static_assert(WGT_LDS_OFF == MISC_OFF + 256 && WGT_LDS_OFF + 256 <= LDS_BYTES, "wave-index table inside the LDS control area");
    if ((threadIdx.x & 63) == 0) ((LAS unsigned*)((LAS unsigned char*)lds + WGT_LDS_OFF))[wgt_slot()] = threadIdx.x >> 6;
    __syncthreads();
    XcdBarrier bar; bar.bar = (unsigned*)(args.ws + WS_CTL) + CW_BAR; bar.x = 0; bar.st = nullptr;
    if (!MK_PER_PHASE) bar = xcd_barrier_post((unsigned*)(args.ws + WS_CTL) + CW_BAR, (volatile LAS unsigned*)((LAS unsigned char*)lds + MISC_OFF) + 8);
#define GRID_BAR() do { if (!MK_PER_PHASE) xcd_barrier(bar); } while (0)
    const int plo = args.ph_lo, phi = args.ph_hi; (void)plo; (void)phi;
#ifndef PHMASK
#define PHMASK 0x1ff
#endif
#if MK_PER_PHASE
#define IN(k) (((PHMASK >> (k)) & 1) && ((PHM >> (k)) & 1) && plo <= (k) && (k) < phi)
#else
#define IN(k) (((PHMASK >> (k)) & 1) && ((PHM >> (k)) & 1))
#endif
    bool first = true;
    for (int l = MK_PER_PHASE ? args.l_lo : 0; l < (MK_PER_PHASE ? args.l_hi : DEPTH); ++l) {
        if (IN(0) && (MK_PER_PHASE || l == 0)) { if (!first) GRID_BAR(); first = false; Frame F; make_frame(F, args, lds); phase_weights(F, l); if (l == 0) phase_xb0(F, F.x, F.SS); }
        if (IN(1)) { if (!first) GRID_BAR(); first = false; Frame F; make_frame(F, args, lds);
            pg8::Gemm g{F.H, wset(F, l).in, M, NIN, D}; pg8::StaticOrder S; S.init(M, NIN, F.G, (int)blockIdx.x);
            pg8::EpiIn E{F.QA, F.KA, F.VA, F.QB, F.KB, F.VB, F.IQ, F.IK, F.IW, F.CX, F.CY, F.GT, F.qk_gain_a + l * 128, F.qk_gain_b + l * 128, F.g_idx_k + l * 64, F.b_gate + l * 3072, F.rcos, F.rsin, F.SS + (size_t)(2 * l) * M * 16, (LAS float*)(F.lds + XTRA_OFF)};
            pg8::gemm_phase<pg8::EpiIn, pg8::StaticOrder, PG8_ALIGN, PG8_SP2>(F.lds + RING_OFF, g, S, E); }
        if (IN(2)) { if (!first) GRID_BAR(); first = false; { Frame F0; make_frame(F0, args, lds); phase_lru(F0, l); } __syncthreads(); Frame F; make_frame(F, args, lds); phase_attn_a(F, l); __syncthreads(); phase_idx(F);
            if (F.G == 256) { asm volatile("s_waitcnt vmcnt(0)" ::: "memory"); __syncthreads(); } else GRID_BAR();
            { Frame F2; make_frame(F2, args, lds); phase_attn_b(F2, l); }
            if (!MK_PER_PHASE && l + 1 < DEPTH) { __syncthreads();
                Frame F3; make_frame(F3, args, lds); phase_weights(F3, l + 1, (unsigned*)(args.ws + WS_CTL) + 64 + l); } }
        if (IN(4)) { if (!first) GRID_BAR(); first = false; Frame F; make_frame(F, args, lds);
#ifndef DBG_HALF
#define DBG_HALF 0
#endif
#ifndef DBG_SKIP_BR
#define DBG_SKIP_BR 0
#endif
            pg8::Gemm g{F.YCAT, wset(F, l).ba, M, D, D}; pg8::StaticOrder S; S.init(M, D, F.G, (int)blockIdx.x); pg8::EpiGateCat E{F.MG, F.GT};
            pg8::gemm_phase<pg8::EpiGateCat, pg8::StaticOrder, PG8_ALIGN, PG8_SP2, true>(F.lds + RING_OFF, g, S, E); }
        if (IN(5)) { if (!first) GRID_BAR(); first = false; Frame F; make_frame(F, args, lds);
            pg8::Gemm g{F.MG, wset(F, l).out, M, D, D}; pg8::StaticOrder S; S.init(M, D, F.G, (int)blockIdx.x); pg8::EpiResidB E{F.H, F.SS + (size_t)(2 * l + 1) * M * 16, nullptr};
            pg8::gemm_phase<pg8::EpiResidB, pg8::StaticOrder, PG8_ALIGN, PG8_SP2>(F.lds + RING_OFF, g, S, E); }
        if (IN(7)) { if (!first) GRID_BAR(); first = false; Frame F; make_frame(F, args, lds);
            pg8::Gemm g{F.H, wset(F, l).f1, M, NF1, D}; pg8::StaticOrder S; S.init(M, NF1, F.G, (int)blockIdx.x); pg8::EpiSwiGLU E{F.ACT, F.SS + (size_t)(2 * l + 1) * M * 16, (LAS float*)(F.lds + XTRA_OFF)};
            pg8::gemm_phase<pg8::EpiSwiGLU, pg8::StaticOrder, PG8_ALIGN, PG8_SP2>(F.lds + RING_OFF, g, S, E); }
        if (IN(8)) { if (!first) GRID_BAR(); first = false; Frame F; make_frame(F, args, lds);
            pg8::Gemm g{F.ACT, wset(F, l).f2, M, D, FF}; pg8::StaticOrder S; S.init(M, D, F.G, (int)blockIdx.x); pg8::EpiResidB E{F.H, F.SS + (size_t)(2 * l + 2 < 2 * DEPTH ? 2 * l + 2 : 0) * M * 16, (l + 1 < DEPTH) ? (float*)nullptr : F.out};
            pg8::gemm_phase<pg8::EpiResidB, pg8::StaticOrder, PG8_ALIGN, PG8_SP2>(F.lds + RING_OFF, g, S, E); }
    }
#undef IN
}

extern "C" void kernel_launch(void* const* d_in, const int* in_sizes, int n_in, void* d_out, int out_size, void* d_ws, size_t ws_size, hipStream_t stream) {
    static int grid = 0;
    if (grid == 0) {
        if (n_in != 20 || in_sizes[0] != M * D || out_size != M * D || ws_size < WS_END) { fprintf(stderr, "kernel_launch: unexpected problem shape / workspace (n_in %d, ws %zu); nothing launched\n", n_in, ws_size); grid = -1; return; }
        int dev = 0, cus = 0, per_cu = 0;
        if (hipGetDevice(&dev) != hipSuccess || hipDeviceGetAttribute(&cus, hipDeviceAttributeMultiprocessorCount, dev) != hipSuccess) { grid = -1; return; }
#if MK_PER_PHASE
        const void* fns[NPH] = {(const void*)fwd<1>, (const void*)fwd<2>, (const void*)fwd<4>, (const void*)fwd<8>, (const void*)fwd<16>, (const void*)fwd<32>, (const void*)fwd<64>, (const void*)fwd<128>, (const void*)fwd<256>};
        for (int i = 0; i < NPH; ++i) if (hipFuncSetAttribute(fns[i], hipFuncAttributeMaxDynamicSharedMemorySize, LDS_BYTES) != hipSuccess) { fprintf(stderr, "kernel_launch: hipFuncSetAttribute failed\n"); grid = -1; return; }
#else
        if (hipFuncSetAttribute((const void*)fwd<0x1ff>, hipFuncAttributeMaxDynamicSharedMemorySize, LDS_BYTES) != hipSuccess) { fprintf(stderr, "kernel_launch: hipFuncSetAttribute failed\n"); grid = -1; return; }
        if (hipOccupancyMaxActiveBlocksPerMultiprocessor(&per_cu, (const void*)fwd<0x1ff>, NWAVES * 64, LDS_BYTES) != hipSuccess || per_cu < 1) fprintf(stderr, "kernel_launch: occupancy query reports %d workgroups per CU\n", per_cu);
#endif
        (void)hipGetLastError(); (void)per_cu;
        grid = cus;
    }
    if (grid < 0) return;
    if (hipMemsetAsync((char*)d_ws + WS_CTL, 0, CTL_ZERO_BYTES, stream) != hipSuccess) return;
    Args a{};
    for (int i = 0; i < 20; ++i) a.in[i] = (const float*)d_in[i];
    a.out = (float*)d_out; a.ws = (unsigned char*)d_ws;
#if MK_PER_PHASE
    for (int l = 0; l < DEPTH; ++l) for (int p = 0; p < NPH; ++p) { a.l_lo = l; a.l_hi = l + 1; a.ph_lo = p; a.ph_hi = p + 1;
        switch (p) {
            case 0: hipLaunchKernelGGL(fwd<1>, dim3(grid), dim3(NWAVES * 64), LDS_BYTES, stream, a); break;
            case 1: hipLaunchKernelGGL(fwd<2>, dim3(grid), dim3(NWAVES * 64), LDS_BYTES, stream, a); break;
            case 2: hipLaunchKernelGGL(fwd<4>, dim3(grid), dim3(NWAVES * 64), LDS_BYTES, stream, a); break;
            case 3: hipLaunchKernelGGL(fwd<8>, dim3(grid), dim3(NWAVES * 64), LDS_BYTES, stream, a); break;
            case 4: hipLaunchKernelGGL(fwd<16>, dim3(grid), dim3(NWAVES * 64), LDS_BYTES, stream, a); break;
            case 5: hipLaunchKernelGGL(fwd<32>, dim3(grid), dim3(NWAVES * 64), LDS_BYTES, stream, a); break;
            case 6: hipLaunchKernelGGL(fwd<64>, dim3(grid), dim3(NWAVES * 64), LDS_BYTES, stream, a); break;
            case 7: hipLaunchKernelGGL(fwd<128>, dim3(grid), dim3(NWAVES * 64), LDS_BYTES, stream, a); break;
            default: hipLaunchKernelGGL(fwd<256>, dim3(grid), dim3(NWAVES * 64), LDS_BYTES, stream, a); break;
        } }
#else
    a.l_lo = 0; a.l_hi = DEPTH; a.ph_lo = 0; a.ph_hi = NPH;
    hipLaunchKernelGGL(fwd<0x1ff>, dim3(grid), dim3(NWAVES * 64), LDS_BYTES, stream, a);
#endif
}
```
